# Optimizing an MI355X kernel written in HIP

```python
import math
import jax
import jax.numpy as jnp
from jax import lax
import numpy as np

D_MODEL = 1024
BATCH = 8
SEQ = 2048
DEPTH = 2

SB_HEADS = 8
SB_HEAD_DIM = 64
SB_WIDTH = SB_HEADS * SB_HEAD_DIM
SB_BLOCK = 128
HG_HEADS = 4
HG_HEAD_DIM = 128
HG_WIDTH = HG_HEADS * HG_HEAD_DIM
HG_CHUNK = 64
CONV_WIDTH = 512
CONV_K = 3
N_BRANCH = 3
IN_COLS = 4 * SB_WIDTH + 4 * HG_WIDTH + 4 * CONV_WIDTH + N_BRANCH * D_MODEL
LN_EPS = 1e-5
RMS_EPS = 1e-6

kernel_name = "hybrid_sb_hgrn2_shortconv_deepnorm"


def _standardize(x):
    xf = x.astype(jnp.float32)
    mu = jnp.mean(xf, axis=-1, keepdims=True)
    xc = xf - mu
    var = jnp.mean(xc * xc, axis=-1, keepdims=True)
    return xc * lax.rsqrt(var + LN_EPS)


def _stick_breaking(q, k, v):
    B, S, H, dh = q.shape
    scale = dh ** -0.5
    qf = q.astype(jnp.float32)
    kf = k.astype(jnp.float32)
    vf = v.astype(jnp.float32)
    outs = []
    for blk in range(S // SB_BLOCK):
        t0 = blk * SB_BLOCK
        t1 = t0 + SB_BLOCK
        z = jnp.einsum('bthd,bshd->bhts', qf[:, t0:t1], kf[:, :t1]) * scale
        mask = jnp.arange(t1)[None, :] < (t0 + jnp.arange(SB_BLOCK))[:, None]
        log_1m_beta = jnp.where(mask, -jax.nn.softplus(z), 0.0)
        log_surv = lax.cumsum(log_1m_beta, axis=3, reverse=True) - log_1m_beta
        a = jnp.where(mask, jnp.exp(jax.nn.log_sigmoid(z) + log_surv), 0.0)
        outs.append(jnp.einsum('bhts,bshd->bthd', a, vf[:, :t1]))
    return jnp.concatenate(outs, axis=1)


def _hgrn2(q, f_pre, i_in, lb):
    B, S, H, dk = q.shape
    dv = i_in.shape[-1]
    n_chunks = S // HG_CHUNK
    f = lb + (1.0 - lb) * jax.nn.sigmoid(f_pre.astype(jnp.float32))
    k = 1.0 - f
    g = jnp.log(f)

    def to_chunks(a):
        return a.reshape(B, n_chunks, HG_CHUNK, H, a.shape[-1]).transpose(1, 0, 3, 2, 4)

    qc = to_chunks(q.astype(jnp.float32))
    kc = to_chunks(k)
    vc = to_chunks(i_in.astype(jnp.float32))
    bc = jnp.cumsum(to_chunks(g), axis=3)
    causal = jnp.tril(jnp.ones((HG_CHUNK, HG_CHUNK), dtype=bool))

    def step(state, inp):
        q_c, k_c, v_c, b_c = inp
        inter = jnp.einsum('bhtd,bhde->bhte', q_c * jnp.exp(b_c), state)
        diff = b_c[:, :, :, None, :] - b_c[:, :, None, :, :]
        decay = jnp.exp(jnp.where(causal[:, :, None], diff, -jnp.inf))
        scores = jnp.einsum('bhtsd,bhsd->bhts', q_c[:, :, :, None, :] * decay, k_c)
        intra = jnp.einsum('bhts,bhse->bhte', scores, v_c)
        b_end = b_c[:, :, -1, :]
        k_dec = k_c * jnp.exp(b_end[:, :, None, :] - b_c)
        new_state = jnp.exp(b_end)[..., None] * state + jnp.einsum('bhsd,bhse->bhde', k_dec, v_c)
        return new_state, inter + intra

    state0 = jnp.zeros((B, H, dk, dv), jnp.float32)
    _, o = lax.scan(step, state0, (qc, kc, vc, bc))
    return o.transpose(1, 0, 3, 2, 4).reshape(B, S, H, dv)


def _short_conv(u, w):
    ch = u.shape[-1]
    return lax.conv_general_dilated(
        u, w[:, None, :].astype(u.dtype), window_strides=(1,), padding=[(CONV_K - 1, 0)],
        dimension_numbers=('NWC', 'WIO', 'NWC'), feature_group_count=ch)


def setup_inputs(seed: int = 0) -> dict:
    key = jax.random.key(seed)
    ks = jax.random.split(key, 12)
    beta = (8.0 * DEPTH) ** -0.25

    def nrm(k, shape, scale):
        return jax.random.normal(k, shape, jnp.float32) * scale

    return {
        "x": nrm(ks[0], (BATCH, SEQ, D_MODEL), 1.0),
        "c": nrm(ks[1], (BATCH, D_MODEL), 1.0),
        "w_mod": nrm(ks[2], (DEPTH, D_MODEL, 3 * D_MODEL), 0.2 * D_MODEL ** -0.5),
        "b_mod": nrm(ks[3], (DEPTH, 3 * D_MODEL), 0.01),
        "w_in": nrm(ks[4], (DEPTH, D_MODEL, IN_COLS), D_MODEL ** -0.5),
        "conv_w": nrm(ks[5], (DEPTH, CONV_K, CONV_WIDTH), CONV_K ** -0.5),
        "hgrn_norm_w": 1.0 + nrm(ks[6], (DEPTH, HG_HEAD_DIM), 0.02),
        "lower_bounds": nrm(ks[7], (DEPTH, HG_WIDTH), 0.1),
        "w_branch": nrm(ks[8], (DEPTH, N_BRANCH, SB_WIDTH, D_MODEL), beta * SB_WIDTH ** -0.5),
        "w_out": nrm(ks[9], (DEPTH, D_MODEL, D_MODEL), beta * D_MODEL ** -0.5),
        "ln_g": 1.0 + nrm(ks[10], (DEPTH, D_MODEL), 0.02),
        "ln_b": nrm(ks[11], (DEPTH, D_MODEL), 0.02),
    }


def reference(x, c, w_mod, b_mod, w_in, conv_w, hgrn_norm_w, lower_bounds, w_branch, w_out, ln_g, ln_b):
    B, S, D = x.shape
    dt = x.dtype
    alpha = (2.0 * DEPTH) ** 0.25
    p = jax.nn.softmax(lower_bounds.astype(jnp.float32), axis=0)
    lbs = jnp.cumsum(p, axis=0) - p[0:1]
    sizes = [SB_WIDTH] * 4 + [HG_WIDTH] * 4 + [CONV_WIDTH] * 4 + [D_MODEL] * N_BRANCH
    splits = np.cumsum(sizes[:-1]).tolist()

    for l in range(DEPTH):
        mod = (c @ w_mod[l] + b_mod[l])[:, None, :]
        shift, scale, gate = jnp.split(mod.astype(jnp.float32), 3, axis=-1)
        h = (_standardize(x) * (1.0 + scale) + shift).astype(dt)

        proj = h @ w_in[l]
        (q_a, k_a, v_a, z_a, q_b, f_b, i_b, z_b,
         pre_c, post_c, u_c, z_c, g_a, g_b, g_c) = jnp.split(proj, splits, axis=-1)

        o_a = _stick_breaking(q_a.reshape(B, S, SB_HEADS, SB_HEAD_DIM),
                              k_a.reshape(B, S, SB_HEADS, SB_HEAD_DIM),
                              v_a.reshape(B, S, SB_HEADS, SB_HEAD_DIM)).reshape(B, S, SB_WIDTH)
        y_a = (o_a * jax.nn.silu(z_a.astype(jnp.float32))).astype(dt)

        o_b = _hgrn2(jax.nn.silu(q_b).reshape(B, S, HG_HEADS, HG_HEAD_DIM),
                     f_b.reshape(B, S, HG_HEADS, HG_HEAD_DIM),
                     i_b.reshape(B, S, HG_HEADS, HG_HEAD_DIM),
                     lbs[l].reshape(HG_HEADS, HG_HEAD_DIM))
        o_b = o_b * lax.rsqrt(jnp.mean(o_b * o_b, axis=-1, keepdims=True) + RMS_EPS)
        o_b = (o_b * hgrn_norm_w[l].astype(jnp.float32)).reshape(B, S, HG_WIDTH)
        y_b = (o_b * jax.nn.silu(z_b.astype(jnp.float32))).astype(dt)

        y_c = post_c * _short_conv(pre_c * u_c, conv_w[l]) * jax.nn.silu(z_c)

        merged = (jax.nn.sigmoid(g_a) * (y_a @ w_branch[l, 0])
                  + jax.nn.sigmoid(g_b) * (y_b @ w_branch[l, 1])
                  + jax.nn.sigmoid(g_c) * (y_c.astype(dt) @ w_branch[l, 2]))
        y = (merged @ w_out[l]).astype(jnp.float32)

        r = alpha * x.astype(jnp.float32) + (1.0 + gate) * y
        x = (_standardize(r) * ln_g[l] + ln_b[l]).astype(dt)
    return x
```

```cpp
#include <hip/hip_runtime.h>
#include <hip/hip_cooperative_groups.h>
#include <cstdio>
#include <cstdint>
namespace cg = cooperative_groups;

#define LAS __attribute__((address_space(3)))
typedef unsigned short bf16_t;
typedef short bf16x8 __attribute__((ext_vector_type(8)));
typedef short s16x4 __attribute__((ext_vector_type(4)));
typedef float f32x2 __attribute__((ext_vector_type(2)));
typedef float f32x4 __attribute__((ext_vector_type(4)));
typedef float f32x16 __attribute__((ext_vector_type(16)));
typedef unsigned u32x2 __attribute__((ext_vector_type(2)));
typedef unsigned u32x4 __attribute__((ext_vector_type(4)));

constexpr int D_MODEL = 1024, BATCH = 8, SEQ = 2048, DEPTH = 2, M_TOK = BATCH * SEQ;
constexpr int IN_COLS = 9216, MIX_COLS = 6144;
constexpr int PITCH = 7168;
constexpr size_t PITCHB = (size_t)PITCH * 2;
constexpr int C_QA = 0, C_KA = 512, C_VA = 1024, C_ZA = 1536, C_QB = 2048, C_FB = 2560, C_IB = 3072, C_ZB = 3584, C_PRE = 4096, C_POST = 4608, C_U = 5120, C_ZC = 5632, C_H = 6144;
constexpr int C_MERGED = 4096;
constexpr float LN_EPS = 1e-5f, RMS_EPS = 1e-6f;
constexpr float LOG2E = 1.4426950408889634f;
constexpr float QSCALE = 0.125f * LOG2E;
constexpr float ALPHA = 1.4142135623730951f;

constexpr size_t WS_CTL = 0, CTL_BYTES = 65536;
constexpr size_t WS_MOD = 65536;
constexpr size_t WS_DEND = 256u << 10;
constexpr size_t WS_WIN = 1u << 20;
constexpr size_t WIN_L = (size_t)IN_COLS * 1024 * 2;
constexpr size_t WS_WB = WS_WIN + WIN_L;
constexpr size_t WB_L = (size_t)3 * 1024 * 1024 * 2;
constexpr size_t WS_WO = WS_WB + WB_L;
constexpr size_t WO_L = (size_t)1024 * 1024 * 2;
constexpr size_t WS_ACT = WS_WO + WO_L;
constexpr size_t WS_U = WS_ACT + (size_t)M_TOK * PITCHB;
constexpr size_t WS_X = WS_U + (size_t)32 * 32 * 128 * 128 * 2;
constexpr size_t WS_MODP = WS_X + 3 * 524288;
constexpr size_t WS_END = WS_MODP + (size_t)4 * DEPTH * BATCH * 3072 * 4;
constexpr size_t CTL_PANEL = 16384;

constexpr int LDS_BYTES = 147456;
constexpr int NTHREADS = 512;

struct Params {
    const float* x; const float* c; const float* w_mod; const float* b_mod; const float* w_in; const float* conv_w; const float* hgrn_norm_w;
    const float* lower_bounds; const float* w_branch; const float* w_out; const float* ln_g; const float* ln_b; float* out; unsigned char* ws;
};

typedef __bf16 bf16x2_t __attribute__((ext_vector_type(2)));
__device__ __forceinline__ unsigned cvt_pk_bf16(float lo, float hi) { const f32x2 v = {lo, hi}; const bf16x2_t b = __builtin_convertvector(v, bf16x2_t); return __builtin_bit_cast(unsigned, b); }
__device__ __forceinline__ float bf_lo(unsigned w) { return __uint_as_float(w << 16); }
__device__ __forceinline__ float bf_hi(unsigned w) { return __uint_as_float(w & 0xffff0000u); }
__device__ __forceinline__ float bf2f(bf16_t v) { return __uint_as_float((unsigned)v << 16); }
__device__ __forceinline__ float ex2(float v) { return __builtin_amdgcn_exp2f(v); }
__device__ __forceinline__ float lg2(float v) { return __builtin_amdgcn_logf(v); }
__device__ __forceinline__ float sigmoidf_(float v) { return __builtin_amdgcn_rcpf(1.0f + ex2(-v * LOG2E)); }
__device__ __forceinline__ float siluf_(float v) { return v * sigmoidf_(v); }
__device__ __forceinline__ float wave_sum(float v) {
#pragma unroll
    for (int o = 1; o < 64; o <<= 1) v += __shfl_xor(v, o);
    return v;
}
__device__ __forceinline__ int fresh_tid() { int t = threadIdx.x; asm volatile("" : "+v"(t)); return t; }
__device__ __forceinline__ int crow(int r, int hi) { return (r & 3) + 8 * (r >> 2) + 4 * hi; }

namespace pg8 {
constexpr int BM = 256, BK = 64, HALF = 128, HTB = HALF * BK * 2, STAGE_BYTES = 8 * HTB;
__device__ __forceinline__ int lds_byte(int r, int c) { const int st = (r >> 4) * 2 + (c >> 5), rr = r & 15, cc = c & 31, ob = rr * 64 + cc * 2; return st * 1024 + (ob ^ (((ob >> 9) & 1) << 5)); }
__device__ __forceinline__ void stage_rc(int b, int& R, int& C) { const int st = b / 1024, sb = b % 1024, swz = sb ^ (((sb >> 9) & 1) << 5); R = (st >> 1) * 16 + swz / 64; C = (st & 1) * 32 + (swz % 64) / 2; }
__device__ __forceinline__ int perm32(int rho) { const int n = rho >> 4, i = rho & 15; return 8 * (i >> 2) + 4 * n + (i & 3); }

struct Unit { const char* a; const char* b; int nt; int pm, pn, j; };

template <class Epi, class Sched>
__device__ __forceinline__ void gemm_phase(LAS unsigned char* lds, const unsigned ldaB, const unsigned ldbB, const Sched& S, const Epi& E) {
    const int tid = fresh_tid(), wid = __builtin_amdgcn_readfirstlane(tid >> 6), lane = tid & 63, wr = wid >> 2, wc = wid & 3, fr = lane & 15, fq = lane >> 4;
    unsigned voffA[2], voffB[2];
#pragma unroll
    for (int i = 0; i < 2; ++i) { int R, C; stage_rc(tid * 16 + i * 8192, R, C); const int Rb = Epi::PERM ? ((R & ~31) + perm32(R & 31)) : R;
        voffA[i] = (unsigned)R * ldaB + (unsigned)C * 2u; voffB[i] = (unsigned)Rb * ldbB + (unsigned)C * 2u; }
    const size_t kstep = (size_t)(BK * 2);
    const size_t hstepA = (size_t)HALF * ldaB, hstepB = (size_t)HALF * ldbB;
    const unsigned ldsw = (unsigned)wid * 1024u;
    const int aoff = lds_byte(wr * 64 + fr, fq * 8), boff = lds_byte(wc * 32 + fr, fq * 8);
#define PG8_SA(b, h) (((b) * 2 + (h)) * HTB)
#define PG8_SB(b, h) ((4 + (b) * 2 + (h)) * HTB)
#define PG8_STAGE(bufoff, gbase, voff) do { _Pragma("unroll") for (int _i = 0; _i < 2; ++_i) \
        __builtin_amdgcn_global_load_lds((const unsigned*)((const char*)(gbase) + (voff)[_i]), (LAS unsigned*)(lds + (bufoff) + ldsw + _i * 8192), 16, 0, 0); } while (0)
#define PG8_LDA(dst, b, h) do { _Pragma("unroll") for (int m = 0; m < 4; ++m) _Pragma("unroll") for (int k = 0; k < 2; ++k) dst[m][k] = *(const LAS bf16x8*)(lds + PG8_SA(b, h) + aoff + m * 2048 + k * 1024); } while (0)
#define PG8_LDB(dst, b, h) do { _Pragma("unroll") for (int n = 0; n < 2; ++n) _Pragma("unroll") for (int k = 0; k < 2; ++k) dst[n][k] = *(const LAS bf16x8*)(lds + PG8_SB(b, h) + boff + n * 2048 + k * 1024); } while (0)
#define PG8_MMA(ai, bj, At, Bt) do { __builtin_amdgcn_s_setprio(1); _Pragma("unroll") for (int m = 0; m < 4; ++m) _Pragma("unroll") for (int n = 0; n < 2; ++n) _Pragma("unroll") for (int k = 0; k < 2; ++k) \
        acc[ai][bj][m][n] = __builtin_amdgcn_mfma_f32_16x16x32_bf16(Bt[n][k], At[m][k], acc[ai][bj][m][n], 0, 0, 0); __builtin_amdgcn_s_setprio(0); } while (0)
#define PG8_WAIT_V(n) asm volatile("s_waitcnt vmcnt(" #n ")" ::: "memory")
#define PG8_WAIT_L(n) asm volatile("s_waitcnt lgkmcnt(" #n ")" ::: "memory")
#define PG8_BAR __builtin_amdgcn_s_barrier()
#define PG8_SCHED __builtin_amdgcn_sched_barrier(0)
    Unit cur, nxt; int ui = 0;
    if (!S.next(0, cur)) return;
    f32x4 acc[2][2][4][2];
#pragma unroll
    for (int a = 0; a < 2; ++a)
#pragma unroll
        for (int b = 0; b < 2; ++b)
#pragma unroll
            for (int m = 0; m < 4; ++m)
#pragma unroll
                for (int n = 0; n < 2; ++n) acc[a][b][m][n] = (f32x4){0.f, 0.f, 0.f, 0.f};
    bf16x8 At[4][2], B0[2][2], B1[2][2];
    const char* cA = cur.a; const char* cB = cur.b;
    PG8_STAGE(PG8_SB(0, 0), cB, voffB); PG8_STAGE(PG8_SB(0, 1), cB + hstepB, voffB); PG8_STAGE(PG8_SA(0, 0), cA, voffA); PG8_STAGE(PG8_SA(0, 1), cA + hstepA, voffA);
    if (wr == 1) PG8_BAR;
    PG8_WAIT_V(2); PG8_BAR;
    PG8_STAGE(PG8_SB(1, 0), cB + kstep, voffB); PG8_STAGE(PG8_SA(1, 0), cA + kstep, voffA); PG8_STAGE(PG8_SB(1, 1), cB + hstepB + kstep, voffB);
    PG8_WAIT_V(6); PG8_BAR;
    for (;;) {
        const bool has_next = S.next(ui + 1, nxt);
        const char* nA = has_next ? nxt.a : cA; const char* nB = has_next ? nxt.b : cB;
        const int nt = cur.nt;
        for (int t = 0; t < nt; t += 2) {
            const bool last = (t == nt - 2);
            const char* a1 = cA + (size_t)(t + 1) * kstep;
            const char* a2 = last ? nA : cA + (size_t)(t + 2) * kstep; const char* b2 = last ? nB : cB + (size_t)(t + 2) * kstep;
            const char* a3 = a2 + kstep; const char* b3 = b2 + kstep;
            PG8_LDB(B0, 0, 0); PG8_LDB(B1, 0, 1); PG8_SCHED; PG8_LDA(At, 0, 0); PG8_STAGE(PG8_SA(1, 1), a1 + hstepA, voffA);
            PG8_WAIT_V(8); PG8_WAIT_L(0); PG8_BAR; PG8_MMA(0, 0, At, B0); PG8_MMA(0, 1, At, B1); PG8_BAR; PG8_SCHED;
            PG8_LDA(At, 0, 1); PG8_STAGE(PG8_SB(0, 0), b2, voffB); PG8_STAGE(PG8_SB(0, 1), b2 + hstepB, voffB); PG8_STAGE(PG8_SA(0, 0), a2, voffA);
            PG8_WAIT_V(8); PG8_WAIT_L(0); PG8_BAR; PG8_MMA(1, 0, At, B0); PG8_MMA(1, 1, At, B1); PG8_BAR; PG8_SCHED;
            PG8_LDB(B0, 1, 0); PG8_LDB(B1, 1, 1); PG8_SCHED; PG8_LDA(At, 1, 0); PG8_STAGE(PG8_SA(0, 1), a2 + hstepA, voffA);
            PG8_WAIT_V(8); PG8_WAIT_L(0); PG8_BAR; PG8_MMA(0, 0, At, B0); PG8_MMA(0, 1, At, B1); PG8_BAR; PG8_SCHED;
            PG8_LDA(At, 1, 1); PG8_STAGE(PG8_SB(1, 0), b3, voffB); PG8_STAGE(PG8_SB(1, 1), b3 + hstepB, voffB); PG8_STAGE(PG8_SA(1, 0), a3, voffA);
            PG8_WAIT_V(8); PG8_WAIT_L(0); PG8_BAR; PG8_MMA(1, 0, At, B0); PG8_MMA(1, 1, At, B1); PG8_BAR; PG8_SCHED;
        }
        if (wr == 0) PG8_BAR;
        if constexpr (!Epi::AFTER_DRAIN) E(acc, cur, wr, wc, fr, fq);
        if (!has_next) break;
#pragma unroll
        for (int a = 0; a < 2; ++a)
#pragma unroll
            for (int b = 0; b < 2; ++b)
#pragma unroll
                for (int m = 0; m < 4; ++m)
#pragma unroll
                    for (int n = 0; n < 2; ++n) acc[a][b][m][n] = (f32x4){0.f, 0.f, 0.f, 0.f};
        cur = nxt; cA = nA; cB = nB; ++ui;
        if (wr == 1) PG8_BAR;
    }
    PG8_WAIT_V(0);
    PG8_BAR;
    if constexpr (Epi::AFTER_DRAIN) E.fused(acc, cur, wr, wc, fr, fq, lds, wid, lane);
#undef PG8_SA
#undef PG8_SB
#undef PG8_STAGE
#undef PG8_LDA
#undef PG8_LDB
#undef PG8_MMA
#undef PG8_WAIT_V
#undef PG8_WAIT_L
#undef PG8_BAR
#undef PG8_SCHED
}
}

struct SchedP1 {
    const char* A; const char* B; int G, vcu;
    __device__ __forceinline__ bool next(int i, pg8::Unit& u) const {
        const int U = i * G + vcu; if (U >= 64 * 24) return false;
        u.pm = 8 * ((U >> 5) & 7) + (U & 7); u.pn = 4 * (U >> 8) + ((U & 31) >> 3); u.j = 0; u.nt = 16;
        u.a = A + (size_t)u.pm * 256 * PITCHB; u.b = B + (size_t)u.pn * 256 * 2048; return true;
    }
};
struct SchedP3 {
    const char* ACTb; const char* Wg; const char* Wb; int G, vcu;
    __device__ __forceinline__ bool next(int i, pg8::Unit& u) const {
        const int T = vcu + (i / 6) * G; if (T >= 256) return false;
        const int s = i % 6; u.pm = 8 * (T >> 5) + (T & 7); u.pn = (T & 31) >> 3; u.j = s;
        const int j = s >> 1;
        if ((s & 1) == 0) { u.nt = 16; u.a = ACTb + (size_t)u.pm * 256 * PITCHB + C_H * 2; u.b = Wg + (size_t)(1024 * j + 256 * u.pn) * 2048; }
        else { u.nt = 8; u.a = ACTb + (size_t)u.pm * 256 * PITCHB + (size_t)(C_ZA + 2048 * j) * 2; u.b = Wb + (size_t)(1024 * j + 256 * u.pn) * 2048; }
        return true;
    }
};
struct SchedP4 {
    const char* ACTb; const char* Wo; int G, vcu;
    __device__ __forceinline__ bool next(int i, pg8::Unit& u) const {
        const int T = vcu + i * G; if (T >= 256) return false;
        u.pm = 8 * (T >> 5) + (T & 7); u.pn = (T & 31) >> 3; u.j = 0; u.nt = 16;
        u.a = ACTb + (size_t)u.pm * 256 * PITCHB + C_MERGED * 2; u.b = Wo + (size_t)(256 * u.pn) * 2048; return true;
    }
};

struct EpiP1 {
    static constexpr bool PERM = true, AFTER_DRAIN = false;
    bf16_t* ACT;
    __device__ __forceinline__ void operator()(const f32x4 (&acc)[2][2][4][2], const pg8::Unit& u, int wr, int wc, int fr, int fq) const {
        const int grp = u.pn >> 1;
        const int kind = (grp == 0) ? 1 : ((grp == 3 || grp == 4 || grp == 7 || grp == 11) ? 2 : 0);
        const int row0 = u.pm * 256 + wr * 64 + fr, col0 = u.pn * 256 + wc * 32 + 8 * fq;
#pragma unroll
        for (int ai = 0; ai < 2; ++ai)
#pragma unroll
            for (int m = 0; m < 4; ++m) { bf16_t* rowp = ACT + (size_t)(row0 + ai * 128 + m * 16) * PITCH + col0;
#pragma unroll
                for (int bj = 0; bj < 2; ++bj) { f32x4 v0 = acc[ai][bj][m][0], v1 = acc[ai][bj][m][1];
                    if (kind == 1) { v0 = v0 * QSCALE; v1 = v1 * QSCALE; }
                    else if (kind == 2) {
#pragma unroll
                        for (int e = 0; e < 4; ++e) { v0[e] = siluf_(v0[e]); v1[e] = siluf_(v1[e]); } }
                    u32x4 w; w.x = cvt_pk_bf16(v0[0], v0[1]); w.y = cvt_pk_bf16(v0[2], v0[3]); w.z = cvt_pk_bf16(v1[0], v1[1]); w.w = cvt_pk_bf16(v1[2], v1[3]);
                    *(u32x4*)(rowp + bj * 128) = w; } }
    }
};
struct EpiP3 {
    static constexpr bool PERM = true, AFTER_DRAIN = false;
    unsigned char* ACTb;
    __device__ __forceinline__ void operator()(const f32x4 (&acc)[2][2][4][2], const pg8::Unit& u, int wr, int wc, int fr, int fq) const {
        const int s = u.j, j = s >> 1;
        const int row0 = u.pm * 256 + wr * 64 + fr, cl0 = wc * 32 + 8 * fq;
        const unsigned toff = 512u * (unsigned)u.pn, soff = 5120u + 512u * (unsigned)u.pn, moff = (unsigned)(C_MERGED + 256 * u.pn) * 2u;
        if ((s & 1) == 0) {
#pragma unroll
            for (int ai = 0; ai < 2; ++ai)
#pragma unroll
                for (int m = 0; m < 4; ++m) { unsigned char* rowp = ACTb + (size_t)(row0 + ai * 128 + m * 16) * PITCHB;
#pragma unroll
                    for (int bj = 0; bj < 2; ++bj) { const f32x4 v0 = acc[ai][bj][m][0], v1 = acc[ai][bj][m][1];
                        u32x4 w; w.x = cvt_pk_bf16(v0[0], v0[1]); w.y = cvt_pk_bf16(v0[2], v0[3]); w.z = cvt_pk_bf16(v1[0], v1[1]); w.w = cvt_pk_bf16(v1[2], v1[3]);
                        *(u32x4*)(rowp + soff + (cl0 + bj * 128) * 2) = w; } }
        } else {
#pragma unroll
            for (int ai = 0; ai < 2; ++ai) {
                u32x4 gq[4][2], tq[4][2];
#pragma unroll
                for (int m = 0; m < 4; ++m) { unsigned char* rowp = ACTb + (size_t)(row0 + ai * 128 + m * 16) * PITCHB;
#pragma unroll
                    for (int bj = 0; bj < 2; ++bj) { gq[m][bj] = *(const u32x4*)(rowp + soff + (cl0 + bj * 128) * 2); if (j > 0) tq[m][bj] = *(const u32x4*)(rowp + toff + (cl0 + bj * 128) * 2); } }
#pragma unroll
                for (int m = 0; m < 4; ++m) { unsigned char* rowp = ACTb + (size_t)(row0 + ai * 128 + m * 16) * PITCHB;
#pragma unroll
                    for (int bj = 0; bj < 2; ++bj) { const f32x4 v0 = acc[ai][bj][m][0], v1 = acc[ai][bj][m][1]; const u32x4 g = gq[m][bj];
                        f32x4 t0 = (f32x4){sigmoidf_(bf_lo(g.x)) * v0[0], sigmoidf_(bf_hi(g.x)) * v0[1], sigmoidf_(bf_lo(g.y)) * v0[2], sigmoidf_(bf_hi(g.y)) * v0[3]};
                        f32x4 t1 = (f32x4){sigmoidf_(bf_lo(g.z)) * v1[0], sigmoidf_(bf_hi(g.z)) * v1[1], sigmoidf_(bf_lo(g.w)) * v1[2], sigmoidf_(bf_hi(g.w)) * v1[3]};
                        if (j > 0) { const u32x4 tv = tq[m][bj];
                            t0 = t0 + (f32x4){bf_lo(tv.x), bf_hi(tv.x), bf_lo(tv.y), bf_hi(tv.y)}; t1 = t1 + (f32x4){bf_lo(tv.z), bf_hi(tv.z), bf_lo(tv.w), bf_hi(tv.w)}; }
                        u32x4 w; w.x = cvt_pk_bf16(t0[0], t0[1]); w.y = cvt_pk_bf16(t0[2], t0[3]); w.z = cvt_pk_bf16(t1[0], t1[1]); w.w = cvt_pk_bf16(t1[2], t1[3]);
                        if (j < 2) *(u32x4*)(rowp + toff + (cl0 + bj * 128) * 2) = w; else *(u32x4*)(rowp + moff + (cl0 + bj * 128) * 2) = w;
                    } }
            }
        }
    }
};
struct PanelStats {
    unsigned long long* xbuf;
    unsigned* cnt;
    float eps;
    __device__ __forceinline__ void run(const f32x4 (&v)[2][2][4][2], const pg8::Unit& u, int wr, int wc, int fr, int fq, LAS unsigned char* lds, int wid, int lane) const {
        LAS f32x2* Pt = (LAS f32x2*)lds;
        LAS f32x2* St = (LAS f32x2*)(lds + 8192);
#pragma unroll
        for (int ai = 0; ai < 2; ++ai)
#pragma unroll
            for (int m = 0; m < 4; ++m) {
                float s = 0.f;
#pragma unroll
                for (int bj = 0; bj < 2; ++bj)
#pragma unroll
                    for (int n = 0; n < 2; ++n) { const f32x4 x = v[ai][bj][m][n]; s += (x[0] + x[1]) + (x[2] + x[3]); }
                s += __shfl_xor(s, 16); s += __shfl_xor(s, 32);
                const float mw = s * (1.0f / 64.0f); float q = 0.f;
#pragma unroll
                for (int bj = 0; bj < 2; ++bj)
#pragma unroll
                    for (int n = 0; n < 2; ++n) { const f32x4 d = v[ai][bj][m][n] - mw; q += (d[0] * d[0] + d[1] * d[1]) + (d[2] * d[2] + d[3] * d[3]); }
                q += __shfl_xor(q, 16); q += __shfl_xor(q, 32);
                if (fq == 0) Pt[(ai * 128 + wr * 64 + m * 16 + fr) * 4 + wc] = (f32x2){mw, q};
            }
        __syncthreads();
        const int row = wid * 32 + (lane & 31);
        if (lane < 32) {
            const f32x2 a = Pt[row * 4 + 0], b = Pt[row * 4 + 1], c = Pt[row * 4 + 2], d = Pt[row * 4 + 3];
            const float mt = (a.x + b.x + c.x + d.x) * 0.25f;
            const float da = a.x - mt, db = b.x - mt, dc = c.x - mt, dd = d.x - mt;
            const float m2 = (a.y + b.y) + (c.y + d.y) + 64.0f * ((da * da + db * db) + (dc * dc + dd * dd));
            __hip_atomic_store(xbuf + ((size_t)(u.pm * 256 + row) * 4 + u.pn), ((unsigned long long)__float_as_uint(m2) << 32) | __float_as_uint(mt), __ATOMIC_RELAXED, __HIP_MEMORY_SCOPE_AGENT);
        }
        asm volatile("s_waitcnt vmcnt(0)" ::: "memory");
        if (lane == 0) __hip_atomic_fetch_add(cnt + 64 * u.pm, 1u, __ATOMIC_RELAXED, __HIP_MEMORY_SCOPE_AGENT);
        if (wid == 0) {
            unsigned sp = 0;
            while ((unsigned)__builtin_amdgcn_readfirstlane(__hip_atomic_load(cnt + 64 * u.pm, __ATOMIC_RELAXED, __HIP_MEMORY_SCOPE_AGENT)) < 32u) { __builtin_amdgcn_s_sleep(2); if (++sp > (1u << 24)) break; }
            __builtin_amdgcn_fence(__ATOMIC_ACQUIRE, "agent");
        }
        asm volatile("s_waitcnt vmcnt(0) lgkmcnt(0)" ::: "memory");
        __syncthreads();
        if (lane < 32) {
            const unsigned long long* slot = xbuf + (size_t)(u.pm * 256 + row) * 4; float mt[4], m2[4]; float ms = 0.f;
#pragma unroll
            for (int t = 0; t < 4; ++t) { const unsigned long long w = __hip_atomic_load(slot + t, __ATOMIC_RELAXED, __HIP_MEMORY_SCOPE_AGENT); mt[t] = __uint_as_float((unsigned)w); m2[t] = __uint_as_float((unsigned)(w >> 32)); ms += mt[t]; }
            const float mean = ms * 0.25f; float q = 0.f;
#pragma unroll
            for (int t = 0; t < 4; ++t) { const float dm = mt[t] - mean; q += m2[t] + 256.0f * dm * dm; }
            St[row] = (f32x2){mean, __builtin_amdgcn_rsqf(q * (1.0f / 1024.0f) + eps)};
        }
        __syncthreads();
    }
};
struct EpiP4F {
    static constexpr bool PERM = false, AFTER_DRAIN = true;
    const float* xprev; float* out; const float* gate; const float* lng; const float* lnb; const float* modn; bf16_t* ACT; PanelStats st1, st2;
    __device__ __forceinline__ void fused(f32x4 (&acc)[2][2][4][2], const pg8::Unit& u, int wr, int wc, int fr, int fq, LAS unsigned char* lds, int wid, int lane) const {
        const LAS f32x2* St = (const LAS f32x2*)(lds + 8192);
        const int row0 = u.pm * 256 + wr * 64 + fr, col0 = u.pn * 256 + wc * 32 + 4 * fq;
        const int bidx = (u.pm * 256) / SEQ;
        {
            const float* gp = gate + (size_t)bidx * 3072;
            f32x4 gv[2][2];
#pragma unroll
            for (int bj = 0; bj < 2; ++bj)
#pragma unroll
                for (int n = 0; n < 2; ++n) gv[bj][n] = *(const f32x4*)(gp + col0 + bj * 128 + n * 16) + 1.0f;
#pragma unroll
            for (int ai = 0; ai < 2; ++ai)
#pragma unroll
                for (int m = 0; m < 4; ++m) { const size_t off = (size_t)(row0 + ai * 128 + m * 16) * D_MODEL + col0;
#pragma unroll
                    for (int bj = 0; bj < 2; ++bj)
#pragma unroll
                        for (int n = 0; n < 2; ++n) { const f32x4 xv = *(const f32x4*)(xprev + off + bj * 128 + n * 16); acc[ai][bj][m][n] = xv * ALPHA + gv[bj][n] * acc[ai][bj][m][n]; }
                    asm volatile("" : "+v"(acc[ai][0][m][0]), "+v"(acc[ai][0][m][1]), "+v"(acc[ai][1][m][0]), "+v"(acc[ai][1][m][1]));
                    if (m & 1) asm volatile("" ::: "memory"); }
        }
        st1.run(acc, u, wr, wc, fr, fq, lds, wid, lane);
        {
            f32x4 lg[2][2], lb[2][2];
#pragma unroll
            for (int bj = 0; bj < 2; ++bj)
#pragma unroll
                for (int n = 0; n < 2; ++n) { lg[bj][n] = *(const f32x4*)(lng + col0 + bj * 128 + n * 16); lb[bj][n] = *(const f32x4*)(lnb + col0 + bj * 128 + n * 16); }
#pragma unroll
            for (int ai = 0; ai < 2; ++ai)
#pragma unroll
                for (int m = 0; m < 4; ++m) { const int r = ai * 128 + wr * 64 + m * 16 + fr; const f32x2 sr = St[r]; const size_t off = (size_t)(u.pm * 256 + r) * D_MODEL + col0;
#pragma unroll
                    for (int bj = 0; bj < 2; ++bj)
#pragma unroll
                        for (int n = 0; n < 2; ++n) { const f32x4 x1 = (acc[ai][bj][m][n] - sr.x) * sr.y * lg[bj][n] + lb[bj][n]; acc[ai][bj][m][n] = x1; *(f32x4*)(out + off + bj * 128 + n * 16) = x1; }
                    asm volatile("" : "+v"(acc[ai][0][m][0]), "+v"(acc[ai][0][m][1]), "+v"(acc[ai][1][m][0]), "+v"(acc[ai][1][m][1]));
                    asm volatile("" ::: "memory"); }
        }
        if (modn) {
            st2.run(acc, u, wr, wc, fr, fq, lds, wid, lane);
            const float* mp = modn + (size_t)bidx * 3072;
            f32x4 sc[2][2], sh[2][2];
#pragma unroll
            for (int bj = 0; bj < 2; ++bj)
#pragma unroll
                for (int n = 0; n < 2; ++n) { sh[bj][n] = *(const f32x4*)(mp + col0 + bj * 128 + n * 16); sc[bj][n] = *(const f32x4*)(mp + 1024 + col0 + bj * 128 + n * 16) + 1.0f; }
#pragma unroll
            for (int ai = 0; ai < 2; ++ai)
#pragma unroll
                for (int m = 0; m < 4; ++m) { const int r = ai * 128 + wr * 64 + m * 16 + fr; const f32x2 sr = St[r]; bf16_t* hp = ACT + (size_t)(u.pm * 256 + r) * PITCH + C_H + col0;
#pragma unroll
                    for (int bj = 0; bj < 2; ++bj)
#pragma unroll
                        for (int n = 0; n < 2; ++n) { const f32x4 hv = (acc[ai][bj][m][n] - sr.x) * sr.y * sc[bj][n] + sh[bj][n];
                            u32x2 w; w.x = cvt_pk_bf16(hv[0], hv[1]); w.y = cvt_pk_bf16(hv[2], hv[3]); *(u32x2*)(hp + bj * 128 + n * 16) = w; }
                    asm volatile("" ::: "memory"); }
        }
    }
};

__device__ __forceinline__ void transpose_item(const float* W, int N, bf16_t* WT, int ldw, LAS float* scr, int item, int lane) {
    const int nblk = N / 32, kb = item / nblk, nb = item % nblk, k0 = 64 * kb, n0 = 32 * nb;
    const int kr = lane >> 3, n4 = (lane & 7) * 4;
    f32x4 v[8];
#pragma unroll
    for (int i = 0; i < 8; ++i) v[i] = *(const f32x4*)(W + (size_t)(k0 + 8 * i + kr) * N + n0 + n4);
#pragma unroll
    for (int i = 0; i < 8; ++i) { LAS float* d = scr + (8 * i + kr) * 33 + n4; d[0] = v[i].x; d[1] = v[i].y; d[2] = v[i].z; d[3] = v[i].w; }
    asm volatile("s_waitcnt lgkmcnt(0)" ::: "memory");
    const int c = lane & 7;
#pragma unroll
    for (int j = 0; j < 4; ++j) { const int n = (lane >> 3) + 8 * j; const LAS float* s = scr + (8 * c) * 33 + n;
        u32x4 o; o.x = cvt_pk_bf16(s[0 * 33], s[1 * 33]); o.y = cvt_pk_bf16(s[2 * 33], s[3 * 33]); o.z = cvt_pk_bf16(s[4 * 33], s[5 * 33]); o.w = cvt_pk_bf16(s[6 * 33], s[7 * 33]);
        *(u32x4*)(WT + (size_t)(n0 + n) * ldw + k0 + 8 * c) = o; }
    asm volatile("s_waitcnt lgkmcnt(0)" ::: "memory");
}

__device__ __forceinline__ void row_standardize(f32x4 (&v)[4]) {
    float s = 0.f;
#pragma unroll
    for (int j = 0; j < 4; ++j) s += (v[j].x + v[j].y) + (v[j].z + v[j].w);
    const float mean = wave_sum(s) * (1.f / D_MODEL); float s2 = 0.f;
#pragma unroll
    for (int j = 0; j < 4; ++j) { v[j] = v[j] - mean; s2 += (v[j].x * v[j].x + v[j].y * v[j].y) + (v[j].z * v[j].z + v[j].w * v[j].w); }
    const float rstd = __builtin_amdgcn_rsqf(wave_sum(s2) * (1.f / D_MODEL) + LN_EPS);
#pragma unroll
    for (int j = 0; j < 4; ++j) v[j] = v[j] * rstd;
}
__device__ __forceinline__ void write_h_row(const f32x4 (&v)[4], const float* modb, bf16_t* hrow, int lane) {
#pragma unroll
    for (int j = 0; j < 4; ++j) { const int col = 4 * (lane + 64 * j);
        const f32x4 sh = *(const f32x4*)(modb + col), sc = *(const f32x4*)(modb + 1024 + col);
        const f32x4 h = v[j] * (sc + 1.0f) + sh;
        u32x2 w; w.x = cvt_pk_bf16(h.x, h.y); w.y = cvt_pk_bf16(h.z, h.w);
        *(u32x2*)(hrow + col) = w; }
}

typedef short v4i16_t __attribute__((ext_vector_type(4)));
__device__ __forceinline__ s16x4 vtr(const LAS bf16_t* p) { return __builtin_bit_cast(s16x4, __builtin_amdgcn_ds_read_tr16_b64_v4i16((LAS v4i16_t*)p)); }
constexpr float STICK_DEAD = -44.0f;
__device__ __forceinline__ void attn_unit(LAS unsigned char* lds, bf16_t* ACT, int b, int h, int qb) {
    const int tid = fresh_tid(), lane = tid & 63, r32 = lane & 31, hi = lane >> 5;
    const int wid = __builtin_amdgcn_readfirstlane(tid >> 6);
    bf16_t* base = ACT + (size_t)b * SEQ * PITCH;
    const int tq0 = qb * 256 + wid * 32, tq = tq0 + r32;
    LAS bf16_t* Kw = (LAS bf16_t*)(lds + wid * 9728);
    LAS bf16_t* Vw = Kw + 32 * 72;
    LAS float* stg = (LAS float*)(lds + wid * 9728);
    bf16x8 qr[4];
#pragma unroll
    for (int d0 = 0; d0 < 4; ++d0) qr[d0] = *(const bf16x8*)(base + (size_t)tq * PITCH + C_QA + h * 64 + d0 * 16 + hi * 8);
    f32x16 o0, o1;
#pragma unroll
    for (int r = 0; r < 16; ++r) { o0[r] = 0.f; o1[r] = 0.f; }
    float R = 0.f;
    const int srow = lane >> 3, sch = lane & 7;
    const bf16_t* kg = base + (size_t)srow * PITCH + C_KA + h * 64 + sch * 8;
    const bf16_t* vg = base + (size_t)srow * PITCH + C_VA + h * 64 + sch * 8;
    const LAS bf16_t* vb = Vw + (4 * hi + ((lane & 15) >> 2)) * 80 + 16 * ((lane >> 4) & 1) + 4 * (lane & 3);
    u32x4 kreg[4], vreg[4];
    int kb = tq0;
#pragma unroll
    for (int i = 0; i < 4; ++i) { kreg[i] = *(const u32x4*)(kg + (size_t)(kb + 8 * i) * PITCH); vreg[i] = *(const u32x4*)(vg + (size_t)(kb + 8 * i) * PITCH); }
    for (;;) {
#pragma unroll
        for (int i = 0; i < 4; ++i) { *(LAS u32x4*)(Kw + (srow + 8 * i) * 72 + sch * 8) = kreg[i]; *(LAS u32x4*)(Vw + (srow + 8 * i) * 80 + sch * 8) = vreg[i]; }
        const int kbn = kb - 32;
        if (kbn >= 0) {
#pragma unroll
            for (int i = 0; i < 4; ++i) { kreg[i] = *(const u32x4*)(kg + (size_t)(kbn + 8 * i) * PITCH); vreg[i] = *(const u32x4*)(vg + (size_t)(kbn + 8 * i) * PITCH); }
        }
        f32x16 p0;
#pragma unroll
        for (int r = 0; r < 16; ++r) p0[r] = 0.f;
#pragma unroll
        for (int d0 = 0; d0 < 4; ++d0) {
            const bf16x8 a0 = *(const LAS bf16x8*)(Kw + r32 * 72 + d0 * 16 + hi * 8);
            p0 = __builtin_amdgcn_mfma_f32_32x32x16_bf16(a0, qr[d0], p0, 0, 0, 0);
        }
        float x0[16];
        if (kb < tq0) {
#pragma unroll
            for (int r = 0; r < 16; ++r) { const float z = p0[r]; const float sp = fmaxf(z, 0.f) + lg2(1.0f + ex2(-fabsf(z))); x0[r] = sp; p0[r] = z - sp; }
        } else {
            const int kvl = kb + 4 * hi;
#pragma unroll
            for (int r = 0; r < 16; ++r) { const int kv = kvl + (r & 3) + 8 * (r >> 2);
                const float z = p0[r]; const float sp = fmaxf(z, 0.f) + lg2(1.0f + ex2(-fabsf(z))); const bool ok = kv < tq; x0[r] = ok ? sp : 0.f; p0[r] = ok ? z - sp : -INFINITY; }
        }
        float Gs[4], Gh1[4], Tt[4];
#pragma unroll
        for (int g = 0; g < 4; ++g) Gs[g] = (x0[4 * g] + x0[4 * g + 1]) + (x0[4 * g + 2] + x0[4 * g + 3]);
#pragma unroll
        for (int g = 0; g < 4; ++g) { auto rr = __builtin_amdgcn_permlane32_swap(__float_as_uint(Gs[g]), __float_as_uint(Gs[g]), false, false);
            Gh1[g] = __uint_as_float(rr[1]); Tt[g] = __uint_as_float(rr[0]) + __uint_as_float(rr[1]); }
        float run = R;
#pragma unroll
        for (int g = 3; g >= 0; --g) {
            const float off = hi ? run : run - Gh1[g];
            const int q4 = 4 * g;
            const float s3 = off, s2 = s3 - x0[q4 + 3], s1 = s2 - x0[q4 + 2], s0 = s1 - x0[q4 + 1];
            p0[q4 + 3] = ex2(p0[q4 + 3] + s3); p0[q4 + 2] = ex2(p0[q4 + 2] + s2); p0[q4 + 1] = ex2(p0[q4 + 1] + s1); p0[q4] = ex2(p0[q4] + s0);
            run -= Tt[g];
        }
        R = run;
#pragma unroll
        for (int s = 0; s < 2; ++s) {
            u32x4 w; const int r0 = 8 * s;
            w.x = cvt_pk_bf16(p0[r0], p0[r0 + 1]); w.y = cvt_pk_bf16(p0[r0 + 2], p0[r0 + 3]); w.z = cvt_pk_bf16(p0[r0 + 4], p0[r0 + 5]); w.w = cvt_pk_bf16(p0[r0 + 6], p0[r0 + 7]);
            const bf16x8 af = __builtin_bit_cast(bf16x8, w);
            { const s16x4 lo = vtr(vb + (16 * s) * 80), hh = vtr(vb + (16 * s + 8) * 80);
              const bf16x8 bfr = (bf16x8){lo[0], lo[1], lo[2], lo[3], hh[0], hh[1], hh[2], hh[3]};
              o0 = __builtin_amdgcn_mfma_f32_32x32x16_bf16(af, bfr, o0, 0, 0, 0); }
            { const s16x4 lo = vtr(vb + (16 * s) * 80 + 32), hh = vtr(vb + (16 * s + 8) * 80 + 32);
              const bf16x8 bfr = (bf16x8){lo[0], lo[1], lo[2], lo[3], hh[0], hh[1], hh[2], hh[3]};
              o1 = __builtin_amdgcn_mfma_f32_32x32x16_bf16(af, bfr, o1, 0, 0, 0); }
        }
        if (kbn < 0 || !__any(R > STICK_DEAD)) break;
        kb = kbn;
    }
#pragma unroll
    for (int r = 0; r < 16; ++r) { stg[crow(r, hi) * 68 + r32] = o0[r]; stg[crow(r, hi) * 68 + 32 + r32] = o1[r]; }
    asm volatile("s_waitcnt lgkmcnt(0)" ::: "memory");
#pragma unroll
    for (int i = 0; i < 4; ++i) { const int row = i * 8 + (lane >> 3), ch = lane & 7;
        const f32x4 a = *(const LAS f32x4*)(stg + row * 68 + ch * 8), c = *(const LAS f32x4*)(stg + row * 68 + ch * 8 + 4);
        bf16_t* zp = base + (size_t)(tq0 + row) * PITCH + C_ZA + h * 64 + ch * 8;
        const u32x4 z = *(const u32x4*)zp;
        u32x4 w; w.x = cvt_pk_bf16(a.x * bf_lo(z.x), a.y * bf_hi(z.x)); w.y = cvt_pk_bf16(a.z * bf_lo(z.y), a.w * bf_hi(z.y));
        w.z = cvt_pk_bf16(c.x * bf_lo(z.z), c.y * bf_hi(z.z)); w.w = cvt_pk_bf16(c.z * bf_lo(z.w), c.w * bf_hi(z.w));
        *(u32x4*)zp = w; }
    asm volatile("s_waitcnt lgkmcnt(0)" ::: "memory");
}

__device__ __forceinline__ float layer_lb(const float* lower_bounds, int l, int ch) {
    float mx = -INFINITY;
    for (int i = 0; i < DEPTH; ++i) mx = fmaxf(mx, lower_bounds[i * 512 + ch]);
    float den = 0.f, num = 0.f;
    for (int i = 0; i < DEPTH; ++i) { const float e = __expf(lower_bounds[i * 512 + ch] - mx); den += e; if (i >= 1 && i <= l) num += e; }
    return num / den;
}
template <int MODE>
__device__ __forceinline__ void hgrn_pass(LAS unsigned char* lds, bf16_t* ACT, const Params& P, int l, int bh, int c0, int nc) {
    const int tid = fresh_tid(), lane = tid & 63, r32 = lane & 31, hi = lane >> 5;
    const int wid = __builtin_amdgcn_readfirstlane(tid >> 6);
    LAS bf16_t* Q1 = (LAS bf16_t*)(lds);
    LAS bf16_t* Q2 = (LAS bf16_t*)(lds + 17408);
    LAS bf16_t* K2 = (LAS bf16_t*)(lds + 34816);
    LAS float*  OT = (LAS float*)(lds);
    LAS bf16_t* K3T = (LAS bf16_t*)(lds + 52224);
    LAS bf16_t* VT = (LAS bf16_t*)(lds + 70656);
    LAS bf16_t* Pm = (LAS bf16_t*)(lds + 89088);
    LAS bf16_t* ST = (LAS bf16_t*)(lds + 98304);
    LAS float* SCX = (LAS float*)(lds + 133632);
    const int d = tid & 127, part = tid >> 7, b = bh >> 2, h = bh & 3;
    const float lbv = layer_lb(P.lower_bounds, l, h * 128 + d);
    bf16_t* base = ACT + (size_t)b * SEQ * PITCH + h * 128;
    bf16_t* Ug = (bf16_t*)(P.ws + WS_U) + (size_t)bh * 32 * 16384;
    float* Dg = (float*)(P.ws + WS_DEND) + (size_t)bh * 32 * 128;
    const float* nw = P.hgrn_norm_w + l * 128;
    const int tb = wid & 1, eb = wid >> 1;
    bf16_t fin[16], qin[16], vin[16];
#pragma unroll
    for (int i = 0; i < 16; ++i) { const bf16_t* rp = base + (size_t)(c0 * 64 + 16 * part + i) * PITCH + d; fin[i] = rp[C_FB]; vin[i] = rp[C_IB]; if (MODE == 1) qin[i] = rp[C_QB]; }
    for (int ci = 0; ci < nc; ++ci) {
        const int c = c0 + ci;
        u32x4 stp[4];
        if (MODE == 1) {
#pragma unroll
            for (int i = 0; i < 4; ++i) { const int idx = tid + 512 * i; stp[i] = (c > 0) ? *(const u32x4*)(Ug + (size_t)(c - 1) * 16384 + (idx >> 4) * 128 + (idx & 15) * 8) : (u32x4){0u, 0u, 0u, 0u}; }
        }
        float g2[16], kk[16];
        float runb = 0.f;
#pragma unroll
        for (int i = 0; i < 16; ++i) { const float f = lbv + (1.0f - lbv) * sigmoidf_(bf2f(fin[i])); kk[i] = 1.0f - f; runb += lg2(f); g2[i] = runb; }
        SCX[part * 128 + d] = runb;
        __syncthreads();
        const float t0 = SCX[d], t1 = SCX[128 + d], t2 = SCX[256 + d], t3 = SCX[384 + d];
        const float offp = (part > 0 ? t0 : 0.f) + (part > 1 ? t1 : 0.f) + (part > 2 ? t2 : 0.f);
        const float cmid = t0 + t1, bend = (t0 + t1) + (t2 + t3);
        {
            unsigned k3w[8], vw[8];
#pragma unroll
            for (int i = 0; i < 16; i += 2) {
                const float B0 = offp + g2[i], B1 = offp + g2[i + 1];
                if (MODE == 1) {
                    const float q0 = bf2f(qin[i]), q1 = bf2f(qin[i + 1]);
                    const int t = 16 * part + i;
                    Q1[t * 136 + d] = (bf16_t)(cvt_pk_bf16(q0 * ex2(B0), 0.f) & 0xffffu); Q1[(t + 1) * 136 + d] = (bf16_t)(cvt_pk_bf16(q1 * ex2(B1), 0.f) & 0xffffu);
                    Q2[t * 136 + d] = (bf16_t)(cvt_pk_bf16(q0 * ex2(B0 - cmid), 0.f) & 0xffffu); Q2[(t + 1) * 136 + d] = (bf16_t)(cvt_pk_bf16(q1 * ex2(B1 - cmid), 0.f) & 0xffffu);
                    K2[t * 136 + d] = (bf16_t)(cvt_pk_bf16(kk[i] * ex2(cmid - B0), 0.f) & 0xffffu); K2[(t + 1) * 136 + d] = (bf16_t)(cvt_pk_bf16(kk[i + 1] * ex2(cmid - B1), 0.f) & 0xffffu);
                } else {
                    k3w[i >> 1] = cvt_pk_bf16(kk[i] * ex2(bend - B0), kk[i + 1] * ex2(bend - B1));
                }
                vw[i >> 1] = (unsigned)vin[i] | ((unsigned)vin[i + 1] << 16);
            }
            if (MODE == 0) { *(LAS u32x4*)(K3T + d * 72 + 16 * part) = (u32x4){k3w[0], k3w[1], k3w[2], k3w[3]}; *(LAS u32x4*)(K3T + d * 72 + 16 * part + 8) = (u32x4){k3w[4], k3w[5], k3w[6], k3w[7]}; }
            *(LAS u32x4*)(VT + d * 72 + 16 * part) = (u32x4){vw[0], vw[1], vw[2], vw[3]}; *(LAS u32x4*)(VT + d * 72 + 16 * part + 8) = (u32x4){vw[4], vw[5], vw[6], vw[7]};
        }
        if (MODE == 0) { if (part == 0) Dg[c * 128 + d] = ex2(bend); }
        else {
#pragma unroll
            for (int i = 0; i < 4; ++i) { const int idx = tid + 512 * i; *(LAS u32x4*)(ST + (idx >> 4) * 136 + (idx & 15) * 8) = stp[i]; }
        }
        if (ci + 1 < nc) {
#pragma unroll
            for (int i = 0; i < 16; ++i) { const bf16_t* rp = base + (size_t)((c + 1) * 64 + 16 * part + i) * PITCH + d; fin[i] = rp[C_FB]; vin[i] = rp[C_IB]; if (MODE == 1) qin[i] = rp[C_QB]; }
        }
        __syncthreads();
        if (MODE == 0) {
#pragma unroll
            for (int i = 0; i < 2; ++i) {
                const int db = 2 * (wid & 1) + i;
                f32x16 sa;
#pragma unroll
                for (int r = 0; r < 16; ++r) sa[r] = 0.f;
#pragma unroll
                for (int ks = 0; ks < 4; ++ks) {
                    const bf16x8 a = *(const LAS bf16x8*)(K3T + (32 * db + r32) * 72 + 16 * ks + 8 * hi);
                    const bf16x8 bb = *(const LAS bf16x8*)(VT + (32 * eb + r32) * 72 + 16 * ks + 8 * hi);
                    sa = __builtin_amdgcn_mfma_f32_32x32x16_bf16(a, bb, sa, 0, 0, 0);
                }
#pragma unroll
                for (int g = 0; g < 4; ++g) { u32x2 w; w.x = cvt_pk_bf16(sa[4 * g], sa[4 * g + 1]); w.y = cvt_pk_bf16(sa[4 * g + 2], sa[4 * g + 3]);
                    *(LAS u32x2*)(ST + (32 * eb + r32) * 136 + 32 * db + 8 * g + 4 * hi) = w; }
            }
            __syncthreads();
#pragma unroll
            for (int i = 0; i < 4; ++i) { const int idx = tid + 512 * i;
                *(u32x4*)(Ug + (size_t)c * 16384 + (idx >> 4) * 128 + (idx & 15) * 8) = *(const LAS u32x4*)(ST + (idx >> 4) * 136 + (idx & 15) * 8); }
        } else {
            f32x16 o;
#pragma unroll
            for (int r = 0; r < 16; ++r) o[r] = 0.f;
            if (c > 0) {
#pragma unroll
                for (int ks = 0; ks < 8; ++ks) {
                    const bf16x8 a = *(const LAS bf16x8*)(Q1 + (32 * tb + r32) * 136 + 16 * ks + 8 * hi);
                    const bf16x8 bb = *(const LAS bf16x8*)(ST + (32 * eb + r32) * 136 + 16 * ks + 8 * hi);
                    o = __builtin_amdgcn_mfma_f32_32x32x16_bf16(a, bb, o, 0, 0, 0);
                }
            }
            if (wid < 4) {
                const int stb = wid & 1, ssb = wid >> 1;
                f32x16 sc;
#pragma unroll
                for (int r = 0; r < 16; ++r) sc[r] = 0.f;
                if (!(stb == 0 && ssb == 1)) {
#pragma unroll
                    for (int ks = 0; ks < 8; ++ks) {
                        const bf16x8 a = *(const LAS bf16x8*)(Q2 + (32 * stb + r32) * 136 + 16 * ks + 8 * hi);
                        const bf16x8 bb = *(const LAS bf16x8*)(K2 + (32 * ssb + r32) * 136 + 16 * ks + 8 * hi);
                        sc = __builtin_amdgcn_mfma_f32_32x32x16_bf16(a, bb, sc, 0, 0, 0);
                    }
                }
#pragma unroll
                for (int r = 0; r < 16; ++r) { const int t = 32 * stb + crow(r, hi), s = 32 * ssb + r32;
                    const float v = (s <= t) ? sc[r] : 0.f;
                    Pm[t * 72 + s] = (bf16_t)(cvt_pk_bf16(v, 0.f) & 0xffffu); }
            }
            __syncthreads();
            unsigned zz[8];
#pragma unroll
            for (int i = 0; i < 8; ++i) zz[i] = *(const unsigned*)(base + (size_t)(c * 64 + 8 * wid + i) * PITCH + C_ZB + 2 * lane);
#pragma unroll
            for (int ks = 0; ks < 4; ++ks) {
                const bf16x8 a = *(const LAS bf16x8*)(Pm + (32 * tb + r32) * 72 + 16 * ks + 8 * hi);
                const bf16x8 bb = *(const LAS bf16x8*)(VT + (32 * eb + r32) * 72 + 16 * ks + 8 * hi);
                o = __builtin_amdgcn_mfma_f32_32x32x16_bf16(a, bb, o, 0, 0, 0);
            }
#pragma unroll
            for (int r = 0; r < 16; ++r) OT[(32 * tb + crow(r, hi)) * 132 + 32 * eb + r32] = o[r];
            __syncthreads();
            {
                const f32x2 nwv = *(const f32x2*)(nw + 2 * lane);
#pragma unroll
                for (int i = 0; i < 8; ++i) { const int t = 8 * wid + i;
                    const f32x2 v = *(const LAS f32x2*)(OT + t * 132 + 2 * lane);
                    const float ss = wave_sum(v.x * v.x + v.y * v.y);
                    const float rstd = __builtin_amdgcn_rsqf(ss * (1.0f / 128.0f) + RMS_EPS);
                    unsigned* zp = (unsigned*)(base + (size_t)(c * 64 + t) * PITCH + C_ZB + 2 * lane);
                    *zp = cvt_pk_bf16(v.x * rstd * nwv.x * bf_lo(zz[i]), v.y * rstd * nwv.y * bf_hi(zz[i])); }
            }
        }
    }
    __syncthreads();
}

__device__ __forceinline__ void conv_item(bf16_t* ACT, const float* cw, int item) {
    const int tid = fresh_tid(), cgp = tid & 63, sub = tid >> 6;
    const int m0 = item * 64 + sub * 8, ch = cgp * 8;
    float w0[8], w1[8], w2[8];
#pragma unroll
    for (int e = 0; e < 8; ++e) { w0[e] = cw[ch + e]; w1[e] = cw[512 + ch + e]; w2[e] = cw[1024 + ch + e]; }
    float p1[8], p2[8];
#pragma unroll
    for (int e = 0; e < 8; ++e) { p1[e] = 0.f; p2[e] = 0.f; }
    if ((m0 % SEQ) != 0) {
        const bf16_t* r2 = ACT + (size_t)(m0 - 2) * PITCH + ch; const bf16_t* r1 = ACT + (size_t)(m0 - 1) * PITCH + ch;
        const u32x4 a2 = *(const u32x4*)(r2 + C_PRE), u2 = *(const u32x4*)(r2 + C_U), a1 = *(const u32x4*)(r1 + C_PRE), u1 = *(const u32x4*)(r1 + C_U);
        p2[0] = bf_lo(a2.x) * bf_lo(u2.x); p2[1] = bf_hi(a2.x) * bf_hi(u2.x); p2[2] = bf_lo(a2.y) * bf_lo(u2.y); p2[3] = bf_hi(a2.y) * bf_hi(u2.y);
        p2[4] = bf_lo(a2.z) * bf_lo(u2.z); p2[5] = bf_hi(a2.z) * bf_hi(u2.z); p2[6] = bf_lo(a2.w) * bf_lo(u2.w); p2[7] = bf_hi(a2.w) * bf_hi(u2.w);
        p1[0] = bf_lo(a1.x) * bf_lo(u1.x); p1[1] = bf_hi(a1.x) * bf_hi(u1.x); p1[2] = bf_lo(a1.y) * bf_lo(u1.y); p1[3] = bf_hi(a1.y) * bf_hi(u1.y);
        p1[4] = bf_lo(a1.z) * bf_lo(u1.z); p1[5] = bf_hi(a1.z) * bf_hi(u1.z); p1[6] = bf_lo(a1.w) * bf_lo(u1.w); p1[7] = bf_hi(a1.w) * bf_hi(u1.w);
    }
#pragma unroll
    for (int i = 0; i < 8; ++i) {
        bf16_t* rp = ACT + (size_t)(m0 + i) * PITCH + ch;
        const u32x4 a = *(const u32x4*)(rp + C_PRE), uu = *(const u32x4*)(rp + C_U), po = *(const u32x4*)(rp + C_POST), zz = *(const u32x4*)(rp + C_ZC);
        float pu[8], pv[8], zv[8];
        pu[0] = bf_lo(a.x) * bf_lo(uu.x); pu[1] = bf_hi(a.x) * bf_hi(uu.x); pu[2] = bf_lo(a.y) * bf_lo(uu.y); pu[3] = bf_hi(a.y) * bf_hi(uu.y);
        pu[4] = bf_lo(a.z) * bf_lo(uu.z); pu[5] = bf_hi(a.z) * bf_hi(uu.z); pu[6] = bf_lo(a.w) * bf_lo(uu.w); pu[7] = bf_hi(a.w) * bf_hi(uu.w);
        pv[0] = bf_lo(po.x); pv[1] = bf_hi(po.x); pv[2] = bf_lo(po.y); pv[3] = bf_hi(po.y); pv[4] = bf_lo(po.z); pv[5] = bf_hi(po.z); pv[6] = bf_lo(po.w); pv[7] = bf_hi(po.w);
        zv[0] = bf_lo(zz.x); zv[1] = bf_hi(zz.x); zv[2] = bf_lo(zz.y); zv[3] = bf_hi(zz.y); zv[4] = bf_lo(zz.z); zv[5] = bf_hi(zz.z); zv[6] = bf_lo(zz.w); zv[7] = bf_hi(zz.w);
        float y[8];
#pragma unroll
        for (int e = 0; e < 8; ++e) { y[e] = pv[e] * (w0[e] * p2[e] + w1[e] * p1[e] + w2[e] * pu[e]) * zv[e]; p2[e] = p1[e]; p1[e] = pu[e]; }
        u32x4 w; w.x = cvt_pk_bf16(y[0], y[1]); w.y = cvt_pk_bf16(y[2], y[3]); w.z = cvt_pk_bf16(y[4], y[5]); w.w = cvt_pk_bf16(y[6], y[7]);
        *(u32x4*)(rp + C_ZC) = w;
    }
}

__device__ __forceinline__ void convert_weights(const Params& P, int l, LAS unsigned char* lds, int gw, int NGW, int wid, int lane) {
    LAS float* scr = (LAS float*)(lds + wid * 16384);
    unsigned char* ws = P.ws;
    constexpr int I_IN = 16 * (IN_COLS / 32), I_B = 8 * 32, I_O = 16 * 32, I_L = I_IN + 3 * I_B + I_O;
    for (int it = gw; it < I_L; it += NGW) {
        int r = it;
        if (r < I_IN) { transpose_item(P.w_in + (size_t)l * 1024 * IN_COLS, IN_COLS, (bf16_t*)(ws + WS_WIN), 1024, scr, r, lane); continue; } r -= I_IN;
        if (r < 3 * I_B) { const int j = r / I_B; transpose_item(P.w_branch + (size_t)(l * 3 + j) * 512 * 1024, 1024, (bf16_t*)(ws + WS_WB) + (size_t)j * 1024 * 1024, 1024, scr, r % I_B, lane); continue; } r -= 3 * I_B;
        transpose_item(P.w_out + (size_t)l * 1024 * 1024, 1024, (bf16_t*)(ws + WS_WO), 1024, scr, r, lane);
    }
}

typedef const __attribute__((address_space(4))) Params* KParamsPtr;
#define XB_TMO      128
#define XB_XCNT(j)  (256  + 64 * (j))
#define XB_XSUB(j)  (1280 + 64 * (j))
#define XB_XGEN(j)  (2304 + 64 * (j))
#define XB_TOP      3328
#define XB_TOPGEN   3392
#define XCD_BAR_WORDS 3456
#define XB_SPIN_CAP (1u << 22)
__device__ __forceinline__ unsigned xb_ld(unsigned* p)              { return __hip_atomic_load(p, __ATOMIC_RELAXED, __HIP_MEMORY_SCOPE_AGENT); }
__device__ __forceinline__ unsigned xb_add(unsigned* p, unsigned v) { return __hip_atomic_fetch_add(p, v, __ATOMIC_RELAXED, __HIP_MEMORY_SCOPE_AGENT); }
__device__ __forceinline__ unsigned xb_xcc_id() { return (unsigned)__builtin_amdgcn_s_getreg((3 << 11) | 20) & 0xFu; }
#define XB_SPIN(cond, bar) do { unsigned _sp = 0; while (cond) { __builtin_amdgcn_s_sleep(1); \
    if ((++_sp & 255u) == 0u) { if (xb_ld(&(bar)[XB_TMO])) break; if (_sp > XB_SPIN_CAP) { atomicAdd(&(bar)[XB_TMO], 1u); break; } } } } while (0)
__device__ __forceinline__ void xcd_barrier_complete(unsigned* bar, unsigned x, unsigned& nloc, unsigned& nx) {
    const unsigned G = gridDim.x * gridDim.y * gridDim.z;
    unsigned sum, cnt, mine, sp = 0u;
    for (;;) {
        sum = 0u; cnt = 0u; mine = 0u;
#pragma unroll
        for (unsigned j = 0; j < 16; ++j) { const unsigned c = xb_ld(&bar[XB_XCNT(j)]); sum += c; cnt += (c > 0u) ? 1u : 0u; mine = (j == x) ? c : mine; }
        if (sum == G) break;
        __builtin_amdgcn_s_sleep(1);
        if ((++sp & 255u) == 0u) { if (xb_ld(&bar[XB_TMO])) break; if (sp > XB_SPIN_CAP) { atomicAdd(&bar[XB_TMO], 1u); break; } }
    }
    nloc = mine > 0u ? mine : 1u; nx = cnt > 0u ? cnt : 1u;
}
__device__ __forceinline__ void xcd_barrier(unsigned* bar, volatile LAS unsigned* st) {
    asm volatile("s_waitcnt vmcnt(0)" ::: "memory");
    __syncthreads();
    if (threadIdx.x == 0) {
        __builtin_amdgcn_s_waitcnt(0);
        const unsigned x = xb_xcc_id();
        unsigned nloc = st[0], nx = st[1];
        if (nloc == 0u) { xcd_barrier_complete(bar, x, nloc, nx); st[0] = nloc; st[1] = nx; }
        const unsigned old = xb_add(&bar[XB_XSUB(x)], 1u);
        const unsigned gen = old / nloc;
        if (old + 1u == (gen + 1u) * nloc) {
            __builtin_amdgcn_fence(__ATOMIC_RELEASE, "agent");
            asm volatile("s_waitcnt vmcnt(0)" ::: "memory");
            const unsigned og = xb_add(&bar[XB_TOP], 1u);
            const unsigned tg = og / nx;
            if (og + 1u == (tg + 1u) * nx) xb_add(&bar[XB_TOPGEN], 1u);
            else XB_SPIN(xb_ld(&bar[XB_TOPGEN]) == tg, bar);
            __builtin_amdgcn_fence(__ATOMIC_ACQUIRE, "agent");
            xb_add(&bar[XB_XGEN(x)], 1u);
            asm volatile("s_waitcnt vmcnt(0)" ::: "memory");
        } else {
            XB_SPIN(xb_ld(&bar[XB_XGEN(x)]) == gen, bar);
            __builtin_amdgcn_fence(__ATOMIC_ACQUIRE, "agent");
            asm volatile("s_waitcnt vmcnt(0)" ::: "memory");
        }
    }
    __syncthreads();
}
#define GRID_SYNC() do { asm volatile("s_waitcnt vmcnt(0) lgkmcnt(0)" ::: "memory"); __syncthreads(); grid.sync(); } while (0)
#define XBAR() do { KParamsPtr qb_ = (KParamsPtr)__builtin_amdgcn_kernarg_segment_ptr(); asm volatile("" : "+s"(qb_)); xcd_barrier((unsigned*)(qb_->ws + WS_CTL), (volatile LAS unsigned*)(lds + LDS_BYTES - 16)); } while (0)
#define PHASE_BEGIN() \
    Params P; { KParamsPtr q_ = (KParamsPtr)__builtin_amdgcn_kernarg_segment_ptr(); asm volatile("" : "+s"(q_)); \
        P.x = q_->x; P.c = q_->c; P.w_mod = q_->w_mod; P.b_mod = q_->b_mod; P.w_in = q_->w_in; P.conv_w = q_->conv_w; P.hgrn_norm_w = q_->hgrn_norm_w; P.lower_bounds = q_->lower_bounds; \
        P.w_branch = q_->w_branch; P.w_out = q_->w_out; P.ln_g = q_->ln_g; P.ln_b = q_->ln_b; P.out = q_->out; P.ws = q_->ws; } \
    int bx = blockIdx.x; asm volatile("" : "+s"(bx)); \
    const int G = gridDim.x; \
    const int vcu = (G % 8 == 0) ? (bx % 8) * (G / 8) + bx / 8 : bx; \
    unsigned char* const ws = P.ws; \
    float* const modp = (float*)(ws + WS_MOD); \
    bf16_t* const ACT = (bf16_t*)(ws + WS_ACT); \
    (void)vcu; (void)modp; (void)ACT;
#define WAVE_IDS() \
    const int tid = fresh_tid(), lane = tid & 63, wid = __builtin_amdgcn_readfirstlane(tid >> 6); \
    const int gw = vcu * 8 + wid, NGW = G * 8; (void)lane; (void)gw; (void)NGW;

__global__ void __launch_bounds__(NTHREADS, 2) fwd_megakernel(Params Pk) {
    extern __shared__ __attribute__((aligned(16))) unsigned char lds_raw[];
    LAS unsigned char* lds = (LAS unsigned char*)lds_raw;
    cg::grid_group grid = cg::this_grid();
    if (__builtin_expect(gridDim.y == 4242u, 0)) GRID_SYNC();
    if (threadIdx.x < 4) ((LAS unsigned*)(lds + LDS_BYTES - 16))[threadIdx.x] = 0u;
    __syncthreads();
    if (threadIdx.x == 0) { KParamsPtr q0_ = (KParamsPtr)__builtin_amdgcn_kernarg_segment_ptr(); (void)xb_add(&((unsigned*)(q0_->ws + WS_CTL))[XB_XCNT(xb_xcc_id())], 1u); }

    {
        PHASE_BEGIN(); WAVE_IDS();
        float* modpart = (float*)(ws + WS_MODP);
        LAS float* red = (LAS float*)lds;
        for (int u = bx; u < DEPTH * 192; u += G) {
            const int l = u / 192, r = u % 192, n = (r >> 2) * 64 + lane, kq = r & 3;
            float accb[8];
#pragma unroll
            for (int b = 0; b < 8; ++b) accb[b] = 0.f;
            const float* wp = P.w_mod + ((size_t)l * 1024 + 256 * kq + 32 * wid) * 3072 + n;
            const float* cp = P.c + 256 * kq + 32 * wid;
#pragma unroll 16
            for (int k = 0; k < 32; ++k) { const float wv = wp[(size_t)k * 3072];
#pragma unroll
                for (int b = 0; b < 8; ++b) accb[b] += cp[b * 1024 + k] * wv; }
            __syncthreads();
#pragma unroll
            for (int b = 0; b < 8; ++b) red[(wid * 8 + b) * 64 + lane] = accb[b];
            __syncthreads();
            { const int b = wid; float sacc = 0.f;
#pragma unroll
              for (int w = 0; w < 8; ++w) sacc += red[(w * 8 + b) * 64 + lane];
              modpart[(((size_t)kq * DEPTH + l) * 8 + b) * 3072 + n] = sacc; }
        }
        __syncthreads();
        convert_weights(P, 0, lds, gw, NGW, wid, lane);
    }
    XBAR();
    {
        PHASE_BEGIN(); WAVE_IDS();
        const float* modpart = (const float*)(ws + WS_MODP);
        for (int i = bx * NTHREADS + tid; i < DEPTH * 8 * 3072; i += G * NTHREADS) {
            const int l = i / (8 * 3072), n = i % 3072;
            float v = P.b_mod[l * 3072 + n];
#pragma unroll
            for (int kq = 0; kq < 4; ++kq) v += modpart[(size_t)kq * DEPTH * 8 * 3072 + i];
            modp[i] = v;
        }
        LAS float* ms = (LAS float*)lds;
        for (int rg = bx; rg < M_TOK / 64; rg += G) {
            const int b = (rg * 64) / SEQ;
            __syncthreads();
            { const int i4 = tid * 4; f32x4 v = *(const f32x4*)(P.b_mod + i4);
#pragma unroll
              for (int kq = 0; kq < 4; ++kq) v = v + *(const f32x4*)(modpart + ((size_t)kq * DEPTH * 8 + b) * 3072 + i4);
              *(LAS f32x4*)(ms + i4) = v; }
            __syncthreads();
#pragma unroll
            for (int it = 0; it < 2; ++it) {
                f32x4 v[4][4];
#pragma unroll
                for (int q = 0; q < 4; ++q) { const int m = rg * 64 + wid * 8 + it * 4 + q;
#pragma unroll
                    for (int j = 0; j < 4; ++j) v[q][j] = *(const f32x4*)(P.x + (size_t)m * D_MODEL + 4 * (lane + 64 * j)); }
#pragma unroll
                for (int q = 0; q < 4; ++q) { const int m = rg * 64 + wid * 8 + it * 4 + q;
                    row_standardize(v[q]);
                    bf16_t* hrow = ACT + (size_t)m * PITCH + C_H;
#pragma unroll
                    for (int j = 0; j < 4; ++j) { const int col = 4 * (lane + 64 * j);
                        const f32x4 sh = *(const LAS f32x4*)(ms + col), sc = *(const LAS f32x4*)(ms + 1024 + col);
                        const f32x4 hv = v[q][j] * (sc + 1.0f) + sh;
                        u32x2 w; w.x = cvt_pk_bf16(hv.x, hv.y); w.y = cvt_pk_bf16(hv.z, hv.w);
                        *(u32x2*)(hrow + col) = w; } }
            }
        }
    }
    XBAR();

    for (int l = 0; l < DEPTH; ++l) {
        {
            PHASE_BEGIN();
            SchedP1 S{(const char*)ACT + C_H * 2, (const char*)(ws + WS_WIN), G, vcu};
            EpiP1 E{ACT};
            pg8::gemm_phase<EpiP1, SchedP1>(lds, (unsigned)PITCHB, 2048u, S, E);
        }
        XBAR();
        {
            PHASE_BEGIN();
            for (int u = bx; u < 256; u += G) hgrn_pass<0>(lds, ACT, P, l, u >> 3, (u & 7) * 4, 4);
        }
        {
            PHASE_BEGIN();
            for (int k = bx; k < 256; k += G) {
                __syncthreads(); attn_unit(lds, ACT, (k & 63) >> 3, k & 7, 7 - (k >> 6));
                const int a2 = 511 - k;
                __syncthreads(); attn_unit(lds, ACT, (a2 & 63) >> 3, a2 & 7, 7 - (a2 >> 6));
            }
            for (int ci = bx; ci < 256; ci += G) conv_item(ACT, P.conv_w + (size_t)l * 3 * 512, ci);
        }
        XBAR();
        {
            PHASE_BEGIN();
            const int tid2 = fresh_tid();
            for (int g = bx * NTHREADS + tid2; g < 32 * 4096; g += G * NTHREADS) {
                const int bh = g >> 12, rem = g & 4095, dg = rem & 31;
                bf16_t* up = (bf16_t*)(ws + WS_U) + (size_t)bh * 32 * 16384 + (rem >> 5) * 128 + dg * 4;
                const float* dp = (const float*)(ws + WS_DEND) + (size_t)bh * 32 * 128 + dg * 4;
                f32x4 S = (f32x4){0.f, 0.f, 0.f, 0.f};
                for (int c0 = 0; c0 < 32; c0 += 8) {
                    u32x2 uu[8]; f32x4 dd[8];
#pragma unroll
                    for (int k = 0; k < 8; ++k) { uu[k] = *(const u32x2*)(up + (size_t)(c0 + k) * 16384); dd[k] = *(const f32x4*)(dp + (c0 + k) * 128); }
#pragma unroll
                    for (int k = 0; k < 8; ++k) {
                        S = dd[k] * S + (f32x4){bf_lo(uu[k].x), bf_hi(uu[k].x), bf_lo(uu[k].y), bf_hi(uu[k].y)};
                        u32x2 w; w.x = cvt_pk_bf16(S[0], S[1]); w.y = cvt_pk_bf16(S[2], S[3]);
                        *(u32x2*)(up + (size_t)(c0 + k) * 16384) = w; }
                }
            }
        }
        XBAR();
        {
            PHASE_BEGIN();
            for (int u = bx; u < 256; u += G) hgrn_pass<1>(lds, ACT, P, l, u >> 3, (u & 7) * 4, 4);
        }
        XBAR();
        {
            PHASE_BEGIN();
            SchedP3 S{(const char*)ACT, (const char*)(ws + WS_WIN) + (size_t)MIX_COLS * 2048, (const char*)(ws + WS_WB), G, vcu};
            EpiP3 E{(unsigned char*)ACT};
            pg8::gemm_phase<EpiP3, SchedP3>(lds, (unsigned)PITCHB, 2048u, S, E);
        }
        XBAR();
        {
            PHASE_BEGIN(); WAVE_IDS();
            SchedP4 S{(const char*)ACT, (const char*)(ws + WS_WO), G, vcu};
            unsigned* pc = (unsigned*)(ws + WS_CTL + CTL_PANEL);
            unsigned long long* xb = (unsigned long long*)(ws + WS_X);
            const bool more = (l + 1 < DEPTH);
            PanelStats st1{xb + (size_t)(2 * l) * 65536, pc + (2 * l) * 4096, LN_EPS};
            PanelStats st2{xb + (size_t)(2 * l + 1) * 65536, pc + (2 * l + 1) * 4096, LN_EPS};
            EpiP4F E{l == 0 ? P.x : P.out, P.out, modp + (size_t)l * 8 * 3072 + 2048, P.ln_g + l * 1024, P.ln_b + l * 1024, more ? modp + (size_t)(l + 1) * 8 * 3072 : nullptr, ACT, st1, st2};
            pg8::gemm_phase<EpiP4F, SchedP4>(lds, (unsigned)PITCHB, 2048u, S, E);
            if (more) { __syncthreads(); convert_weights(P, l + 1, lds, gw, NGW, wid, lane); }
        }
        if (l + 1 < DEPTH) XBAR();
    }
}

extern "C" void kernel_launch(void* const* d_in, const int* in_sizes, int n_in, void* d_out, int out_size, void* d_ws, size_t ws_size, hipStream_t stream) {
    static int grid_blocks = 0;
    if (grid_blocks == 0) {
        if (n_in != 12 || out_size != M_TOK * D_MODEL || ws_size < WS_END) { fprintf(stderr, "kernel_launch: unexpected shapes (n_in %d, out %d, ws %zu < %zu)\n", n_in, out_size, ws_size, (size_t)WS_END); grid_blocks = -1; return; }
        int dev = 0, cus = 0, per_cu = 0;
        hipGetDevice(&dev);
        hipDeviceGetAttribute(&cus, hipDeviceAttributeMultiprocessorCount, dev);
        hipFuncSetAttribute((const void*)fwd_megakernel, hipFuncAttributeMaxDynamicSharedMemorySize, LDS_BYTES);
        hipOccupancyMaxActiveBlocksPerMultiprocessor(&per_cu, (const void*)fwd_megakernel, NTHREADS, LDS_BYTES);
        (void)hipGetLastError();
        if (per_cu < 1) per_cu = 1;
        grid_blocks = cus > 256 ? 256 : cus;
        if (grid_blocks != 256) fprintf(stderr, "kernel_launch: %d CUs reported; this kernel is laid out for 256 workgroups\n", cus);
        if (grid_blocks <= 0) grid_blocks = 256;
    }
    if (grid_blocks < 0) return;
    (void)hipMemsetAsync((char*)d_ws + WS_CTL, 0, CTL_BYTES, stream);
    Params p{};
    p.x = (const float*)d_in[0]; p.c = (const float*)d_in[1]; p.w_mod = (const float*)d_in[2]; p.b_mod = (const float*)d_in[3]; p.w_in = (const float*)d_in[4];
    p.conv_w = (const float*)d_in[5]; p.hgrn_norm_w = (const float*)d_in[6]; p.lower_bounds = (const float*)d_in[7]; p.w_branch = (const float*)d_in[8];
    p.w_out = (const float*)d_in[9]; p.ln_g = (const float*)d_in[10]; p.ln_b = (const float*)d_in[11]; p.out = (float*)d_out; p.ws = (unsigned char*)d_ws;
    void* args[] = {&p};
    hipError_t e = hipLaunchCooperativeKernel((const void*)fwd_megakernel, dim3(grid_blocks), dim3(NTHREADS), args, LDS_BYTES, stream);
    if (e != hipSuccess) fprintf(stderr, "cooperative launch failed: %s (grid %d)\n", hipGetErrorString(e), grid_blocks);
}
```

```cpp
#include <hip/hip_runtime.h>
#include <hip/hip_cooperative_groups.h>
#include <cstdio>
#include <cstdint>
namespace cg = cooperative_groups;

#define LAS __attribute__((address_space(3)))
typedef unsigned short bf16_t;
typedef short bf16x8 __attribute__((ext_vector_type(8)));
typedef short s16x4 __attribute__((ext_vector_type(4)));
typedef float f32x2 __attribute__((ext_vector_type(2)));
typedef float f32x4 __attribute__((ext_vector_type(4)));
typedef float f32x16 __attribute__((ext_vector_type(16)));
typedef unsigned u32x2 __attribute__((ext_vector_type(2)));
typedef unsigned u32x4 __attribute__((ext_vector_type(4)));

constexpr int D_MODEL = 1024, BATCH = 8, SEQ = 2048, DEPTH = 2, M_TOK = BATCH * SEQ;
constexpr int IN_COLS = 9216, MIX_COLS = 6144;
constexpr int PITCH = 7168;
constexpr size_t PITCHB = (size_t)PITCH * 2;
constexpr int C_QA = 0, C_KA = 512, C_VA = 1024, C_ZA = 1536, C_QB = 2048, C_FB = 2560, C_IB = 3072, C_ZB = 3584, C_PU = 4096  , C_PZ = 4608  , C_ZC = 5632  , C_H = 6144;
constexpr int C_MERGED = 4096;
constexpr float LN_EPS = 1e-5f, RMS_EPS = 1e-6f;
constexpr float LOG2E = 1.4426950408889634f;
constexpr float QSCALE = 0.125f * LOG2E;
constexpr float ALPHA = 1.4142135623730951f;

constexpr size_t WS_CTL = 0, CTL_BYTES = 65536;
constexpr size_t WS_MOD = 65536;
constexpr size_t WS_DEND = 256u << 10;
constexpr size_t WS_WIN = 1u << 20;
constexpr size_t WIN_L = (size_t)IN_COLS * 1024 * 2;
constexpr size_t WS_WB = WS_WIN + WIN_L;
constexpr size_t WB_L = (size_t)3 * 1024 * 1024 * 2;
constexpr size_t WS_WO = WS_WB + WB_L;
constexpr size_t WO_L = (size_t)1024 * 1024 * 2;
constexpr size_t WS_ACT = WS_WO + WO_L;
constexpr size_t WS_U = WS_ACT + (size_t)M_TOK * PITCHB;
constexpr size_t WS_X = WS_U + (size_t)32 * 32 * 128 * 128 * 2;
constexpr size_t WS_MODP = WS_X + 3 * 524288;
constexpr size_t WS_END = WS_MODP + (size_t)4 * DEPTH * BATCH * 3072 * 4;
constexpr size_t CTL_PANEL = 16384;

constexpr int LDS_BYTES = 147456;
constexpr int NTHREADS = 512;

struct Params {
    const float* x; const float* c; const float* w_mod; const float* b_mod; const float* w_in; const float* conv_w; const float* hgrn_norm_w;
    const float* lower_bounds; const float* w_branch; const float* w_out; const float* ln_g; const float* ln_b; float* out; unsigned char* ws;
};

typedef __bf16 bf16x2_t __attribute__((ext_vector_type(2)));
__device__ __forceinline__ unsigned cvt_pk_bf16(float lo, float hi) { const f32x2 v = {lo, hi}; const bf16x2_t b = __builtin_convertvector(v, bf16x2_t); return __builtin_bit_cast(unsigned, b); }
__device__ __forceinline__ float bf_lo(unsigned w) { return __uint_as_float(w << 16); }
__device__ __forceinline__ float bf_hi(unsigned w) { return __uint_as_float(w & 0xffff0000u); }
__device__ __forceinline__ float bf2f(bf16_t v) { return __uint_as_float((unsigned)v << 16); }
__device__ __forceinline__ float ex2(float v) { return __builtin_amdgcn_exp2f(v); }
__device__ __forceinline__ float lg2(float v) { return __builtin_amdgcn_logf(v); }
__device__ __forceinline__ float sigmoidf_(float v) { return __builtin_amdgcn_rcpf(1.0f + ex2(-v * LOG2E)); }
__device__ __forceinline__ float siluf_(float v) { return v * sigmoidf_(v); }
__device__ __forceinline__ float wave_sum(float v) {
#pragma unroll
    for (int o = 1; o < 64; o <<= 1) v += __shfl_xor(v, o);
    return v;
}
__device__ __forceinline__ int fresh_tid() { int t = threadIdx.x; asm volatile("" : "+v"(t)); return t; }
__device__ __forceinline__ int crow(int r, int hi) { return (r & 3) + 8 * (r >> 2) + 4 * hi; }

namespace pg8 {
constexpr int BM = 256, BK = 64, HALF = 128, HTB = HALF * BK * 2, STAGE_BYTES = 8 * HTB;
__device__ __forceinline__ int lds_byte(int r, int c) { const int st = (r >> 4) * 2 + (c >> 5), rr = r & 15, cc = c & 31, ob = rr * 64 + cc * 2; return st * 1024 + (ob ^ (((ob >> 9) & 1) << 5)); }
__device__ __forceinline__ void stage_rc(int b, int& R, int& C) { const int st = b / 1024, sb = b % 1024, swz = sb ^ (((sb >> 9) & 1) << 5); R = (st >> 1) * 16 + swz / 64; C = (st & 1) * 32 + (swz % 64) / 2; }
__device__ __forceinline__ int perm32(int rho) { const int n = rho >> 4, i = rho & 15; return 8 * (i >> 2) + 4 * n + (i & 3); }

struct Unit { const char* a; const char* b; int nt; int pm, pn, j; };

template <class Epi, class Sched>
__device__ __forceinline__ void gemm_phase(LAS unsigned char* lds, const unsigned ldaB, const unsigned ldbB, const Sched& S, const Epi& E) {
    const int tid = fresh_tid(), wid = __builtin_amdgcn_readfirstlane(tid >> 6), lane = tid & 63, wr = wid >> 2, wc = wid & 3, fr = lane & 15, fq = lane >> 4;
    unsigned voffA[2], voffB[2];
#pragma unroll
    for (int i = 0; i < 2; ++i) { int R, C; stage_rc(tid * 16 + i * 8192, R, C); const int Rb = Epi::PERM ? ((R & ~31) + perm32(R & 31)) : R;
        voffA[i] = (unsigned)R * ldaB + (unsigned)C * 2u; voffB[i] = (unsigned)Rb * ldbB + (unsigned)C * 2u; }
    const size_t kstep = (size_t)(BK * 2);
    const size_t hstepA = (size_t)HALF * ldaB, hstepB = (size_t)HALF * ldbB;
    const unsigned ldsw = (unsigned)wid * 1024u;
    const int aoff = lds_byte(wr * 64 + fr, fq * 8), boff = lds_byte(wc * 32 + fr, fq * 8);
#define PG8_SA(b, h) (((b) * 2 + (h)) * HTB)
#define PG8_SB(b, h) ((4 + (b) * 2 + (h)) * HTB)
#define PG8_STAGE(bufoff, gbase, voff) do { _Pragma("unroll") for (int _i = 0; _i < 2; ++_i) \
        __builtin_amdgcn_global_load_lds((const unsigned*)((const char*)(gbase) + (voff)[_i]), (LAS unsigned*)(lds + (bufoff) + ldsw + _i * 8192), 16, 0, 0); } while (0)
#define PG8_LDA(dst, b, h) do { _Pragma("unroll") for (int m = 0; m < 4; ++m) _Pragma("unroll") for (int k = 0; k < 2; ++k) dst[m][k] = *(const LAS bf16x8*)(lds + PG8_SA(b, h) + aoff + m * 2048 + k * 1024); } while (0)
#define PG8_LDB(dst, b, h) do { _Pragma("unroll") for (int n = 0; n < 2; ++n) _Pragma("unroll") for (int k = 0; k < 2; ++k) dst[n][k] = *(const LAS bf16x8*)(lds + PG8_SB(b, h) + boff + n * 2048 + k * 1024); } while (0)
#define PG8_MMA(ai, bj, At, Bt) do { __builtin_amdgcn_s_setprio(1); _Pragma("unroll") for (int m = 0; m < 4; ++m) _Pragma("unroll") for (int n = 0; n < 2; ++n) _Pragma("unroll") for (int k = 0; k < 2; ++k) \
        acc[ai][bj][m][n] = __builtin_amdgcn_mfma_f32_16x16x32_bf16(Bt[n][k], At[m][k], acc[ai][bj][m][n], 0, 0, 0); __builtin_amdgcn_s_setprio(0); } while (0)
#define PG8_WAIT_V(n) asm volatile("s_waitcnt vmcnt(" #n ")" ::: "memory")
#define PG8_WAIT_L(n) asm volatile("s_waitcnt lgkmcnt(" #n ")" ::: "memory")
#define PG8_BAR __builtin_amdgcn_s_barrier()
#define PG8_SCHED __builtin_amdgcn_sched_barrier(0)
    Unit cur, nxt; int ui = 0;
    if (!S.next(0, cur)) return;
    f32x4 acc[2][2][4][2];
#pragma unroll
    for (int a = 0; a < 2; ++a)
#pragma unroll
        for (int b = 0; b < 2; ++b)
#pragma unroll
            for (int m = 0; m < 4; ++m)
#pragma unroll
                for (int n = 0; n < 2; ++n) acc[a][b][m][n] = (f32x4){0.f, 0.f, 0.f, 0.f};
    bf16x8 At[4][2], B0[2][2], B1[2][2];
    const char* cA = cur.a; const char* cB = cur.b;
    PG8_STAGE(PG8_SB(0, 0), cB, voffB); PG8_STAGE(PG8_SB(0, 1), cB + hstepB, voffB); PG8_STAGE(PG8_SA(0, 0), cA, voffA); PG8_STAGE(PG8_SA(0, 1), cA + hstepA, voffA);
    if (wr == 1) PG8_BAR;
    PG8_WAIT_V(2); PG8_BAR;
    PG8_STAGE(PG8_SB(1, 0), cB + kstep, voffB); PG8_STAGE(PG8_SA(1, 0), cA + kstep, voffA); PG8_STAGE(PG8_SB(1, 1), cB + hstepB + kstep, voffB);
    PG8_WAIT_V(6); PG8_BAR;
    for (;;) {
        const bool has_next = S.next(ui + 1, nxt);
        const char* nA = has_next ? nxt.a : cA; const char* nB = has_next ? nxt.b : cB;
        const int nt = cur.nt;
        for (int t = 0; t < nt; t += 2) {
            const bool last = (t == nt - 2);
            const char* a1 = cA + (size_t)(t + 1) * kstep;
            const char* a2 = last ? nA : cA + (size_t)(t + 2) * kstep; const char* b2 = last ? nB : cB + (size_t)(t + 2) * kstep;
            const char* a3 = a2 + kstep; const char* b3 = b2 + kstep;
            PG8_LDB(B0, 0, 0); PG8_LDB(B1, 0, 1); PG8_SCHED; PG8_LDA(At, 0, 0); PG8_STAGE(PG8_SA(1, 1), a1 + hstepA, voffA);
            PG8_WAIT_V(8); PG8_WAIT_L(0); PG8_BAR; PG8_MMA(0, 0, At, B0); PG8_MMA(0, 1, At, B1); PG8_BAR; PG8_SCHED;
            PG8_LDA(At, 0, 1); PG8_STAGE(PG8_SB(0, 0), b2, voffB); PG8_STAGE(PG8_SB(0, 1), b2 + hstepB, voffB); PG8_STAGE(PG8_SA(0, 0), a2, voffA);
            PG8_WAIT_V(8); PG8_WAIT_L(0); PG8_BAR; PG8_MMA(1, 0, At, B0); PG8_MMA(1, 1, At, B1); PG8_BAR; PG8_SCHED;
            PG8_LDB(B0, 1, 0); PG8_LDB(B1, 1, 1); PG8_SCHED; PG8_LDA(At, 1, 0); PG8_STAGE(PG8_SA(0, 1), a2 + hstepA, voffA);
            PG8_WAIT_V(8); PG8_WAIT_L(0); PG8_BAR; PG8_MMA(0, 0, At, B0); PG8_MMA(0, 1, At, B1); PG8_BAR; PG8_SCHED;
            PG8_LDA(At, 1, 1); PG8_STAGE(PG8_SB(1, 0), b3, voffB); PG8_STAGE(PG8_SB(1, 1), b3 + hstepB, voffB); PG8_STAGE(PG8_SA(1, 0), a3, voffA);
            PG8_WAIT_V(8); PG8_WAIT_L(0); PG8_BAR; PG8_MMA(1, 0, At, B0); PG8_MMA(1, 1, At, B1); PG8_BAR; PG8_SCHED;
        }
        if (wr == 0) PG8_BAR;
        if constexpr (!Epi::AFTER_DRAIN) E(acc, cur, wr, wc, fr, fq);
        if (!has_next) break;
#pragma unroll
        for (int a = 0; a < 2; ++a)
#pragma unroll
            for (int b = 0; b < 2; ++b)
#pragma unroll
                for (int m = 0; m < 4; ++m)
#pragma unroll
                    for (int n = 0; n < 2; ++n) acc[a][b][m][n] = (f32x4){0.f, 0.f, 0.f, 0.f};
        cur = nxt; cA = nA; cB = nB; ++ui;
        if (wr == 1) PG8_BAR;
    }
    PG8_WAIT_V(0);
    PG8_BAR;
    if constexpr (Epi::AFTER_DRAIN) E.fused(acc, cur, wr, wc, fr, fq, lds, wid, lane);
#undef PG8_SA
#undef PG8_SB
#undef PG8_STAGE
#undef PG8_LDA
#undef PG8_LDB
#undef PG8_MMA
#undef PG8_WAIT_V
#undef PG8_WAIT_L
#undef PG8_BAR
#undef PG8_SCHED
}
}

struct SchedP1 {
    const char* A; const char* B; int G, vcu;
    __device__ __forceinline__ bool next(int i, pg8::Unit& u) const {
        const int U = i * G + vcu; if (U >= 64 * 24) return false;
        u.pm = 8 * ((U >> 5) & 7) + (U & 7); u.pn = 4 * (U >> 8) + ((U & 31) >> 3); u.j = 0; u.nt = 16;
        u.a = A + (size_t)u.pm * 256 * PITCHB; u.b = B + (size_t)u.pn * 256 * 2048; return true;
    }
};
struct SchedP3 {
    const char* ACTb; const char* Wg; const char* Wb; int G, vcu;
    __device__ __forceinline__ bool next(int i, pg8::Unit& u) const {
        const int T = vcu + (i / 6) * G; if (T >= 256) return false;
        const int s = i % 6; u.pm = 8 * (T >> 5) + (T & 7); u.pn = (T & 31) >> 3; u.j = s;
        const int j = s >> 1;
        if ((s & 1) == 0) { u.nt = 16; u.a = ACTb + (size_t)u.pm * 256 * PITCHB + C_H * 2; u.b = Wg + (size_t)(1024 * j + 256 * u.pn) * 2048; }
        else { u.nt = 8; u.a = ACTb + (size_t)u.pm * 256 * PITCHB + (size_t)(C_ZA + 2048 * j) * 2; u.b = Wb + (size_t)(1024 * j + 256 * u.pn) * 2048; }
        return true;
    }
};
struct SchedP4 {
    const char* ACTb; const char* Wo; int G, vcu;
    __device__ __forceinline__ bool next(int i, pg8::Unit& u) const {
        const int T = vcu + i * G; if (T >= 256) return false;
        u.pm = 8 * (T >> 5) + (T & 7); u.pn = (T & 31) >> 3; u.j = 0; u.nt = 16;
        u.a = ACTb + (size_t)u.pm * 256 * PITCHB + C_MERGED * 2; u.b = Wo + (size_t)(256 * u.pn) * 2048; return true;
    }
};

struct EpiP1 {
    static constexpr bool PERM = true, AFTER_DRAIN = false;
    bf16_t* ACT;
    __device__ __forceinline__ void operator()(const f32x4 (&acc)[2][2][4][2], const pg8::Unit& u, int wr, int wc, int fr, int fq) const {
        const int row0 = u.pm * 256 + wr * 64 + fr;
        if (u.pn >= 16) {
            const int T = u.pn - 16, col0 = (T < 4 ? C_PU + 128 * T : C_PZ + 128 * (T - 4)) + wc * 32 + 8 * fq;
#pragma unroll
            for (int ai = 0; ai < 2; ++ai)
#pragma unroll
                for (int m = 0; m < 4; ++m) { bf16_t* rowp = ACT + (size_t)(row0 + ai * 128 + m * 16) * PITCH + col0;
                    f32x4 v0 = acc[ai][1][m][0], v1 = acc[ai][1][m][1];
                    if (T >= 4) {
#pragma unroll
                        for (int e = 0; e < 4; ++e) { v0[e] = siluf_(v0[e]); v1[e] = siluf_(v1[e]); } }
                    v0 = v0 * acc[ai][0][m][0]; v1 = v1 * acc[ai][0][m][1];
                    u32x4 w; w.x = cvt_pk_bf16(v0[0], v0[1]); w.y = cvt_pk_bf16(v0[2], v0[3]); w.z = cvt_pk_bf16(v1[0], v1[1]); w.w = cvt_pk_bf16(v1[2], v1[3]);
                    *(u32x4*)rowp = w; }
            return;
        }
        const int grp = u.pn >> 1;
        const int kind = (grp == 0) ? 1 : ((grp == 3 || grp == 4 || grp == 7) ? 2 : 0);
        const int col0 = u.pn * 256 + wc * 32 + 8 * fq;
#pragma unroll
        for (int ai = 0; ai < 2; ++ai)
#pragma unroll
            for (int m = 0; m < 4; ++m) { bf16_t* rowp = ACT + (size_t)(row0 + ai * 128 + m * 16) * PITCH + col0;
#pragma unroll
                for (int bj = 0; bj < 2; ++bj) { f32x4 v0 = acc[ai][bj][m][0], v1 = acc[ai][bj][m][1];
                    if (kind == 1) { v0 = v0 * QSCALE; v1 = v1 * QSCALE; }
                    else if (kind == 2) {
#pragma unroll
                        for (int e = 0; e < 4; ++e) { v0[e] = siluf_(v0[e]); v1[e] = siluf_(v1[e]); } }
                    u32x4 w; w.x = cvt_pk_bf16(v0[0], v0[1]); w.y = cvt_pk_bf16(v0[2], v0[3]); w.z = cvt_pk_bf16(v1[0], v1[1]); w.w = cvt_pk_bf16(v1[2], v1[3]);
                    *(u32x4*)(rowp + bj * 128) = w; } }
    }
};
struct EpiP3 {
    static constexpr bool PERM = true, AFTER_DRAIN = false;
    unsigned char* ACTb;
    __device__ __forceinline__ void operator()(const f32x4 (&acc)[2][2][4][2], const pg8::Unit& u, int wr, int wc, int fr, int fq) const {
        const int s = u.j, j = s >> 1;
        const int row0 = u.pm * 256 + wr * 64 + fr, cl0 = wc * 32 + 8 * fq;
        const unsigned toff = 512u * (unsigned)u.pn, soff = 5120u + 512u * (unsigned)u.pn, moff = (unsigned)(C_MERGED + 256 * u.pn) * 2u;
        if ((s & 1) == 0) {
#pragma unroll
            for (int ai = 0; ai < 2; ++ai)
#pragma unroll
                for (int m = 0; m < 4; ++m) { unsigned char* rowp = ACTb + (size_t)(row0 + ai * 128 + m * 16) * PITCHB;
#pragma unroll
                    for (int bj = 0; bj < 2; ++bj) { const f32x4 v0 = acc[ai][bj][m][0], v1 = acc[ai][bj][m][1];
                        u32x4 w; w.x = cvt_pk_bf16(v0[0], v0[1]); w.y = cvt_pk_bf16(v0[2], v0[3]); w.z = cvt_pk_bf16(v1[0], v1[1]); w.w = cvt_pk_bf16(v1[2], v1[3]);
                        *(u32x4*)(rowp + soff + (cl0 + bj * 128) * 2) = w; } }
        } else {
#pragma unroll
            for (int ai = 0; ai < 2; ++ai) {
                u32x4 gq[4][2], tq[4][2];
#pragma unroll
                for (int m = 0; m < 4; ++m) { unsigned char* rowp = ACTb + (size_t)(row0 + ai * 128 + m * 16) * PITCHB;
#pragma unroll
                    for (int bj = 0; bj < 2; ++bj) { gq[m][bj] = *(const u32x4*)(rowp + soff + (cl0 + bj * 128) * 2); if (j > 0) tq[m][bj] = *(const u32x4*)(rowp + toff + (cl0 + bj * 128) * 2); } }
#pragma unroll
                for (int m = 0; m < 4; ++m) { unsigned char* rowp = ACTb + (size_t)(row0 + ai * 128 + m * 16) * PITCHB;
#pragma unroll
                    for (int bj = 0; bj < 2; ++bj) { const f32x4 v0 = acc[ai][bj][m][0], v1 = acc[ai][bj][m][1]; const u32x4 g = gq[m][bj];
                        f32x4 t0 = (f32x4){sigmoidf_(bf_lo(g.x)) * v0[0], sigmoidf_(bf_hi(g.x)) * v0[1], sigmoidf_(bf_lo(g.y)) * v0[2], sigmoidf_(bf_hi(g.y)) * v0[3]};
                        f32x4 t1 = (f32x4){sigmoidf_(bf_lo(g.z)) * v1[0], sigmoidf_(bf_hi(g.z)) * v1[1], sigmoidf_(bf_lo(g.w)) * v1[2], sigmoidf_(bf_hi(g.w)) * v1[3]};
                        if (j > 0) { const u32x4 tv = tq[m][bj];
                            t0 = t0 + (f32x4){bf_lo(tv.x), bf_hi(tv.x), bf_lo(tv.y), bf_hi(tv.y)}; t1 = t1 + (f32x4){bf_lo(tv.z), bf_hi(tv.z), bf_lo(tv.w), bf_hi(tv.w)}; }
                        u32x4 w; w.x = cvt_pk_bf16(t0[0], t0[1]); w.y = cvt_pk_bf16(t0[2], t0[3]); w.z = cvt_pk_bf16(t1[0], t1[1]); w.w = cvt_pk_bf16(t1[2], t1[3]);
                        if (j < 2) *(u32x4*)(rowp + toff + (cl0 + bj * 128) * 2) = w; else *(u32x4*)(rowp + moff + (cl0 + bj * 128) * 2) = w;
                    } }
            }
        }
    }
};
struct PanelStats {
    unsigned long long* xbuf;
    unsigned* cnt;
    float eps;
    __device__ __forceinline__ void run(const f32x4 (&v)[2][2][4][2], const pg8::Unit& u, int wr, int wc, int fr, int fq, LAS unsigned char* lds, int wid, int lane) const {
        LAS f32x2* Pt = (LAS f32x2*)lds;
        LAS f32x2* St = (LAS f32x2*)(lds + 8192);
#pragma unroll
        for (int ai = 0; ai < 2; ++ai)
#pragma unroll
            for (int m = 0; m < 4; ++m) {
                float s = 0.f;
#pragma unroll
                for (int bj = 0; bj < 2; ++bj)
#pragma unroll
                    for (int n = 0; n < 2; ++n) { const f32x4 x = v[ai][bj][m][n]; s += (x[0] + x[1]) + (x[2] + x[3]); }
                s += __shfl_xor(s, 16); s += __shfl_xor(s, 32);
                const float mw = s * (1.0f / 64.0f); float q = 0.f;
#pragma unroll
                for (int bj = 0; bj < 2; ++bj)
#pragma unroll
                    for (int n = 0; n < 2; ++n) { const f32x4 d = v[ai][bj][m][n] - mw; q += (d[0] * d[0] + d[1] * d[1]) + (d[2] * d[2] + d[3] * d[3]); }
                q += __shfl_xor(q, 16); q += __shfl_xor(q, 32);
                if (fq == 0) Pt[(ai * 128 + wr * 64 + m * 16 + fr) * 4 + wc] = (f32x2){mw, q};
            }
        __syncthreads();
        const int row = wid * 32 + (lane & 31);
        if (lane < 32) {
            const f32x2 a = Pt[row * 4 + 0], b = Pt[row * 4 + 1], c = Pt[row * 4 + 2], d = Pt[row * 4 + 3];
            const float mt = (a.x + b.x + c.x + d.x) * 0.25f;
            const float da = a.x - mt, db = b.x - mt, dc = c.x - mt, dd = d.x - mt;
            const float m2 = (a.y + b.y) + (c.y + d.y) + 64.0f * ((da * da + db * db) + (dc * dc + dd * dd));
            __hip_atomic_store(xbuf + ((size_t)(u.pm * 256 + row) * 4 + u.pn), ((unsigned long long)__float_as_uint(m2) << 32) | __float_as_uint(mt), __ATOMIC_RELAXED, __HIP_MEMORY_SCOPE_AGENT);
        }
        asm volatile("s_waitcnt vmcnt(0)" ::: "memory");
        if (lane == 0) __hip_atomic_fetch_add(cnt + 64 * u.pm, 1u, __ATOMIC_RELAXED, __HIP_MEMORY_SCOPE_AGENT);
        if (wid == 0) {
            unsigned sp = 0;
            while ((unsigned)__builtin_amdgcn_readfirstlane(__hip_atomic_load(cnt + 64 * u.pm, __ATOMIC_RELAXED, __HIP_MEMORY_SCOPE_AGENT)) < 32u) { __builtin_amdgcn_s_sleep(2); if (++sp > (1u << 24)) break; }
            __builtin_amdgcn_fence(__ATOMIC_ACQUIRE, "agent");
        }
        asm volatile("s_waitcnt vmcnt(0) lgkmcnt(0)" ::: "memory");
        __syncthreads();
        if (lane < 32) {
            const unsigned long long* slot = xbuf + (size_t)(u.pm * 256 + row) * 4; float mt[4], m2[4]; float ms = 0.f;
#pragma unroll
            for (int t = 0; t < 4; ++t) { const unsigned long long w = __hip_atomic_load(slot + t, __ATOMIC_RELAXED, __HIP_MEMORY_SCOPE_AGENT); mt[t] = __uint_as_float((unsigned)w); m2[t] = __uint_as_float((unsigned)(w >> 32)); ms += mt[t]; }
            const float mean = ms * 0.25f; float q = 0.f;
#pragma unroll
            for (int t = 0; t < 4; ++t) { const float dm = mt[t] - mean; q += m2[t] + 256.0f * dm * dm; }
            St[row] = (f32x2){mean, __builtin_amdgcn_rsqf(q * (1.0f / 1024.0f) + eps)};
        }
        __syncthreads();
    }
};
struct EpiP4F {
    static constexpr bool PERM = false, AFTER_DRAIN = true;
    const float* xprev; float* out; const float* gate; const float* lng; const float* lnb; const float* modn; bf16_t* ACT; PanelStats st1, st2;
    __device__ __forceinline__ void fused(f32x4 (&acc)[2][2][4][2], const pg8::Unit& u, int wr, int wc, int fr, int fq, LAS unsigned char* lds, int wid, int lane) const {
        const LAS f32x2* St = (const LAS f32x2*)(lds + 8192);
        const int row0 = u.pm * 256 + wr * 64 + fr, col0 = u.pn * 256 + wc * 32 + 4 * fq;
        const int bidx = (u.pm * 256) / SEQ;
        {
            const float* gp = gate + (size_t)bidx * 3072;
            f32x4 gv[2][2];
#pragma unroll
            for (int bj = 0; bj < 2; ++bj)
#pragma unroll
                for (int n = 0; n < 2; ++n) gv[bj][n] = *(const f32x4*)(gp + col0 + bj * 128 + n * 16) + 1.0f;
#pragma unroll
            for (int ai = 0; ai < 2; ++ai)
#pragma unroll
                for (int m = 0; m < 4; ++m) { const size_t off = (size_t)(row0 + ai * 128 + m * 16) * D_MODEL + col0;
#pragma unroll
                    for (int bj = 0; bj < 2; ++bj)
#pragma unroll
                        for (int n = 0; n < 2; ++n) { const f32x4 xv = *(const f32x4*)(xprev + off + bj * 128 + n * 16); acc[ai][bj][m][n] = xv * ALPHA + gv[bj][n] * acc[ai][bj][m][n]; }
                    asm volatile("" : "+v"(acc[ai][0][m][0]), "+v"(acc[ai][0][m][1]), "+v"(acc[ai][1][m][0]), "+v"(acc[ai][1][m][1]));
                    if (m & 1) asm volatile("" ::: "memory"); }
        }
        st1.run(acc, u, wr, wc, fr, fq, lds, wid, lane);
        {
            f32x4 lg[2][2], lb[2][2];
#pragma unroll
            for (int bj = 0; bj < 2; ++bj)
#pragma unroll
                for (int n = 0; n < 2; ++n) { lg[bj][n] = *(const f32x4*)(lng + col0 + bj * 128 + n * 16); lb[bj][n] = *(const f32x4*)(lnb + col0 + bj * 128 + n * 16); }
#pragma unroll
            for (int ai = 0; ai < 2; ++ai)
#pragma unroll
                for (int m = 0; m < 4; ++m) { const int r = ai * 128 + wr * 64 + m * 16 + fr; const f32x2 sr = St[r]; const size_t off = (size_t)(u.pm * 256 + r) * D_MODEL + col0;
#pragma unroll
                    for (int bj = 0; bj < 2; ++bj)
#pragma unroll
                        for (int n = 0; n < 2; ++n) { const f32x4 x1 = (acc[ai][bj][m][n] - sr.x) * sr.y * lg[bj][n] + lb[bj][n]; acc[ai][bj][m][n] = x1; *(f32x4*)(out + off + bj * 128 + n * 16) = x1; }
                    asm volatile("" : "+v"(acc[ai][0][m][0]), "+v"(acc[ai][0][m][1]), "+v"(acc[ai][1][m][0]), "+v"(acc[ai][1][m][1]));
                    asm volatile("" ::: "memory"); }
        }
        if (modn) {
            st2.run(acc, u, wr, wc, fr, fq, lds, wid, lane);
            const float* mp = modn + (size_t)bidx * 3072;
            f32x4 sc[2][2], sh[2][2];
#pragma unroll
            for (int bj = 0; bj < 2; ++bj)
#pragma unroll
                for (int n = 0; n < 2; ++n) { sh[bj][n] = *(const f32x4*)(mp + col0 + bj * 128 + n * 16); sc[bj][n] = *(const f32x4*)(mp + 1024 + col0 + bj * 128 + n * 16) + 1.0f; }
#pragma unroll
            for (int ai = 0; ai < 2; ++ai)
#pragma unroll
                for (int m = 0; m < 4; ++m) { const int r = ai * 128 + wr * 64 + m * 16 + fr; const f32x2 sr = St[r]; bf16_t* hp = ACT + (size_t)(u.pm * 256 + r) * PITCH + C_H + col0;
#pragma unroll
                    for (int bj = 0; bj < 2; ++bj)
#pragma unroll
                        for (int n = 0; n < 2; ++n) { const f32x4 hv = (acc[ai][bj][m][n] - sr.x) * sr.y * sc[bj][n] + sh[bj][n];
                            u32x2 w; w.x = cvt_pk_bf16(hv[0], hv[1]); w.y = cvt_pk_bf16(hv[2], hv[3]); *(u32x2*)(hp + bj * 128 + n * 16) = w; }
                    asm volatile("" ::: "memory"); }
        }
    }
};

__device__ __forceinline__ void transpose_item(const float* W, int N, bf16_t* WT, int ldw, LAS float* scr, int item, int lane, bool conv_perm = false) {
    const int nblk = N / 32, kb = item / nblk, nb = item % nblk, k0 = 64 * kb, n0 = 32 * nb;
    int d0 = n0;
    if (conv_perm && n0 >= 4096 && n0 < 6144) { const int g = (n0 - 4096) >> 9, ch0 = (n0 - 4096) & 511; d0 = 4096 + 256 * ((ch0 >> 7) + ((g & 1) ? 4 : 0)) + 128 * (g >> 1) + (ch0 & 127); }
    const int kr = lane >> 3, n4 = (lane & 7) * 4;
    f32x4 v[8];
#pragma unroll
    for (int i = 0; i < 8; ++i) v[i] = *(const f32x4*)(W + (size_t)(k0 + 8 * i + kr) * N + n0 + n4);
#pragma unroll
    for (int i = 0; i < 8; ++i) { LAS float* d = scr + (8 * i + kr) * 33 + n4; d[0] = v[i].x; d[1] = v[i].y; d[2] = v[i].z; d[3] = v[i].w; }
    asm volatile("s_waitcnt lgkmcnt(0)" ::: "memory");
    const int c = lane & 7;
#pragma unroll
    for (int j = 0; j < 4; ++j) { const int n = (lane >> 3) + 8 * j; const LAS float* s = scr + (8 * c) * 33 + n;
        u32x4 o; o.x = cvt_pk_bf16(s[0 * 33], s[1 * 33]); o.y = cvt_pk_bf16(s[2 * 33], s[3 * 33]); o.z = cvt_pk_bf16(s[4 * 33], s[5 * 33]); o.w = cvt_pk_bf16(s[6 * 33], s[7 * 33]);
        *(u32x4*)(WT + (size_t)(d0 + n) * ldw + k0 + 8 * c) = o; }
    asm volatile("s_waitcnt lgkmcnt(0)" ::: "memory");
}

__device__ __forceinline__ void row_standardize(f32x4 (&v)[4]) {
    float s = 0.f;
#pragma unroll
    for (int j = 0; j < 4; ++j) s += (v[j].x + v[j].y) + (v[j].z + v[j].w);
    const float mean = wave_sum(s) * (1.f / D_MODEL); float s2 = 0.f;
#pragma unroll
    for (int j = 0; j < 4; ++j) { v[j] = v[j] - mean; s2 += (v[j].x * v[j].x + v[j].y * v[j].y) + (v[j].z * v[j].z + v[j].w * v[j].w); }
    const float rstd = __builtin_amdgcn_rsqf(wave_sum(s2) * (1.f / D_MODEL) + LN_EPS);
#pragma unroll
    for (int j = 0; j < 4; ++j) v[j] = v[j] * rstd;
}
__device__ __forceinline__ void write_h_row(const f32x4 (&v)[4], const float* modb, bf16_t* hrow, int lane) {
#pragma unroll
    for (int j = 0; j < 4; ++j) { const int col = 4 * (lane + 64 * j);
        const f32x4 sh = *(const f32x4*)(modb + col), sc = *(const f32x4*)(modb + 1024 + col);
        const f32x4 h = v[j] * (sc + 1.0f) + sh;
        u32x2 w; w.x = cvt_pk_bf16(h.x, h.y); w.y = cvt_pk_bf16(h.z, h.w);
        *(u32x2*)(hrow + col) = w; }
}

typedef short v4i16_t __attribute__((ext_vector_type(4)));
__device__ __forceinline__ s16x4 vtr(const LAS bf16_t* p) { return __builtin_bit_cast(s16x4, __builtin_amdgcn_ds_read_tr16_b64_v4i16((LAS v4i16_t*)p)); }
constexpr float STICK_DEAD = -44.0f;
__device__ __forceinline__ void attn_unit(LAS unsigned char* lds, bf16_t* ACT, int b, int h, int qb) {
    const int tid = fresh_tid(), lane = tid & 63, r32 = lane & 31, hi = lane >> 5;
    const int wid = __builtin_amdgcn_readfirstlane(tid >> 6);
    bf16_t* base = ACT + (size_t)b * SEQ * PITCH;
    const int tq0 = qb * 256 + wid * 32, tq = tq0 + r32;
    LAS bf16_t* Kw = (LAS bf16_t*)(lds + wid * 9728);
    LAS bf16_t* Vw = Kw + 32 * 72;
    LAS float* stg = (LAS float*)(lds + wid * 9728);
    bf16x8 qr[4];
#pragma unroll
    for (int d0 = 0; d0 < 4; ++d0) qr[d0] = *(const bf16x8*)(base + (size_t)tq * PITCH + C_QA + h * 64 + d0 * 16 + hi * 8);
    f32x16 o0, o1;
#pragma unroll
    for (int r = 0; r < 16; ++r) { o0[r] = 0.f; o1[r] = 0.f; }
    float R = 0.f;
    const int srow = lane >> 3, sch = lane & 7;
    const bf16_t* kg = base + (size_t)srow * PITCH + C_KA + h * 64 + sch * 8;
    const bf16_t* vg = base + (size_t)srow * PITCH + C_VA + h * 64 + sch * 8;
    const LAS bf16_t* vb = Vw + (4 * hi + ((lane & 15) >> 2)) * 80 + 16 * ((lane >> 4) & 1) + 4 * (lane & 3);
    u32x4 kreg[4], vreg[4];
    int kb = tq0;
#pragma unroll
    for (int i = 0; i < 4; ++i) { kreg[i] = *(const u32x4*)(kg + (size_t)(kb + 8 * i) * PITCH); vreg[i] = *(const u32x4*)(vg + (size_t)(kb + 8 * i) * PITCH); }
    for (;;) {
#pragma unroll
        for (int i = 0; i < 4; ++i) { *(LAS u32x4*)(Kw + (srow + 8 * i) * 72 + sch * 8) = kreg[i]; *(LAS u32x4*)(Vw + (srow + 8 * i) * 80 + sch * 8) = vreg[i]; }
        const int kbn = kb - 32;
        if (kbn >= 0) {
#pragma unroll
            for (int i = 0; i < 4; ++i) { kreg[i] = *(const u32x4*)(kg + (size_t)(kbn + 8 * i) * PITCH); vreg[i] = *(const u32x4*)(vg + (size_t)(kbn + 8 * i) * PITCH); }
        }
        f32x16 p0;
#pragma unroll
        for (int r = 0; r < 16; ++r) p0[r] = 0.f;
#pragma unroll
        for (int d0 = 0; d0 < 4; ++d0) {
            const bf16x8 a0 = *(const LAS bf16x8*)(Kw + r32 * 72 + d0 * 16 + hi * 8);
            p0 = __builtin_amdgcn_mfma_f32_32x32x16_bf16(a0, qr[d0], p0, 0, 0, 0);
        }
        float x0[16];
        if (kb < tq0) {
#pragma unroll
            for (int r = 0; r < 16; ++r) { const float z = p0[r]; const float sp = fmaxf(z, 0.f) + lg2(1.0f + ex2(-fabsf(z))); x0[r] = sp; p0[r] = z - sp; }
        } else {
            const int kvl = kb + 4 * hi;
#pragma unroll
            for (int r = 0; r < 16; ++r) { const int kv = kvl + (r & 3) + 8 * (r >> 2);
                const float z = p0[r]; const float sp = fmaxf(z, 0.f) + lg2(1.0f + ex2(-fabsf(z))); const bool ok = kv < tq; x0[r] = ok ? sp : 0.f; p0[r] = ok ? z - sp : -INFINITY; }
        }
        float Gs[4], Gh1[4], Tt[4];
#pragma unroll
        for (int g = 0; g < 4; ++g) Gs[g] = (x0[4 * g] + x0[4 * g + 1]) + (x0[4 * g + 2] + x0[4 * g + 3]);
#pragma unroll
        for (int g = 0; g < 4; ++g) { auto rr = __builtin_amdgcn_permlane32_swap(__float_as_uint(Gs[g]), __float_as_uint(Gs[g]), false, false);
            Gh1[g] = __uint_as_float(rr[1]); Tt[g] = __uint_as_float(rr[0]) + __uint_as_float(rr[1]); }
        float run = R;
#pragma unroll
        for (int g = 3; g >= 0; --g) {
            const float off = hi ? run : run - Gh1[g];
            const int q4 = 4 * g;
            const float s3 = off, s2 = s3 - x0[q4 + 3], s1 = s2 - x0[q4 + 2], s0 = s1 - x0[q4 + 1];
            p0[q4 + 3] = ex2(p0[q4 + 3] + s3); p0[q4 + 2] = ex2(p0[q4 + 2] + s2); p0[q4 + 1] = ex2(p0[q4 + 1] + s1); p0[q4] = ex2(p0[q4] + s0);
            run -= Tt[g];
        }
        R = run;
#pragma unroll
        for (int s = 0; s < 2; ++s) {
            u32x4 w; const int r0 = 8 * s;
            w.x = cvt_pk_bf16(p0[r0], p0[r0 + 1]); w.y = cvt_pk_bf16(p0[r0 + 2], p0[r0 + 3]); w.z = cvt_pk_bf16(p0[r0 + 4], p0[r0 + 5]); w.w = cvt_pk_bf16(p0[r0 + 6], p0[r0 + 7]);
            const bf16x8 af = __builtin_bit_cast(bf16x8, w);
            { const s16x4 lo = vtr(vb + (16 * s) * 80), hh = vtr(vb + (16 * s + 8) * 80);
              const bf16x8 bfr = (bf16x8){lo[0], lo[1], lo[2], lo[3], hh[0], hh[1], hh[2], hh[3]};
              o0 = __builtin_amdgcn_mfma_f32_32x32x16_bf16(af, bfr, o0, 0, 0, 0); }
            { const s16x4 lo = vtr(vb + (16 * s) * 80 + 32), hh = vtr(vb + (16 * s + 8) * 80 + 32);
              const bf16x8 bfr = (bf16x8){lo[0], lo[1], lo[2], lo[3], hh[0], hh[1], hh[2], hh[3]};
              o1 = __builtin_amdgcn_mfma_f32_32x32x16_bf16(af, bfr, o1, 0, 0, 0); }
        }
        if (kbn < 0 || !__any(R > STICK_DEAD)) break;
        kb = kbn;
    }
#pragma unroll
    for (int r = 0; r < 16; ++r) { stg[crow(r, hi) * 68 + r32] = o0[r]; stg[crow(r, hi) * 68 + 32 + r32] = o1[r]; }
    asm volatile("s_waitcnt lgkmcnt(0)" ::: "memory");
#pragma unroll
    for (int i = 0; i < 4; ++i) { const int row = i * 8 + (lane >> 3), ch = lane & 7;
        const f32x4 a = *(const LAS f32x4*)(stg + row * 68 + ch * 8), c = *(const LAS f32x4*)(stg + row * 68 + ch * 8 + 4);
        bf16_t* zp = base + (size_t)(tq0 + row) * PITCH + C_ZA + h * 64 + ch * 8;
        const u32x4 z = *(const u32x4*)zp;
        u32x4 w; w.x = cvt_pk_bf16(a.x * bf_lo(z.x), a.y * bf_hi(z.x)); w.y = cvt_pk_bf16(a.z * bf_lo(z.y), a.w * bf_hi(z.y));
        w.z = cvt_pk_bf16(c.x * bf_lo(z.z), c.y * bf_hi(z.z)); w.w = cvt_pk_bf16(c.z * bf_lo(z.w), c.w * bf_hi(z.w));
        *(u32x4*)zp = w; }
    asm volatile("s_waitcnt lgkmcnt(0)" ::: "memory");
}

__device__ __forceinline__ float layer_lb(const float* lower_bounds, int l, int ch) {
    float mx = -INFINITY;
    for (int i = 0; i < DEPTH; ++i) mx = fmaxf(mx, lower_bounds[i * 512 + ch]);
    float den = 0.f, num = 0.f;
    for (int i = 0; i < DEPTH; ++i) { const float e = __expf(lower_bounds[i * 512 + ch] - mx); den += e; if (i >= 1 && i <= l) num += e; }
    return num / den;
}
template <int MODE>
__device__ __forceinline__ void hgrn_pass(LAS unsigned char* lds, bf16_t* ACT, const Params& P, int l, int bh, int c0, int nc) {
    const int tid = fresh_tid(), lane = tid & 63, r32 = lane & 31, hi = lane >> 5;
    const int wid = __builtin_amdgcn_readfirstlane(tid >> 6);
    LAS bf16_t* Q1 = (LAS bf16_t*)(lds);
    LAS bf16_t* Q2 = (LAS bf16_t*)(lds + 17408);
    LAS bf16_t* K2 = (LAS bf16_t*)(lds + 34816);
    LAS float*  OT = (LAS float*)(lds);
    LAS bf16_t* K3T = (LAS bf16_t*)(lds + 52224);
    LAS bf16_t* VT = (LAS bf16_t*)(lds + 70656);
    LAS bf16_t* Pm = (LAS bf16_t*)(lds + 89088);
    LAS bf16_t* ST = (LAS bf16_t*)(lds + 98304);
    LAS float* SCX = (LAS float*)(lds + 133632);
    const int d = tid & 127, part = tid >> 7, b = bh >> 2, h = bh & 3;
    const float lbv = layer_lb(P.lower_bounds, l, h * 128 + d);
    bf16_t* base = ACT + (size_t)b * SEQ * PITCH + h * 128;
    bf16_t* Ug = (bf16_t*)(P.ws + WS_U) + (size_t)bh * 32 * 16384;
    float* Dg = (float*)(P.ws + WS_DEND) + (size_t)bh * 32 * 128;
    const float* nw = P.hgrn_norm_w + l * 128;
    const int tb = wid & 1, eb = wid >> 1;
    bf16_t fin[16], qin[16], vin[16];
#pragma unroll
    for (int i = 0; i < 16; ++i) { const bf16_t* rp = base + (size_t)(c0 * 64 + 16 * part + i) * PITCH + d; fin[i] = rp[C_FB]; vin[i] = rp[C_IB]; if (MODE == 1) qin[i] = rp[C_QB]; }
    for (int ci = 0; ci < nc; ++ci) {
        const int c = c0 + ci;
        u32x4 stp[4];
        if (MODE == 1) {
#pragma unroll
            for (int i = 0; i < 4; ++i) { const int idx = tid + 512 * i; stp[i] = (c > 0) ? *(const u32x4*)(Ug + (size_t)(c - 1) * 16384 + (idx >> 4) * 128 + (idx & 15) * 8) : (u32x4){0u, 0u, 0u, 0u}; }
        }
        float g2[16], kk[16];
        float runb = 0.f;
#pragma unroll
        for (int i = 0; i < 16; ++i) { const float f = lbv + (1.0f - lbv) * sigmoidf_(bf2f(fin[i])); kk[i] = 1.0f - f; runb += lg2(f); g2[i] = runb; }
        SCX[part * 128 + d] = runb;
        __syncthreads();
        const float t0 = SCX[d], t1 = SCX[128 + d], t2 = SCX[256 + d], t3 = SCX[384 + d];
        const float offp = (part > 0 ? t0 : 0.f) + (part > 1 ? t1 : 0.f) + (part > 2 ? t2 : 0.f);
        const float cmid = t0 + t1, bend = (t0 + t1) + (t2 + t3);
        {
            unsigned k3w[8], vw[8];
#pragma unroll
            for (int i = 0; i < 16; i += 2) {
                const float B0 = offp + g2[i], B1 = offp + g2[i + 1];
                if (MODE == 1) {
                    const float q0 = bf2f(qin[i]), q1 = bf2f(qin[i + 1]);
                    const int t = 16 * part + i;
                    Q1[t * 136 + d] = (bf16_t)(cvt_pk_bf16(q0 * ex2(B0), 0.f) & 0xffffu); Q1[(t + 1) * 136 + d] = (bf16_t)(cvt_pk_bf16(q1 * ex2(B1), 0.f) & 0xffffu);
                    Q2[t * 136 + d] = (bf16_t)(cvt_pk_bf16(q0 * ex2(B0 - cmid), 0.f) & 0xffffu); Q2[(t + 1) * 136 + d] = (bf16_t)(cvt_pk_bf16(q1 * ex2(B1 - cmid), 0.f) & 0xffffu);
                    K2[t * 136 + d] = (bf16_t)(cvt_pk_bf16(kk[i] * ex2(cmid - B0), 0.f) & 0xffffu); K2[(t + 1) * 136 + d] = (bf16_t)(cvt_pk_bf16(kk[i + 1] * ex2(cmid - B1), 0.f) & 0xffffu);
                } else {
                    k3w[i >> 1] = cvt_pk_bf16(kk[i] * ex2(bend - B0), kk[i + 1] * ex2(bend - B1));
                }
                vw[i >> 1] = (unsigned)vin[i] | ((unsigned)vin[i + 1] << 16);
            }
            if (MODE == 0) { *(LAS u32x4*)(K3T + d * 72 + 16 * part) = (u32x4){k3w[0], k3w[1], k3w[2], k3w[3]}; *(LAS u32x4*)(K3T + d * 72 + 16 * part + 8) = (u32x4){k3w[4], k3w[5], k3w[6], k3w[7]}; }
            *(LAS u32x4*)(VT + d * 72 + 16 * part) = (u32x4){vw[0], vw[1], vw[2], vw[3]}; *(LAS u32x4*)(VT + d * 72 + 16 * part + 8) = (u32x4){vw[4], vw[5], vw[6], vw[7]};
        }
        if (MODE == 0) { if (part == 0) Dg[c * 128 + d] = ex2(bend); }
        else {
#pragma unroll
            for (int i = 0; i < 4; ++i) { const int idx = tid + 512 * i; *(LAS u32x4*)(ST + (idx >> 4) * 136 + (idx & 15) * 8) = stp[i]; }
        }
        if (ci + 1 < nc) {
#pragma unroll
            for (int i = 0; i < 16; ++i) { const bf16_t* rp = base + (size_t)((c + 1) * 64 + 16 * part + i) * PITCH + d; fin[i] = rp[C_FB]; vin[i] = rp[C_IB]; if (MODE == 1) qin[i] = rp[C_QB]; }
        }
        __syncthreads();
        if (MODE == 0) {
#pragma unroll
            for (int i = 0; i < 2; ++i) {
                const int db = 2 * (wid & 1) + i;
                f32x16 sa;
#pragma unroll
                for (int r = 0; r < 16; ++r) sa[r] = 0.f;
#pragma unroll
                for (int ks = 0; ks < 4; ++ks) {
                    const bf16x8 a = *(const LAS bf16x8*)(K3T + (32 * db + r32) * 72 + 16 * ks + 8 * hi);
                    const bf16x8 bb = *(const LAS bf16x8*)(VT + (32 * eb + r32) * 72 + 16 * ks + 8 * hi);
                    sa = __builtin_amdgcn_mfma_f32_32x32x16_bf16(a, bb, sa, 0, 0, 0);
                }
#pragma unroll
                for (int g = 0; g < 4; ++g) { u32x2 w; w.x = cvt_pk_bf16(sa[4 * g], sa[4 * g + 1]); w.y = cvt_pk_bf16(sa[4 * g + 2], sa[4 * g + 3]);
                    *(LAS u32x2*)(ST + (32 * eb + r32) * 136 + 32 * db + 8 * g + 4 * hi) = w; }
            }
            __syncthreads();
#pragma unroll
            for (int i = 0; i < 4; ++i) { const int idx = tid + 512 * i;
                *(u32x4*)(Ug + (size_t)c * 16384 + (idx >> 4) * 128 + (idx & 15) * 8) = *(const LAS u32x4*)(ST + (idx >> 4) * 136 + (idx & 15) * 8); }
        } else {
            f32x16 o;
#pragma unroll
            for (int r = 0; r < 16; ++r) o[r] = 0.f;
            if (c > 0) {
#pragma unroll
                for (int ks = 0; ks < 8; ++ks) {
                    const bf16x8 a = *(const LAS bf16x8*)(Q1 + (32 * tb + r32) * 136 + 16 * ks + 8 * hi);
                    const bf16x8 bb = *(const LAS bf16x8*)(ST + (32 * eb + r32) * 136 + 16 * ks + 8 * hi);
                    o = __builtin_amdgcn_mfma_f32_32x32x16_bf16(a, bb, o, 0, 0, 0);
                }
            }
            if (wid < 4) {
                const int stb = wid & 1, ssb = wid >> 1;
                f32x16 sc;
#pragma unroll
                for (int r = 0; r < 16; ++r) sc[r] = 0.f;
                if (!(stb == 0 && ssb == 1)) {
#pragma unroll
                    for (int ks = 0; ks < 8; ++ks) {
                        const bf16x8 a = *(const LAS bf16x8*)(Q2 + (32 * stb + r32) * 136 + 16 * ks + 8 * hi);
                        const bf16x8 bb = *(const LAS bf16x8*)(K2 + (32 * ssb + r32) * 136 + 16 * ks + 8 * hi);
                        sc = __builtin_amdgcn_mfma_f32_32x32x16_bf16(a, bb, sc, 0, 0, 0);
                    }
                }
#pragma unroll
                for (int r = 0; r < 16; ++r) { const int t = 32 * stb + crow(r, hi), s = 32 * ssb + r32;
                    const float v = (s <= t) ? sc[r] : 0.f;
                    Pm[t * 72 + s] = (bf16_t)(cvt_pk_bf16(v, 0.f) & 0xffffu); }
            }
            __syncthreads();
            unsigned zz[8];
#pragma unroll
            for (int i = 0; i < 8; ++i) zz[i] = *(const unsigned*)(base + (size_t)(c * 64 + 8 * wid + i) * PITCH + C_ZB + 2 * lane);
#pragma unroll
            for (int ks = 0; ks < 4; ++ks) {
                const bf16x8 a = *(const LAS bf16x8*)(Pm + (32 * tb + r32) * 72 + 16 * ks + 8 * hi);
                const bf16x8 bb = *(const LAS bf16x8*)(VT + (32 * eb + r32) * 72 + 16 * ks + 8 * hi);
                o = __builtin_amdgcn_mfma_f32_32x32x16_bf16(a, bb, o, 0, 0, 0);
            }
#pragma unroll
            for (int r = 0; r < 16; ++r) OT[(32 * tb + crow(r, hi)) * 132 + 32 * eb + r32] = o[r];
            __syncthreads();
            {
                const f32x2 nwv = *(const f32x2*)(nw + 2 * lane);
#pragma unroll
                for (int i = 0; i < 8; ++i) { const int t = 8 * wid + i;
                    const f32x2 v = *(const LAS f32x2*)(OT + t * 132 + 2 * lane);
                    const float ss = wave_sum(v.x * v.x + v.y * v.y);
                    const float rstd = __builtin_amdgcn_rsqf(ss * (1.0f / 128.0f) + RMS_EPS);
                    unsigned* zp = (unsigned*)(base + (size_t)(c * 64 + t) * PITCH + C_ZB + 2 * lane);
                    *zp = cvt_pk_bf16(v.x * rstd * nwv.x * bf_lo(zz[i]), v.y * rstd * nwv.y * bf_hi(zz[i])); }
            }
        }
    }
    __syncthreads();
}

__device__ __forceinline__ void unpack8(const u32x4 a, float (&o)[8]) {
    o[0] = bf_lo(a.x); o[1] = bf_hi(a.x); o[2] = bf_lo(a.y); o[3] = bf_hi(a.y); o[4] = bf_lo(a.z); o[5] = bf_hi(a.z); o[6] = bf_lo(a.w); o[7] = bf_hi(a.w);
}
__device__ __forceinline__ void conv_item(bf16_t* ACT, const float* cw, int item) {
    const int tid = fresh_tid(), cgp = tid & 63, sub = tid >> 6;
    const int m0 = item * 64 + sub * 8, ch = cgp * 8;
    float w0[8], w1[8], w2[8];
#pragma unroll
    for (int e = 0; e < 8; ++e) { w0[e] = cw[ch + e]; w1[e] = cw[512 + ch + e]; w2[e] = cw[1024 + ch + e]; }
    float p1[8], p2[8];
#pragma unroll
    for (int e = 0; e < 8; ++e) { p1[e] = 0.f; p2[e] = 0.f; }
    if ((m0 % SEQ) != 0) {
        unpack8(*(const u32x4*)(ACT + (size_t)(m0 - 2) * PITCH + C_PU + ch), p2);
        unpack8(*(const u32x4*)(ACT + (size_t)(m0 - 1) * PITCH + C_PU + ch), p1);
    }
    u32x4 pa[8], pzv[8];
#pragma unroll
    for (int i = 0; i < 8; ++i) { const bf16_t* rp = ACT + (size_t)(m0 + i) * PITCH + ch; pa[i] = *(const u32x4*)(rp + C_PU); pzv[i] = *(const u32x4*)(rp + C_PZ); }
#pragma unroll
    for (int i = 0; i < 8; ++i) {
        float pu[8], pz[8], y[8];
        unpack8(pa[i], pu); unpack8(pzv[i], pz);
#pragma unroll
        for (int e = 0; e < 8; ++e) { y[e] = pz[e] * (w0[e] * p2[e] + w1[e] * p1[e] + w2[e] * pu[e]); p2[e] = p1[e]; p1[e] = pu[e]; }
        u32x4 w; w.x = cvt_pk_bf16(y[0], y[1]); w.y = cvt_pk_bf16(y[2], y[3]); w.z = cvt_pk_bf16(y[4], y[5]); w.w = cvt_pk_bf16(y[6], y[7]);
        *(u32x4*)(ACT + (size_t)(m0 + i) * PITCH + C_ZC + ch) = w;
    }
}

__device__ __forceinline__ void convert_weights(const Params& P, int l, LAS unsigned char* lds, int gw, int NGW, int wid, int lane) {
    LAS float* scr = (LAS float*)(lds + wid * 16384);
    unsigned char* ws = P.ws;
    constexpr int I_IN = 16 * (IN_COLS / 32), I_B = 8 * 32, I_O = 16 * 32, I_L = I_IN + 3 * I_B + I_O;
    for (int it = gw; it < I_L; it += NGW) {
        int r = it;
        if (r < I_IN) { transpose_item(P.w_in + (size_t)l * 1024 * IN_COLS, IN_COLS, (bf16_t*)(ws + WS_WIN), 1024, scr, r, lane, true); continue; } r -= I_IN;
        if (r < 3 * I_B) { const int j = r / I_B; transpose_item(P.w_branch + (size_t)(l * 3 + j) * 512 * 1024, 1024, (bf16_t*)(ws + WS_WB) + (size_t)j * 1024 * 1024, 1024, scr, r % I_B, lane); continue; } r -= 3 * I_B;
        transpose_item(P.w_out + (size_t)l * 1024 * 1024, 1024, (bf16_t*)(ws + WS_WO), 1024, scr, r, lane);
    }
}

typedef const __attribute__((address_space(4))) Params* KParamsPtr;
#define XB_TMO      128
#define XB_XCNT(j)  (256  + 64 * (j))
#define XB_XSUB(j)  (1280 + 64 * (j))
#define XB_XGEN(j)  (2304 + 64 * (j))
#define XB_TOP      3328
#define XB_TOPGEN   3392
#define XCD_BAR_WORDS 3456
#define XB_SPIN_CAP (1u << 22)
__device__ __forceinline__ unsigned xb_ld(unsigned* p)              { return __hip_atomic_load(p, __ATOMIC_RELAXED, __HIP_MEMORY_SCOPE_AGENT); }
__device__ __forceinline__ unsigned xb_add(unsigned* p, unsigned v) { return __hip_atomic_fetch_add(p, v, __ATOMIC_RELAXED, __HIP_MEMORY_SCOPE_AGENT); }
__device__ __forceinline__ unsigned xb_xcc_id() { return (unsigned)__builtin_amdgcn_s_getreg((3 << 11) | 20) & 0xFu; }
#define XB_SPIN(cond, bar) do { unsigned _sp = 0; while (cond) { __builtin_amdgcn_s_sleep(1); \
    if ((++_sp & 255u) == 0u) { if (xb_ld(&(bar)[XB_TMO])) break; if (_sp > XB_SPIN_CAP) { atomicAdd(&(bar)[XB_TMO], 1u); break; } } } } while (0)
__device__ __forceinline__ void xcd_barrier_complete(unsigned* bar, unsigned x, unsigned& nloc, unsigned& nx) {
    const unsigned G = gridDim.x * gridDim.y * gridDim.z;
    unsigned sum, cnt, mine, sp = 0u;
    for (;;) {
        sum = 0u; cnt = 0u; mine = 0u;
#pragma unroll
        for (unsigned j = 0; j < 16; ++j) { const unsigned c = xb_ld(&bar[XB_XCNT(j)]); sum += c; cnt += (c > 0u) ? 1u : 0u; mine = (j == x) ? c : mine; }
        if (sum == G) break;
        __builtin_amdgcn_s_sleep(1);
        if ((++sp & 255u) == 0u) { if (xb_ld(&bar[XB_TMO])) break; if (sp > XB_SPIN_CAP) { atomicAdd(&bar[XB_TMO], 1u); break; } }
    }
    nloc = mine > 0u ? mine : 1u; nx = cnt > 0u ? cnt : 1u;
}
__device__ __forceinline__ void xcd_barrier(unsigned* bar, volatile LAS unsigned* st) {
    asm volatile("s_waitcnt vmcnt(0)" ::: "memory");
    __syncthreads();
    if (threadIdx.x == 0) {
        __builtin_amdgcn_s_waitcnt(0);
        const unsigned x = xb_xcc_id();
        unsigned nloc = st[0], nx = st[1];
        if (nloc == 0u) { xcd_barrier_complete(bar, x, nloc, nx); st[0] = nloc; st[1] = nx; }
        const unsigned old = xb_add(&bar[XB_XSUB(x)], 1u);
        const unsigned gen = old / nloc;
        if (old + 1u == (gen + 1u) * nloc) {
            __builtin_amdgcn_fence(__ATOMIC_RELEASE, "agent");
            asm volatile("s_waitcnt vmcnt(0)" ::: "memory");
            const unsigned og = xb_add(&bar[XB_TOP], 1u);
            const unsigned tg = og / nx;
            if (og + 1u == (tg + 1u) * nx) xb_add(&bar[XB_TOPGEN], 1u);
            else XB_SPIN(xb_ld(&bar[XB_TOPGEN]) == tg, bar);
            __builtin_amdgcn_fence(__ATOMIC_ACQUIRE, "agent");
            xb_add(&bar[XB_XGEN(x)], 1u);
            asm volatile("s_waitcnt vmcnt(0)" ::: "memory");
        } else {
            XB_SPIN(xb_ld(&bar[XB_XGEN(x)]) == gen, bar);
            __builtin_amdgcn_fence(__ATOMIC_ACQUIRE, "agent");
            asm volatile("s_waitcnt vmcnt(0)" ::: "memory");
        }
    }
    __syncthreads();
}
#define GRID_SYNC() do { asm volatile("s_waitcnt vmcnt(0) lgkmcnt(0)" ::: "memory"); __syncthreads(); grid.sync(); } while (0)
#define XBAR() do { KParamsPtr qb_ = (KParamsPtr)__builtin_amdgcn_kernarg_segment_ptr(); asm volatile("" : "+s"(qb_)); xcd_barrier((unsigned*)(qb_->ws + WS_CTL), (volatile LAS unsigned*)(lds + LDS_BYTES - 16)); } while (0)
#define PHASE_BEGIN() \
    Params P; { KParamsPtr q_ = (KParamsPtr)__builtin_amdgcn_kernarg_segment_ptr(); asm volatile("" : "+s"(q_)); \
        P.x = q_->x; P.c = q_->c; P.w_mod = q_->w_mod; P.b_mod = q_->b_mod; P.w_in = q_->w_in; P.conv_w = q_->conv_w; P.hgrn_norm_w = q_->hgrn_norm_w; P.lower_bounds = q_->lower_bounds; \
        P.w_branch = q_->w_branch; P.w_out = q_->w_out; P.ln_g = q_->ln_g; P.ln_b = q_->ln_b; P.out = q_->out; P.ws = q_->ws; } \
    int bx = blockIdx.x; asm volatile("" : "+s"(bx)); \
    const int G = gridDim.x; \
    const int vcu = (G % 8 == 0) ? (bx % 8) * (G / 8) + bx / 8 : bx; \
    unsigned char* const ws = P.ws; \
    float* const modp = (float*)(ws + WS_MOD); \
    bf16_t* const ACT = (bf16_t*)(ws + WS_ACT); \
    (void)vcu; (void)modp; (void)ACT;
#define WAVE_IDS() \
    const int tid = fresh_tid(), lane = tid & 63, wid = __builtin_amdgcn_readfirstlane(tid >> 6); \
    const int gw = vcu * 8 + wid, NGW = G * 8; (void)lane; (void)gw; (void)NGW;

__global__ void __launch_bounds__(NTHREADS, 2) fwd_megakernel(Params Pk) {
    extern __shared__ __attribute__((aligned(16))) unsigned char lds_raw[];
    LAS unsigned char* lds = (LAS unsigned char*)lds_raw;
    cg::grid_group grid = cg::this_grid();
    if (__builtin_expect(gridDim.y == 4242u, 0)) GRID_SYNC();
    if (threadIdx.x < 4) ((LAS unsigned*)(lds + LDS_BYTES - 16))[threadIdx.x] = 0u;
    __syncthreads();
    if (threadIdx.x == 0) { KParamsPtr q0_ = (KParamsPtr)__builtin_amdgcn_kernarg_segment_ptr(); (void)xb_add(&((unsigned*)(q0_->ws + WS_CTL))[XB_XCNT(xb_xcc_id())], 1u); }

    {
        PHASE_BEGIN(); WAVE_IDS();
        float* modpart = (float*)(ws + WS_MODP);
        LAS float* red = (LAS float*)lds;
        for (int u = bx; u < DEPTH * 192; u += G) {
            const int l = u / 192, r = u % 192, n = (r >> 2) * 64 + lane, kq = r & 3;
            float accb[8];
#pragma unroll
            for (int b = 0; b < 8; ++b) accb[b] = 0.f;
            const float* wp = P.w_mod + ((size_t)l * 1024 + 256 * kq + 32 * wid) * 3072 + n;
            const float* cp = P.c + 256 * kq + 32 * wid;
#pragma unroll 16
            for (int k = 0; k < 32; ++k) { const float wv = wp[(size_t)k * 3072];
#pragma unroll
                for (int b = 0; b < 8; ++b) accb[b] += cp[b * 1024 + k] * wv; }
            __syncthreads();
#pragma unroll
            for (int b = 0; b < 8; ++b) red[(wid * 8 + b) * 64 + lane] = accb[b];
            __syncthreads();
            { const int b = wid; float sacc = 0.f;
#pragma unroll
              for (int w = 0; w < 8; ++w) sacc += red[(w * 8 + b) * 64 + lane];
              modpart[(((size_t)kq * DEPTH + l) * 8 + b) * 3072 + n] = sacc; }
        }
        __syncthreads();
        convert_weights(P, 0, lds, gw, NGW, wid, lane);
    }
    XBAR();
    {
        PHASE_BEGIN(); WAVE_IDS();
        const float* modpart = (const float*)(ws + WS_MODP);
        for (int i = bx * NTHREADS + tid; i < DEPTH * 8 * 3072; i += G * NTHREADS) {
            const int l = i / (8 * 3072), n = i % 3072;
            float v = P.b_mod[l * 3072 + n];
#pragma unroll
            for (int kq = 0; kq < 4; ++kq) v += modpart[(size_t)kq * DEPTH * 8 * 3072 + i];
            modp[i] = v;
        }
        LAS float* ms = (LAS float*)lds;
        for (int rg = bx; rg < M_TOK / 64; rg += G) {
            const int b = (rg * 64) / SEQ;
            __syncthreads();
            { const int i4 = tid * 4; f32x4 v = *(const f32x4*)(P.b_mod + i4);
#pragma unroll
              for (int kq = 0; kq < 4; ++kq) v = v + *(const f32x4*)(modpart + ((size_t)kq * DEPTH * 8 + b) * 3072 + i4);
              *(LAS f32x4*)(ms + i4) = v; }
            __syncthreads();
#pragma unroll
            for (int it = 0; it < 2; ++it) {
                f32x4 v[4][4];
#pragma unroll
                for (int q = 0; q < 4; ++q) { const int m = rg * 64 + wid * 8 + it * 4 + q;
#pragma unroll
                    for (int j = 0; j < 4; ++j) v[q][j] = *(const f32x4*)(P.x + (size_t)m * D_MODEL + 4 * (lane + 64 * j)); }
#pragma unroll
                for (int q = 0; q < 4; ++q) { const int m = rg * 64 + wid * 8 + it * 4 + q;
                    row_standardize(v[q]);
                    bf16_t* hrow = ACT + (size_t)m * PITCH + C_H;
#pragma unroll
                    for (int j = 0; j < 4; ++j) { const int col = 4 * (lane + 64 * j);
                        const f32x4 sh = *(const LAS f32x4*)(ms + col), sc = *(const LAS f32x4*)(ms + 1024 + col);
                        const f32x4 hv = v[q][j] * (sc + 1.0f) + sh;
                        u32x2 w; w.x = cvt_pk_bf16(hv.x, hv.y); w.y = cvt_pk_bf16(hv.z, hv.w);
                        *(u32x2*)(hrow + col) = w; } }
            }
        }
    }
    XBAR();

    for (int l = 0; l < DEPTH; ++l) {
        {
            PHASE_BEGIN();
            SchedP1 S{(const char*)ACT + C_H * 2, (const char*)(ws + WS_WIN), G, vcu};
            EpiP1 E{ACT};
            pg8::gemm_phase<EpiP1, SchedP1>(lds, (unsigned)PITCHB, 2048u, S, E);
        }
        XBAR();
        {
            PHASE_BEGIN();
            for (int u = bx; u < 256; u += G) hgrn_pass<0>(lds, ACT, P, l, u >> 3, (u & 7) * 4, 4);
        }
        {
            PHASE_BEGIN();
            for (int k = bx; k < 256; k += G) {
                __syncthreads(); attn_unit(lds, ACT, (k & 63) >> 3, k & 7, 7 - (k >> 6));
                const int a2 = 511 - k;
                __syncthreads(); attn_unit(lds, ACT, (a2 & 63) >> 3, a2 & 7, 7 - (a2 >> 6));
            }
            for (int ci = bx; ci < 256; ci += G) conv_item(ACT, P.conv_w + (size_t)l * 3 * 512, ci);
        }
        XBAR();
        {
            PHASE_BEGIN();
            const int tid2 = fresh_tid();
            for (int g = bx * NTHREADS + tid2; g < 32 * 4096; g += G * NTHREADS) {
                const int bh = g >> 12, rem = g & 4095, dg = rem & 31;
                bf16_t* up = (bf16_t*)(ws + WS_U) + (size_t)bh * 32 * 16384 + (rem >> 5) * 128 + dg * 4;
                const float* dp = (const float*)(ws + WS_DEND) + (size_t)bh * 32 * 128 + dg * 4;
                f32x4 S = (f32x4){0.f, 0.f, 0.f, 0.f};
                for (int c0 = 0; c0 < 32; c0 += 8) {
                    u32x2 uu[8]; f32x4 dd[8];
#pragma unroll
                    for (int k = 0; k < 8; ++k) { uu[k] = *(const u32x2*)(up + (size_t)(c0 + k) * 16384); dd[k] = *(const f32x4*)(dp + (c0 + k) * 128); }
#pragma unroll
                    for (int k = 0; k < 8; ++k) {
                        S = dd[k] * S + (f32x4){bf_lo(uu[k].x), bf_hi(uu[k].x), bf_lo(uu[k].y), bf_hi(uu[k].y)};
                        u32x2 w; w.x = cvt_pk_bf16(S[0], S[1]); w.y = cvt_pk_bf16(S[2], S[3]);
                        *(u32x2*)(up + (size_t)(c0 + k) * 16384) = w; }
                }
            }
        }
        XBAR();
        {
            PHASE_BEGIN();
            for (int u = bx; u < 256; u += G) hgrn_pass<1>(lds, ACT, P, l, u >> 3, (u & 7) * 4, 4);
        }
        XBAR();
        {
            PHASE_BEGIN();
            SchedP3 S{(const char*)ACT, (const char*)(ws + WS_WIN) + (size_t)MIX_COLS * 2048, (const char*)(ws + WS_WB), G, vcu};
            EpiP3 E{(unsigned char*)ACT};
            pg8::gemm_phase<EpiP3, SchedP3>(lds, (unsigned)PITCHB, 2048u, S, E);
        }
        XBAR();
        {
            PHASE_BEGIN(); WAVE_IDS();
            SchedP4 S{(const char*)ACT, (const char*)(ws + WS_WO), G, vcu};
            unsigned* pc = (unsigned*)(ws + WS_CTL + CTL_PANEL);
            unsigned long long* xb = (unsigned long long*)(ws + WS_X);
            const bool more = (l + 1 < DEPTH);
            PanelStats st1{xb + (size_t)(2 * l) * 65536, pc + (2 * l) * 4096, LN_EPS};
            PanelStats st2{xb + (size_t)(2 * l + 1) * 65536, pc + (2 * l + 1) * 4096, LN_EPS};
            EpiP4F E{l == 0 ? P.x : P.out, P.out, modp + (size_t)l * 8 * 3072 + 2048, P.ln_g + l * 1024, P.ln_b + l * 1024, more ? modp + (size_t)(l + 1) * 8 * 3072 : nullptr, ACT, st1, st2};
            pg8::gemm_phase<EpiP4F, SchedP4>(lds, (unsigned)PITCHB, 2048u, S, E);
            if (more) { __syncthreads(); convert_weights(P, l + 1, lds, gw, NGW, wid, lane); }
        }
        if (l + 1 < DEPTH) XBAR();
    }
}

extern "C" void kernel_launch(void* const* d_in, const int* in_sizes, int n_in, void* d_out, int out_size, void* d_ws, size_t ws_size, hipStream_t stream) {
    static int grid_blocks = 0;
    if (grid_blocks == 0) {
        if (n_in != 12 || out_size != M_TOK * D_MODEL || ws_size < WS_END) { fprintf(stderr, "kernel_launch: unexpected shapes (n_in %d, out %d, ws %zu < %zu)\n", n_in, out_size, ws_size, (size_t)WS_END); grid_blocks = -1; return; }
        int dev = 0, cus = 0, per_cu = 0;
        hipGetDevice(&dev);
        hipDeviceGetAttribute(&cus, hipDeviceAttributeMultiprocessorCount, dev);
        hipFuncSetAttribute((const void*)fwd_megakernel, hipFuncAttributeMaxDynamicSharedMemorySize, LDS_BYTES);
        hipOccupancyMaxActiveBlocksPerMultiprocessor(&per_cu, (const void*)fwd_megakernel, NTHREADS, LDS_BYTES);
        (void)hipGetLastError();
        if (per_cu < 1) per_cu = 1;
        grid_blocks = cus > 256 ? 256 : cus;
        if (grid_blocks != 256) fprintf(stderr, "kernel_launch: %d CUs reported; this kernel is laid out for 256 workgroups\n", cus);
        if (grid_blocks <= 0) grid_blocks = 256;
    }
    if (grid_blocks < 0) return;
    (void)hipMemsetAsync((char*)d_ws + WS_CTL, 0, CTL_BYTES, stream);
    Params p{};
    p.x = (const float*)d_in[0]; p.c = (const float*)d_in[1]; p.w_mod = (const float*)d_in[2]; p.b_mod = (const float*)d_in[3]; p.w_in = (const float*)d_in[4];
    p.conv_w = (const float*)d_in[5]; p.hgrn_norm_w = (const float*)d_in[6]; p.lower_bounds = (const float*)d_in[7]; p.w_branch = (const float*)d_in[8];
    p.w_out = (const float*)d_in[9]; p.ln_g = (const float*)d_in[10]; p.ln_b = (const float*)d_in[11]; p.out = (float*)d_out; p.ws = (unsigned char*)d_ws;
    void* args[] = {&p};
    hipError_t e = hipLaunchCooperativeKernel((const void*)fwd_megakernel, dim3(grid_blocks), dim3(NTHREADS), args, LDS_BYTES, stream);
    if (e != hipSuccess) fprintf(stderr, "cooperative launch failed: %s (grid %d)\n", hipGetErrorString(e), grid_blocks);
}
```

```cpp
#include <hip/hip_runtime.h>
#include <hip/hip_cooperative_groups.h>
#include <cstdio>
#include <cstdint>
namespace cg = cooperative_groups;

#define LAS __attribute__((address_space(3)))
typedef unsigned short bf16_t;
typedef short bf16x8 __attribute__((ext_vector_type(8)));
typedef short s16x4 __attribute__((ext_vector_type(4)));
typedef float f32x2 __attribute__((ext_vector_type(2)));
typedef float f32x4 __attribute__((ext_vector_type(4)));
typedef float f32x16 __attribute__((ext_vector_type(16)));
typedef unsigned u32x2 __attribute__((ext_vector_type(2)));
typedef unsigned u32x4 __attribute__((ext_vector_type(4)));

constexpr int D_MODEL = 1024, BATCH = 8, SEQ = 2048, DEPTH = 2, M_TOK = BATCH * SEQ;
constexpr int IN_COLS = 9216, MIX_COLS = 6144;
constexpr int PITCH = 7168;
constexpr size_t PITCHB = (size_t)PITCH * 2;
constexpr int C_QA = 0, C_KA = 512, C_VA = 1024, C_ZA = 1536, C_QB = 2048, C_FB = 2560, C_IB = 3072, C_ZB = 3584, C_PU = 4096  , C_PZ = 4608  , C_ZC = 5632  , C_H = 6144;
constexpr int C_MERGED = 4096;
constexpr float LN_EPS = 1e-5f, RMS_EPS = 1e-6f;
constexpr float LOG2E = 1.4426950408889634f;
constexpr float QSCALE = 0.125f * LOG2E;
constexpr float ALPHA = 1.4142135623730951f;

constexpr size_t WS_CTL = 0, CTL_BYTES = 65536;
constexpr size_t WS_MOD = 65536;
constexpr size_t WS_DEND = 256u << 10;
constexpr size_t WS_WIN = 1u << 20;
constexpr size_t WIN_L = (size_t)IN_COLS * 1024 * 2;
constexpr size_t WS_WB = WS_WIN + WIN_L;
constexpr size_t WB_L = (size_t)3 * 1024 * 1024 * 2;
constexpr size_t WS_WO = WS_WB + WB_L;
constexpr size_t WO_L = (size_t)1024 * 1024 * 2;
constexpr size_t WS_ACT = WS_WO + WO_L;
constexpr size_t WS_U = WS_ACT + (size_t)M_TOK * PITCHB;
constexpr size_t WS_X = WS_U + (size_t)32 * 32 * 128 * 128 * 2;
constexpr size_t WS_MODP = WS_X + 3 * 524288;
constexpr size_t WS_END = WS_MODP + (size_t)4 * DEPTH * BATCH * 3072 * 4;
constexpr size_t CTL_PANEL = 16384;

constexpr int LDS_BYTES = 147456;
constexpr int NTHREADS = 512;

struct Params {
    const float* x; const float* c; const float* w_mod; const float* b_mod; const float* w_in; const float* conv_w; const float* hgrn_norm_w;
    const float* lower_bounds; const float* w_branch; const float* w_out; const float* ln_g; const float* ln_b; float* out; unsigned char* ws;
};

typedef __bf16 bf16x2_t __attribute__((ext_vector_type(2)));
__device__ __forceinline__ unsigned cvt_pk_bf16(float lo, float hi) { const f32x2 v = {lo, hi}; const bf16x2_t b = __builtin_convertvector(v, bf16x2_t); return __builtin_bit_cast(unsigned, b); }
__device__ __forceinline__ float bf_lo(unsigned w) { return __uint_as_float(w << 16); }
__device__ __forceinline__ float bf_hi(unsigned w) { return __uint_as_float(w & 0xffff0000u); }
__device__ __forceinline__ float bf2f(bf16_t v) { return __uint_as_float((unsigned)v << 16); }
__device__ __forceinline__ float ex2(float v) { return __builtin_amdgcn_exp2f(v); }
__device__ __forceinline__ float lg2(float v) { return __builtin_amdgcn_logf(v); }
__device__ __forceinline__ float sigmoidf_(float v) { return __builtin_amdgcn_rcpf(1.0f + ex2(-v * LOG2E)); }
__device__ __forceinline__ float siluf_(float v) { return v * sigmoidf_(v); }
__device__ __forceinline__ float wave_sum(float v) {
#pragma unroll
    for (int o = 1; o < 64; o <<= 1) v += __shfl_xor(v, o);
    return v;
}
__device__ __forceinline__ int fresh_tid() { int t = threadIdx.x; asm volatile("" : "+v"(t)); return t; }
__device__ __forceinline__ int crow(int r, int hi) { return (r & 3) + 8 * (r >> 2) + 4 * hi; }

namespace pg8 {
constexpr int BM = 256, BK = 64, HALF = 128, HTB = HALF * BK * 2, STAGE_BYTES = 8 * HTB;
__device__ __forceinline__ int lds_byte(int r, int c) { const int st = (r >> 4) * 2 + (c >> 5), rr = r & 15, cc = c & 31, ob = rr * 64 + cc * 2; return st * 1024 + (ob ^ (((ob >> 9) & 1) << 5)); }
__device__ __forceinline__ void stage_rc(int b, int& R, int& C) { const int st = b / 1024, sb = b % 1024, swz = sb ^ (((sb >> 9) & 1) << 5); R = (st >> 1) * 16 + swz / 64; C = (st & 1) * 32 + (swz % 64) / 2; }
__device__ __forceinline__ int perm32(int rho) { const int n = rho >> 4, i = rho & 15; return 8 * (i >> 2) + 4 * n + (i & 3); }

struct Unit { const char* a; const char* b; int nt; int pm, pn, j; };

template <class Epi, class Sched>
__device__ __forceinline__ void gemm_phase(LAS unsigned char* lds, const unsigned ldaB, const unsigned ldbB, const Sched& S, const Epi& E) {
    const int tid = fresh_tid(), wid = __builtin_amdgcn_readfirstlane(tid >> 6), lane = tid & 63, wr = wid >> 2, wc = wid & 3, fr = lane & 15, fq = lane >> 4;
    unsigned voffA[2], voffB[2];
#pragma unroll
    for (int i = 0; i < 2; ++i) { int R, C; stage_rc(tid * 16 + i * 8192, R, C); const int Rb = Epi::PERM ? ((R & ~31) + perm32(R & 31)) : R;
        voffA[i] = (unsigned)R * ldaB + (unsigned)C * 2u; voffB[i] = (unsigned)Rb * ldbB + (unsigned)C * 2u; }
    const size_t kstep = (size_t)(BK * 2);
    const size_t hstepA = (size_t)HALF * ldaB, hstepB = (size_t)HALF * ldbB;
    const unsigned ldsw = (unsigned)wid * 1024u;
    const int aoff = lds_byte(wr * 64 + fr, fq * 8), boff = lds_byte(wc * 32 + fr, fq * 8);
#define PG8_SA(b, h) (((b) * 2 + (h)) * HTB)
#define PG8_SB(b, h) ((4 + (b) * 2 + (h)) * HTB)
#define PG8_STAGE(bufoff, gbase, voff) do { _Pragma("unroll") for (int _i = 0; _i < 2; ++_i) \
        __builtin_amdgcn_global_load_lds((const unsigned*)((const char*)(gbase) + (voff)[_i]), (LAS unsigned*)(lds + (bufoff) + ldsw + _i * 8192), 16, 0, 0); } while (0)
#define PG8_LDA(dst, b, h) do { _Pragma("unroll") for (int m = 0; m < 4; ++m) _Pragma("unroll") for (int k = 0; k < 2; ++k) dst[m][k] = *(const LAS bf16x8*)(lds + PG8_SA(b, h) + aoff + m * 2048 + k * 1024); } while (0)
#define PG8_LDB(dst, b, h) do { _Pragma("unroll") for (int n = 0; n < 2; ++n) _Pragma("unroll") for (int k = 0; k < 2; ++k) dst[n][k] = *(const LAS bf16x8*)(lds + PG8_SB(b, h) + boff + n * 2048 + k * 1024); } while (0)
#define PG8_MMA(ai, bj, At, Bt) do { __builtin_amdgcn_s_setprio(1); _Pragma("unroll") for (int m = 0; m < 4; ++m) _Pragma("unroll") for (int n = 0; n < 2; ++n) _Pragma("unroll") for (int k = 0; k < 2; ++k) \
        acc[ai][bj][m][n] = __builtin_amdgcn_mfma_f32_16x16x32_bf16(Bt[n][k], At[m][k], acc[ai][bj][m][n], 0, 0, 0); __builtin_amdgcn_s_setprio(0); } while (0)
#define PG8_WAIT_V(n) asm volatile("s_waitcnt vmcnt(" #n ")" ::: "memory")
#define PG8_WAIT_L(n) asm volatile("s_waitcnt lgkmcnt(" #n ")" ::: "memory")
#define PG8_BAR __builtin_amdgcn_s_barrier()
#define PG8_SCHED __builtin_amdgcn_sched_barrier(0)
    Unit cur, nxt; int ui = 0;
    if (!S.next(0, cur)) return;
    f32x4 acc[2][2][4][2];
#pragma unroll
    for (int a = 0; a < 2; ++a)
#pragma unroll
        for (int b = 0; b < 2; ++b)
#pragma unroll
            for (int m = 0; m < 4; ++m)
#pragma unroll
                for (int n = 0; n < 2; ++n) acc[a][b][m][n] = (f32x4){0.f, 0.f, 0.f, 0.f};
    bf16x8 At[4][2], B0[2][2], B1[2][2];
    const char* cA = cur.a; const char* cB = cur.b;
    PG8_STAGE(PG8_SB(0, 0), cB, voffB); PG8_STAGE(PG8_SB(0, 1), cB + hstepB, voffB); PG8_STAGE(PG8_SA(0, 0), cA, voffA); PG8_STAGE(PG8_SA(0, 1), cA + hstepA, voffA);
    if (wr == 1) PG8_BAR;
    PG8_WAIT_V(2); PG8_BAR;
    PG8_STAGE(PG8_SB(1, 0), cB + kstep, voffB); PG8_STAGE(PG8_SA(1, 0), cA + kstep, voffA); PG8_STAGE(PG8_SB(1, 1), cB + hstepB + kstep, voffB);
    PG8_WAIT_V(6); PG8_BAR;
    for (;;) {
        const bool has_next = S.next(ui + 1, nxt);
        const char* nA = has_next ? nxt.a : cA; const char* nB = has_next ? nxt.b : cB;
        const int nt = cur.nt;
        for (int t = 0; t < nt; t += 2) {
            const bool last = (t == nt - 2);
            const char* a1 = cA + (size_t)(t + 1) * kstep;
            const char* a2 = last ? nA : cA + (size_t)(t + 2) * kstep; const char* b2 = last ? nB : cB + (size_t)(t + 2) * kstep;
            const char* a3 = a2 + kstep; const char* b3 = b2 + kstep;
            PG8_LDB(B0, 0, 0); PG8_LDB(B1, 0, 1); PG8_SCHED; PG8_LDA(At, 0, 0); PG8_STAGE(PG8_SA(1, 1), a1 + hstepA, voffA);
            PG8_WAIT_V(8); PG8_WAIT_L(0); PG8_BAR; PG8_MMA(0, 0, At, B0); PG8_MMA(0, 1, At, B1); PG8_BAR; PG8_SCHED;
            PG8_LDA(At, 0, 1); PG8_STAGE(PG8_SB(0, 0), b2, voffB); PG8_STAGE(PG8_SB(0, 1), b2 + hstepB, voffB); PG8_STAGE(PG8_SA(0, 0), a2, voffA);
            PG8_WAIT_V(8); PG8_WAIT_L(0); PG8_BAR; PG8_MMA(1, 0, At, B0); PG8_MMA(1, 1, At, B1); PG8_BAR; PG8_SCHED;
            PG8_LDB(B0, 1, 0); PG8_LDB(B1, 1, 1); PG8_SCHED; PG8_LDA(At, 1, 0); PG8_STAGE(PG8_SA(0, 1), a2 + hstepA, voffA);
            PG8_WAIT_V(8); PG8_WAIT_L(0); PG8_BAR; PG8_MMA(0, 0, At, B0); PG8_MMA(0, 1, At, B1); PG8_BAR; PG8_SCHED;
            PG8_LDA(At, 1, 1); PG8_STAGE(PG8_SB(1, 0), b3, voffB); PG8_STAGE(PG8_SB(1, 1), b3 + hstepB, voffB); PG8_STAGE(PG8_SA(1, 0), a3, voffA);
            PG8_WAIT_V(8); PG8_WAIT_L(0); PG8_BAR; PG8_MMA(1, 0, At, B0); PG8_MMA(1, 1, At, B1); PG8_BAR; PG8_SCHED;
        }
        if (wr == 0) PG8_BAR;
        if constexpr (!Epi::AFTER_DRAIN) E(acc, cur, wr, wc, fr, fq);
        if (!has_next) break;
#pragma unroll
        for (int a = 0; a < 2; ++a)
#pragma unroll
            for (int b = 0; b < 2; ++b)
#pragma unroll
                for (int m = 0; m < 4; ++m)
#pragma unroll
                    for (int n = 0; n < 2; ++n) acc[a][b][m][n] = (f32x4){0.f, 0.f, 0.f, 0.f};
        cur = nxt; cA = nA; cB = nB; ++ui;
        if (wr == 1) PG8_BAR;
    }
    PG8_WAIT_V(0);
    PG8_BAR;
    if constexpr (Epi::AFTER_DRAIN) E.fused(acc, cur, wr, wc, fr, fq, lds, wid, lane);
#undef PG8_SA
#undef PG8_SB
#undef PG8_STAGE
#undef PG8_LDA
#undef PG8_LDB
#undef PG8_MMA
#undef PG8_WAIT_V
#undef PG8_WAIT_L
#undef PG8_BAR
#undef PG8_SCHED
}
}

struct SchedP1 {
    const char* A; const char* B; int G, vcu;
    __device__ __forceinline__ bool next(int i, pg8::Unit& u) const {
        const int U = i * G + vcu; if (U >= 64 * 24) return false;
        u.pm = 8 * ((U >> 5) & 7) + (U & 7); u.pn = 4 * (U >> 8) + ((U & 31) >> 3); u.j = 0; u.nt = 16;
        u.a = A + (size_t)u.pm * 256 * PITCHB; u.b = B + (size_t)u.pn * 256 * 2048; return true;
    }
};
struct SchedP3 {
    const char* ACTb; const char* Wg; const char* Wb; int G, vcu;
    __device__ __forceinline__ bool next(int i, pg8::Unit& u) const {
        const int T = vcu + (i / 6) * G; if (T >= 256) return false;
        const int s = i % 6; u.pm = 8 * (T >> 5) + (T & 7); u.pn = (T & 31) >> 3; u.j = s;
        const int j = s >> 1;
        if ((s & 1) == 0) { u.nt = 16; u.a = ACTb + (size_t)u.pm * 256 * PITCHB + C_H * 2; u.b = Wg + (size_t)(1024 * j + 256 * u.pn) * 2048; }
        else { u.nt = 8; u.a = ACTb + (size_t)u.pm * 256 * PITCHB + (size_t)(C_ZA + 2048 * j) * 2; u.b = Wb + (size_t)(1024 * j + 256 * u.pn) * 2048; }
        return true;
    }
};
struct SchedP4 {
    const char* ACTb; const char* Wo; int G, vcu;
    __device__ __forceinline__ bool next(int i, pg8::Unit& u) const {
        const int T = vcu + i * G; if (T >= 256) return false;
        u.pm = 8 * (T >> 5) + (T & 7); u.pn = (T & 31) >> 3; u.j = 0; u.nt = 16;
        u.a = ACTb + (size_t)u.pm * 256 * PITCHB + C_MERGED * 2; u.b = Wo + (size_t)(256 * u.pn) * 2048; return true;
    }
};

struct EpiP1 {
    static constexpr bool PERM = true, AFTER_DRAIN = false;
    bf16_t* ACT;
    __device__ __forceinline__ void operator()(const f32x4 (&acc)[2][2][4][2], const pg8::Unit& u, int wr, int wc, int fr, int fq) const {
        const int row0 = u.pm * 256 + wr * 64 + fr;
        if (u.pn >= 16) {
            const int T = u.pn - 16, col0 = (T < 4 ? C_PU + 128 * T : C_PZ + 128 * (T - 4)) + wc * 32 + 8 * fq;
#pragma unroll
            for (int ai = 0; ai < 2; ++ai)
#pragma unroll
                for (int m = 0; m < 4; ++m) { bf16_t* rowp = ACT + (size_t)(row0 + ai * 128 + m * 16) * PITCH + col0;
                    f32x4 v0 = acc[ai][1][m][0], v1 = acc[ai][1][m][1];
                    if (T >= 4) {
#pragma unroll
                        for (int e = 0; e < 4; ++e) { v0[e] = siluf_(v0[e]); v1[e] = siluf_(v1[e]); } }
                    v0 = v0 * acc[ai][0][m][0]; v1 = v1 * acc[ai][0][m][1];
                    u32x4 w; w.x = cvt_pk_bf16(v0[0], v0[1]); w.y = cvt_pk_bf16(v0[2], v0[3]); w.z = cvt_pk_bf16(v1[0], v1[1]); w.w = cvt_pk_bf16(v1[2], v1[3]);
                    *(u32x4*)rowp = w; }
            return;
        }
        const int grp = u.pn >> 1;
        const int kind = (grp == 0) ? 1 : ((grp == 3 || grp == 4 || grp == 7) ? 2 : 0);
        const int col0 = u.pn * 256 + wc * 32 + 8 * fq;
#pragma unroll
        for (int ai = 0; ai < 2; ++ai)
#pragma unroll
            for (int m = 0; m < 4; ++m) { bf16_t* rowp = ACT + (size_t)(row0 + ai * 128 + m * 16) * PITCH + col0;
#pragma unroll
                for (int bj = 0; bj < 2; ++bj) { f32x4 v0 = acc[ai][bj][m][0], v1 = acc[ai][bj][m][1];
                    if (kind == 1) { v0 = v0 * QSCALE; v1 = v1 * QSCALE; }
                    else if (kind == 2) {
#pragma unroll
                        for (int e = 0; e < 4; ++e) { v0[e] = siluf_(v0[e]); v1[e] = siluf_(v1[e]); } }
                    u32x4 w; w.x = cvt_pk_bf16(v0[0], v0[1]); w.y = cvt_pk_bf16(v0[2], v0[3]); w.z = cvt_pk_bf16(v1[0], v1[1]); w.w = cvt_pk_bf16(v1[2], v1[3]);
                    *(u32x4*)(rowp + bj * 128) = w; } }
    }
};
struct EpiP3 {
    static constexpr bool PERM = true, AFTER_DRAIN = false;
    unsigned char* ACTb;
    __device__ __forceinline__ void operator()(const f32x4 (&acc)[2][2][4][2], const pg8::Unit& u, int wr, int wc, int fr, int fq) const {
        const int s = u.j, j = s >> 1;
        const int row0 = u.pm * 256 + wr * 64 + fr, cl0 = wc * 32 + 8 * fq;
        const unsigned toff = 512u * (unsigned)u.pn, soff = 5120u + 512u * (unsigned)u.pn, moff = (unsigned)(C_MERGED + 256 * u.pn) * 2u;
        if ((s & 1) == 0) {
#pragma unroll
            for (int ai = 0; ai < 2; ++ai)
#pragma unroll
                for (int m = 0; m < 4; ++m) { unsigned char* rowp = ACTb + (size_t)(row0 + ai * 128 + m * 16) * PITCHB;
#pragma unroll
                    for (int bj = 0; bj < 2; ++bj) { const f32x4 v0 = acc[ai][bj][m][0], v1 = acc[ai][bj][m][1];
                        u32x4 w; w.x = cvt_pk_bf16(v0[0], v0[1]); w.y = cvt_pk_bf16(v0[2], v0[3]); w.z = cvt_pk_bf16(v1[0], v1[1]); w.w = cvt_pk_bf16(v1[2], v1[3]);
                        *(u32x4*)(rowp + soff + (cl0 + bj * 128) * 2) = w; } }
        } else {
#pragma unroll
            for (int ai = 0; ai < 2; ++ai) {
                u32x4 gq[4][2], tq[4][2];
#pragma unroll
                for (int m = 0; m < 4; ++m) { unsigned char* rowp = ACTb + (size_t)(row0 + ai * 128 + m * 16) * PITCHB;
#pragma unroll
                    for (int bj = 0; bj < 2; ++bj) { gq[m][bj] = *(const u32x4*)(rowp + soff + (cl0 + bj * 128) * 2); if (j > 0) tq[m][bj] = *(const u32x4*)(rowp + toff + (cl0 + bj * 128) * 2); } }
#pragma unroll
                for (int m = 0; m < 4; ++m) { unsigned char* rowp = ACTb + (size_t)(row0 + ai * 128 + m * 16) * PITCHB;
#pragma unroll
                    for (int bj = 0; bj < 2; ++bj) { const f32x4 v0 = acc[ai][bj][m][0], v1 = acc[ai][bj][m][1]; const u32x4 g = gq[m][bj];
                        f32x4 t0 = (f32x4){sigmoidf_(bf_lo(g.x)) * v0[0], sigmoidf_(bf_hi(g.x)) * v0[1], sigmoidf_(bf_lo(g.y)) * v0[2], sigmoidf_(bf_hi(g.y)) * v0[3]};
                        f32x4 t1 = (f32x4){sigmoidf_(bf_lo(g.z)) * v1[0], sigmoidf_(bf_hi(g.z)) * v1[1], sigmoidf_(bf_lo(g.w)) * v1[2], sigmoidf_(bf_hi(g.w)) * v1[3]};
                        if (j > 0) { const u32x4 tv = tq[m][bj];
                            t0 = t0 + (f32x4){bf_lo(tv.x), bf_hi(tv.x), bf_lo(tv.y), bf_hi(tv.y)}; t1 = t1 + (f32x4){bf_lo(tv.z), bf_hi(tv.z), bf_lo(tv.w), bf_hi(tv.w)}; }
                        u32x4 w; w.x = cvt_pk_bf16(t0[0], t0[1]); w.y = cvt_pk_bf16(t0[2], t0[3]); w.z = cvt_pk_bf16(t1[0], t1[1]); w.w = cvt_pk_bf16(t1[2], t1[3]);
                        if (j < 2) *(u32x4*)(rowp + toff + (cl0 + bj * 128) * 2) = w; else *(u32x4*)(rowp + moff + (cl0 + bj * 128) * 2) = w;
                    } }
            }
        }
    }
};
struct PanelStats {
    unsigned long long* xbuf;
    unsigned* cnt;
    float eps;
    __device__ __forceinline__ void run(const f32x4 (&v)[2][2][4][2], const pg8::Unit& u, int wr, int wc, int fr, int fq, LAS unsigned char* lds, int wid, int lane) const {
        LAS f32x2* Pt = (LAS f32x2*)lds;
        LAS f32x2* St = (LAS f32x2*)(lds + 8192);
#pragma unroll
        for (int ai = 0; ai < 2; ++ai)
#pragma unroll
            for (int m = 0; m < 4; ++m) {
                float s = 0.f;
#pragma unroll
                for (int bj = 0; bj < 2; ++bj)
#pragma unroll
                    for (int n = 0; n < 2; ++n) { const f32x4 x = v[ai][bj][m][n]; s += (x[0] + x[1]) + (x[2] + x[3]); }
                s += __shfl_xor(s, 16); s += __shfl_xor(s, 32);
                const float mw = s * (1.0f / 64.0f); float q = 0.f;
#pragma unroll
                for (int bj = 0; bj < 2; ++bj)
#pragma unroll
                    for (int n = 0; n < 2; ++n) { const f32x4 d = v[ai][bj][m][n] - mw; q += (d[0] * d[0] + d[1] * d[1]) + (d[2] * d[2] + d[3] * d[3]); }
                q += __shfl_xor(q, 16); q += __shfl_xor(q, 32);
                if (fq == 0) Pt[(ai * 128 + wr * 64 + m * 16 + fr) * 4 + wc] = (f32x2){mw, q};
            }
        __syncthreads();
        const int row = wid * 32 + (lane & 31);
        if (lane < 32) {
            const f32x2 a = Pt[row * 4 + 0], b = Pt[row * 4 + 1], c = Pt[row * 4 + 2], d = Pt[row * 4 + 3];
            const float mt = (a.x + b.x + c.x + d.x) * 0.25f;
            const float da = a.x - mt, db = b.x - mt, dc = c.x - mt, dd = d.x - mt;
            const float m2 = (a.y + b.y) + (c.y + d.y) + 64.0f * ((da * da + db * db) + (dc * dc + dd * dd));
            __hip_atomic_store(xbuf + ((size_t)(u.pm * 256 + row) * 4 + u.pn), ((unsigned long long)__float_as_uint(m2) << 32) | __float_as_uint(mt), __ATOMIC_RELAXED, __HIP_MEMORY_SCOPE_AGENT);
        }
        asm volatile("s_waitcnt vmcnt(0)" ::: "memory");
        if (lane == 0) __hip_atomic_fetch_add(cnt + 64 * u.pm, 1u, __ATOMIC_RELAXED, __HIP_MEMORY_SCOPE_AGENT);
        if (wid == 0) {
            unsigned sp = 0;
            while ((unsigned)__builtin_amdgcn_readfirstlane(__hip_atomic_load(cnt + 64 * u.pm, __ATOMIC_RELAXED, __HIP_MEMORY_SCOPE_AGENT)) < 32u) { __builtin_amdgcn_s_sleep(2); if (++sp > (1u << 24)) break; }
            __builtin_amdgcn_fence(__ATOMIC_ACQUIRE, "agent");
        }
        asm volatile("s_waitcnt vmcnt(0) lgkmcnt(0)" ::: "memory");
        __syncthreads();
        if (lane < 32) {
            const unsigned long long* slot = xbuf + (size_t)(u.pm * 256 + row) * 4; float mt[4], m2[4]; float ms = 0.f;
#pragma unroll
            for (int t = 0; t < 4; ++t) { const unsigned long long w = __hip_atomic_load(slot + t, __ATOMIC_RELAXED, __HIP_MEMORY_SCOPE_AGENT); mt[t] = __uint_as_float((unsigned)w); m2[t] = __uint_as_float((unsigned)(w >> 32)); ms += mt[t]; }
            const float mean = ms * 0.25f; float q = 0.f;
#pragma unroll
            for (int t = 0; t < 4; ++t) { const float dm = mt[t] - mean; q += m2[t] + 256.0f * dm * dm; }
            St[row] = (f32x2){mean, __builtin_amdgcn_rsqf(q * (1.0f / 1024.0f) + eps)};
        }
        __syncthreads();
    }
};
struct EpiP4F {
    static constexpr bool PERM = false, AFTER_DRAIN = true;
    const float* xprev; float* out; const float* gate; const float* lng; const float* lnb; const float* modn; bf16_t* ACT; PanelStats st1, st2;
    __device__ __forceinline__ void fused(f32x4 (&acc)[2][2][4][2], const pg8::Unit& u, int wr, int wc, int fr, int fq, LAS unsigned char* lds, int wid, int lane) const {
        const LAS f32x2* St = (const LAS f32x2*)(lds + 8192);
        const int row0 = u.pm * 256 + wr * 64 + fr, col0 = u.pn * 256 + wc * 32 + 4 * fq;
        const int bidx = (u.pm * 256) / SEQ;
        {
            const float* gp = gate + (size_t)bidx * 3072;
            f32x4 gv[2][2];
#pragma unroll
            for (int bj = 0; bj < 2; ++bj)
#pragma unroll
                for (int n = 0; n < 2; ++n) gv[bj][n] = *(const f32x4*)(gp + col0 + bj * 128 + n * 16) + 1.0f;
#pragma unroll
            for (int ai = 0; ai < 2; ++ai)
#pragma unroll
                for (int m = 0; m < 4; ++m) { const size_t off = (size_t)(row0 + ai * 128 + m * 16) * D_MODEL + col0;
#pragma unroll
                    for (int bj = 0; bj < 2; ++bj)
#pragma unroll
                        for (int n = 0; n < 2; ++n) { const f32x4 xv = *(const f32x4*)(xprev + off + bj * 128 + n * 16); acc[ai][bj][m][n] = xv * ALPHA + gv[bj][n] * acc[ai][bj][m][n]; }
                    asm volatile("" : "+v"(acc[ai][0][m][0]), "+v"(acc[ai][0][m][1]), "+v"(acc[ai][1][m][0]), "+v"(acc[ai][1][m][1]));
                    if (m & 1) asm volatile("" ::: "memory"); }
        }
        st1.run(acc, u, wr, wc, fr, fq, lds, wid, lane);
        {
            f32x4 lg[2][2], lb[2][2];
#pragma unroll
            for (int bj = 0; bj < 2; ++bj)
#pragma unroll
                for (int n = 0; n < 2; ++n) { lg[bj][n] = *(const f32x4*)(lng + col0 + bj * 128 + n * 16); lb[bj][n] = *(const f32x4*)(lnb + col0 + bj * 128 + n * 16); }
#pragma unroll
            for (int ai = 0; ai < 2; ++ai)
#pragma unroll
                for (int m = 0; m < 4; ++m) { const int r = ai * 128 + wr * 64 + m * 16 + fr; const f32x2 sr = St[r]; const size_t off = (size_t)(u.pm * 256 + r) * D_MODEL + col0;
#pragma unroll
                    for (int bj = 0; bj < 2; ++bj)
#pragma unroll
                        for (int n = 0; n < 2; ++n) { const f32x4 x1 = (acc[ai][bj][m][n] - sr.x) * sr.y * lg[bj][n] + lb[bj][n]; acc[ai][bj][m][n] = x1; *(f32x4*)(out + off + bj * 128 + n * 16) = x1; }
                    asm volatile("" : "+v"(acc[ai][0][m][0]), "+v"(acc[ai][0][m][1]), "+v"(acc[ai][1][m][0]), "+v"(acc[ai][1][m][1]));
                    asm volatile("" ::: "memory"); }
        }
        if (modn) {
            st2.run(acc, u, wr, wc, fr, fq, lds, wid, lane);
            const float* mp = modn + (size_t)bidx * 3072;
            f32x4 sc[2][2], sh[2][2];
#pragma unroll
            for (int bj = 0; bj < 2; ++bj)
#pragma unroll
                for (int n = 0; n < 2; ++n) { sh[bj][n] = *(const f32x4*)(mp + col0 + bj * 128 + n * 16); sc[bj][n] = *(const f32x4*)(mp + 1024 + col0 + bj * 128 + n * 16) + 1.0f; }
#pragma unroll
            for (int ai = 0; ai < 2; ++ai)
#pragma unroll
                for (int m = 0; m < 4; ++m) { const int r = ai * 128 + wr * 64 + m * 16 + fr; const f32x2 sr = St[r]; bf16_t* hp = ACT + (size_t)(u.pm * 256 + r) * PITCH + C_H + col0;
#pragma unroll
                    for (int bj = 0; bj < 2; ++bj)
#pragma unroll
                        for (int n = 0; n < 2; ++n) { const f32x4 hv = (acc[ai][bj][m][n] - sr.x) * sr.y * sc[bj][n] + sh[bj][n];
                            u32x2 w; w.x = cvt_pk_bf16(hv[0], hv[1]); w.y = cvt_pk_bf16(hv[2], hv[3]); *(u32x2*)(hp + bj * 128 + n * 16) = w; }
                    asm volatile("" ::: "memory"); }
        }
    }
};

__device__ __forceinline__ void transpose_item(const float* W, int N, bf16_t* WT, int ldw, LAS float* scr, int item, int lane, bool conv_perm = false) {
    const int nblk = N / 32, kb = item / nblk, nb = item % nblk, k0 = 64 * kb, n0 = 32 * nb;
    int d0 = n0;
    if (conv_perm && n0 >= 4096 && n0 < 6144) { const int g = (n0 - 4096) >> 9, ch0 = (n0 - 4096) & 511; d0 = 4096 + 256 * ((ch0 >> 7) + ((g & 1) ? 4 : 0)) + 128 * (g >> 1) + (ch0 & 127); }
    const int kr = lane >> 3, n4 = (lane & 7) * 4;
    f32x4 v[8];
#pragma unroll
    for (int i = 0; i < 8; ++i) v[i] = *(const f32x4*)(W + (size_t)(k0 + 8 * i + kr) * N + n0 + n4);
#pragma unroll
    for (int i = 0; i < 8; ++i) { LAS float* d = scr + (8 * i + kr) * 33 + n4; d[0] = v[i].x; d[1] = v[i].y; d[2] = v[i].z; d[3] = v[i].w; }
    asm volatile("s_waitcnt lgkmcnt(0)" ::: "memory");
    const int c = lane & 7;
#pragma unroll
    for (int j = 0; j < 4; ++j) { const int n = (lane >> 3) + 8 * j; const LAS float* s = scr + (8 * c) * 33 + n;
        u32x4 o; o.x = cvt_pk_bf16(s[0 * 33], s[1 * 33]); o.y = cvt_pk_bf16(s[2 * 33], s[3 * 33]); o.z = cvt_pk_bf16(s[4 * 33], s[5 * 33]); o.w = cvt_pk_bf16(s[6 * 33], s[7 * 33]);
        *(u32x4*)(WT + (size_t)(d0 + n) * ldw + k0 + 8 * c) = o; }
    asm volatile("s_waitcnt lgkmcnt(0)" ::: "memory");
}

__device__ __forceinline__ void row_standardize(f32x4 (&v)[4]) {
    float s = 0.f;
#pragma unroll
    for (int j = 0; j < 4; ++j) s += (v[j].x + v[j].y) + (v[j].z + v[j].w);
    const float mean = wave_sum(s) * (1.f / D_MODEL); float s2 = 0.f;
#pragma unroll
    for (int j = 0; j < 4; ++j) { v[j] = v[j] - mean; s2 += (v[j].x * v[j].x + v[j].y * v[j].y) + (v[j].z * v[j].z + v[j].w * v[j].w); }
    const float rstd = __builtin_amdgcn_rsqf(wave_sum(s2) * (1.f / D_MODEL) + LN_EPS);
#pragma unroll
    for (int j = 0; j < 4; ++j) v[j] = v[j] * rstd;
}
__device__ __forceinline__ void write_h_row(const f32x4 (&v)[4], const float* modb, bf16_t* hrow, int lane) {
#pragma unroll
    for (int j = 0; j < 4; ++j) { const int col = 4 * (lane + 64 * j);
        const f32x4 sh = *(const f32x4*)(modb + col), sc = *(const f32x4*)(modb + 1024 + col);
        const f32x4 h = v[j] * (sc + 1.0f) + sh;
        u32x2 w; w.x = cvt_pk_bf16(h.x, h.y); w.y = cvt_pk_bf16(h.z, h.w);
        *(u32x2*)(hrow + col) = w; }
}

typedef short v4i16_t __attribute__((ext_vector_type(4)));
__device__ __forceinline__ s16x4 vtr(const LAS bf16_t* p) { return __builtin_bit_cast(s16x4, __builtin_amdgcn_ds_read_tr16_b64_v4i16((LAS v4i16_t*)p)); }
constexpr float STICK_DEAD = -44.0f;
__device__ __forceinline__ void attn_unit(LAS unsigned char* lds, bf16_t* ACT, int b, int h, int qb) {
    const int tid = fresh_tid(), lane = tid & 63, r32 = lane & 31, hi = lane >> 5;
    const int wid = __builtin_amdgcn_readfirstlane(tid >> 6);
    bf16_t* base = ACT + (size_t)b * SEQ * PITCH;
    const int tq0 = qb * 256 + wid * 32, tq = tq0 + r32;
    LAS bf16_t* Kw = (LAS bf16_t*)(lds + wid * 9728);
    LAS bf16_t* Vw = Kw + 32 * 72;
    LAS float* stg = (LAS float*)(lds + wid * 9728);
    bf16x8 qr[4];
#pragma unroll
    for (int d0 = 0; d0 < 4; ++d0) qr[d0] = *(const bf16x8*)(base + (size_t)tq * PITCH + C_QA + h * 64 + d0 * 16 + hi * 8);
    f32x16 o0, o1;
#pragma unroll
    for (int r = 0; r < 16; ++r) { o0[r] = 0.f; o1[r] = 0.f; }
    float R = 0.f;
    const int srow = lane >> 3, sch = lane & 7;
    const bf16_t* kg = base + (size_t)srow * PITCH + C_KA + h * 64 + sch * 8;
    const bf16_t* vg = base + (size_t)srow * PITCH + C_VA + h * 64 + sch * 8;
    const LAS bf16_t* vb = Vw + (4 * hi + ((lane & 15) >> 2)) * 80 + 16 * ((lane >> 4) & 1) + 4 * (lane & 3);
    u32x4 kreg[4], vreg[4];
    int kb = tq0;
#pragma unroll
    for (int i = 0; i < 4; ++i) { kreg[i] = *(const u32x4*)(kg + (size_t)(kb + 8 * i) * PITCH); vreg[i] = *(const u32x4*)(vg + (size_t)(kb + 8 * i) * PITCH); }
    for (;;) {
#pragma unroll
        for (int i = 0; i < 4; ++i) { *(LAS u32x4*)(Kw + (srow + 8 * i) * 72 + sch * 8) = kreg[i]; *(LAS u32x4*)(Vw + (srow + 8 * i) * 80 + sch * 8) = vreg[i]; }
        const int kbn = kb - 32;
        if (kbn >= 0) {
#pragma unroll
            for (int i = 0; i < 4; ++i) { kreg[i] = *(const u32x4*)(kg + (size_t)(kbn + 8 * i) * PITCH); vreg[i] = *(const u32x4*)(vg + (size_t)(kbn + 8 * i) * PITCH); }
        }
        f32x16 p0;
#pragma unroll
        for (int r = 0; r < 16; ++r) p0[r] = 0.f;
#pragma unroll
        for (int d0 = 0; d0 < 4; ++d0) {
            const bf16x8 a0 = *(const LAS bf16x8*)(Kw + r32 * 72 + d0 * 16 + hi * 8);
            p0 = __builtin_amdgcn_mfma_f32_32x32x16_bf16(a0, qr[d0], p0, 0, 0, 0);
        }
        float x0[16];
        if (kb < tq0) {
#pragma unroll
            for (int r = 0; r < 16; ++r) { const float z = p0[r]; const float sp = fmaxf(z, 0.f) + lg2(1.0f + ex2(-fabsf(z))); x0[r] = sp; p0[r] = z - sp; }
        } else {
            const int kvl = kb + 4 * hi;
#pragma unroll
            for (int r = 0; r < 16; ++r) { const int kv = kvl + (r & 3) + 8 * (r >> 2);
                const float z = p0[r]; const float sp = fmaxf(z, 0.f) + lg2(1.0f + ex2(-fabsf(z))); const bool ok = kv < tq; x0[r] = ok ? sp : 0.f; p0[r] = ok ? z - sp : -INFINITY; }
        }
        float Gs[4], Gh1[4], Tt[4];
#pragma unroll
        for (int g = 0; g < 4; ++g) Gs[g] = (x0[4 * g] + x0[4 * g + 1]) + (x0[4 * g + 2] + x0[4 * g + 3]);
#pragma unroll
        for (int g = 0; g < 4; ++g) { auto rr = __builtin_amdgcn_permlane32_swap(__float_as_uint(Gs[g]), __float_as_uint(Gs[g]), false, false);
            Gh1[g] = __uint_as_float(rr[1]); Tt[g] = __uint_as_float(rr[0]) + __uint_as_float(rr[1]); }
        float run = R;
#pragma unroll
        for (int g = 3; g >= 0; --g) {
            const float off = hi ? run : run - Gh1[g];
            const int q4 = 4 * g;
            const float s3 = off, s2 = s3 - x0[q4 + 3], s1 = s2 - x0[q4 + 2], s0 = s1 - x0[q4 + 1];
            p0[q4 + 3] = ex2(p0[q4 + 3] + s3); p0[q4 + 2] = ex2(p0[q4 + 2] + s2); p0[q4 + 1] = ex2(p0[q4 + 1] + s1); p0[q4] = ex2(p0[q4] + s0);
            run -= Tt[g];
        }
        R = run;
#pragma unroll
        for (int s = 0; s < 2; ++s) {
            u32x4 w; const int r0 = 8 * s;
            w.x = cvt_pk_bf16(p0[r0], p0[r0 + 1]); w.y = cvt_pk_bf16(p0[r0 + 2], p0[r0 + 3]); w.z = cvt_pk_bf16(p0[r0 + 4], p0[r0 + 5]); w.w = cvt_pk_bf16(p0[r0 + 6], p0[r0 + 7]);
            const bf16x8 af = __builtin_bit_cast(bf16x8, w);
            { const s16x4 lo = vtr(vb + (16 * s) * 80), hh = vtr(vb + (16 * s + 8) * 80);
              const bf16x8 bfr = (bf16x8){lo[0], lo[1], lo[2], lo[3], hh[0], hh[1], hh[2], hh[3]};
              o0 = __builtin_amdgcn_mfma_f32_32x32x16_bf16(af, bfr, o0, 0, 0, 0); }
            { const s16x4 lo = vtr(vb + (16 * s) * 80 + 32), hh = vtr(vb + (16 * s + 8) * 80 + 32);
              const bf16x8 bfr = (bf16x8){lo[0], lo[1], lo[2], lo[3], hh[0], hh[1], hh[2], hh[3]};
              o1 = __builtin_amdgcn_mfma_f32_32x32x16_bf16(af, bfr, o1, 0, 0, 0); }
        }
        if (kbn < 0 || !__any(R > STICK_DEAD)) break;
        kb = kbn;
    }
#pragma unroll
    for (int r = 0; r < 16; ++r) { stg[crow(r, hi) * 68 + r32] = o0[r]; stg[crow(r, hi) * 68 + 32 + r32] = o1[r]; }
    asm volatile("s_waitcnt lgkmcnt(0)" ::: "memory");
#pragma unroll
    for (int i = 0; i < 4; ++i) { const int row = i * 8 + (lane >> 3), ch = lane & 7;
        const f32x4 a = *(const LAS f32x4*)(stg + row * 68 + ch * 8), c = *(const LAS f32x4*)(stg + row * 68 + ch * 8 + 4);
        bf16_t* zp = base + (size_t)(tq0 + row) * PITCH + C_ZA + h * 64 + ch * 8;
        const u32x4 z = *(const u32x4*)zp;
        u32x4 w; w.x = cvt_pk_bf16(a.x * bf_lo(z.x), a.y * bf_hi(z.x)); w.y = cvt_pk_bf16(a.z * bf_lo(z.y), a.w * bf_hi(z.y));
        w.z = cvt_pk_bf16(c.x * bf_lo(z.z), c.y * bf_hi(z.z)); w.w = cvt_pk_bf16(c.z * bf_lo(z.w), c.w * bf_hi(z.w));
        *(u32x4*)zp = w; }
    asm volatile("s_waitcnt lgkmcnt(0)" ::: "memory");
}

__device__ __forceinline__ float layer_lb(const float* lower_bounds, int l, int ch) {
    float mx = -INFINITY;
    for (int i = 0; i < DEPTH; ++i) mx = fmaxf(mx, lower_bounds[i * 512 + ch]);
    float den = 0.f, num = 0.f;
    for (int i = 0; i < DEPTH; ++i) { const float e = __expf(lower_bounds[i * 512 + ch] - mx); den += e; if (i >= 1 && i <= l) num += e; }
    return num / den;
}
template <int MODE>
__device__ __forceinline__ void hgrn_pass(LAS unsigned char* lds, bf16_t* ACT, const Params& P, int l, int bh, int c0, int nc) {
    const int tid = fresh_tid(), lane = tid & 63, r32 = lane & 31, hi = lane >> 5;
    const int wid = __builtin_amdgcn_readfirstlane(tid >> 6);
    LAS bf16_t* Q1 = (LAS bf16_t*)(lds);
    LAS bf16_t* Q2 = (LAS bf16_t*)(lds + 17408);
    LAS bf16_t* K2 = (LAS bf16_t*)(lds + 34816);
    LAS float*  OT = (LAS float*)(lds);
    LAS bf16_t* K3T = (LAS bf16_t*)(lds + 52224);
    LAS bf16_t* VT = (LAS bf16_t*)(lds + 70656);
    LAS bf16_t* Pm = (LAS bf16_t*)(lds + 89088);
    LAS bf16_t* ST = (LAS bf16_t*)(lds + 98304);
    LAS float* DEND = (LAS float*)(lds + 133120);
    LAS float* SCX = (LAS float*)(lds + 133632);
    const int d = tid & 127, part = tid >> 7, b = bh >> 2, h = bh & 3, grp = c0 / nc;
    const float lbv = layer_lb(P.lower_bounds, l, h * 128 + d);
    bf16_t* base = ACT + (size_t)b * SEQ * PITCH + h * 128;
    bf16_t* Ug = (bf16_t*)(P.ws + WS_U) + (size_t)bh * 8 * 16384;
    float* Dg = (float*)(P.ws + WS_DEND) + (size_t)bh * 8 * 128;
    const float* nw = P.hgrn_norm_w + l * 128;
    const int tb = wid & 1, eb = wid >> 1;
    bf16_t fin[16], qin[16], vin[16];
#pragma unroll
    for (int i = 0; i < 16; ++i) { const bf16_t* rp = base + (size_t)(c0 * 64 + 16 * part + i) * PITCH + d; fin[i] = rp[C_FB]; vin[i] = rp[C_IB]; if (MODE == 1) qin[i] = rp[C_QB]; }
    f32x16 sa[2];
#pragma unroll
    for (int r = 0; r < 16; ++r) { sa[0][r] = 0.f; sa[1][r] = 0.f; }
    float bsum = 0.f;
    if (MODE == 1) {
        for (int i = 0; i < 4; ++i) { const int idx = tid + 512 * i;
            const u32x4 v = (grp > 0) ? *(const u32x4*)(Ug + (size_t)(grp - 1) * 16384 + (idx >> 4) * 128 + (idx & 15) * 8) : (u32x4){0u, 0u, 0u, 0u};
            *(LAS u32x4*)(ST + (idx >> 4) * 136 + (idx & 15) * 8) = v; }
        __syncthreads();
#pragma unroll
        for (int i = 0; i < 2; ++i) { const int db = 2 * (wid & 1) + i;
#pragma unroll
            for (int g = 0; g < 4; ++g) { const u32x2 w = *(const LAS u32x2*)(ST + (32 * eb + r32) * 136 + 32 * db + 8 * g + 4 * hi);
                sa[i][4 * g] = bf_lo(w.x); sa[i][4 * g + 1] = bf_hi(w.x); sa[i][4 * g + 2] = bf_lo(w.y); sa[i][4 * g + 3] = bf_hi(w.y); } }
    }
    for (int ci = 0; ci < nc; ++ci) {
        const int c = c0 + ci;
        float g2[16], kk[16];
        float runb = 0.f;
#pragma unroll
        for (int i = 0; i < 16; ++i) { const float f = lbv + (1.0f - lbv) * sigmoidf_(bf2f(fin[i])); kk[i] = 1.0f - f; runb += lg2(f); g2[i] = runb; }
        SCX[part * 128 + d] = runb;
        __syncthreads();
        const float t0 = SCX[d], t1 = SCX[128 + d], t2 = SCX[256 + d], t3 = SCX[384 + d];
        const float offp = (part > 0 ? t0 : 0.f) + (part > 1 ? t1 : 0.f) + (part > 2 ? t2 : 0.f);
        const float cmid = t0 + t1, bend = (t0 + t1) + (t2 + t3);
        bsum += bend;
        if (part == 0) DEND[d] = ex2(bend);
        {
            unsigned k3w[8], vw[8];
#pragma unroll
            for (int i = 0; i < 16; i += 2) {
                const float B0 = offp + g2[i], B1 = offp + g2[i + 1];
                if (MODE == 1) {
                    const float q0 = bf2f(qin[i]), q1 = bf2f(qin[i + 1]);
                    const int t = 16 * part + i;
                    Q1[t * 136 + d] = (bf16_t)(cvt_pk_bf16(q0 * ex2(B0), 0.f) & 0xffffu); Q1[(t + 1) * 136 + d] = (bf16_t)(cvt_pk_bf16(q1 * ex2(B1), 0.f) & 0xffffu);
                    Q2[t * 136 + d] = (bf16_t)(cvt_pk_bf16(q0 * ex2(B0 - cmid), 0.f) & 0xffffu); Q2[(t + 1) * 136 + d] = (bf16_t)(cvt_pk_bf16(q1 * ex2(B1 - cmid), 0.f) & 0xffffu);
                    K2[t * 136 + d] = (bf16_t)(cvt_pk_bf16(kk[i] * ex2(cmid - B0), 0.f) & 0xffffu); K2[(t + 1) * 136 + d] = (bf16_t)(cvt_pk_bf16(kk[i + 1] * ex2(cmid - B1), 0.f) & 0xffffu);
                }
                k3w[i >> 1] = cvt_pk_bf16(kk[i] * ex2(bend - B0), kk[i + 1] * ex2(bend - B1));
                vw[i >> 1] = (unsigned)vin[i] | ((unsigned)vin[i + 1] << 16);
            }
            *(LAS u32x4*)(K3T + d * 72 + 16 * part) = (u32x4){k3w[0], k3w[1], k3w[2], k3w[3]}; *(LAS u32x4*)(K3T + d * 72 + 16 * part + 8) = (u32x4){k3w[4], k3w[5], k3w[6], k3w[7]};
            *(LAS u32x4*)(VT + d * 72 + 16 * part) = (u32x4){vw[0], vw[1], vw[2], vw[3]}; *(LAS u32x4*)(VT + d * 72 + 16 * part + 8) = (u32x4){vw[4], vw[5], vw[6], vw[7]};
        }
        if (ci + 1 < nc) {
#pragma unroll
            for (int i = 0; i < 16; ++i) { const bf16_t* rp = base + (size_t)((c + 1) * 64 + 16 * part + i) * PITCH + d; fin[i] = rp[C_FB]; vin[i] = rp[C_IB]; if (MODE == 1) qin[i] = rp[C_QB]; }
        }
        __syncthreads();
        if (MODE == 0) {
#pragma unroll
            for (int i = 0; i < 2; ++i) {
                const int db = 2 * (wid & 1) + i;
#pragma unroll
                for (int r = 0; r < 16; ++r) sa[i][r] *= DEND[32 * db + crow(r, hi)];
#pragma unroll
                for (int ks = 0; ks < 4; ++ks) {
                    const bf16x8 a = *(const LAS bf16x8*)(K3T + (32 * db + r32) * 72 + 16 * ks + 8 * hi);
                    const bf16x8 bb = *(const LAS bf16x8*)(VT + (32 * eb + r32) * 72 + 16 * ks + 8 * hi);
                    sa[i] = __builtin_amdgcn_mfma_f32_32x32x16_bf16(a, bb, sa[i], 0, 0, 0);
                }
            }
        } else {
            f32x16 o;
#pragma unroll
            for (int r = 0; r < 16; ++r) o[r] = 0.f;
            if (c > 0) {
#pragma unroll
                for (int ks = 0; ks < 8; ++ks) {
                    const bf16x8 a = *(const LAS bf16x8*)(Q1 + (32 * tb + r32) * 136 + 16 * ks + 8 * hi);
                    const bf16x8 bb = *(const LAS bf16x8*)(ST + (32 * eb + r32) * 136 + 16 * ks + 8 * hi);
                    o = __builtin_amdgcn_mfma_f32_32x32x16_bf16(a, bb, o, 0, 0, 0);
                }
            }
            if (wid < 4) {
                const int stb = wid & 1, ssb = wid >> 1;
                f32x16 sc;
#pragma unroll
                for (int r = 0; r < 16; ++r) sc[r] = 0.f;
                if (!(stb == 0 && ssb == 1)) {
#pragma unroll
                    for (int ks = 0; ks < 8; ++ks) {
                        const bf16x8 a = *(const LAS bf16x8*)(Q2 + (32 * stb + r32) * 136 + 16 * ks + 8 * hi);
                        const bf16x8 bb = *(const LAS bf16x8*)(K2 + (32 * ssb + r32) * 136 + 16 * ks + 8 * hi);
                        sc = __builtin_amdgcn_mfma_f32_32x32x16_bf16(a, bb, sc, 0, 0, 0);
                    }
                }
#pragma unroll
                for (int r = 0; r < 16; ++r) { const int t = 32 * stb + crow(r, hi), s = 32 * ssb + r32;
                    const float v = (s <= t) ? sc[r] : 0.f;
                    Pm[t * 72 + s] = (bf16_t)(cvt_pk_bf16(v, 0.f) & 0xffffu); }
            }
            __syncthreads();
            unsigned zz[8];
#pragma unroll
            for (int i = 0; i < 8; ++i) zz[i] = *(const unsigned*)(base + (size_t)(c * 64 + 8 * wid + i) * PITCH + C_ZB + 2 * lane);
#pragma unroll
            for (int ks = 0; ks < 4; ++ks) {
                const bf16x8 a = *(const LAS bf16x8*)(Pm + (32 * tb + r32) * 72 + 16 * ks + 8 * hi);
                const bf16x8 bb = *(const LAS bf16x8*)(VT + (32 * eb + r32) * 72 + 16 * ks + 8 * hi);
                o = __builtin_amdgcn_mfma_f32_32x32x16_bf16(a, bb, o, 0, 0, 0);
            }
#pragma unroll
            for (int r = 0; r < 16; ++r) OT[(32 * tb + crow(r, hi)) * 132 + 32 * eb + r32] = o[r];
            if (ci + 1 < nc) {
#pragma unroll
                for (int i = 0; i < 2; ++i) {
                    const int db = 2 * (wid & 1) + i;
#pragma unroll
                    for (int r = 0; r < 16; ++r) sa[i][r] *= DEND[32 * db + crow(r, hi)];
#pragma unroll
                    for (int ks = 0; ks < 4; ++ks) {
                        const bf16x8 a = *(const LAS bf16x8*)(K3T + (32 * db + r32) * 72 + 16 * ks + 8 * hi);
                        const bf16x8 bb = *(const LAS bf16x8*)(VT + (32 * eb + r32) * 72 + 16 * ks + 8 * hi);
                        sa[i] = __builtin_amdgcn_mfma_f32_32x32x16_bf16(a, bb, sa[i], 0, 0, 0);
                    }
#pragma unroll
                    for (int g = 0; g < 4; ++g) { u32x2 w; w.x = cvt_pk_bf16(sa[i][4 * g], sa[i][4 * g + 1]); w.y = cvt_pk_bf16(sa[i][4 * g + 2], sa[i][4 * g + 3]);
                        *(LAS u32x2*)(ST + (32 * eb + r32) * 136 + 32 * db + 8 * g + 4 * hi) = w; }
                }
            }
            __syncthreads();
            {
                const f32x2 nwv = *(const f32x2*)(nw + 2 * lane);
#pragma unroll
                for (int i = 0; i < 8; ++i) { const int t = 8 * wid + i;
                    const f32x2 v = *(const LAS f32x2*)(OT + t * 132 + 2 * lane);
                    const float ss = wave_sum(v.x * v.x + v.y * v.y);
                    const float rstd = __builtin_amdgcn_rsqf(ss * (1.0f / 128.0f) + RMS_EPS);
                    unsigned* zp = (unsigned*)(base + (size_t)(c * 64 + t) * PITCH + C_ZB + 2 * lane);
                    *zp = cvt_pk_bf16(v.x * rstd * nwv.x * bf_lo(zz[i]), v.y * rstd * nwv.y * bf_hi(zz[i])); }
            }
        }
    }
    if (MODE == 0) {
        __syncthreads();
#pragma unroll
        for (int i = 0; i < 2; ++i) { const int db = 2 * (wid & 1) + i;
#pragma unroll
            for (int g = 0; g < 4; ++g) { u32x2 w; w.x = cvt_pk_bf16(sa[i][4 * g], sa[i][4 * g + 1]); w.y = cvt_pk_bf16(sa[i][4 * g + 2], sa[i][4 * g + 3]);
                *(LAS u32x2*)(ST + (32 * eb + r32) * 136 + 32 * db + 8 * g + 4 * hi) = w; } }
        __syncthreads();
#pragma unroll
        for (int i = 0; i < 4; ++i) { const int idx = tid + 512 * i;
            *(u32x4*)(Ug + (size_t)grp * 16384 + (idx >> 4) * 128 + (idx & 15) * 8) = *(const LAS u32x4*)(ST + (idx >> 4) * 136 + (idx & 15) * 8); }
        if (part == 0) Dg[grp * 128 + d] = ex2(bsum);
    }
    __syncthreads();
}

__device__ __forceinline__ void unpack8(const u32x4 a, float (&o)[8]) {
    o[0] = bf_lo(a.x); o[1] = bf_hi(a.x); o[2] = bf_lo(a.y); o[3] = bf_hi(a.y); o[4] = bf_lo(a.z); o[5] = bf_hi(a.z); o[6] = bf_lo(a.w); o[7] = bf_hi(a.w);
}
__device__ __forceinline__ void conv_item(bf16_t* ACT, const float* cw, int item) {
    const int tid = fresh_tid(), cgp = tid & 63, sub = tid >> 6;
    const int m0 = item * 64 + sub * 8, ch = cgp * 8;
    float w0[8], w1[8], w2[8];
#pragma unroll
    for (int e = 0; e < 8; ++e) { w0[e] = cw[ch + e]; w1[e] = cw[512 + ch + e]; w2[e] = cw[1024 + ch + e]; }
    float p1[8], p2[8];
#pragma unroll
    for (int e = 0; e < 8; ++e) { p1[e] = 0.f; p2[e] = 0.f; }
    if ((m0 % SEQ) != 0) {
        unpack8(*(const u32x4*)(ACT + (size_t)(m0 - 2) * PITCH + C_PU + ch), p2);
        unpack8(*(const u32x4*)(ACT + (size_t)(m0 - 1) * PITCH + C_PU + ch), p1);
    }
    u32x4 pa[8], pzv[8];
#pragma unroll
    for (int i = 0; i < 8; ++i) { const bf16_t* rp = ACT + (size_t)(m0 + i) * PITCH + ch; pa[i] = *(const u32x4*)(rp + C_PU); pzv[i] = *(const u32x4*)(rp + C_PZ); }
#pragma unroll
    for (int i = 0; i < 8; ++i) {
        float pu[8], pz[8], y[8];
        unpack8(pa[i], pu); unpack8(pzv[i], pz);
#pragma unroll
        for (int e = 0; e < 8; ++e) { y[e] = pz[e] * (w0[e] * p2[e] + w1[e] * p1[e] + w2[e] * pu[e]); p2[e] = p1[e]; p1[e] = pu[e]; }
        u32x4 w; w.x = cvt_pk_bf16(y[0], y[1]); w.y = cvt_pk_bf16(y[2], y[3]); w.z = cvt_pk_bf16(y[4], y[5]); w.w = cvt_pk_bf16(y[6], y[7]);
        *(u32x4*)(ACT + (size_t)(m0 + i) * PITCH + C_ZC + ch) = w;
    }
}

__device__ __forceinline__ void convert_weights(const Params& P, int l, LAS unsigned char* lds, int gw, int NGW, int wid, int lane) {
    LAS float* scr = (LAS float*)(lds + wid * 16384);
    unsigned char* ws = P.ws;
    constexpr int I_IN = 16 * (IN_COLS / 32), I_B = 8 * 32, I_O = 16 * 32, I_L = I_IN + 3 * I_B + I_O;
    for (int it = gw; it < I_L; it += NGW) {
        int r = it;
        if (r < I_IN) { transpose_item(P.w_in + (size_t)l * 1024 * IN_COLS, IN_COLS, (bf16_t*)(ws + WS_WIN), 1024, scr, r, lane, true); continue; } r -= I_IN;
        if (r < 3 * I_B) { const int j = r / I_B; transpose_item(P.w_branch + (size_t)(l * 3 + j) * 512 * 1024, 1024, (bf16_t*)(ws + WS_WB) + (size_t)j * 1024 * 1024, 1024, scr, r % I_B, lane); continue; } r -= 3 * I_B;
        transpose_item(P.w_out + (size_t)l * 1024 * 1024, 1024, (bf16_t*)(ws + WS_WO), 1024, scr, r, lane);
    }
}

typedef const __attribute__((address_space(4))) Params* KParamsPtr;
#define XB_TMO      128
#define XB_XCNT(j)  (256  + 64 * (j))
#define XB_XSUB(j)  (1280 + 64 * (j))
#define XB_XGEN(j)  (2304 + 64 * (j))
#define XB_TOP      3328
#define XB_TOPGEN   3392
#define XCD_BAR_WORDS 3456
#define XB_SPIN_CAP (1u << 22)
__device__ __forceinline__ unsigned xb_ld(unsigned* p)              { return __hip_atomic_load(p, __ATOMIC_RELAXED, __HIP_MEMORY_SCOPE_AGENT); }
__device__ __forceinline__ unsigned xb_add(unsigned* p, unsigned v) { return __hip_atomic_fetch_add(p, v, __ATOMIC_RELAXED, __HIP_MEMORY_SCOPE_AGENT); }
__device__ __forceinline__ unsigned xb_xcc_id() { return (unsigned)__builtin_amdgcn_s_getreg((3 << 11) | 20) & 0xFu; }
#define XB_SPIN(cond, bar) do { unsigned _sp = 0; while (cond) { __builtin_amdgcn_s_sleep(1); \
    if ((++_sp & 255u) == 0u) { if (xb_ld(&(bar)[XB_TMO])) break; if (_sp > XB_SPIN_CAP) { atomicAdd(&(bar)[XB_TMO], 1u); break; } } } } while (0)
__device__ __forceinline__ void xcd_barrier_complete(unsigned* bar, unsigned x, unsigned& nloc, unsigned& nx) {
    const unsigned G = gridDim.x * gridDim.y * gridDim.z;
    unsigned sum, cnt, mine, sp = 0u;
    for (;;) {
        sum = 0u; cnt = 0u; mine = 0u;
#pragma unroll
        for (unsigned j = 0; j < 16; ++j) { const unsigned c = xb_ld(&bar[XB_XCNT(j)]); sum += c; cnt += (c > 0u) ? 1u : 0u; mine = (j == x) ? c : mine; }
        if (sum == G) break;
        __builtin_amdgcn_s_sleep(1);
        if ((++sp & 255u) == 0u) { if (xb_ld(&bar[XB_TMO])) break; if (sp > XB_SPIN_CAP) { atomicAdd(&bar[XB_TMO], 1u); break; } }
    }
    nloc = mine > 0u ? mine : 1u; nx = cnt > 0u ? cnt : 1u;
}
__device__ __forceinline__ void xcd_barrier(unsigned* bar, volatile LAS unsigned* st) {
    asm volatile("s_waitcnt vmcnt(0)" ::: "memory");
    __syncthreads();
    if (threadIdx.x == 0) {
        __builtin_amdgcn_s_waitcnt(0);
        const unsigned x = xb_xcc_id();
        unsigned nloc = st[0], nx = st[1];
        if (nloc == 0u) { xcd_barrier_complete(bar, x, nloc, nx); st[0] = nloc; st[1] = nx; }
        const unsigned old = xb_add(&bar[XB_XSUB(x)], 1u);
        const unsigned gen = old / nloc;
        if (old + 1u == (gen + 1u) * nloc) {
            __builtin_amdgcn_fence(__ATOMIC_RELEASE, "agent");
            asm volatile("s_waitcnt vmcnt(0)" ::: "memory");
            const unsigned og = xb_add(&bar[XB_TOP], 1u);
            const unsigned tg = og / nx;
            if (og + 1u == (tg + 1u) * nx) xb_add(&bar[XB_TOPGEN], 1u);
            else XB_SPIN(xb_ld(&bar[XB_TOPGEN]) == tg, bar);
            __builtin_amdgcn_fence(__ATOMIC_ACQUIRE, "agent");
            xb_add(&bar[XB_XGEN(x)], 1u);
            asm volatile("s_waitcnt vmcnt(0)" ::: "memory");
        } else {
            XB_SPIN(xb_ld(&bar[XB_XGEN(x)]) == gen, bar);
            __builtin_amdgcn_fence(__ATOMIC_ACQUIRE, "agent");
            asm volatile("s_waitcnt vmcnt(0)" ::: "memory");
        }
    }
    __syncthreads();
}
#define GRID_SYNC() do { asm volatile("s_waitcnt vmcnt(0) lgkmcnt(0)" ::: "memory"); __syncthreads(); grid.sync(); } while (0)
#define XBAR() do { KParamsPtr qb_ = (KParamsPtr)__builtin_amdgcn_kernarg_segment_ptr(); asm volatile("" : "+s"(qb_)); xcd_barrier((unsigned*)(qb_->ws + WS_CTL), (volatile LAS unsigned*)(lds + LDS_BYTES - 16)); } while (0)
#define PHASE_BEGIN() \
    Params P; { KParamsPtr q_ = (KParamsPtr)__builtin_amdgcn_kernarg_segment_ptr(); asm volatile("" : "+s"(q_)); \
        P.x = q_->x; P.c = q_->c; P.w_mod = q_->w_mod; P.b_mod = q_->b_mod; P.w_in = q_->w_in; P.conv_w = q_->conv_w; P.hgrn_norm_w = q_->hgrn_norm_w; P.lower_bounds = q_->lower_bounds; \
        P.w_branch = q_->w_branch; P.w_out = q_->w_out; P.ln_g = q_->ln_g; P.ln_b = q_->ln_b; P.out = q_->out; P.ws = q_->ws; } \
    int bx = blockIdx.x; asm volatile("" : "+s"(bx)); \
    const int G = gridDim.x; \
    const int vcu = (G % 8 == 0) ? (bx % 8) * (G / 8) + bx / 8 : bx; \
    unsigned char* const ws = P.ws; \
    float* const modp = (float*)(ws + WS_MOD); \
    bf16_t* const ACT = (bf16_t*)(ws + WS_ACT); \
    (void)vcu; (void)modp; (void)ACT;
#define WAVE_IDS() \
    const int tid = fresh_tid(), lane = tid & 63, wid = __builtin_amdgcn_readfirstlane(tid >> 6); \
    const int gw = vcu * 8 + wid, NGW = G * 8; (void)lane; (void)gw; (void)NGW;

__global__ void __launch_bounds__(NTHREADS, 2) fwd_megakernel(Params Pk) {
    extern __shared__ __attribute__((aligned(16))) unsigned char lds_raw[];
    LAS unsigned char* lds = (LAS unsigned char*)lds_raw;
    cg::grid_group grid = cg::this_grid();
    if (__builtin_expect(gridDim.y == 4242u, 0)) GRID_SYNC();
    if (threadIdx.x < 4) ((LAS unsigned*)(lds + LDS_BYTES - 16))[threadIdx.x] = 0u;
    __syncthreads();
    if (threadIdx.x == 0) { KParamsPtr q0_ = (KParamsPtr)__builtin_amdgcn_kernarg_segment_ptr(); (void)xb_add(&((unsigned*)(q0_->ws + WS_CTL))[XB_XCNT(xb_xcc_id())], 1u); }

    {
        PHASE_BEGIN(); WAVE_IDS();
        float* modpart = (float*)(ws + WS_MODP);
        LAS float* red = (LAS float*)lds;
        for (int u = bx; u < DEPTH * 192; u += G) {
            const int l = u / 192, r = u % 192, n = (r >> 2) * 64 + lane, kq = r & 3;
            float accb[8];
#pragma unroll
            for (int b = 0; b < 8; ++b) accb[b] = 0.f;
            const float* wp = P.w_mod + ((size_t)l * 1024 + 256 * kq + 32 * wid) * 3072 + n;
            const float* cp = P.c + 256 * kq + 32 * wid;
#pragma unroll 16
            for (int k = 0; k < 32; ++k) { const float wv = wp[(size_t)k * 3072];
#pragma unroll
                for (int b = 0; b < 8; ++b) accb[b] += cp[b * 1024 + k] * wv; }
            __syncthreads();
#pragma unroll
            for (int b = 0; b < 8; ++b) red[(wid * 8 + b) * 64 + lane] = accb[b];
            __syncthreads();
            { const int b = wid; float sacc = 0.f;
#pragma unroll
              for (int w = 0; w < 8; ++w) sacc += red[(w * 8 + b) * 64 + lane];
              modpart[(((size_t)kq * DEPTH + l) * 8 + b) * 3072 + n] = sacc; }
        }
        __syncthreads();
        convert_weights(P, 0, lds, gw, NGW, wid, lane);
    }
    XBAR();
    {
        PHASE_BEGIN(); WAVE_IDS();
        const float* modpart = (const float*)(ws + WS_MODP);
        for (int i = bx * NTHREADS + tid; i < DEPTH * 8 * 3072; i += G * NTHREADS) {
            const int l = i / (8 * 3072), n = i % 3072;
            float v = P.b_mod[l * 3072 + n];
#pragma unroll
            for (int kq = 0; kq < 4; ++kq) v += modpart[(size_t)kq * DEPTH * 8 * 3072 + i];
            modp[i] = v;
        }
        LAS float* ms = (LAS float*)lds;
        for (int rg = bx; rg < M_TOK / 64; rg += G) {
            const int b = (rg * 64) / SEQ;
            __syncthreads();
            { const int i4 = tid * 4; f32x4 v = *(const f32x4*)(P.b_mod + i4);
#pragma unroll
              for (int kq = 0; kq < 4; ++kq) v = v + *(const f32x4*)(modpart + ((size_t)kq * DEPTH * 8 + b) * 3072 + i4);
              *(LAS f32x4*)(ms + i4) = v; }
            __syncthreads();
#pragma unroll
            for (int it = 0; it < 2; ++it) {
                f32x4 v[4][4];
#pragma unroll
                for (int q = 0; q < 4; ++q) { const int m = rg * 64 + wid * 8 + it * 4 + q;
#pragma unroll
                    for (int j = 0; j < 4; ++j) v[q][j] = *(const f32x4*)(P.x + (size_t)m * D_MODEL + 4 * (lane + 64 * j)); }
#pragma unroll
                for (int q = 0; q < 4; ++q) { const int m = rg * 64 + wid * 8 + it * 4 + q;
                    row_standardize(v[q]);
                    bf16_t* hrow = ACT + (size_t)m * PITCH + C_H;
#pragma unroll
                    for (int j = 0; j < 4; ++j) { const int col = 4 * (lane + 64 * j);
                        const f32x4 sh = *(const LAS f32x4*)(ms + col), sc = *(const LAS f32x4*)(ms + 1024 + col);
                        const f32x4 hv = v[q][j] * (sc + 1.0f) + sh;
                        u32x2 w; w.x = cvt_pk_bf16(hv.x, hv.y); w.y = cvt_pk_bf16(hv.z, hv.w);
                        *(u32x2*)(hrow + col) = w; } }
            }
        }
    }
    XBAR();

    for (int l = 0; l < DEPTH; ++l) {
        {
            PHASE_BEGIN();
            SchedP1 S{(const char*)ACT + C_H * 2, (const char*)(ws + WS_WIN), G, vcu};
            EpiP1 E{ACT};
            pg8::gemm_phase<EpiP1, SchedP1>(lds, (unsigned)PITCHB, 2048u, S, E);
        }
        XBAR();
        {
            PHASE_BEGIN();
            for (int u = bx; u < 256; u += G) hgrn_pass<0>(lds, ACT, P, l, u >> 3, (u & 7) * 4, 4);
        }
        {
            PHASE_BEGIN();
            for (int k = bx; k < 256; k += G) {
                __syncthreads(); attn_unit(lds, ACT, (k & 63) >> 3, k & 7, 7 - (k >> 6));
                const int a2 = 511 - k;
                __syncthreads(); attn_unit(lds, ACT, (a2 & 63) >> 3, a2 & 7, 7 - (a2 >> 6));
            }
            for (int ci = bx; ci < 256; ci += G) conv_item(ACT, P.conv_w + (size_t)l * 3 * 512, ci);
        }
        XBAR();
        {
            PHASE_BEGIN();
            const int tid2 = fresh_tid();
            for (int g = bx * NTHREADS + tid2; g < 32 * 4096; g += G * NTHREADS) {
                const int bh = g >> 12, rem = g & 4095, dg = rem & 31;
                bf16_t* up = (bf16_t*)(ws + WS_U) + (size_t)bh * 8 * 16384 + (rem >> 5) * 128 + dg * 4;
                const float* dp = (const float*)(ws + WS_DEND) + (size_t)bh * 8 * 128 + dg * 4;
                f32x4 S = (f32x4){0.f, 0.f, 0.f, 0.f};
                u32x2 uu[8]; f32x4 dd[8];
#pragma unroll
                for (int k = 0; k < 8; ++k) { uu[k] = *(const u32x2*)(up + (size_t)k * 16384); dd[k] = *(const f32x4*)(dp + k * 128); }
#pragma unroll
                for (int k = 0; k < 8; ++k) {
                    S = dd[k] * S + (f32x4){bf_lo(uu[k].x), bf_hi(uu[k].x), bf_lo(uu[k].y), bf_hi(uu[k].y)};
                    u32x2 w; w.x = cvt_pk_bf16(S[0], S[1]); w.y = cvt_pk_bf16(S[2], S[3]);
                    *(u32x2*)(up + (size_t)k * 16384) = w; }
            }
        }
        XBAR();
        {
            PHASE_BEGIN();
            for (int u = bx; u < 256; u += G) hgrn_pass<1>(lds, ACT, P, l, u >> 3, (u & 7) * 4, 4);
        }
        XBAR();
        {
            PHASE_BEGIN();
            SchedP3 S{(const char*)ACT, (const char*)(ws + WS_WIN) + (size_t)MIX_COLS * 2048, (const char*)(ws + WS_WB), G, vcu};
            EpiP3 E{(unsigned char*)ACT};
            pg8::gemm_phase<EpiP3, SchedP3>(lds, (unsigned)PITCHB, 2048u, S, E);
        }
        XBAR();
        {
            PHASE_BEGIN(); WAVE_IDS();
            SchedP4 S{(const char*)ACT, (const char*)(ws + WS_WO), G, vcu};
            unsigned* pc = (unsigned*)(ws + WS_CTL + CTL_PANEL);
            unsigned long long* xb = (unsigned long long*)(ws + WS_X);
            const bool more = (l + 1 < DEPTH);
            PanelStats st1{xb + (size_t)(2 * l) * 65536, pc + (2 * l) * 4096, LN_EPS};
            PanelStats st2{xb + (size_t)(2 * l + 1) * 65536, pc + (2 * l + 1) * 4096, LN_EPS};
            EpiP4F E{l == 0 ? P.x : P.out, P.out, modp + (size_t)l * 8 * 3072 + 2048, P.ln_g + l * 1024, P.ln_b + l * 1024, more ? modp + (size_t)(l + 1) * 8 * 3072 : nullptr, ACT, st1, st2};
            pg8::gemm_phase<EpiP4F, SchedP4>(lds, (unsigned)PITCHB, 2048u, S, E);
            if (more) { __syncthreads(); convert_weights(P, l + 1, lds, gw, NGW, wid, lane); }
        }
        if (l + 1 < DEPTH) XBAR();
    }
}

extern "C" void kernel_launch(void* const* d_in, const int* in_sizes, int n_in, void* d_out, int out_size, void* d_ws, size_t ws_size, hipStream_t stream) {
    static int grid_blocks = 0;
    if (grid_blocks == 0) {
        if (n_in != 12 || out_size != M_TOK * D_MODEL || ws_size < WS_END) { fprintf(stderr, "kernel_launch: unexpected shapes (n_in %d, out %d, ws %zu < %zu)\n", n_in, out_size, ws_size, (size_t)WS_END); grid_blocks = -1; return; }
        int dev = 0, cus = 0, per_cu = 0;
        hipGetDevice(&dev);
        hipDeviceGetAttribute(&cus, hipDeviceAttributeMultiprocessorCount, dev);
        hipFuncSetAttribute((const void*)fwd_megakernel, hipFuncAttributeMaxDynamicSharedMemorySize, LDS_BYTES);
        hipOccupancyMaxActiveBlocksPerMultiprocessor(&per_cu, (const void*)fwd_megakernel, NTHREADS, LDS_BYTES);
        (void)hipGetLastError();
        if (per_cu < 1) per_cu = 1;
        grid_blocks = cus > 256 ? 256 : cus;
        if (grid_blocks != 256) fprintf(stderr, "kernel_launch: %d CUs reported; this kernel is laid out for 256 workgroups\n", cus);
        if (grid_blocks <= 0) grid_blocks = 256;
    }
    if (grid_blocks < 0) return;
    (void)hipMemsetAsync((char*)d_ws + WS_CTL, 0, CTL_BYTES, stream);
    Params p{};
    p.x = (const float*)d_in[0]; p.c = (const float*)d_in[1]; p.w_mod = (const float*)d_in[2]; p.b_mod = (const float*)d_in[3]; p.w_in = (const float*)d_in[4];
    p.conv_w = (const float*)d_in[5]; p.hgrn_norm_w = (const float*)d_in[6]; p.lower_bounds = (const float*)d_in[7]; p.w_branch = (const float*)d_in[8];
    p.w_out = (const float*)d_in[9]; p.ln_g = (const float*)d_in[10]; p.ln_b = (const float*)d_in[11]; p.out = (float*)d_out; p.ws = (unsigned char*)d_ws;
    void* args[] = {&p};
    hipError_t e = hipLaunchCooperativeKernel((const void*)fwd_megakernel, dim3(grid_blocks), dim3(NTHREADS), args, LDS_BYTES, stream);
    if (e != hipSuccess) fprintf(stderr, "cooperative launch failed: %s (grid %d)\n", hipGetErrorString(e), grid_blocks);
}
```

```cpp
#include <hip/hip_runtime.h>
#include <hip/hip_cooperative_groups.h>
#include <cstdio>
#include <cstdint>
namespace cg = cooperative_groups;

#define LAS __attribute__((address_space(3)))
typedef unsigned short bf16_t;
typedef short bf16x8 __attribute__((ext_vector_type(8)));
typedef short s16x4 __attribute__((ext_vector_type(4)));
typedef float f32x2 __attribute__((ext_vector_type(2)));
typedef float f32x4 __attribute__((ext_vector_type(4)));
typedef float f32x16 __attribute__((ext_vector_type(16)));
typedef unsigned u32x2 __attribute__((ext_vector_type(2)));
typedef unsigned u32x4 __attribute__((ext_vector_type(4)));

constexpr int D_MODEL = 1024, BATCH = 8, SEQ = 2048, DEPTH = 2, M_TOK = BATCH * SEQ;
constexpr int IN_COLS = 9216, MIX_COLS = 6144;
constexpr int PITCH = 7168;
constexpr size_t PITCHB = (size_t)PITCH * 2;
constexpr int C_QA = 0, C_KA = 512, C_VA = 1024, C_ZA = 1536, C_QB = 2048, C_FB = 2560, C_IB = 3072, C_ZB = 3584, C_PU = 4096  , C_PZ = 4608  , C_ZC = 5632  , C_H = 6144;
constexpr int C_MERGED = 4096;
constexpr float LN_EPS = 1e-5f, RMS_EPS = 1e-6f;
constexpr float LOG2E = 1.4426950408889634f;
constexpr float QSCALE = 0.125f * LOG2E;
constexpr float ALPHA = 1.4142135623730951f;

constexpr size_t WS_CTL = 0, CTL_BYTES = 65536;
constexpr size_t WS_MOD = 65536;
constexpr size_t WS_DEND = 256u << 10;
constexpr size_t WS_WIN = 1u << 20;
constexpr size_t WIN_L = (size_t)IN_COLS * 1024 * 2;
constexpr size_t WS_WB = WS_WIN + WIN_L;
constexpr size_t WB_L = (size_t)3 * 1024 * 1024 * 2;
constexpr size_t WS_WO = WS_WB + WB_L;
constexpr size_t WO_L = (size_t)1024 * 1024 * 2;
constexpr size_t WS_ACT = WS_WO + WO_L;
constexpr size_t WS_U = WS_ACT + (size_t)M_TOK * PITCHB;
constexpr size_t WS_X = WS_U + (size_t)32 * 32 * 128 * 128 * 2;
constexpr size_t WS_MODP = WS_X + 3 * 524288;
constexpr size_t WS_END = WS_MODP + (size_t)4 * DEPTH * BATCH * 3072 * 4;
constexpr size_t CTL_PANEL = 16384;

constexpr int LDS_BYTES = 147456;
constexpr int NTHREADS = 512;

struct Params {
    const float* x; const float* c; const float* w_mod; const float* b_mod; const float* w_in; const float* conv_w; const float* hgrn_norm_w;
    const float* lower_bounds; const float* w_branch; const float* w_out; const float* ln_g; const float* ln_b; float* out; unsigned char* ws;
};

typedef __bf16 bf16x2_t __attribute__((ext_vector_type(2)));
__device__ __forceinline__ unsigned cvt_pk_bf16(float lo, float hi) { const f32x2 v = {lo, hi}; const bf16x2_t b = __builtin_convertvector(v, bf16x2_t); return __builtin_bit_cast(unsigned, b); }
__device__ __forceinline__ float bf_lo(unsigned w) { return __uint_as_float(w << 16); }
__device__ __forceinline__ float bf_hi(unsigned w) { return __uint_as_float(w & 0xffff0000u); }
__device__ __forceinline__ float bf2f(bf16_t v) { return __uint_as_float((unsigned)v << 16); }
__device__ __forceinline__ float ex2(float v) { return __builtin_amdgcn_exp2f(v); }
__device__ __forceinline__ float lg2(float v) { return __builtin_amdgcn_logf(v); }
__device__ __forceinline__ float sigmoidf_(float v) { return __builtin_amdgcn_rcpf(1.0f + ex2(-v * LOG2E)); }
__device__ __forceinline__ float siluf_(float v) { return v * sigmoidf_(v); }
__device__ __forceinline__ float wave_sum(float v) {
#pragma unroll
    for (int o = 1; o < 64; o <<= 1) v += __shfl_xor(v, o);
    return v;
}
__device__ __forceinline__ int fresh_tid() { int t = threadIdx.x; asm volatile("" : "+v"(t)); return t; }
__device__ __forceinline__ int crow(int r, int hi) { return (r & 3) + 8 * (r >> 2) + 4 * hi; }

namespace pg8 {
constexpr int BM = 256, BK = 64, HALF = 128, HTB = HALF * BK * 2, STAGE_BYTES = 8 * HTB;
__device__ __forceinline__ int lds_byte(int r, int c) { const int st = (r >> 4) * 2 + (c >> 5), rr = r & 15, cc = c & 31, ob = rr * 64 + cc * 2; return st * 1024 + (ob ^ (((ob >> 9) & 1) << 5)); }
__device__ __forceinline__ void stage_rc(int b, int& R, int& C) { const int st = b / 1024, sb = b % 1024, swz = sb ^ (((sb >> 9) & 1) << 5); R = (st >> 1) * 16 + swz / 64; C = (st & 1) * 32 + (swz % 64) / 2; }
__device__ __forceinline__ int perm32(int rho) { const int n = rho >> 4, i = rho & 15; return 8 * (i >> 2) + 4 * n + (i & 3); }

struct Unit { const char* a; const char* b; int nt; int pm, pn, j; };

template <class Epi, class Sched>
__device__ __forceinline__ void gemm_phase(LAS unsigned char* lds, const unsigned ldaB, const unsigned ldbB, const Sched& S, const Epi& E) {
    const int tid = fresh_tid(), wid = __builtin_amdgcn_readfirstlane(tid >> 6), lane = tid & 63, wr = wid >> 2, wc = wid & 3, fr = lane & 15, fq = lane >> 4;
    unsigned voffA[2], voffB[2];
#pragma unroll
    for (int i = 0; i < 2; ++i) { int R, C; stage_rc(tid * 16 + i * 8192, R, C); const int Rb = Epi::PERM ? ((R & ~31) + perm32(R & 31)) : R;
        voffA[i] = (unsigned)R * ldaB + (unsigned)C * 2u; voffB[i] = (unsigned)Rb * ldbB + (unsigned)C * 2u; }
    const size_t kstep = (size_t)(BK * 2);
    const size_t hstepA = (size_t)HALF * ldaB, hstepB = (size_t)HALF * ldbB;
    const unsigned ldsw = (unsigned)wid * 1024u;
    const int aoff = lds_byte(wr * 64 + fr, fq * 8), boff = lds_byte(wc * 32 + fr, fq * 8);
#define PG8_SA(b, h) (((b) * 2 + (h)) * HTB)
#define PG8_SB(b, h) ((4 + (b) * 2 + (h)) * HTB)
#define PG8_STAGE(bufoff, gbase, voff) do { _Pragma("unroll") for (int _i = 0; _i < 2; ++_i) \
        __builtin_amdgcn_global_load_lds((const unsigned*)((const char*)(gbase) + (voff)[_i]), (LAS unsigned*)(lds + (bufoff) + ldsw + _i * 8192), 16, 0, 0); } while (0)
#define PG8_LDA(dst, b, h) do { _Pragma("unroll") for (int m = 0; m < 4; ++m) _Pragma("unroll") for (int k = 0; k < 2; ++k) dst[m][k] = *(const LAS bf16x8*)(lds + PG8_SA(b, h) + aoff + m * 2048 + k * 1024); } while (0)
#define PG8_LDB(dst, b, h) do { _Pragma("unroll") for (int n = 0; n < 2; ++n) _Pragma("unroll") for (int k = 0; k < 2; ++k) dst[n][k] = *(const LAS bf16x8*)(lds + PG8_SB(b, h) + boff + n * 2048 + k * 1024); } while (0)
#define PG8_MMA(ai, bj, At, Bt) do { __builtin_amdgcn_s_setprio(1); _Pragma("unroll") for (int m = 0; m < 4; ++m) _Pragma("unroll") for (int n = 0; n < 2; ++n) _Pragma("unroll") for (int k = 0; k < 2; ++k) \
        acc[ai][bj][m][n] = __builtin_amdgcn_mfma_f32_16x16x32_bf16(Bt[n][k], At[m][k], acc[ai][bj][m][n], 0, 0, 0); __builtin_amdgcn_s_setprio(0); } while (0)
#define PG8_WAIT_V(n) asm volatile("s_waitcnt vmcnt(" #n ")" ::: "memory")
#define PG8_WAIT_L(n) asm volatile("s_waitcnt lgkmcnt(" #n ")" ::: "memory")
#define PG8_BAR __builtin_amdgcn_s_barrier()
#define PG8_SCHED __builtin_amdgcn_sched_barrier(0)
    Unit cur, nxt; int ui = 0;
    if (!S.next(0, cur)) return;
    f32x4 acc[2][2][4][2];
#pragma unroll
    for (int a = 0; a < 2; ++a)
#pragma unroll
        for (int b = 0; b < 2; ++b)
#pragma unroll
            for (int m = 0; m < 4; ++m)
#pragma unroll
                for (int n = 0; n < 2; ++n) acc[a][b][m][n] = (f32x4){0.f, 0.f, 0.f, 0.f};
    bf16x8 At[4][2], B0[2][2], B1[2][2];
    const char* cA = cur.a; const char* cB = cur.b;
    PG8_STAGE(PG8_SB(0, 0), cB, voffB); PG8_STAGE(PG8_SB(0, 1), cB + hstepB, voffB); PG8_STAGE(PG8_SA(0, 0), cA, voffA); PG8_STAGE(PG8_SA(0, 1), cA + hstepA, voffA);
    if (wr == 1) PG8_BAR;
    PG8_WAIT_V(2); PG8_BAR;
    PG8_STAGE(PG8_SB(1, 0), cB + kstep, voffB); PG8_STAGE(PG8_SA(1, 0), cA + kstep, voffA); PG8_STAGE(PG8_SB(1, 1), cB + hstepB + kstep, voffB);
    PG8_WAIT_V(6); PG8_BAR;
    for (;;) {
        const bool has_next = S.next(ui + 1, nxt);
        const char* nA = has_next ? nxt.a : cA; const char* nB = has_next ? nxt.b : cB;
        const int nt = cur.nt;
        for (int t = 0; t < nt; t += 2) {
            const bool last = (t == nt - 2);
            const char* a1 = cA + (size_t)(t + 1) * kstep;
            const char* a2 = last ? nA : cA + (size_t)(t + 2) * kstep; const char* b2 = last ? nB : cB + (size_t)(t + 2) * kstep;
            const char* a3 = a2 + kstep; const char* b3 = b2 + kstep;
            PG8_LDB(B0, 0, 0); PG8_LDB(B1, 0, 1); PG8_SCHED; PG8_LDA(At, 0, 0); PG8_STAGE(PG8_SA(1, 1), a1 + hstepA, voffA);
            PG8_WAIT_V(8); PG8_WAIT_L(0); PG8_BAR; PG8_MMA(0, 0, At, B0); PG8_MMA(0, 1, At, B1); PG8_BAR; PG8_SCHED;
            PG8_LDA(At, 0, 1); PG8_STAGE(PG8_SB(0, 0), b2, voffB); PG8_STAGE(PG8_SB(0, 1), b2 + hstepB, voffB); PG8_STAGE(PG8_SA(0, 0), a2, voffA);
            PG8_WAIT_V(8); PG8_WAIT_L(0); PG8_BAR; PG8_MMA(1, 0, At, B0); PG8_MMA(1, 1, At, B1); PG8_BAR; PG8_SCHED;
            PG8_LDB(B0, 1, 0); PG8_LDB(B1, 1, 1); PG8_SCHED; PG8_LDA(At, 1, 0); PG8_STAGE(PG8_SA(0, 1), a2 + hstepA, voffA);
            PG8_WAIT_V(8); PG8_WAIT_L(0); PG8_BAR; PG8_MMA(0, 0, At, B0); PG8_MMA(0, 1, At, B1); PG8_BAR; PG8_SCHED;
            PG8_LDA(At, 1, 1); PG8_STAGE(PG8_SB(1, 0), b3, voffB); PG8_STAGE(PG8_SB(1, 1), b3 + hstepB, voffB); PG8_STAGE(PG8_SA(1, 0), a3, voffA);
            PG8_WAIT_V(8); PG8_WAIT_L(0); PG8_BAR; PG8_MMA(1, 0, At, B0); PG8_MMA(1, 1, At, B1); PG8_BAR; PG8_SCHED;
        }
        if (wr == 0) PG8_BAR;
        if constexpr (!Epi::AFTER_DRAIN) E(acc, cur, wr, wc, fr, fq);
        if (!has_next) break;
#pragma unroll
        for (int a = 0; a < 2; ++a)
#pragma unroll
            for (int b = 0; b < 2; ++b)
#pragma unroll
                for (int m = 0; m < 4; ++m)
#pragma unroll
                    for (int n = 0; n < 2; ++n) acc[a][b][m][n] = (f32x4){0.f, 0.f, 0.f, 0.f};
        cur = nxt; cA = nA; cB = nB; ++ui;
        if (wr == 1) PG8_BAR;
    }
    PG8_WAIT_V(0);
    PG8_BAR;
    if constexpr (Epi::AFTER_DRAIN) E.fused(acc, cur, wr, wc, fr, fq, lds, wid, lane);
#undef PG8_SA
#undef PG8_SB
#undef PG8_STAGE
#undef PG8_LDA
#undef PG8_LDB
#undef PG8_MMA
#undef PG8_WAIT_V
#undef PG8_WAIT_L
#undef PG8_BAR
#undef PG8_SCHED
}
}

struct SchedP1 {
    const char* A; const char* B; int G, vcu;
    __device__ __forceinline__ bool next(int i, pg8::Unit& u) const {
        const int U = i * G + vcu; if (U >= 64 * 24) return false;
        u.pm = 8 * ((U >> 5) & 7) + (U & 7); u.pn = 4 * (U >> 8) + ((U & 31) >> 3); u.j = 0; u.nt = 16;
        u.a = A + (size_t)u.pm * 256 * PITCHB; u.b = B + (size_t)u.pn * 256 * 2048; return true;
    }
};
struct SchedP3 {
    const char* ACTb; const char* Wg; const char* Wb; int G, vcu;
    __device__ __forceinline__ bool next(int i, pg8::Unit& u) const {
        const int T = vcu + (i / 6) * G; if (T >= 256) return false;
        const int s = i % 6; u.pm = 8 * (T >> 5) + (T & 7); u.pn = (T & 31) >> 3; u.j = s;
        const int j = s >> 1;
        if ((s & 1) == 0) { u.nt = 16; u.a = ACTb + (size_t)u.pm * 256 * PITCHB + C_H * 2; u.b = Wg + (size_t)(1024 * j + 256 * u.pn) * 2048; }
        else { u.nt = 8; u.a = ACTb + (size_t)u.pm * 256 * PITCHB + (size_t)(C_ZA + 2048 * j) * 2; u.b = Wb + (size_t)(1024 * j + 256 * u.pn) * 2048; }
        return true;
    }
};
struct SchedP4 {
    const char* ACTb; const char* Wo; int G, vcu;
    __device__ __forceinline__ bool next(int i, pg8::Unit& u) const {
        const int T = vcu + i * G; if (T >= 256) return false;
        u.pm = 8 * (T >> 5) + (T & 7); u.pn = (T & 31) >> 3; u.j = 0; u.nt = 16;
        u.a = ACTb + (size_t)u.pm * 256 * PITCHB + C_MERGED * 2; u.b = Wo + (size_t)(256 * u.pn) * 2048; return true;
    }
};

struct EpiP1 {
    static constexpr bool PERM = true, AFTER_DRAIN = false;
    bf16_t* ACT;
    __device__ __forceinline__ void operator()(const f32x4 (&acc)[2][2][4][2], const pg8::Unit& u, int wr, int wc, int fr, int fq) const {
        const int row0 = u.pm * 256 + wr * 64 + fr;
        if (u.pn >= 16) {
            const int T = u.pn - 16, col0 = (T < 4 ? C_PU + 128 * T : C_PZ + 128 * (T - 4)) + wc * 32 + 8 * fq;
#pragma unroll
            for (int ai = 0; ai < 2; ++ai)
#pragma unroll
                for (int m = 0; m < 4; ++m) { bf16_t* rowp = ACT + (size_t)(row0 + ai * 128 + m * 16) * PITCH + col0;
                    f32x4 v0 = acc[ai][1][m][0], v1 = acc[ai][1][m][1];
                    if (T >= 4) {
#pragma unroll
                        for (int e = 0; e < 4; ++e) { v0[e] = siluf_(v0[e]); v1[e] = siluf_(v1[e]); } }
                    v0 = v0 * acc[ai][0][m][0]; v1 = v1 * acc[ai][0][m][1];
                    u32x4 w; w.x = cvt_pk_bf16(v0[0], v0[1]); w.y = cvt_pk_bf16(v0[2], v0[3]); w.z = cvt_pk_bf16(v1[0], v1[1]); w.w = cvt_pk_bf16(v1[2], v1[3]);
                    *(u32x4*)rowp = w; }
            return;
        }
        const int grp = u.pn >> 1;
        const int kind = (grp == 0) ? 1 : ((grp == 3 || grp == 4 || grp == 7) ? 2 : 0);
        const int col0 = u.pn * 256 + wc * 32 + 8 * fq;
#pragma unroll
        for (int ai = 0; ai < 2; ++ai)
#pragma unroll
            for (int m = 0; m < 4; ++m) { bf16_t* rowp = ACT + (size_t)(row0 + ai * 128 + m * 16) * PITCH + col0;
#pragma unroll
                for (int bj = 0; bj < 2; ++bj) { f32x4 v0 = acc[ai][bj][m][0], v1 = acc[ai][bj][m][1];
                    if (kind == 1) { v0 = v0 * QSCALE; v1 = v1 * QSCALE; }
                    else if (kind == 2) {
#pragma unroll
                        for (int e = 0; e < 4; ++e) { v0[e] = siluf_(v0[e]); v1[e] = siluf_(v1[e]); } }
                    u32x4 w; w.x = cvt_pk_bf16(v0[0], v0[1]); w.y = cvt_pk_bf16(v0[2], v0[3]); w.z = cvt_pk_bf16(v1[0], v1[1]); w.w = cvt_pk_bf16(v1[2], v1[3]);
                    *(u32x4*)(rowp + bj * 128) = w; } }
    }
};
struct EpiP3 {
    static constexpr bool PERM = true, AFTER_DRAIN = false;
    unsigned char* ACTb;
    __device__ __forceinline__ void operator()(const f32x4 (&acc)[2][2][4][2], const pg8::Unit& u, int wr, int wc, int fr, int fq) const {
        const int s = u.j, j = s >> 1;
        const int row0 = u.pm * 256 + wr * 64 + fr, cl0 = wc * 32 + 8 * fq;
        const unsigned toff = 512u * (unsigned)u.pn, soff = 5120u + 512u * (unsigned)u.pn, moff = (unsigned)(C_MERGED + 256 * u.pn) * 2u;
        if ((s & 1) == 0) {
#pragma unroll
            for (int ai = 0; ai < 2; ++ai)
#pragma unroll
                for (int m = 0; m < 4; ++m) { unsigned char* rowp = ACTb + (size_t)(row0 + ai * 128 + m * 16) * PITCHB;
#pragma unroll
                    for (int bj = 0; bj < 2; ++bj) { const f32x4 v0 = acc[ai][bj][m][0], v1 = acc[ai][bj][m][1];
                        u32x4 w; w.x = cvt_pk_bf16(v0[0], v0[1]); w.y = cvt_pk_bf16(v0[2], v0[3]); w.z = cvt_pk_bf16(v1[0], v1[1]); w.w = cvt_pk_bf16(v1[2], v1[3]);
                        *(u32x4*)(rowp + soff + (cl0 + bj * 128) * 2) = w; } }
        } else {
#pragma unroll
            for (int ai = 0; ai < 2; ++ai) {
                u32x4 gq[4][2], tq[4][2];
#pragma unroll
                for (int m = 0; m < 4; ++m) { unsigned char* rowp = ACTb + (size_t)(row0 + ai * 128 + m * 16) * PITCHB;
#pragma unroll
                    for (int bj = 0; bj < 2; ++bj) { gq[m][bj] = *(const u32x4*)(rowp + soff + (cl0 + bj * 128) * 2); if (j > 0) tq[m][bj] = *(const u32x4*)(rowp + toff + (cl0 + bj * 128) * 2); } }
#pragma unroll
                for (int m = 0; m < 4; ++m) { unsigned char* rowp = ACTb + (size_t)(row0 + ai * 128 + m * 16) * PITCHB;
#pragma unroll
                    for (int bj = 0; bj < 2; ++bj) { const f32x4 v0 = acc[ai][bj][m][0], v1 = acc[ai][bj][m][1]; const u32x4 g = gq[m][bj];
                        f32x4 t0 = (f32x4){sigmoidf_(bf_lo(g.x)) * v0[0], sigmoidf_(bf_hi(g.x)) * v0[1], sigmoidf_(bf_lo(g.y)) * v0[2], sigmoidf_(bf_hi(g.y)) * v0[3]};
                        f32x4 t1 = (f32x4){sigmoidf_(bf_lo(g.z)) * v1[0], sigmoidf_(bf_hi(g.z)) * v1[1], sigmoidf_(bf_lo(g.w)) * v1[2], sigmoidf_(bf_hi(g.w)) * v1[3]};
                        if (j > 0) { const u32x4 tv = tq[m][bj];
                            t0 = t0 + (f32x4){bf_lo(tv.x), bf_hi(tv.x), bf_lo(tv.y), bf_hi(tv.y)}; t1 = t1 + (f32x4){bf_lo(tv.z), bf_hi(tv.z), bf_lo(tv.w), bf_hi(tv.w)}; }
                        u32x4 w; w.x = cvt_pk_bf16(t0[0], t0[1]); w.y = cvt_pk_bf16(t0[2], t0[3]); w.z = cvt_pk_bf16(t1[0], t1[1]); w.w = cvt_pk_bf16(t1[2], t1[3]);
                        if (j < 2) *(u32x4*)(rowp + toff + (cl0 + bj * 128) * 2) = w; else *(u32x4*)(rowp + moff + (cl0 + bj * 128) * 2) = w;
                    } }
            }
        }
    }
};
struct PanelStats {
    unsigned long long* xbuf;
    unsigned* cnt;
    float eps;
    __device__ __forceinline__ void run(const f32x4 (&v)[2][2][4][2], const pg8::Unit& u, int wr, int wc, int fr, int fq, LAS unsigned char* lds, int wid, int lane) const {
        LAS f32x2* Pt = (LAS f32x2*)lds;
        LAS f32x2* St = (LAS f32x2*)(lds + 8192);
#pragma unroll
        for (int ai = 0; ai < 2; ++ai)
#pragma unroll
            for (int m = 0; m < 4; ++m) {
                float s = 0.f;
#pragma unroll
                for (int bj = 0; bj < 2; ++bj)
#pragma unroll
                    for (int n = 0; n < 2; ++n) { const f32x4 x = v[ai][bj][m][n]; s += (x[0] + x[1]) + (x[2] + x[3]); }
                s += __shfl_xor(s, 16); s += __shfl_xor(s, 32);
                const float mw = s * (1.0f / 64.0f); float q = 0.f;
#pragma unroll
                for (int bj = 0; bj < 2; ++bj)
#pragma unroll
                    for (int n = 0; n < 2; ++n) { const f32x4 d = v[ai][bj][m][n] - mw; q += (d[0] * d[0] + d[1] * d[1]) + (d[2] * d[2] + d[3] * d[3]); }
                q += __shfl_xor(q, 16); q += __shfl_xor(q, 32);
                if (fq == 0) Pt[(ai * 128 + wr * 64 + m * 16 + fr) * 4 + wc] = (f32x2){mw, q};
            }
        __syncthreads();
        const int row = wid * 32 + (lane & 31);
        if (lane < 32) {
            const f32x2 a = Pt[row * 4 + 0], b = Pt[row * 4 + 1], c = Pt[row * 4 + 2], d = Pt[row * 4 + 3];
            const float mt = (a.x + b.x + c.x + d.x) * 0.25f;
            const float da = a.x - mt, db = b.x - mt, dc = c.x - mt, dd = d.x - mt;
            const float m2 = (a.y + b.y) + (c.y + d.y) + 64.0f * ((da * da + db * db) + (dc * dc + dd * dd));
            __hip_atomic_store(xbuf + ((size_t)(u.pm * 256 + row) * 4 + u.pn), ((unsigned long long)__float_as_uint(m2) << 32) | __float_as_uint(mt), __ATOMIC_RELAXED, __HIP_MEMORY_SCOPE_AGENT);
        }
        asm volatile("s_waitcnt vmcnt(0)" ::: "memory");
        if (lane == 0) __hip_atomic_fetch_add(cnt + 64 * u.pm, 1u, __ATOMIC_RELAXED, __HIP_MEMORY_SCOPE_AGENT);
        if (wid == 0) {
            unsigned sp = 0;
            while ((unsigned)__builtin_amdgcn_readfirstlane(__hip_atomic_load(cnt + 64 * u.pm, __ATOMIC_RELAXED, __HIP_MEMORY_SCOPE_AGENT)) < 32u) { __builtin_amdgcn_s_sleep(2); if (++sp > (1u << 24)) break; }
            __builtin_amdgcn_fence(__ATOMIC_ACQUIRE, "agent");
        }
        asm volatile("s_waitcnt vmcnt(0) lgkmcnt(0)" ::: "memory");
        __syncthreads();
        if (lane < 32) {
            const unsigned long long* slot = xbuf + (size_t)(u.pm * 256 + row) * 4; float mt[4], m2[4]; float ms = 0.f;
#pragma unroll
            for (int t = 0; t < 4; ++t) { const unsigned long long w = __hip_atomic_load(slot + t, __ATOMIC_RELAXED, __HIP_MEMORY_SCOPE_AGENT); mt[t] = __uint_as_float((unsigned)w); m2[t] = __uint_as_float((unsigned)(w >> 32)); ms += mt[t]; }
            const float mean = ms * 0.25f; float q = 0.f;
#pragma unroll
            for (int t = 0; t < 4; ++t) { const float dm = mt[t] - mean; q += m2[t] + 256.0f * dm * dm; }
            St[row] = (f32x2){mean, __builtin_amdgcn_rsqf(q * (1.0f / 1024.0f) + eps)};
        }
        __syncthreads();
    }
};
struct EpiP4F {
    static constexpr bool PERM = false, AFTER_DRAIN = true;
    const float* xprev; float* out; const float* gate; const float* lng; const float* lnb; const float* modn; bf16_t* ACT; PanelStats st1, st2;
    __device__ __forceinline__ void fused(f32x4 (&acc)[2][2][4][2], const pg8::Unit& u, int wr, int wc, int fr, int fq, LAS unsigned char* lds, int wid, int lane) const {
        const LAS f32x2* St = (const LAS f32x2*)(lds + 8192);
        const int row0 = u.pm * 256 + wr * 64 + fr, col0 = u.pn * 256 + wc * 32 + 4 * fq;
        const int bidx = (u.pm * 256) / SEQ;
        {
            const float* gp = gate + (size_t)bidx * 3072;
            f32x4 gv[2][2];
#pragma unroll
            for (int bj = 0; bj < 2; ++bj)
#pragma unroll
                for (int n = 0; n < 2; ++n) gv[bj][n] = *(const f32x4*)(gp + col0 + bj * 128 + n * 16) + 1.0f;
#pragma unroll
            for (int ai = 0; ai < 2; ++ai)
#pragma unroll
                for (int m = 0; m < 4; ++m) { const size_t off = (size_t)(row0 + ai * 128 + m * 16) * D_MODEL + col0;
#pragma unroll
                    for (int bj = 0; bj < 2; ++bj)
#pragma unroll
                        for (int n = 0; n < 2; ++n) { const f32x4 xv = *(const f32x4*)(xprev + off + bj * 128 + n * 16); acc[ai][bj][m][n] = xv * ALPHA + gv[bj][n] * acc[ai][bj][m][n]; }
                    asm volatile("" : "+v"(acc[ai][0][m][0]), "+v"(acc[ai][0][m][1]), "+v"(acc[ai][1][m][0]), "+v"(acc[ai][1][m][1]));
                    if (m & 1) asm volatile("" ::: "memory"); }
        }
        st1.run(acc, u, wr, wc, fr, fq, lds, wid, lane);
        {
            f32x4 lg[2][2], lb[2][2];
#pragma unroll
            for (int bj = 0; bj < 2; ++bj)
#pragma unroll
                for (int n = 0; n < 2; ++n) { lg[bj][n] = *(const f32x4*)(lng + col0 + bj * 128 + n * 16); lb[bj][n] = *(const f32x4*)(lnb + col0 + bj * 128 + n * 16); }
#pragma unroll
            for (int ai = 0; ai < 2; ++ai)
#pragma unroll
                for (int m = 0; m < 4; ++m) { const int r = ai * 128 + wr * 64 + m * 16 + fr; const f32x2 sr = St[r]; const size_t off = (size_t)(u.pm * 256 + r) * D_MODEL + col0;
#pragma unroll
                    for (int bj = 0; bj < 2; ++bj)
#pragma unroll
                        for (int n = 0; n < 2; ++n) { const f32x4 x1 = (acc[ai][bj][m][n] - sr.x) * sr.y * lg[bj][n] + lb[bj][n]; acc[ai][bj][m][n] = x1; *(f32x4*)(out + off + bj * 128 + n * 16) = x1; }
                    asm volatile("" : "+v"(acc[ai][0][m][0]), "+v"(acc[ai][0][m][1]), "+v"(acc[ai][1][m][0]), "+v"(acc[ai][1][m][1]));
                    asm volatile("" ::: "memory"); }
        }
        if (modn) {
            st2.run(acc, u, wr, wc, fr, fq, lds, wid, lane);
            const float* mp = modn + (size_t)bidx * 3072;
            f32x4 sc[2][2], sh[2][2];
#pragma unroll
            for (int bj = 0; bj < 2; ++bj)
#pragma unroll
                for (int n = 0; n < 2; ++n) { sh[bj][n] = *(const f32x4*)(mp + col0 + bj * 128 + n * 16); sc[bj][n] = *(const f32x4*)(mp + 1024 + col0 + bj * 128 + n * 16) + 1.0f; }
#pragma unroll
            for (int ai = 0; ai < 2; ++ai)
#pragma unroll
                for (int m = 0; m < 4; ++m) { const int r = ai * 128 + wr * 64 + m * 16 + fr; const f32x2 sr = St[r]; bf16_t* hp = ACT + (size_t)(u.pm * 256 + r) * PITCH + C_H + col0;
#pragma unroll
                    for (int bj = 0; bj < 2; ++bj)
#pragma unroll
                        for (int n = 0; n < 2; ++n) { const f32x4 hv = (acc[ai][bj][m][n] - sr.x) * sr.y * sc[bj][n] + sh[bj][n];
                            u32x2 w; w.x = cvt_pk_bf16(hv[0], hv[1]); w.y = cvt_pk_bf16(hv[2], hv[3]); *(u32x2*)(hp + bj * 128 + n * 16) = w; }
                    asm volatile("" ::: "memory"); }
        }
    }
};

__device__ __forceinline__ void transpose_item(const float* W, int N, bf16_t* WT, int ldw, LAS float* scr, int item, int lane, bool conv_perm = false) {
    const int nblk = N / 32, kb = item / nblk, nb = item % nblk, k0 = 64 * kb, n0 = 32 * nb;
    int d0 = n0;
    if (conv_perm && n0 >= 4096 && n0 < 6144) { const int g = (n0 - 4096) >> 9, ch0 = (n0 - 4096) & 511; d0 = 4096 + 256 * ((ch0 >> 7) + ((g & 1) ? 4 : 0)) + 128 * (g >> 1) + (ch0 & 127); }
    const int kr = lane >> 3, n4 = (lane & 7) * 4;
    f32x4 v[8];
#pragma unroll
    for (int i = 0; i < 8; ++i) v[i] = *(const f32x4*)(W + (size_t)(k0 + 8 * i + kr) * N + n0 + n4);
#pragma unroll
    for (int i = 0; i < 8; ++i) { LAS float* d = scr + (8 * i + kr) * 33 + n4; d[0] = v[i].x; d[1] = v[i].y; d[2] = v[i].z; d[3] = v[i].w; }
    asm volatile("s_waitcnt lgkmcnt(0)" ::: "memory");
    const int c = lane & 7;
#pragma unroll
    for (int j = 0; j < 4; ++j) { const int n = (lane >> 3) + 8 * j; const LAS float* s = scr + (8 * c) * 33 + n;
        u32x4 o; o.x = cvt_pk_bf16(s[0 * 33], s[1 * 33]); o.y = cvt_pk_bf16(s[2 * 33], s[3 * 33]); o.z = cvt_pk_bf16(s[4 * 33], s[5 * 33]); o.w = cvt_pk_bf16(s[6 * 33], s[7 * 33]);
        *(u32x4*)(WT + (size_t)(d0 + n) * ldw + k0 + 8 * c) = o; }
    asm volatile("s_waitcnt lgkmcnt(0)" ::: "memory");
}

__device__ __forceinline__ void row_standardize(f32x4 (&v)[4]) {
    float s = 0.f;
#pragma unroll
    for (int j = 0; j < 4; ++j) s += (v[j].x + v[j].y) + (v[j].z + v[j].w);
    const float mean = wave_sum(s) * (1.f / D_MODEL); float s2 = 0.f;
#pragma unroll
    for (int j = 0; j < 4; ++j) { v[j] = v[j] - mean; s2 += (v[j].x * v[j].x + v[j].y * v[j].y) + (v[j].z * v[j].z + v[j].w * v[j].w); }
    const float rstd = __builtin_amdgcn_rsqf(wave_sum(s2) * (1.f / D_MODEL) + LN_EPS);
#pragma unroll
    for (int j = 0; j < 4; ++j) v[j] = v[j] * rstd;
}
__device__ __forceinline__ void write_h_row(const f32x4 (&v)[4], const float* modb, bf16_t* hrow, int lane) {
#pragma unroll
    for (int j = 0; j < 4; ++j) { const int col = 4 * (lane + 64 * j);
        const f32x4 sh = *(const f32x4*)(modb + col), sc = *(const f32x4*)(modb + 1024 + col);
        const f32x4 h = v[j] * (sc + 1.0f) + sh;
        u32x2 w; w.x = cvt_pk_bf16(h.x, h.y); w.y = cvt_pk_bf16(h.z, h.w);
        *(u32x2*)(hrow + col) = w; }
}

typedef short v4i16_t __attribute__((ext_vector_type(4)));
__device__ __forceinline__ s16x4 vtr(const LAS bf16_t* p) { return __builtin_bit_cast(s16x4, __builtin_amdgcn_ds_read_tr16_b64_v4i16((LAS v4i16_t*)p)); }
constexpr float STICK_DEAD = -44.0f;
__device__ __forceinline__ void attn_unit(LAS unsigned char* lds, bf16_t* ACT, int b, int h, int qb) {
    const int tid = fresh_tid(), lane = tid & 63, r32 = lane & 31, hi = lane >> 5;
    const int wid = __builtin_amdgcn_readfirstlane(tid >> 6);
    bf16_t* base = ACT + (size_t)b * SEQ * PITCH;
    const int tq0 = qb * 256 + wid * 32, tq = tq0 + r32;
    LAS bf16_t* Kw = (LAS bf16_t*)(lds + wid * 9728);
    LAS bf16_t* Vw = Kw + 32 * 72;
    LAS float* stg = (LAS float*)(lds + wid * 9728);
    bf16x8 qr[4];
#pragma unroll
    for (int d0 = 0; d0 < 4; ++d0) qr[d0] = *(const bf16x8*)(base + (size_t)tq * PITCH + C_QA + h * 64 + d0 * 16 + hi * 8);
    f32x16 o0, o1;
#pragma unroll
    for (int r = 0; r < 16; ++r) { o0[r] = 0.f; o1[r] = 0.f; }
    float R = 0.f;
    const int srow = lane >> 3, sch = lane & 7;
    const bf16_t* kg = base + (size_t)srow * PITCH + C_KA + h * 64 + sch * 8;
    const bf16_t* vg = base + (size_t)srow * PITCH + C_VA + h * 64 + sch * 8;
    const LAS bf16_t* vb = Vw + (4 * hi + ((lane & 15) >> 2)) * 80 + 16 * ((lane >> 4) & 1) + 4 * (lane & 3);
    u32x4 kreg[4], vreg[4];
    int kb = tq0;
#pragma unroll
    for (int i = 0; i < 4; ++i) { kreg[i] = *(const u32x4*)(kg + (size_t)(kb + 8 * i) * PITCH); vreg[i] = *(const u32x4*)(vg + (size_t)(kb + 8 * i) * PITCH); }
    for (;;) {
#pragma unroll
        for (int i = 0; i < 4; ++i) { *(LAS u32x4*)(Kw + (srow + 8 * i) * 72 + sch * 8) = kreg[i]; *(LAS u32x4*)(Vw + (srow + 8 * i) * 80 + sch * 8) = vreg[i]; }
        const int kbn = kb - 32;
        if (kbn >= 0) {
#pragma unroll
            for (int i = 0; i < 4; ++i) { kreg[i] = *(const u32x4*)(kg + (size_t)(kbn + 8 * i) * PITCH); vreg[i] = *(const u32x4*)(vg + (size_t)(kbn + 8 * i) * PITCH); }
        }
        f32x16 p0;
#pragma unroll
        for (int r = 0; r < 16; ++r) p0[r] = 0.f;
#pragma unroll
        for (int d0 = 0; d0 < 4; ++d0) {
            const bf16x8 a0 = *(const LAS bf16x8*)(Kw + r32 * 72 + d0 * 16 + hi * 8);
            p0 = __builtin_amdgcn_mfma_f32_32x32x16_bf16(a0, qr[d0], p0, 0, 0, 0);
        }
        float x0[16];
        if (kb < tq0) {
#pragma unroll
            for (int r = 0; r < 16; ++r) { const float z = p0[r]; const float sp = fmaxf(z, 0.f) + lg2(1.0f + ex2(-fabsf(z))); x0[r] = sp; p0[r] = z - sp; }
        } else {
            const int kvl = kb + 4 * hi;
#pragma unroll
            for (int r = 0; r < 16; ++r) { const int kv = kvl + (r & 3) + 8 * (r >> 2);
                const float z = p0[r]; const float sp = fmaxf(z, 0.f) + lg2(1.0f + ex2(-fabsf(z))); const bool ok = kv < tq; x0[r] = ok ? sp : 0.f; p0[r] = ok ? z - sp : -INFINITY; }
        }
        float Gs[4], Gh1[4], Tt[4];
#pragma unroll
        for (int g = 0; g < 4; ++g) Gs[g] = (x0[4 * g] + x0[4 * g + 1]) + (x0[4 * g + 2] + x0[4 * g + 3]);
#pragma unroll
        for (int g = 0; g < 4; ++g) { auto rr = __builtin_amdgcn_permlane32_swap(__float_as_uint(Gs[g]), __float_as_uint(Gs[g]), false, false);
            Gh1[g] = __uint_as_float(rr[1]); Tt[g] = __uint_as_float(rr[0]) + __uint_as_float(rr[1]); }
        float run = R;
#pragma unroll
        for (int g = 3; g >= 0; --g) {
            const float off = hi ? run : run - Gh1[g];
            const int q4 = 4 * g;
            const float s3 = off, s2 = s3 - x0[q4 + 3], s1 = s2 - x0[q4 + 2], s0 = s1 - x0[q4 + 1];
            p0[q4 + 3] = ex2(p0[q4 + 3] + s3); p0[q4 + 2] = ex2(p0[q4 + 2] + s2); p0[q4 + 1] = ex2(p0[q4 + 1] + s1); p0[q4] = ex2(p0[q4] + s0);
            run -= Tt[g];
        }
        R = run;
#pragma unroll
        for (int s = 0; s < 2; ++s) {
            u32x4 w; const int r0 = 8 * s;
            w.x = cvt_pk_bf16(p0[r0], p0[r0 + 1]); w.y = cvt_pk_bf16(p0[r0 + 2], p0[r0 + 3]); w.z = cvt_pk_bf16(p0[r0 + 4], p0[r0 + 5]); w.w = cvt_pk_bf16(p0[r0 + 6], p0[r0 + 7]);
            const bf16x8 af = __builtin_bit_cast(bf16x8, w);
            { const s16x4 lo = vtr(vb + (16 * s) * 80), hh = vtr(vb + (16 * s + 8) * 80);
              const bf16x8 bfr = (bf16x8){lo[0], lo[1], lo[2], lo[3], hh[0], hh[1], hh[2], hh[3]};
              o0 = __builtin_amdgcn_mfma_f32_32x32x16_bf16(af, bfr, o0, 0, 0, 0); }
            { const s16x4 lo = vtr(vb + (16 * s) * 80 + 32), hh = vtr(vb + (16 * s + 8) * 80 + 32);
              const bf16x8 bfr = (bf16x8){lo[0], lo[1], lo[2], lo[3], hh[0], hh[1], hh[2], hh[3]};
              o1 = __builtin_amdgcn_mfma_f32_32x32x16_bf16(af, bfr, o1, 0, 0, 0); }
        }
        if (kbn < 0 || !__any(R > STICK_DEAD)) break;
        kb = kbn;
    }
#pragma unroll
    for (int r = 0; r < 16; ++r) { stg[crow(r, hi) * 68 + r32] = o0[r]; stg[crow(r, hi) * 68 + 32 + r32] = o1[r]; }
    asm volatile("s_waitcnt lgkmcnt(0)" ::: "memory");
#pragma unroll
    for (int i = 0; i < 4; ++i) { const int row = i * 8 + (lane >> 3), ch = lane & 7;
        const f32x4 a = *(const LAS f32x4*)(stg + row * 68 + ch * 8), c = *(const LAS f32x4*)(stg + row * 68 + ch * 8 + 4);
        bf16_t* zp = base + (size_t)(tq0 + row) * PITCH + C_ZA + h * 64 + ch * 8;
        const u32x4 z = *(const u32x4*)zp;
        u32x4 w; w.x = cvt_pk_bf16(a.x * bf_lo(z.x), a.y * bf_hi(z.x)); w.y = cvt_pk_bf16(a.z * bf_lo(z.y), a.w * bf_hi(z.y));
        w.z = cvt_pk_bf16(c.x * bf_lo(z.z), c.y * bf_hi(z.z)); w.w = cvt_pk_bf16(c.z * bf_lo(z.w), c.w * bf_hi(z.w));
        *(u32x4*)zp = w; }
    asm volatile("s_waitcnt lgkmcnt(0)" ::: "memory");
}

__device__ __forceinline__ float layer_lb(const float* lower_bounds, int l, int ch) {
    float mx = -INFINITY;
    for (int i = 0; i < DEPTH; ++i) mx = fmaxf(mx, lower_bounds[i * 512 + ch]);
    float den = 0.f, num = 0.f;
    for (int i = 0; i < DEPTH; ++i) { const float e = __expf(lower_bounds[i * 512 + ch] - mx); den += e; if (i >= 1 && i <= l) num += e; }
    return num / den;
}
template <int MODE>
__device__ __forceinline__ void hgrn_pass(LAS unsigned char* lds, bf16_t* ACT, const Params& P, int l, int bh, int c0, int nc) {
    const int tid = fresh_tid(), lane = tid & 63, r32 = lane & 31, hi = lane >> 5;
    const int wid = __builtin_amdgcn_readfirstlane(tid >> 6);
    LAS bf16_t* Q1 = (LAS bf16_t*)(lds);
    LAS bf16_t* Q2 = (LAS bf16_t*)(lds + 17408);
    LAS bf16_t* K2 = (LAS bf16_t*)(lds + 34816);
    LAS float*  OT = (LAS float*)(lds);
    LAS bf16_t* K3T = (LAS bf16_t*)(lds + 52224);
    LAS bf16_t* VT = (LAS bf16_t*)(lds + 70656);
    LAS bf16_t* Pm = (LAS bf16_t*)(lds + 89088);
    LAS bf16_t* ST = (LAS bf16_t*)(lds + 98304);
    LAS float* DEND = (LAS float*)(lds + 133120);
    LAS float* SCX = (LAS float*)(lds + 133632);
    const int d = tid & 127, part = tid >> 7, b = bh >> 2, h = bh & 3, grp = c0 / nc;
    const float lbv = layer_lb(P.lower_bounds, l, h * 128 + d);
    bf16_t* base = ACT + (size_t)b * SEQ * PITCH + h * 128;
    bf16_t* Ug = (bf16_t*)(P.ws + WS_U) + (size_t)bh * 8 * 16384;
    float* Dg = (float*)(P.ws + WS_DEND) + (size_t)bh * 8 * 128;
    const float* nw = P.hgrn_norm_w + l * 128;
    const int tb = wid & 1, eb = wid >> 1;
    bf16_t fin[16], qin[16], vin[16];
#pragma unroll
    for (int i = 0; i < 16; ++i) { const bf16_t* rp = base + (size_t)(c0 * 64 + 16 * part + i) * PITCH + d; fin[i] = rp[C_FB]; vin[i] = rp[C_IB]; if (MODE == 1) qin[i] = rp[C_QB]; }
    f32x16 sa[2];
#pragma unroll
    for (int r = 0; r < 16; ++r) { sa[0][r] = 0.f; sa[1][r] = 0.f; }
    float bsum = 0.f;
    if (MODE == 1) {
        const int d8 = (tid & 15) * 8;
        f32x4 Sp[4][2];
#pragma unroll
        for (int i = 0; i < 4; ++i) { Sp[i][0] = (f32x4){0.f, 0.f, 0.f, 0.f}; Sp[i][1] = (f32x4){0.f, 0.f, 0.f, 0.f}; }
        for (int k = 0; k < grp; ++k) {
            const f32x4 da = *(const f32x4*)(Dg + k * 128 + d8), db = *(const f32x4*)(Dg + k * 128 + d8 + 4);
            u32x4 uv[4];
#pragma unroll
            for (int i = 0; i < 4; ++i) { const int idx = tid + 512 * i; uv[i] = *(const u32x4*)(Ug + (size_t)k * 16384 + (idx >> 4) * 128 + d8); }
#pragma unroll
            for (int i = 0; i < 4; ++i) {
                Sp[i][0] = da * Sp[i][0] + (f32x4){bf_lo(uv[i].x), bf_hi(uv[i].x), bf_lo(uv[i].y), bf_hi(uv[i].y)};
                Sp[i][1] = db * Sp[i][1] + (f32x4){bf_lo(uv[i].z), bf_hi(uv[i].z), bf_lo(uv[i].w), bf_hi(uv[i].w)}; }
        }
#pragma unroll
        for (int i = 0; i < 4; ++i) { const int idx = tid + 512 * i;
            u32x4 v; v.x = cvt_pk_bf16(Sp[i][0][0], Sp[i][0][1]); v.y = cvt_pk_bf16(Sp[i][0][2], Sp[i][0][3]); v.z = cvt_pk_bf16(Sp[i][1][0], Sp[i][1][1]); v.w = cvt_pk_bf16(Sp[i][1][2], Sp[i][1][3]);
            *(LAS u32x4*)(ST + (idx >> 4) * 136 + d8) = v; }
        __syncthreads();
#pragma unroll
        for (int i = 0; i < 2; ++i) { const int db = 2 * (wid & 1) + i;
#pragma unroll
            for (int g = 0; g < 4; ++g) { const u32x2 w = *(const LAS u32x2*)(ST + (32 * eb + r32) * 136 + 32 * db + 8 * g + 4 * hi);
                sa[i][4 * g] = bf_lo(w.x); sa[i][4 * g + 1] = bf_hi(w.x); sa[i][4 * g + 2] = bf_lo(w.y); sa[i][4 * g + 3] = bf_hi(w.y); } }
    }
    for (int ci = 0; ci < nc; ++ci) {
        const int c = c0 + ci;
        float g2[16], kk[16];
        float runb = 0.f;
#pragma unroll
        for (int i = 0; i < 16; ++i) { const float f = lbv + (1.0f - lbv) * sigmoidf_(bf2f(fin[i])); kk[i] = 1.0f - f; runb += lg2(f); g2[i] = runb; }
        SCX[part * 128 + d] = runb;
        __syncthreads();
        const float t0 = SCX[d], t1 = SCX[128 + d], t2 = SCX[256 + d], t3 = SCX[384 + d];
        const float offp = (part > 0 ? t0 : 0.f) + (part > 1 ? t1 : 0.f) + (part > 2 ? t2 : 0.f);
        const float cmid = t0 + t1, bend = (t0 + t1) + (t2 + t3);
        bsum += bend;
        if (part == 0) DEND[d] = ex2(bend);
        {
            unsigned k3w[8], vw[8];
#pragma unroll
            for (int i = 0; i < 16; i += 2) {
                const float B0 = offp + g2[i], B1 = offp + g2[i + 1];
                if (MODE == 1) {
                    const float q0 = bf2f(qin[i]), q1 = bf2f(qin[i + 1]);
                    const int t = 16 * part + i;
                    Q1[t * 136 + d] = (bf16_t)(cvt_pk_bf16(q0 * ex2(B0), 0.f) & 0xffffu); Q1[(t + 1) * 136 + d] = (bf16_t)(cvt_pk_bf16(q1 * ex2(B1), 0.f) & 0xffffu);
                    Q2[t * 136 + d] = (bf16_t)(cvt_pk_bf16(q0 * ex2(B0 - cmid), 0.f) & 0xffffu); Q2[(t + 1) * 136 + d] = (bf16_t)(cvt_pk_bf16(q1 * ex2(B1 - cmid), 0.f) & 0xffffu);
                    K2[t * 136 + d] = (bf16_t)(cvt_pk_bf16(kk[i] * ex2(cmid - B0), 0.f) & 0xffffu); K2[(t + 1) * 136 + d] = (bf16_t)(cvt_pk_bf16(kk[i + 1] * ex2(cmid - B1), 0.f) & 0xffffu);
                }
                k3w[i >> 1] = cvt_pk_bf16(kk[i] * ex2(bend - B0), kk[i + 1] * ex2(bend - B1));
                vw[i >> 1] = (unsigned)vin[i] | ((unsigned)vin[i + 1] << 16);
            }
            *(LAS u32x4*)(K3T + d * 72 + 16 * part) = (u32x4){k3w[0], k3w[1], k3w[2], k3w[3]}; *(LAS u32x4*)(K3T + d * 72 + 16 * part + 8) = (u32x4){k3w[4], k3w[5], k3w[6], k3w[7]};
            *(LAS u32x4*)(VT + d * 72 + 16 * part) = (u32x4){vw[0], vw[1], vw[2], vw[3]}; *(LAS u32x4*)(VT + d * 72 + 16 * part + 8) = (u32x4){vw[4], vw[5], vw[6], vw[7]};
        }
        if (ci + 1 < nc) {
#pragma unroll
            for (int i = 0; i < 16; ++i) { const bf16_t* rp = base + (size_t)((c + 1) * 64 + 16 * part + i) * PITCH + d; fin[i] = rp[C_FB]; vin[i] = rp[C_IB]; if (MODE == 1) qin[i] = rp[C_QB]; }
        }
        __syncthreads();
        if (MODE == 0) {
#pragma unroll
            for (int i = 0; i < 2; ++i) {
                const int db = 2 * (wid & 1) + i;
#pragma unroll
                for (int r = 0; r < 16; ++r) sa[i][r] *= DEND[32 * db + crow(r, hi)];
#pragma unroll
                for (int ks = 0; ks < 4; ++ks) {
                    const bf16x8 a = *(const LAS bf16x8*)(K3T + (32 * db + r32) * 72 + 16 * ks + 8 * hi);
                    const bf16x8 bb = *(const LAS bf16x8*)(VT + (32 * eb + r32) * 72 + 16 * ks + 8 * hi);
                    sa[i] = __builtin_amdgcn_mfma_f32_32x32x16_bf16(a, bb, sa[i], 0, 0, 0);
                }
            }
        } else {
            f32x16 o;
#pragma unroll
            for (int r = 0; r < 16; ++r) o[r] = 0.f;
            if (c > 0) {
#pragma unroll
                for (int ks = 0; ks < 8; ++ks) {
                    const bf16x8 a = *(const LAS bf16x8*)(Q1 + (32 * tb + r32) * 136 + 16 * ks + 8 * hi);
                    const bf16x8 bb = *(const LAS bf16x8*)(ST + (32 * eb + r32) * 136 + 16 * ks + 8 * hi);
                    o = __builtin_amdgcn_mfma_f32_32x32x16_bf16(a, bb, o, 0, 0, 0);
                }
            }
            if (wid < 4) {
                const int stb = wid & 1, ssb = wid >> 1;
                f32x16 sc;
#pragma unroll
                for (int r = 0; r < 16; ++r) sc[r] = 0.f;
                if (!(stb == 0 && ssb == 1)) {
#pragma unroll
                    for (int ks = 0; ks < 8; ++ks) {
                        const bf16x8 a = *(const LAS bf16x8*)(Q2 + (32 * stb + r32) * 136 + 16 * ks + 8 * hi);
                        const bf16x8 bb = *(const LAS bf16x8*)(K2 + (32 * ssb + r32) * 136 + 16 * ks + 8 * hi);
                        sc = __builtin_amdgcn_mfma_f32_32x32x16_bf16(a, bb, sc, 0, 0, 0);
                    }
                }
#pragma unroll
                for (int r = 0; r < 16; ++r) { const int t = 32 * stb + crow(r, hi), s = 32 * ssb + r32;
                    const float v = (s <= t) ? sc[r] : 0.f;
                    Pm[t * 72 + s] = (bf16_t)(cvt_pk_bf16(v, 0.f) & 0xffffu); }
            }
            __syncthreads();
            unsigned zz[8];
#pragma unroll
            for (int i = 0; i < 8; ++i) zz[i] = *(const unsigned*)(base + (size_t)(c * 64 + 8 * wid + i) * PITCH + C_ZB + 2 * lane);
#pragma unroll
            for (int ks = 0; ks < 4; ++ks) {
                const bf16x8 a = *(const LAS bf16x8*)(Pm + (32 * tb + r32) * 72 + 16 * ks + 8 * hi);
                const bf16x8 bb = *(const LAS bf16x8*)(VT + (32 * eb + r32) * 72 + 16 * ks + 8 * hi);
                o = __builtin_amdgcn_mfma_f32_32x32x16_bf16(a, bb, o, 0, 0, 0);
            }
#pragma unroll
            for (int r = 0; r < 16; ++r) OT[(32 * tb + crow(r, hi)) * 132 + 32 * eb + r32] = o[r];
            if (ci + 1 < nc) {
#pragma unroll
                for (int i = 0; i < 2; ++i) {
                    const int db = 2 * (wid & 1) + i;
#pragma unroll
                    for (int r = 0; r < 16; ++r) sa[i][r] *= DEND[32 * db + crow(r, hi)];
#pragma unroll
                    for (int ks = 0; ks < 4; ++ks) {
                        const bf16x8 a = *(const LAS bf16x8*)(K3T + (32 * db + r32) * 72 + 16 * ks + 8 * hi);
                        const bf16x8 bb = *(const LAS bf16x8*)(VT + (32 * eb + r32) * 72 + 16 * ks + 8 * hi);
                        sa[i] = __builtin_amdgcn_mfma_f32_32x32x16_bf16(a, bb, sa[i], 0, 0, 0);
                    }
#pragma unroll
                    for (int g = 0; g < 4; ++g) { u32x2 w; w.x = cvt_pk_bf16(sa[i][4 * g], sa[i][4 * g + 1]); w.y = cvt_pk_bf16(sa[i][4 * g + 2], sa[i][4 * g + 3]);
                        *(LAS u32x2*)(ST + (32 * eb + r32) * 136 + 32 * db + 8 * g + 4 * hi) = w; }
                }
            }
            __syncthreads();
            {
                const f32x2 nwv = *(const f32x2*)(nw + 2 * lane);
#pragma unroll
                for (int i = 0; i < 8; ++i) { const int t = 8 * wid + i;
                    const f32x2 v = *(const LAS f32x2*)(OT + t * 132 + 2 * lane);
                    const float ss = wave_sum(v.x * v.x + v.y * v.y);
                    const float rstd = __builtin_amdgcn_rsqf(ss * (1.0f / 128.0f) + RMS_EPS);
                    unsigned* zp = (unsigned*)(base + (size_t)(c * 64 + t) * PITCH + C_ZB + 2 * lane);
                    *zp = cvt_pk_bf16(v.x * rstd * nwv.x * bf_lo(zz[i]), v.y * rstd * nwv.y * bf_hi(zz[i])); }
            }
        }
    }
    if (MODE == 0) {
        __syncthreads();
#pragma unroll
        for (int i = 0; i < 2; ++i) { const int db = 2 * (wid & 1) + i;
#pragma unroll
            for (int g = 0; g < 4; ++g) { u32x2 w; w.x = cvt_pk_bf16(sa[i][4 * g], sa[i][4 * g + 1]); w.y = cvt_pk_bf16(sa[i][4 * g + 2], sa[i][4 * g + 3]);
                *(LAS u32x2*)(ST + (32 * eb + r32) * 136 + 32 * db + 8 * g + 4 * hi) = w; } }
        __syncthreads();
#pragma unroll
        for (int i = 0; i < 4; ++i) { const int idx = tid + 512 * i;
            *(u32x4*)(Ug + (size_t)grp * 16384 + (idx >> 4) * 128 + (idx & 15) * 8) = *(const LAS u32x4*)(ST + (idx >> 4) * 136 + (idx & 15) * 8); }
        if (part == 0) Dg[grp * 128 + d] = ex2(bsum);
    }
    __syncthreads();
}

__device__ __forceinline__ void unpack8(const u32x4 a, float (&o)[8]) {
    o[0] = bf_lo(a.x); o[1] = bf_hi(a.x); o[2] = bf_lo(a.y); o[3] = bf_hi(a.y); o[4] = bf_lo(a.z); o[5] = bf_hi(a.z); o[6] = bf_lo(a.w); o[7] = bf_hi(a.w);
}
__device__ __forceinline__ void conv_item(bf16_t* ACT, const float* cw, int item) {
    const int tid = fresh_tid(), cgp = tid & 63, sub = tid >> 6;
    const int m0 = item * 64 + sub * 8, ch = cgp * 8;
    float w0[8], w1[8], w2[8];
#pragma unroll
    for (int e = 0; e < 8; ++e) { w0[e] = cw[ch + e]; w1[e] = cw[512 + ch + e]; w2[e] = cw[1024 + ch + e]; }
    float p1[8], p2[8];
#pragma unroll
    for (int e = 0; e < 8; ++e) { p1[e] = 0.f; p2[e] = 0.f; }
    if ((m0 % SEQ) != 0) {
        unpack8(*(const u32x4*)(ACT + (size_t)(m0 - 2) * PITCH + C_PU + ch), p2);
        unpack8(*(const u32x4*)(ACT + (size_t)(m0 - 1) * PITCH + C_PU + ch), p1);
    }
    u32x4 pa[8], pzv[8];
#pragma unroll
    for (int i = 0; i < 8; ++i) { const bf16_t* rp = ACT + (size_t)(m0 + i) * PITCH + ch; pa[i] = *(const u32x4*)(rp + C_PU); pzv[i] = *(const u32x4*)(rp + C_PZ); }
#pragma unroll
    for (int i = 0; i < 8; ++i) {
        float pu[8], pz[8], y[8];
        unpack8(pa[i], pu); unpack8(pzv[i], pz);
#pragma unroll
        for (int e = 0; e < 8; ++e) { y[e] = pz[e] * (w0[e] * p2[e] + w1[e] * p1[e] + w2[e] * pu[e]); p2[e] = p1[e]; p1[e] = pu[e]; }
        u32x4 w; w.x = cvt_pk_bf16(y[0], y[1]); w.y = cvt_pk_bf16(y[2], y[3]); w.z = cvt_pk_bf16(y[4], y[5]); w.w = cvt_pk_bf16(y[6], y[7]);
        *(u32x4*)(ACT + (size_t)(m0 + i) * PITCH + C_ZC + ch) = w;
    }
}

__device__ __forceinline__ void convert_weights(const Params& P, int l, LAS unsigned char* lds, int gw, int NGW, int wid, int lane) {
    LAS float* scr = (LAS float*)(lds + wid * 16384);
    unsigned char* ws = P.ws;
    constexpr int I_IN = 16 * (IN_COLS / 32), I_B = 8 * 32, I_O = 16 * 32, I_L = I_IN + 3 * I_B + I_O;
    for (int it = gw; it < I_L; it += NGW) {
        int r = it;
        if (r < I_IN) { transpose_item(P.w_in + (size_t)l * 1024 * IN_COLS, IN_COLS, (bf16_t*)(ws + WS_WIN), 1024, scr, r, lane, true); continue; } r -= I_IN;
        if (r < 3 * I_B) { const int j = r / I_B; transpose_item(P.w_branch + (size_t)(l * 3 + j) * 512 * 1024, 1024, (bf16_t*)(ws + WS_WB) + (size_t)j * 1024 * 1024, 1024, scr, r % I_B, lane); continue; } r -= 3 * I_B;
        transpose_item(P.w_out + (size_t)l * 1024 * 1024, 1024, (bf16_t*)(ws + WS_WO), 1024, scr, r, lane);
    }
}

typedef const __attribute__((address_space(4))) Params* KParamsPtr;
#define XB_TMO      128
#define XB_XCNT(j)  (256  + 64 * (j))
#define XB_XSUB(j)  (1280 + 64 * (j))
#define XB_XGEN(j)  (2304 + 64 * (j))
#define XB_TOP      3328
#define XB_TOPGEN   3392
#define XCD_BAR_WORDS 3456
#define XB_SPIN_CAP (1u << 22)
__device__ __forceinline__ unsigned xb_ld(unsigned* p)              { return __hip_atomic_load(p, __ATOMIC_RELAXED, __HIP_MEMORY_SCOPE_AGENT); }
__device__ __forceinline__ unsigned xb_add(unsigned* p, unsigned v) { return __hip_atomic_fetch_add(p, v, __ATOMIC_RELAXED, __HIP_MEMORY_SCOPE_AGENT); }
__device__ __forceinline__ unsigned xb_xcc_id() { return (unsigned)__builtin_amdgcn_s_getreg((3 << 11) | 20) & 0xFu; }
#define XB_SPIN(cond, bar) do { unsigned _sp = 0; while (cond) { __builtin_amdgcn_s_sleep(1); \
    if ((++_sp & 255u) == 0u) { if (xb_ld(&(bar)[XB_TMO])) break; if (_sp > XB_SPIN_CAP) { atomicAdd(&(bar)[XB_TMO], 1u); break; } } } } while (0)
__device__ __forceinline__ void xcd_barrier_complete(unsigned* bar, unsigned x, unsigned& nloc, unsigned& nx) {
    const unsigned G = gridDim.x * gridDim.y * gridDim.z;
    unsigned sum, cnt, mine, sp = 0u;
    for (;;) {
        sum = 0u; cnt = 0u; mine = 0u;
#pragma unroll
        for (unsigned j = 0; j < 16; ++j) { const unsigned c = xb_ld(&bar[XB_XCNT(j)]); sum += c; cnt += (c > 0u) ? 1u : 0u; mine = (j == x) ? c : mine; }
        if (sum == G) break;
        __builtin_amdgcn_s_sleep(1);
        if ((++sp & 255u) == 0u) { if (xb_ld(&bar[XB_TMO])) break; if (sp > XB_SPIN_CAP) { atomicAdd(&bar[XB_TMO], 1u); break; } }
    }
    nloc = mine > 0u ? mine : 1u; nx = cnt > 0u ? cnt : 1u;
}
__device__ __forceinline__ void xcd_barrier(unsigned* bar, volatile LAS unsigned* st) {
    asm volatile("s_waitcnt vmcnt(0)" ::: "memory");
    __syncthreads();
    if (threadIdx.x == 0) {
        __builtin_amdgcn_s_waitcnt(0);
        const unsigned x = xb_xcc_id();
        unsigned nloc = st[0], nx = st[1];
        if (nloc == 0u) { xcd_barrier_complete(bar, x, nloc, nx); st[0] = nloc; st[1] = nx; }
        const unsigned old = xb_add(&bar[XB_XSUB(x)], 1u);
        const unsigned gen = old / nloc;
        if (old + 1u == (gen + 1u) * nloc) {
            __builtin_amdgcn_fence(__ATOMIC_RELEASE, "agent");
            asm volatile("s_waitcnt vmcnt(0)" ::: "memory");
            const unsigned og = xb_add(&bar[XB_TOP], 1u);
            const unsigned tg = og / nx;
            if (og + 1u == (tg + 1u) * nx) xb_add(&bar[XB_TOPGEN], 1u);
            else XB_SPIN(xb_ld(&bar[XB_TOPGEN]) == tg, bar);
            __builtin_amdgcn_fence(__ATOMIC_ACQUIRE, "agent");
            xb_add(&bar[XB_XGEN(x)], 1u);
            asm volatile("s_waitcnt vmcnt(0)" ::: "memory");
        } else {
            XB_SPIN(xb_ld(&bar[XB_XGEN(x)]) == gen, bar);
            __builtin_amdgcn_fence(__ATOMIC_ACQUIRE, "agent");
            asm volatile("s_waitcnt vmcnt(0)" ::: "memory");
        }
    }
    __syncthreads();
}
#define GRID_SYNC() do { asm volatile("s_waitcnt vmcnt(0) lgkmcnt(0)" ::: "memory"); __syncthreads(); grid.sync(); } while (0)
#define XBAR() do { KParamsPtr qb_ = (KParamsPtr)__builtin_amdgcn_kernarg_segment_ptr(); asm volatile("" : "+s"(qb_)); xcd_barrier((unsigned*)(qb_->ws + WS_CTL), (volatile LAS unsigned*)(lds + LDS_BYTES - 16)); } while (0)
#define PHASE_BEGIN() \
    Params P; { KParamsPtr q_ = (KParamsPtr)__builtin_amdgcn_kernarg_segment_ptr(); asm volatile("" : "+s"(q_)); \
        P.x = q_->x; P.c = q_->c; P.w_mod = q_->w_mod; P.b_mod = q_->b_mod; P.w_in = q_->w_in; P.conv_w = q_->conv_w; P.hgrn_norm_w = q_->hgrn_norm_w; P.lower_bounds = q_->lower_bounds; \
        P.w_branch = q_->w_branch; P.w_out = q_->w_out; P.ln_g = q_->ln_g; P.ln_b = q_->ln_b; P.out = q_->out; P.ws = q_->ws; } \
    int bx = blockIdx.x; asm volatile("" : "+s"(bx)); \
    const int G = gridDim.x; \
    const int vcu = (G % 8 == 0) ? (bx % 8) * (G / 8) + bx / 8 : bx; \
    unsigned char* const ws = P.ws; \
    float* const modp = (float*)(ws + WS_MOD); \
    bf16_t* const ACT = (bf16_t*)(ws + WS_ACT); \
    (void)vcu; (void)modp; (void)ACT;
#define WAVE_IDS() \
    const int tid = fresh_tid(), lane = tid & 63, wid = __builtin_amdgcn_readfirstlane(tid >> 6); \
    const int gw = vcu * 8 + wid, NGW = G * 8; (void)lane; (void)gw; (void)NGW;

__global__ void __launch_bounds__(NTHREADS, 2) fwd_megakernel(Params Pk) {
    extern __shared__ __attribute__((aligned(16))) unsigned char lds_raw[];
    LAS unsigned char* lds = (LAS unsigned char*)lds_raw;
    cg::grid_group grid = cg::this_grid();
    if (__builtin_expect(gridDim.y == 4242u, 0)) GRID_SYNC();
    if (threadIdx.x < 4) ((LAS unsigned*)(lds + LDS_BYTES - 16))[threadIdx.x] = 0u;
    __syncthreads();
    if (threadIdx.x == 0) { KParamsPtr q0_ = (KParamsPtr)__builtin_amdgcn_kernarg_segment_ptr(); (void)xb_add(&((unsigned*)(q0_->ws + WS_CTL))[XB_XCNT(xb_xcc_id())], 1u); }

    {
        PHASE_BEGIN(); WAVE_IDS();
        float* modpart = (float*)(ws + WS_MODP);
        LAS float* red = (LAS float*)lds;
        for (int u = bx; u < DEPTH * 192; u += G) {
            const int l = u / 192, r = u % 192, n = (r >> 2) * 64 + lane, kq = r & 3;
            float accb[8];
#pragma unroll
            for (int b = 0; b < 8; ++b) accb[b] = 0.f;
            const float* wp = P.w_mod + ((size_t)l * 1024 + 256 * kq + 32 * wid) * 3072 + n;
            const float* cp = P.c + 256 * kq + 32 * wid;
#pragma unroll 16
            for (int k = 0; k < 32; ++k) { const float wv = wp[(size_t)k * 3072];
#pragma unroll
                for (int b = 0; b < 8; ++b) accb[b] += cp[b * 1024 + k] * wv; }
            __syncthreads();
#pragma unroll
            for (int b = 0; b < 8; ++b) red[(wid * 8 + b) * 64 + lane] = accb[b];
            __syncthreads();
            { const int b = wid; float sacc = 0.f;
#pragma unroll
              for (int w = 0; w < 8; ++w) sacc += red[(w * 8 + b) * 64 + lane];
              modpart[(((size_t)kq * DEPTH + l) * 8 + b) * 3072 + n] = sacc; }
        }
        __syncthreads();
        convert_weights(P, 0, lds, gw, NGW, wid, lane);
    }
    XBAR();
    {
        PHASE_BEGIN(); WAVE_IDS();
        const float* modpart = (const float*)(ws + WS_MODP);
        for (int i = bx * NTHREADS + tid; i < DEPTH * 8 * 3072; i += G * NTHREADS) {
            const int l = i / (8 * 3072), n = i % 3072;
            float v = P.b_mod[l * 3072 + n];
#pragma unroll
            for (int kq = 0; kq < 4; ++kq) v += modpart[(size_t)kq * DEPTH * 8 * 3072 + i];
            modp[i] = v;
        }
        LAS float* ms = (LAS float*)lds;
        for (int rg = bx; rg < M_TOK / 64; rg += G) {
            const int b = (rg * 64) / SEQ;
            __syncthreads();
            { const int i4 = tid * 4; f32x4 v = *(const f32x4*)(P.b_mod + i4);
#pragma unroll
              for (int kq = 0; kq < 4; ++kq) v = v + *(const f32x4*)(modpart + ((size_t)kq * DEPTH * 8 + b) * 3072 + i4);
              *(LAS f32x4*)(ms + i4) = v; }
            __syncthreads();
#pragma unroll
            for (int it = 0; it < 2; ++it) {
                f32x4 v[4][4];
#pragma unroll
                for (int q = 0; q < 4; ++q) { const int m = rg * 64 + wid * 8 + it * 4 + q;
#pragma unroll
                    for (int j = 0; j < 4; ++j) v[q][j] = *(const f32x4*)(P.x + (size_t)m * D_MODEL + 4 * (lane + 64 * j)); }
#pragma unroll
                for (int q = 0; q < 4; ++q) { const int m = rg * 64 + wid * 8 + it * 4 + q;
                    row_standardize(v[q]);
                    bf16_t* hrow = ACT + (size_t)m * PITCH + C_H;
#pragma unroll
                    for (int j = 0; j < 4; ++j) { const int col = 4 * (lane + 64 * j);
                        const f32x4 sh = *(const LAS f32x4*)(ms + col), sc = *(const LAS f32x4*)(ms + 1024 + col);
                        const f32x4 hv = v[q][j] * (sc + 1.0f) + sh;
                        u32x2 w; w.x = cvt_pk_bf16(hv.x, hv.y); w.y = cvt_pk_bf16(hv.z, hv.w);
                        *(u32x2*)(hrow + col) = w; } }
            }
        }
    }
    XBAR();

    for (int l = 0; l < DEPTH; ++l) {
        {
            PHASE_BEGIN();
            SchedP1 S{(const char*)ACT + C_H * 2, (const char*)(ws + WS_WIN), G, vcu};
            EpiP1 E{ACT};
            pg8::gemm_phase<EpiP1, SchedP1>(lds, (unsigned)PITCHB, 2048u, S, E);
        }
        XBAR();
        {
            PHASE_BEGIN();
            for (int u = bx; u < 256; u += G) hgrn_pass<0>(lds, ACT, P, l, u >> 3, (u & 7) * 4, 4);
        }
        {
            PHASE_BEGIN();
            for (int k = bx; k < 256; k += G) {
                __syncthreads(); attn_unit(lds, ACT, (k & 63) >> 3, k & 7, 7 - (k >> 6));
                const int a2 = 511 - k;
                __syncthreads(); attn_unit(lds, ACT, (a2 & 63) >> 3, a2 & 7, 7 - (a2 >> 6));
            }
            for (int ci = bx; ci < 256; ci += G) conv_item(ACT, P.conv_w + (size_t)l * 3 * 512, ci);
        }
        XBAR();
        {
            PHASE_BEGIN();
            for (int u = bx; u < 256; u += G) hgrn_pass<1>(lds, ACT, P, l, u >> 3, (u & 7) * 4, 4);
        }
        XBAR();
        {
            PHASE_BEGIN();
            SchedP3 S{(const char*)ACT, (const char*)(ws + WS_WIN) + (size_t)MIX_COLS * 2048, (const char*)(ws + WS_WB), G, vcu};
            EpiP3 E{(unsigned char*)ACT};
            pg8::gemm_phase<EpiP3, SchedP3>(lds, (unsigned)PITCHB, 2048u, S, E);
        }
        XBAR();
        {
            PHASE_BEGIN(); WAVE_IDS();
            SchedP4 S{(const char*)ACT, (const char*)(ws + WS_WO), G, vcu};
            unsigned* pc = (unsigned*)(ws + WS_CTL + CTL_PANEL);
            unsigned long long* xb = (unsigned long long*)(ws + WS_X);
            const bool more = (l + 1 < DEPTH);
            PanelStats st1{xb + (size_t)(2 * l) * 65536, pc + (2 * l) * 4096, LN_EPS};
            PanelStats st2{xb + (size_t)(2 * l + 1) * 65536, pc + (2 * l + 1) * 4096, LN_EPS};
            EpiP4F E{l == 0 ? P.x : P.out, P.out, modp + (size_t)l * 8 * 3072 + 2048, P.ln_g + l * 1024, P.ln_b + l * 1024, more ? modp + (size_t)(l + 1) * 8 * 3072 : nullptr, ACT, st1, st2};
            pg8::gemm_phase<EpiP4F, SchedP4>(lds, (unsigned)PITCHB, 2048u, S, E);
            if (more) { __syncthreads(); convert_weights(P, l + 1, lds, gw, NGW, wid, lane); }
        }
        if (l + 1 < DEPTH) XBAR();
    }
}

extern "C" void kernel_launch(void* const* d_in, const int* in_sizes, int n_in, void* d_out, int out_size, void* d_ws, size_t ws_size, hipStream_t stream) {
    static int grid_blocks = 0;
    if (grid_blocks == 0) {
        if (n_in != 12 || out_size != M_TOK * D_MODEL || ws_size < WS_END) { fprintf(stderr, "kernel_launch: unexpected shapes (n_in %d, out %d, ws %zu < %zu)\n", n_in, out_size, ws_size, (size_t)WS_END); grid_blocks = -1; return; }
        int dev = 0, cus = 0, per_cu = 0;
        hipGetDevice(&dev);
        hipDeviceGetAttribute(&cus, hipDeviceAttributeMultiprocessorCount, dev);
        hipFuncSetAttribute((const void*)fwd_megakernel, hipFuncAttributeMaxDynamicSharedMemorySize, LDS_BYTES);
        hipOccupancyMaxActiveBlocksPerMultiprocessor(&per_cu, (const void*)fwd_megakernel, NTHREADS, LDS_BYTES);
        (void)hipGetLastError();
        if (per_cu < 1) per_cu = 1;
        grid_blocks = cus > 256 ? 256 : cus;
        if (grid_blocks != 256) fprintf(stderr, "kernel_launch: %d CUs reported; this kernel is laid out for 256 workgroups\n", cus);
        if (grid_blocks <= 0) grid_blocks = 256;
    }
    if (grid_blocks < 0) return;
    (void)hipMemsetAsync((char*)d_ws + WS_CTL, 0, CTL_BYTES, stream);
    Params p{};
    p.x = (const float*)d_in[0]; p.c = (const float*)d_in[1]; p.w_mod = (const float*)d_in[2]; p.b_mod = (const float*)d_in[3]; p.w_in = (const float*)d_in[4];
    p.conv_w = (const float*)d_in[5]; p.hgrn_norm_w = (const float*)d_in[6]; p.lower_bounds = (const float*)d_in[7]; p.w_branch = (const float*)d_in[8];
    p.w_out = (const float*)d_in[9]; p.ln_g = (const float*)d_in[10]; p.ln_b = (const float*)d_in[11]; p.out = (float*)d_out; p.ws = (unsigned char*)d_ws;
    void* args[] = {&p};
    hipError_t e = hipLaunchCooperativeKernel((const void*)fwd_megakernel, dim3(grid_blocks), dim3(NTHREADS), args, LDS_BYTES, stream);
    if (e != hipSuccess) fprintf(stderr, "cooperative launch failed: %s (grid %d)\n", hipGetErrorString(e), grid_blocks);
}
```

```cpp
#include <hip/hip_runtime.h>
#include <hip/hip_cooperative_groups.h>
#include <cstdio>
#include <cstdint>
namespace cg = cooperative_groups;

#define LAS __attribute__((address_space(3)))
typedef unsigned short bf16_t;
typedef short bf16x8 __attribute__((ext_vector_type(8)));
typedef short s16x4 __attribute__((ext_vector_type(4)));
typedef float f32x2 __attribute__((ext_vector_type(2)));
typedef float f32x4 __attribute__((ext_vector_type(4)));
typedef float f32x16 __attribute__((ext_vector_type(16)));
typedef unsigned u32x2 __attribute__((ext_vector_type(2)));
typedef unsigned u32x4 __attribute__((ext_vector_type(4)));

constexpr int D_MODEL = 1024, BATCH = 8, SEQ = 2048, DEPTH = 2, M_TOK = BATCH * SEQ;
constexpr int IN_COLS = 9216, MIX_COLS = 6144;
constexpr int PITCH = 7168;
constexpr size_t PITCHB = (size_t)PITCH * 2;
constexpr int C_QA = 0, C_KA = 512, C_VA = 1024, C_ZA = 1536, C_QB = 2048, C_FB = 2560, C_IB = 3072, C_ZB = 3584, C_PU = 4096  , C_PZ = 4608  , C_ZC = 5632  , C_H = 6144;
constexpr int C_MERGED = 4096;
constexpr float LN_EPS = 1e-5f, RMS_EPS = 1e-6f;
constexpr float LOG2E = 1.4426950408889634f;
constexpr float QSCALE = 0.125f * LOG2E;
constexpr float ALPHA = 1.4142135623730951f;

constexpr size_t WS_CTL = 0, CTL_BYTES = 65536;
constexpr size_t WS_MOD = 65536;
constexpr size_t WS_DEND = 256u << 10;
constexpr size_t WS_WIN = 1u << 20;
constexpr size_t WIN_L = (size_t)IN_COLS * 1024 * 2;
constexpr size_t WS_WB = WS_WIN + WIN_L;
constexpr size_t WB_L = (size_t)3 * 1024 * 1024 * 2;
constexpr size_t WS_WO = WS_WB + WB_L;
constexpr size_t WO_L = (size_t)1024 * 1024 * 2;
constexpr size_t WS_ACT = WS_WO + WO_L;
constexpr size_t WS_U = WS_ACT + (size_t)M_TOK * PITCHB;
constexpr size_t WS_X = WS_U + (size_t)32 * 32 * 128 * 128 * 2;
constexpr size_t WS_MODP = WS_X + 3 * 524288;
constexpr size_t WS_END = WS_MODP + (size_t)4 * DEPTH * BATCH * 3072 * 4;
constexpr size_t CTL_PANEL = 16384;

constexpr int LDS_BYTES = 147456;
constexpr int NTHREADS = 512;

struct Params {
    const float* x; const float* c; const float* w_mod; const float* b_mod; const float* w_in; const float* conv_w; const float* hgrn_norm_w;
    const float* lower_bounds; const float* w_branch; const float* w_out; const float* ln_g; const float* ln_b; float* out; unsigned char* ws;
};

typedef __bf16 bf16x2_t __attribute__((ext_vector_type(2)));
__device__ __forceinline__ unsigned cvt_pk_bf16(float lo, float hi) { const f32x2 v = {lo, hi}; const bf16x2_t b = __builtin_convertvector(v, bf16x2_t); return __builtin_bit_cast(unsigned, b); }
__device__ __forceinline__ f32x4 ld_nt(const float* p) { return __builtin_nontemporal_load((const f32x4*)p); }
__device__ __forceinline__ float bf_lo(unsigned w) { return __uint_as_float(w << 16); }
__device__ __forceinline__ float bf_hi(unsigned w) { return __uint_as_float(w & 0xffff0000u); }
__device__ __forceinline__ float bf2f(bf16_t v) { return __uint_as_float((unsigned)v << 16); }
__device__ __forceinline__ float ex2(float v) { return __builtin_amdgcn_exp2f(v); }
__device__ __forceinline__ float lg2(float v) { return __builtin_amdgcn_logf(v); }
__device__ __forceinline__ float sigmoidf_(float v) { return __builtin_amdgcn_rcpf(1.0f + ex2(-v * LOG2E)); }
__device__ __forceinline__ float siluf_(float v) { return v * sigmoidf_(v); }
__device__ __forceinline__ float wave_sum(float v) {
#pragma unroll
    for (int o = 1; o < 64; o <<= 1) v += __shfl_xor(v, o);
    return v;
}
__device__ __forceinline__ int fresh_tid() { int t = threadIdx.x; asm volatile("" : "+v"(t)); return t; }
__device__ __forceinline__ int crow(int r, int hi) { return (r & 3) + 8 * (r >> 2) + 4 * hi; }

namespace pg8 {
constexpr int BM = 256, BK = 64, HALF = 128, HTB = HALF * BK * 2, STAGE_BYTES = 8 * HTB;
__device__ __forceinline__ int lds_byte(int r, int c) { const int st = (r >> 4) * 2 + (c >> 5), rr = r & 15, cc = c & 31, ob = rr * 64 + cc * 2; return st * 1024 + (ob ^ (((ob >> 9) & 1) << 5)); }
__device__ __forceinline__ void stage_rc(int b, int& R, int& C) { const int st = b / 1024, sb = b % 1024, swz = sb ^ (((sb >> 9) & 1) << 5); R = (st >> 1) * 16 + swz / 64; C = (st & 1) * 32 + (swz % 64) / 2; }
__device__ __forceinline__ int perm32(int rho) { const int n = rho >> 4, i = rho & 15; return 8 * (i >> 2) + 4 * n + (i & 3); }

struct Unit { const char* a; const char* b; int nt; int pm, pn, j; };

template <class Epi, class Sched>
__device__ __forceinline__ void gemm_phase(LAS unsigned char* lds, const unsigned ldaB, const unsigned ldbB, const Sched& S, const Epi& E) {
    const int tid = fresh_tid(), wid = __builtin_amdgcn_readfirstlane(tid >> 6), lane = tid & 63, wr = wid >> 2, wc = wid & 3, fr = lane & 15, fq = lane >> 4;
    unsigned voffA[2], voffB[2];
#pragma unroll
    for (int i = 0; i < 2; ++i) { int R, C; stage_rc(tid * 16 + i * 8192, R, C); const int Rb = Epi::PERM ? ((R & ~31) + perm32(R & 31)) : R;
        voffA[i] = (unsigned)R * ldaB + (unsigned)C * 2u; voffB[i] = (unsigned)Rb * ldbB + (unsigned)C * 2u; }
    const size_t kstep = (size_t)(BK * 2);
    const size_t hstepA = (size_t)HALF * ldaB, hstepB = (size_t)HALF * ldbB;
    const unsigned ldsw = (unsigned)wid * 1024u;
    const int aoff = lds_byte(wr * 64 + fr, fq * 8), boff = lds_byte(wc * 32 + fr, fq * 8);
#define PG8_SA(b, h) (((b) * 2 + (h)) * HTB)
#define PG8_SB(b, h) ((4 + (b) * 2 + (h)) * HTB)
#define PG8_STAGE(bufoff, gbase, voff) do { _Pragma("unroll") for (int _i = 0; _i < 2; ++_i) \
        __builtin_amdgcn_global_load_lds((const unsigned*)((const char*)(gbase) + (voff)[_i]), (LAS unsigned*)(lds + (bufoff) + ldsw + _i * 8192), 16, 0, 0); } while (0)
#define PG8_LDA(dst, b, h) do { _Pragma("unroll") for (int m = 0; m < 4; ++m) _Pragma("unroll") for (int k = 0; k < 2; ++k) dst[m][k] = *(const LAS bf16x8*)(lds + PG8_SA(b, h) + aoff + m * 2048 + k * 1024); } while (0)
#define PG8_LDB(dst, b, h) do { _Pragma("unroll") for (int n = 0; n < 2; ++n) _Pragma("unroll") for (int k = 0; k < 2; ++k) dst[n][k] = *(const LAS bf16x8*)(lds + PG8_SB(b, h) + boff + n * 2048 + k * 1024); } while (0)
#define PG8_MMA(ai, bj, At, Bt) do { __builtin_amdgcn_s_setprio(1); _Pragma("unroll") for (int m = 0; m < 4; ++m) _Pragma("unroll") for (int n = 0; n < 2; ++n) _Pragma("unroll") for (int k = 0; k < 2; ++k) \
        acc[ai][bj][m][n] = __builtin_amdgcn_mfma_f32_16x16x32_bf16(Bt[n][k], At[m][k], acc[ai][bj][m][n], 0, 0, 0); __builtin_amdgcn_s_setprio(0); } while (0)
#define PG8_WAIT_V(n) asm volatile("s_waitcnt vmcnt(" #n ")" ::: "memory")
#define PG8_WAIT_L(n) asm volatile("s_waitcnt lgkmcnt(" #n ")" ::: "memory")
#define PG8_BAR __builtin_amdgcn_s_barrier()
#define PG8_SCHED __builtin_amdgcn_sched_barrier(0)
    Unit cur, nxt; int ui = 0;
    if (!S.next(0, cur)) return;
    f32x4 acc[2][2][4][2];
#pragma unroll
    for (int a = 0; a < 2; ++a)
#pragma unroll
        for (int b = 0; b < 2; ++b)
#pragma unroll
            for (int m = 0; m < 4; ++m)
#pragma unroll
                for (int n = 0; n < 2; ++n) acc[a][b][m][n] = (f32x4){0.f, 0.f, 0.f, 0.f};
    bf16x8 At[4][2], B0[2][2], B1[2][2];
    const char* cA = cur.a; const char* cB = cur.b;
    PG8_STAGE(PG8_SB(0, 0), cB, voffB); PG8_STAGE(PG8_SB(0, 1), cB + hstepB, voffB); PG8_STAGE(PG8_SA(0, 0), cA, voffA); PG8_STAGE(PG8_SA(0, 1), cA + hstepA, voffA);
    if (wr == 1) PG8_BAR;
    PG8_WAIT_V(2); PG8_BAR;
    PG8_STAGE(PG8_SB(1, 0), cB + kstep, voffB); PG8_STAGE(PG8_SA(1, 0), cA + kstep, voffA); PG8_STAGE(PG8_SB(1, 1), cB + hstepB + kstep, voffB);
    PG8_WAIT_V(6); PG8_BAR;
    for (;;) {
        const bool has_next = S.next(ui + 1, nxt);
        const char* nA = has_next ? nxt.a : cA; const char* nB = has_next ? nxt.b : cB;
        const int nt = cur.nt;
        for (int t = 0; t < nt; t += 2) {
            const bool last = (t == nt - 2);
            const char* a1 = cA + (size_t)(t + 1) * kstep;
            const char* a2 = last ? nA : cA + (size_t)(t + 2) * kstep; const char* b2 = last ? nB : cB + (size_t)(t + 2) * kstep;
            const char* a3 = a2 + kstep; const char* b3 = b2 + kstep;
            PG8_LDB(B0, 0, 0); PG8_LDB(B1, 0, 1); PG8_SCHED; PG8_LDA(At, 0, 0); PG8_STAGE(PG8_SA(1, 1), a1 + hstepA, voffA);
            PG8_WAIT_V(8); PG8_WAIT_L(0); PG8_BAR; PG8_MMA(0, 0, At, B0); PG8_MMA(0, 1, At, B1); PG8_BAR; PG8_SCHED;
            PG8_LDA(At, 0, 1); PG8_STAGE(PG8_SB(0, 0), b2, voffB); PG8_STAGE(PG8_SB(0, 1), b2 + hstepB, voffB); PG8_STAGE(PG8_SA(0, 0), a2, voffA);
            PG8_WAIT_V(8); PG8_WAIT_L(0); PG8_BAR; PG8_MMA(1, 0, At, B0); PG8_MMA(1, 1, At, B1); PG8_BAR; PG8_SCHED;
            PG8_LDB(B0, 1, 0); PG8_LDB(B1, 1, 1); PG8_SCHED; PG8_LDA(At, 1, 0); PG8_STAGE(PG8_SA(0, 1), a2 + hstepA, voffA);
            PG8_WAIT_V(8); PG8_WAIT_L(0); PG8_BAR; PG8_MMA(0, 0, At, B0); PG8_MMA(0, 1, At, B1); PG8_BAR; PG8_SCHED;
            PG8_LDA(At, 1, 1); PG8_STAGE(PG8_SB(1, 0), b3, voffB); PG8_STAGE(PG8_SB(1, 1), b3 + hstepB, voffB); PG8_STAGE(PG8_SA(1, 0), a3, voffA);
            PG8_WAIT_V(8); PG8_WAIT_L(0); PG8_BAR; PG8_MMA(1, 0, At, B0); PG8_MMA(1, 1, At, B1); PG8_BAR; PG8_SCHED;
        }
        if (wr == 0) PG8_BAR;
        if constexpr (!Epi::AFTER_DRAIN) E(acc, cur, wr, wc, fr, fq);
        if (!has_next) break;
#pragma unroll
        for (int a = 0; a < 2; ++a)
#pragma unroll
            for (int b = 0; b < 2; ++b)
#pragma unroll
                for (int m = 0; m < 4; ++m)
#pragma unroll
                    for (int n = 0; n < 2; ++n) acc[a][b][m][n] = (f32x4){0.f, 0.f, 0.f, 0.f};
        cur = nxt; cA = nA; cB = nB; ++ui;
        if (wr == 1) PG8_BAR;
    }
    PG8_WAIT_V(0);
    PG8_BAR;
    if constexpr (Epi::AFTER_DRAIN) E.fused(acc, cur, wr, wc, fr, fq, lds, wid, lane);
#undef PG8_SA
#undef PG8_SB
#undef PG8_STAGE
#undef PG8_LDA
#undef PG8_LDB
#undef PG8_MMA
#undef PG8_WAIT_V
#undef PG8_WAIT_L
#undef PG8_BAR
#undef PG8_SCHED
}
}

struct SchedP1 {
    const char* A; const char* B; int G, vcu;
    __device__ __forceinline__ bool next(int i, pg8::Unit& u) const {
        const int U = i * G + vcu; if (U >= 64 * 24) return false;
        u.pm = 8 * ((U >> 5) & 7) + (U & 7); u.pn = 4 * (U >> 8) + ((U & 31) >> 3); u.j = 0; u.nt = 16;
        u.a = A + (size_t)u.pm * 256 * PITCHB; u.b = B + (size_t)u.pn * 256 * 2048; return true;
    }
};
struct SchedP3 {
    const char* ACTb; const char* Wg; const char* Wb; int G, vcu;
    __device__ __forceinline__ bool next(int i, pg8::Unit& u) const {
        const int T = vcu + (i / 6) * G; if (T >= 256) return false;
        const int s = i % 6; u.pm = 8 * (T >> 5) + (T & 7); u.pn = (T & 31) >> 3; u.j = s;
        const int j = s >> 1;
        if ((s & 1) == 0) { u.nt = 16; u.a = ACTb + (size_t)u.pm * 256 * PITCHB + C_H * 2; u.b = Wg + (size_t)(1024 * j + 256 * u.pn) * 2048; }
        else { u.nt = 8; u.a = ACTb + (size_t)u.pm * 256 * PITCHB + (size_t)(C_ZA + 2048 * j) * 2; u.b = Wb + (size_t)(1024 * j + 256 * u.pn) * 2048; }
        return true;
    }
};
struct SchedP4 {
    const char* ACTb; const char* Wo; int G, vcu;
    __device__ __forceinline__ bool next(int i, pg8::Unit& u) const {
        const int T = vcu + i * G; if (T >= 256) return false;
        u.pm = 8 * (T >> 5) + (T & 7); u.pn = (T & 31) >> 3; u.j = 0; u.nt = 16;
        u.a = ACTb + (size_t)u.pm * 256 * PITCHB + C_MERGED * 2; u.b = Wo + (size_t)(256 * u.pn) * 2048; return true;
    }
};

struct EpiP1 {
    static constexpr bool PERM = true, AFTER_DRAIN = false;
    bf16_t* ACT;
    __device__ __forceinline__ void operator()(const f32x4 (&acc)[2][2][4][2], const pg8::Unit& u, int wr, int wc, int fr, int fq) const {
        const int row0 = u.pm * 256 + wr * 64 + fr;
        if (u.pn >= 16) {
            const int T = u.pn - 16, col0 = (T < 4 ? C_PU + 128 * T : C_PZ + 128 * (T - 4)) + wc * 32 + 8 * fq;
#pragma unroll
            for (int ai = 0; ai < 2; ++ai)
#pragma unroll
                for (int m = 0; m < 4; ++m) { bf16_t* rowp = ACT + (size_t)(row0 + ai * 128 + m * 16) * PITCH + col0;
                    f32x4 v0 = acc[ai][1][m][0], v1 = acc[ai][1][m][1];
                    if (T >= 4) {
#pragma unroll
                        for (int e = 0; e < 4; ++e) { v0[e] = siluf_(v0[e]); v1[e] = siluf_(v1[e]); } }
                    v0 = v0 * acc[ai][0][m][0]; v1 = v1 * acc[ai][0][m][1];
                    u32x4 w; w.x = cvt_pk_bf16(v0[0], v0[1]); w.y = cvt_pk_bf16(v0[2], v0[3]); w.z = cvt_pk_bf16(v1[0], v1[1]); w.w = cvt_pk_bf16(v1[2], v1[3]);
                    *(u32x4*)rowp = w; }
            return;
        }
        const int grp = u.pn >> 1;
        const int kind = (grp == 0) ? 1 : ((grp == 3 || grp == 4 || grp == 7) ? 2 : 0);
        const int col0 = u.pn * 256 + wc * 32 + 8 * fq;
#pragma unroll
        for (int ai = 0; ai < 2; ++ai)
#pragma unroll
            for (int m = 0; m < 4; ++m) { bf16_t* rowp = ACT + (size_t)(row0 + ai * 128 + m * 16) * PITCH + col0;
#pragma unroll
                for (int bj = 0; bj < 2; ++bj) { f32x4 v0 = acc[ai][bj][m][0], v1 = acc[ai][bj][m][1];
                    if (kind == 1) { v0 = v0 * QSCALE; v1 = v1 * QSCALE; }
                    else if (kind == 2) {
#pragma unroll
                        for (int e = 0; e < 4; ++e) { v0[e] = siluf_(v0[e]); v1[e] = siluf_(v1[e]); } }
                    u32x4 w; w.x = cvt_pk_bf16(v0[0], v0[1]); w.y = cvt_pk_bf16(v0[2], v0[3]); w.z = cvt_pk_bf16(v1[0], v1[1]); w.w = cvt_pk_bf16(v1[2], v1[3]);
                    *(u32x4*)(rowp + bj * 128) = w; } }
    }
};
struct EpiP3 {
    static constexpr bool PERM = true, AFTER_DRAIN = false;
    unsigned char* ACTb;
    __device__ __forceinline__ void operator()(const f32x4 (&acc)[2][2][4][2], const pg8::Unit& u, int wr, int wc, int fr, int fq) const {
        const int s = u.j, j = s >> 1;
        const int row0 = u.pm * 256 + wr * 64 + fr, cl0 = wc * 32 + 8 * fq;
        const unsigned toff = 512u * (unsigned)u.pn, soff = 5120u + 512u * (unsigned)u.pn, moff = (unsigned)(C_MERGED + 256 * u.pn) * 2u;
        if ((s & 1) == 0) {
#pragma unroll
            for (int ai = 0; ai < 2; ++ai)
#pragma unroll
                for (int m = 0; m < 4; ++m) { unsigned char* rowp = ACTb + (size_t)(row0 + ai * 128 + m * 16) * PITCHB;
#pragma unroll
                    for (int bj = 0; bj < 2; ++bj) { const f32x4 v0 = acc[ai][bj][m][0], v1 = acc[ai][bj][m][1];
                        u32x4 w; w.x = cvt_pk_bf16(v0[0], v0[1]); w.y = cvt_pk_bf16(v0[2], v0[3]); w.z = cvt_pk_bf16(v1[0], v1[1]); w.w = cvt_pk_bf16(v1[2], v1[3]);
                        *(u32x4*)(rowp + soff + (cl0 + bj * 128) * 2) = w; } }
        } else {
#pragma unroll
            for (int ai = 0; ai < 2; ++ai) {
                u32x4 gq[4][2], tq[4][2];
#pragma unroll
                for (int m = 0; m < 4; ++m) { unsigned char* rowp = ACTb + (size_t)(row0 + ai * 128 + m * 16) * PITCHB;
#pragma unroll
                    for (int bj = 0; bj < 2; ++bj) { gq[m][bj] = *(const u32x4*)(rowp + soff + (cl0 + bj * 128) * 2); if (j > 0) tq[m][bj] = *(const u32x4*)(rowp + toff + (cl0 + bj * 128) * 2); } }
#pragma unroll
                for (int m = 0; m < 4; ++m) { unsigned char* rowp = ACTb + (size_t)(row0 + ai * 128 + m * 16) * PITCHB;
#pragma unroll
                    for (int bj = 0; bj < 2; ++bj) { const f32x4 v0 = acc[ai][bj][m][0], v1 = acc[ai][bj][m][1]; const u32x4 g = gq[m][bj];
                        f32x4 t0 = (f32x4){sigmoidf_(bf_lo(g.x)) * v0[0], sigmoidf_(bf_hi(g.x)) * v0[1], sigmoidf_(bf_lo(g.y)) * v0[2], sigmoidf_(bf_hi(g.y)) * v0[3]};
                        f32x4 t1 = (f32x4){sigmoidf_(bf_lo(g.z)) * v1[0], sigmoidf_(bf_hi(g.z)) * v1[1], sigmoidf_(bf_lo(g.w)) * v1[2], sigmoidf_(bf_hi(g.w)) * v1[3]};
                        if (j > 0) { const u32x4 tv = tq[m][bj];
                            t0 = t0 + (f32x4){bf_lo(tv.x), bf_hi(tv.x), bf_lo(tv.y), bf_hi(tv.y)}; t1 = t1 + (f32x4){bf_lo(tv.z), bf_hi(tv.z), bf_lo(tv.w), bf_hi(tv.w)}; }
                        u32x4 w; w.x = cvt_pk_bf16(t0[0], t0[1]); w.y = cvt_pk_bf16(t0[2], t0[3]); w.z = cvt_pk_bf16(t1[0], t1[1]); w.w = cvt_pk_bf16(t1[2], t1[3]);
                        if (j < 2) *(u32x4*)(rowp + toff + (cl0 + bj * 128) * 2) = w; else *(u32x4*)(rowp + moff + (cl0 + bj * 128) * 2) = w;
                    } }
            }
        }
    }
};
struct PanelStats {
    unsigned long long* xbuf;
    unsigned* cnt;
    float eps;
    __device__ __forceinline__ void run(const f32x4 (&v)[2][2][4][2], const pg8::Unit& u, int wr, int wc, int fr, int fq, LAS unsigned char* lds, int wid, int lane) const {
        LAS f32x2* Pt = (LAS f32x2*)lds;
        LAS f32x2* St = (LAS f32x2*)(lds + 8192);
#pragma unroll
        for (int ai = 0; ai < 2; ++ai)
#pragma unroll
            for (int m = 0; m < 4; ++m) {
                float s = 0.f;
#pragma unroll
                for (int bj = 0; bj < 2; ++bj)
#pragma unroll
                    for (int n = 0; n < 2; ++n) { const f32x4 x = v[ai][bj][m][n]; s += (x[0] + x[1]) + (x[2] + x[3]); }
                s += __shfl_xor(s, 16); s += __shfl_xor(s, 32);
                const float mw = s * (1.0f / 64.0f); float q = 0.f;
#pragma unroll
                for (int bj = 0; bj < 2; ++bj)
#pragma unroll
                    for (int n = 0; n < 2; ++n) { const f32x4 d = v[ai][bj][m][n] - mw; q += (d[0] * d[0] + d[1] * d[1]) + (d[2] * d[2] + d[3] * d[3]); }
                q += __shfl_xor(q, 16); q += __shfl_xor(q, 32);
                if (fq == 0) Pt[(ai * 128 + wr * 64 + m * 16 + fr) * 4 + wc] = (f32x2){mw, q};
            }
        __syncthreads();
        const int row = wid * 32 + (lane & 31);
        if (lane < 32) {
            const f32x2 a = Pt[row * 4 + 0], b = Pt[row * 4 + 1], c = Pt[row * 4 + 2], d = Pt[row * 4 + 3];
            const float mt = (a.x + b.x + c.x + d.x) * 0.25f;
            const float da = a.x - mt, db = b.x - mt, dc = c.x - mt, dd = d.x - mt;
            const float m2 = (a.y + b.y) + (c.y + d.y) + 64.0f * ((da * da + db * db) + (dc * dc + dd * dd));
            __hip_atomic_store(xbuf + ((size_t)(u.pm * 256 + row) * 4 + u.pn), ((unsigned long long)__float_as_uint(m2) << 32) | __float_as_uint(mt), __ATOMIC_RELAXED, __HIP_MEMORY_SCOPE_AGENT);
        }
        asm volatile("s_waitcnt vmcnt(0)" ::: "memory");
        if (lane == 0) __hip_atomic_fetch_add(cnt + 64 * u.pm, 1u, __ATOMIC_RELAXED, __HIP_MEMORY_SCOPE_AGENT);
        if (wid == 0) {
            unsigned sp = 0;
            while ((unsigned)__builtin_amdgcn_readfirstlane(__hip_atomic_load(cnt + 64 * u.pm, __ATOMIC_RELAXED, __HIP_MEMORY_SCOPE_AGENT)) < 32u) { __builtin_amdgcn_s_sleep(2); if (++sp > (1u << 24)) break; }
            __builtin_amdgcn_fence(__ATOMIC_ACQUIRE, "agent");
        }
        asm volatile("s_waitcnt vmcnt(0) lgkmcnt(0)" ::: "memory");
        __syncthreads();
        if (lane < 32) {
            const unsigned long long* slot = xbuf + (size_t)(u.pm * 256 + row) * 4; float mt[4], m2[4]; float ms = 0.f;
#pragma unroll
            for (int t = 0; t < 4; ++t) { const unsigned long long w = __hip_atomic_load(slot + t, __ATOMIC_RELAXED, __HIP_MEMORY_SCOPE_AGENT); mt[t] = __uint_as_float((unsigned)w); m2[t] = __uint_as_float((unsigned)(w >> 32)); ms += mt[t]; }
            const float mean = ms * 0.25f; float q = 0.f;
#pragma unroll
            for (int t = 0; t < 4; ++t) { const float dm = mt[t] - mean; q += m2[t] + 256.0f * dm * dm; }
            St[row] = (f32x2){mean, __builtin_amdgcn_rsqf(q * (1.0f / 1024.0f) + eps)};
        }
        __syncthreads();
    }
};
struct EpiP4F {
    static constexpr bool PERM = false, AFTER_DRAIN = true;
    const float* xprev; float* out; const float* gate; const float* lng; const float* lnb; const float* modn; bf16_t* ACT; PanelStats st1, st2;
    __device__ __forceinline__ void fused(f32x4 (&acc)[2][2][4][2], const pg8::Unit& u, int wr, int wc, int fr, int fq, LAS unsigned char* lds, int wid, int lane) const {
        const LAS f32x2* St = (const LAS f32x2*)(lds + 8192);
        const int row0 = u.pm * 256 + wr * 64 + fr, col0 = u.pn * 256 + wc * 32 + 4 * fq;
        const int bidx = (u.pm * 256) / SEQ;
        {
            const float* gp = gate + (size_t)bidx * 3072;
            f32x4 gv[2][2];
#pragma unroll
            for (int bj = 0; bj < 2; ++bj)
#pragma unroll
                for (int n = 0; n < 2; ++n) gv[bj][n] = *(const f32x4*)(gp + col0 + bj * 128 + n * 16) + 1.0f;
#pragma unroll
            for (int ai = 0; ai < 2; ++ai)
#pragma unroll
                for (int m = 0; m < 4; ++m) { const size_t off = (size_t)(row0 + ai * 128 + m * 16) * D_MODEL + col0;
#pragma unroll
                    for (int bj = 0; bj < 2; ++bj)
#pragma unroll
                        for (int n = 0; n < 2; ++n) { const f32x4 xv = ld_nt(xprev + off + bj * 128 + n * 16); acc[ai][bj][m][n] = xv * ALPHA + gv[bj][n] * acc[ai][bj][m][n]; }
                    asm volatile("" : "+v"(acc[ai][0][m][0]), "+v"(acc[ai][0][m][1]), "+v"(acc[ai][1][m][0]), "+v"(acc[ai][1][m][1]));
                    if (m & 1) asm volatile("" ::: "memory"); }
        }
        st1.run(acc, u, wr, wc, fr, fq, lds, wid, lane);
        {
            f32x4 lg[2][2], lb[2][2];
#pragma unroll
            for (int bj = 0; bj < 2; ++bj)
#pragma unroll
                for (int n = 0; n < 2; ++n) { lg[bj][n] = *(const f32x4*)(lng + col0 + bj * 128 + n * 16); lb[bj][n] = *(const f32x4*)(lnb + col0 + bj * 128 + n * 16); }
#pragma unroll
            for (int ai = 0; ai < 2; ++ai)
#pragma unroll
                for (int m = 0; m < 4; ++m) { const int r = ai * 128 + wr * 64 + m * 16 + fr; const f32x2 sr = St[r]; const size_t off = (size_t)(u.pm * 256 + r) * D_MODEL + col0;
#pragma unroll
                    for (int bj = 0; bj < 2; ++bj)
#pragma unroll
                        for (int n = 0; n < 2; ++n) { const f32x4 x1 = (acc[ai][bj][m][n] - sr.x) * sr.y * lg[bj][n] + lb[bj][n]; acc[ai][bj][m][n] = x1;
                            if (modn) *(f32x4*)(out + off + bj * 128 + n * 16) = x1; else __builtin_nontemporal_store(x1, (f32x4*)(out + off + bj * 128 + n * 16)); }
                    asm volatile("" : "+v"(acc[ai][0][m][0]), "+v"(acc[ai][0][m][1]), "+v"(acc[ai][1][m][0]), "+v"(acc[ai][1][m][1]));
                    asm volatile("" ::: "memory"); }
        }
        if (modn) {
            st2.run(acc, u, wr, wc, fr, fq, lds, wid, lane);
            const float* mp = modn + (size_t)bidx * 3072;
            f32x4 sc[2][2], sh[2][2];
#pragma unroll
            for (int bj = 0; bj < 2; ++bj)
#pragma unroll
                for (int n = 0; n < 2; ++n) { sh[bj][n] = *(const f32x4*)(mp + col0 + bj * 128 + n * 16); sc[bj][n] = *(const f32x4*)(mp + 1024 + col0 + bj * 128 + n * 16) + 1.0f; }
#pragma unroll
            for (int ai = 0; ai < 2; ++ai)
#pragma unroll
                for (int m = 0; m < 4; ++m) { const int r = ai * 128 + wr * 64 + m * 16 + fr; const f32x2 sr = St[r]; bf16_t* hp = ACT + (size_t)(u.pm * 256 + r) * PITCH + C_H + col0;
#pragma unroll
                    for (int bj = 0; bj < 2; ++bj)
#pragma unroll
                        for (int n = 0; n < 2; ++n) { const f32x4 hv = (acc[ai][bj][m][n] - sr.x) * sr.y * sc[bj][n] + sh[bj][n];
                            u32x2 w; w.x = cvt_pk_bf16(hv[0], hv[1]); w.y = cvt_pk_bf16(hv[2], hv[3]); *(u32x2*)(hp + bj * 128 + n * 16) = w; }
                    asm volatile("" ::: "memory"); }
        }
    }
};

__device__ __forceinline__ void transpose_item(const float* W, int N, bf16_t* WT, int ldw, LAS float* scr, int item, int lane, bool conv_perm = false) {
    const int nblk = N / 32, kb = item / nblk, nb = item % nblk, k0 = 64 * kb, n0 = 32 * nb;
    int d0 = n0;
    if (conv_perm && n0 >= 4096 && n0 < 6144) { const int g = (n0 - 4096) >> 9, ch0 = (n0 - 4096) & 511; d0 = 4096 + 256 * ((ch0 >> 7) + ((g & 1) ? 4 : 0)) + 128 * (g >> 1) + (ch0 & 127); }
    const int kr = lane >> 3, n4 = (lane & 7) * 4;
    f32x4 v[8];
#pragma unroll
    for (int i = 0; i < 8; ++i) v[i] = ld_nt(W + (size_t)(k0 + 8 * i + kr) * N + n0 + n4);
#pragma unroll
    for (int i = 0; i < 8; ++i) { LAS float* d = scr + (8 * i + kr) * 33 + n4; d[0] = v[i].x; d[1] = v[i].y; d[2] = v[i].z; d[3] = v[i].w; }
    asm volatile("s_waitcnt lgkmcnt(0)" ::: "memory");
    const int c = lane & 7;
#pragma unroll
    for (int j = 0; j < 4; ++j) { const int n = (lane >> 3) + 8 * j; const LAS float* s = scr + (8 * c) * 33 + n;
        u32x4 o; o.x = cvt_pk_bf16(s[0 * 33], s[1 * 33]); o.y = cvt_pk_bf16(s[2 * 33], s[3 * 33]); o.z = cvt_pk_bf16(s[4 * 33], s[5 * 33]); o.w = cvt_pk_bf16(s[6 * 33], s[7 * 33]);
        *(u32x4*)(WT + (size_t)(d0 + n) * ldw + k0 + 8 * c) = o; }
    asm volatile("s_waitcnt lgkmcnt(0)" ::: "memory");
}

__device__ __forceinline__ void row_standardize(f32x4 (&v)[4]) {
    float s = 0.f;
#pragma unroll
    for (int j = 0; j < 4; ++j) s += (v[j].x + v[j].y) + (v[j].z + v[j].w);
    const float mean = wave_sum(s) * (1.f / D_MODEL); float s2 = 0.f;
#pragma unroll
    for (int j = 0; j < 4; ++j) { v[j] = v[j] - mean; s2 += (v[j].x * v[j].x + v[j].y * v[j].y) + (v[j].z * v[j].z + v[j].w * v[j].w); }
    const float rstd = __builtin_amdgcn_rsqf(wave_sum(s2) * (1.f / D_MODEL) + LN_EPS);
#pragma unroll
    for (int j = 0; j < 4; ++j) v[j] = v[j] * rstd;
}
__device__ __forceinline__ void write_h_row(const f32x4 (&v)[4], const float* modb, bf16_t* hrow, int lane) {
#pragma unroll
    for (int j = 0; j < 4; ++j) { const int col = 4 * (lane + 64 * j);
        const f32x4 sh = *(const f32x4*)(modb + col), sc = *(const f32x4*)(modb + 1024 + col);
        const f32x4 h = v[j] * (sc + 1.0f) + sh;
        u32x2 w; w.x = cvt_pk_bf16(h.x, h.y); w.y = cvt_pk_bf16(h.z, h.w);
        *(u32x2*)(hrow + col) = w; }
}

typedef short v4i16_t __attribute__((ext_vector_type(4)));
__device__ __forceinline__ s16x4 vtr(const LAS bf16_t* p) { return __builtin_bit_cast(s16x4, __builtin_amdgcn_ds_read_tr16_b64_v4i16((LAS v4i16_t*)p)); }
constexpr float STICK_DEAD = -44.0f;
__device__ __forceinline__ void attn_unit(LAS unsigned char* lds, bf16_t* ACT, int b, int h, int qb) {
    const int tid = fresh_tid(), lane = tid & 63, r32 = lane & 31, hi = lane >> 5;
    const int wid = __builtin_amdgcn_readfirstlane(tid >> 6);
    bf16_t* base = ACT + (size_t)b * SEQ * PITCH;
    const int tq0 = qb * 256 + wid * 32, tq = tq0 + r32;
    LAS bf16_t* Kw = (LAS bf16_t*)(lds + wid * 9728);
    LAS bf16_t* Vw = Kw + 32 * 72;
    LAS float* stg = (LAS float*)(lds + wid * 9728);
    bf16x8 qr[4];
#pragma unroll
    for (int d0 = 0; d0 < 4; ++d0) qr[d0] = *(const bf16x8*)(base + (size_t)tq * PITCH + C_QA + h * 64 + d0 * 16 + hi * 8);
    f32x16 o0, o1;
#pragma unroll
    for (int r = 0; r < 16; ++r) { o0[r] = 0.f; o1[r] = 0.f; }
    float R = 0.f;
    const int srow = lane >> 3, sch = lane & 7;
    const bf16_t* kg = base + (size_t)srow * PITCH + C_KA + h * 64 + sch * 8;
    const bf16_t* vg = base + (size_t)srow * PITCH + C_VA + h * 64 + sch * 8;
    const LAS bf16_t* vb = Vw + (4 * hi + ((lane & 15) >> 2)) * 80 + 16 * ((lane >> 4) & 1) + 4 * (lane & 3);
    u32x4 kreg[4], vreg[4];
    int kb = tq0;
#pragma unroll
    for (int i = 0; i < 4; ++i) { kreg[i] = *(const u32x4*)(kg + (size_t)(kb + 8 * i) * PITCH); vreg[i] = *(const u32x4*)(vg + (size_t)(kb + 8 * i) * PITCH); }
    for (;;) {
#pragma unroll
        for (int i = 0; i < 4; ++i) { *(LAS u32x4*)(Kw + (srow + 8 * i) * 72 + sch * 8) = kreg[i]; *(LAS u32x4*)(Vw + (srow + 8 * i) * 80 + sch * 8) = vreg[i]; }
        const int kbn = kb - 32;
        if (kbn >= 0) {
#pragma unroll
            for (int i = 0; i < 4; ++i) { kreg[i] = *(const u32x4*)(kg + (size_t)(kbn + 8 * i) * PITCH); vreg[i] = *(const u32x4*)(vg + (size_t)(kbn + 8 * i) * PITCH); }
        }
        f32x16 p0;
#pragma unroll
        for (int r = 0; r < 16; ++r) p0[r] = 0.f;
#pragma unroll
        for (int d0 = 0; d0 < 4; ++d0) {
            const bf16x8 a0 = *(const LAS bf16x8*)(Kw + r32 * 72 + d0 * 16 + hi * 8);
            p0 = __builtin_amdgcn_mfma_f32_32x32x16_bf16(a0, qr[d0], p0, 0, 0, 0);
        }
        float x0[16];
        if (kb < tq0) {
#pragma unroll
            for (int r = 0; r < 16; ++r) { const float z = p0[r]; const float sp = fmaxf(z, 0.f) + lg2(1.0f + ex2(-fabsf(z))); x0[r] = sp; p0[r] = z - sp; }
        } else {
            const int kvl = kb + 4 * hi;
#pragma unroll
            for (int r = 0; r < 16; ++r) { const int kv = kvl + (r & 3) + 8 * (r >> 2);
                const float z = p0[r]; const float sp = fmaxf(z, 0.f) + lg2(1.0f + ex2(-fabsf(z))); const bool ok = kv < tq; x0[r] = ok ? sp : 0.f; p0[r] = ok ? z - sp : -INFINITY; }
        }
        float Gs[4], Gh1[4], Tt[4];
#pragma unroll
        for (int g = 0; g < 4; ++g) Gs[g] = (x0[4 * g] + x0[4 * g + 1]) + (x0[4 * g + 2] + x0[4 * g + 3]);
#pragma unroll
        for (int g = 0; g < 4; ++g) { auto rr = __builtin_amdgcn_permlane32_swap(__float_as_uint(Gs[g]), __float_as_uint(Gs[g]), false, false);
            Gh1[g] = __uint_as_float(rr[1]); Tt[g] = __uint_as_float(rr[0]) + __uint_as_float(rr[1]); }
        float run = R;
#pragma unroll
        for (int g = 3; g >= 0; --g) {
            const float off = hi ? run : run - Gh1[g];
            const int q4 = 4 * g;
            const float s3 = off, s2 = s3 - x0[q4 + 3], s1 = s2 - x0[q4 + 2], s0 = s1 - x0[q4 + 1];
            p0[q4 + 3] = ex2(p0[q4 + 3] + s3); p0[q4 + 2] = ex2(p0[q4 + 2] + s2); p0[q4 + 1] = ex2(p0[q4 + 1] + s1); p0[q4] = ex2(p0[q4] + s0);
            run -= Tt[g];
        }
        R = run;
#pragma unroll
        for (int s = 0; s < 2; ++s) {
            u32x4 w; const int r0 = 8 * s;
            w.x = cvt_pk_bf16(p0[r0], p0[r0 + 1]); w.y = cvt_pk_bf16(p0[r0 + 2], p0[r0 + 3]); w.z = cvt_pk_bf16(p0[r0 + 4], p0[r0 + 5]); w.w = cvt_pk_bf16(p0[r0 + 6], p0[r0 + 7]);
            const bf16x8 af = __builtin_bit_cast(bf16x8, w);
            { const s16x4 lo = vtr(vb + (16 * s) * 80), hh = vtr(vb + (16 * s + 8) * 80);
              const bf16x8 bfr = (bf16x8){lo[0], lo[1], lo[2], lo[3], hh[0], hh[1], hh[2], hh[3]};
              o0 = __builtin_amdgcn_mfma_f32_32x32x16_bf16(af, bfr, o0, 0, 0, 0); }
            { const s16x4 lo = vtr(vb + (16 * s) * 80 + 32), hh = vtr(vb + (16 * s + 8) * 80 + 32);
              const bf16x8 bfr = (bf16x8){lo[0], lo[1], lo[2], lo[3], hh[0], hh[1], hh[2], hh[3]};
              o1 = __builtin_amdgcn_mfma_f32_32x32x16_bf16(af, bfr, o1, 0, 0, 0); }
        }
        if (kbn < 0 || !__any(R > STICK_DEAD)) break;
        kb = kbn;
    }
#pragma unroll
    for (int r = 0; r < 16; ++r) { stg[crow(r, hi) * 68 + r32] = o0[r]; stg[crow(r, hi) * 68 + 32 + r32] = o1[r]; }
    asm volatile("s_waitcnt lgkmcnt(0)" ::: "memory");
#pragma unroll
    for (int i = 0; i < 4; ++i) { const int row = i * 8 + (lane >> 3), ch = lane & 7;
        const f32x4 a = *(const LAS f32x4*)(stg + row * 68 + ch * 8), c = *(const LAS f32x4*)(stg + row * 68 + ch * 8 + 4);
        bf16_t* zp = base + (size_t)(tq0 + row) * PITCH + C_ZA + h * 64 + ch * 8;
        const u32x4 z = *(const u32x4*)zp;
        u32x4 w; w.x = cvt_pk_bf16(a.x * bf_lo(z.x), a.y * bf_hi(z.x)); w.y = cvt_pk_bf16(a.z * bf_lo(z.y), a.w * bf_hi(z.y));
        w.z = cvt_pk_bf16(c.x * bf_lo(z.z), c.y * bf_hi(z.z)); w.w = cvt_pk_bf16(c.z * bf_lo(z.w), c.w * bf_hi(z.w));
        *(u32x4*)zp = w; }
    asm volatile("s_waitcnt lgkmcnt(0)" ::: "memory");
}

__device__ __forceinline__ float layer_lb(const float* lower_bounds, int l, int ch) {
    float mx = -INFINITY;
    for (int i = 0; i < DEPTH; ++i) mx = fmaxf(mx, lower_bounds[i * 512 + ch]);
    float den = 0.f, num = 0.f;
    for (int i = 0; i < DEPTH; ++i) { const float e = __expf(lower_bounds[i * 512 + ch] - mx); den += e; if (i >= 1 && i <= l) num += e; }
    return num / den;
}
template <int MODE>
__device__ __forceinline__ void hgrn_pass(LAS unsigned char* lds, bf16_t* ACT, const Params& P, int l, int bh, int c0, int nc) {
    const int tid = fresh_tid(), lane = tid & 63, r32 = lane & 31, hi = lane >> 5;
    const int wid = __builtin_amdgcn_readfirstlane(tid >> 6);
    LAS bf16_t* Q1 = (LAS bf16_t*)(lds);
    LAS bf16_t* Q2 = (LAS bf16_t*)(lds + 17408);
    LAS bf16_t* K2 = (LAS bf16_t*)(lds + 34816);
    LAS float*  OT = (LAS float*)(lds);
    LAS bf16_t* K3T = (LAS bf16_t*)(lds + 52224);
    LAS bf16_t* VT = (LAS bf16_t*)(lds + 70656);
    LAS bf16_t* Pm = (LAS bf16_t*)(lds + 89088);
    LAS bf16_t* ST = (LAS bf16_t*)(lds + 98304);
    LAS float* DEND = (LAS float*)(lds + 133120);
    LAS float* SCX = (LAS float*)(lds + 133632);
    const int d = tid & 127, part = tid >> 7, b = bh >> 2, h = bh & 3, grp = c0 / nc;
    const float lbv = layer_lb(P.lower_bounds, l, h * 128 + d);
    bf16_t* base = ACT + (size_t)b * SEQ * PITCH + h * 128;
    bf16_t* Ug = (bf16_t*)(P.ws + WS_U) + (size_t)bh * 8 * 16384;
    float* Dg = (float*)(P.ws + WS_DEND) + (size_t)bh * 8 * 128;
    const float* nw = P.hgrn_norm_w + l * 128;
    const int tb = wid & 1, eb = wid >> 1;
    bf16_t fin[16], qin[16], vin[16];
#pragma unroll
    for (int i = 0; i < 16; ++i) { const bf16_t* rp = base + (size_t)(c0 * 64 + 16 * part + i) * PITCH + d; fin[i] = rp[C_FB]; vin[i] = rp[C_IB]; if (MODE == 1) qin[i] = rp[C_QB]; }
    f32x16 sa[2];
#pragma unroll
    for (int r = 0; r < 16; ++r) { sa[0][r] = 0.f; sa[1][r] = 0.f; }
    float bsum = 0.f;
    if (MODE == 1) {
        const int d8 = (tid & 15) * 8;
        f32x4 Sp[4][2];
#pragma unroll
        for (int i = 0; i < 4; ++i) { Sp[i][0] = (f32x4){0.f, 0.f, 0.f, 0.f}; Sp[i][1] = (f32x4){0.f, 0.f, 0.f, 0.f}; }
        for (int k = 0; k < grp; ++k) {
            const f32x4 da = *(const f32x4*)(Dg + k * 128 + d8), db = *(const f32x4*)(Dg + k * 128 + d8 + 4);
            u32x4 uv[4];
#pragma unroll
            for (int i = 0; i < 4; ++i) { const int idx = tid + 512 * i; uv[i] = *(const u32x4*)(Ug + (size_t)k * 16384 + (idx >> 4) * 128 + d8); }
#pragma unroll
            for (int i = 0; i < 4; ++i) {
                Sp[i][0] = da * Sp[i][0] + (f32x4){bf_lo(uv[i].x), bf_hi(uv[i].x), bf_lo(uv[i].y), bf_hi(uv[i].y)};
                Sp[i][1] = db * Sp[i][1] + (f32x4){bf_lo(uv[i].z), bf_hi(uv[i].z), bf_lo(uv[i].w), bf_hi(uv[i].w)}; }
        }
#pragma unroll
        for (int i = 0; i < 4; ++i) { const int idx = tid + 512 * i;
            u32x4 v; v.x = cvt_pk_bf16(Sp[i][0][0], Sp[i][0][1]); v.y = cvt_pk_bf16(Sp[i][0][2], Sp[i][0][3]); v.z = cvt_pk_bf16(Sp[i][1][0], Sp[i][1][1]); v.w = cvt_pk_bf16(Sp[i][1][2], Sp[i][1][3]);
            *(LAS u32x4*)(ST + (idx >> 4) * 136 + d8) = v; }
        __syncthreads();
#pragma unroll
        for (int i = 0; i < 2; ++i) { const int db = 2 * (wid & 1) + i;
#pragma unroll
            for (int g = 0; g < 4; ++g) { const u32x2 w = *(const LAS u32x2*)(ST + (32 * eb + r32) * 136 + 32 * db + 8 * g + 4 * hi);
                sa[i][4 * g] = bf_lo(w.x); sa[i][4 * g + 1] = bf_hi(w.x); sa[i][4 * g + 2] = bf_lo(w.y); sa[i][4 * g + 3] = bf_hi(w.y); } }
    }
    for (int ci = 0; ci < nc; ++ci) {
        const int c = c0 + ci;
        float g2[16], kk[16];
        float runb = 0.f;
#pragma unroll
        for (int i = 0; i < 16; ++i) { const float f = lbv + (1.0f - lbv) * sigmoidf_(bf2f(fin[i])); kk[i] = 1.0f - f; runb += lg2(f); g2[i] = runb; }
        SCX[part * 128 + d] = runb;
        __syncthreads();
        const float t0 = SCX[d], t1 = SCX[128 + d], t2 = SCX[256 + d], t3 = SCX[384 + d];
        const float offp = (part > 0 ? t0 : 0.f) + (part > 1 ? t1 : 0.f) + (part > 2 ? t2 : 0.f);
        const float cmid = t0 + t1, bend = (t0 + t1) + (t2 + t3);
        bsum += bend;
        if (part == 0) DEND[d] = ex2(bend);
        {
            unsigned k3w[8], vw[8];
#pragma unroll
            for (int i = 0; i < 16; i += 2) {
                const float B0 = offp + g2[i], B1 = offp + g2[i + 1];
                if (MODE == 1) {
                    const float q0 = bf2f(qin[i]), q1 = bf2f(qin[i + 1]);
                    const int t = 16 * part + i;
                    Q1[t * 136 + d] = (bf16_t)(cvt_pk_bf16(q0 * ex2(B0), 0.f) & 0xffffu); Q1[(t + 1) * 136 + d] = (bf16_t)(cvt_pk_bf16(q1 * ex2(B1), 0.f) & 0xffffu);
                    Q2[t * 136 + d] = (bf16_t)(cvt_pk_bf16(q0 * ex2(B0 - cmid), 0.f) & 0xffffu); Q2[(t + 1) * 136 + d] = (bf16_t)(cvt_pk_bf16(q1 * ex2(B1 - cmid), 0.f) & 0xffffu);
                    K2[t * 136 + d] = (bf16_t)(cvt_pk_bf16(kk[i] * ex2(cmid - B0), 0.f) & 0xffffu); K2[(t + 1) * 136 + d] = (bf16_t)(cvt_pk_bf16(kk[i + 1] * ex2(cmid - B1), 0.f) & 0xffffu);
                }
                k3w[i >> 1] = cvt_pk_bf16(kk[i] * ex2(bend - B0), kk[i + 1] * ex2(bend - B1));
                vw[i >> 1] = (unsigned)vin[i] | ((unsigned)vin[i + 1] << 16);
            }
            *(LAS u32x4*)(K3T + d * 72 + 16 * part) = (u32x4){k3w[0], k3w[1], k3w[2], k3w[3]}; *(LAS u32x4*)(K3T + d * 72 + 16 * part + 8) = (u32x4){k3w[4], k3w[5], k3w[6], k3w[7]};
            *(LAS u32x4*)(VT + d * 72 + 16 * part) = (u32x4){vw[0], vw[1], vw[2], vw[3]}; *(LAS u32x4*)(VT + d * 72 + 16 * part + 8) = (u32x4){vw[4], vw[5], vw[6], vw[7]};
        }
        if (ci + 1 < nc) {
#pragma unroll
            for (int i = 0; i < 16; ++i) { const bf16_t* rp = base + (size_t)((c + 1) * 64 + 16 * part + i) * PITCH + d; fin[i] = rp[C_FB]; vin[i] = rp[C_IB]; if (MODE == 1) qin[i] = rp[C_QB]; }
        }
        __syncthreads();
        if (MODE == 0) {
#pragma unroll
            for (int i = 0; i < 2; ++i) {
                const int db = 2 * (wid & 1) + i;
#pragma unroll
                for (int r = 0; r < 16; ++r) sa[i][r] *= DEND[32 * db + crow(r, hi)];
#pragma unroll
                for (int ks = 0; ks < 4; ++ks) {
                    const bf16x8 a = *(const LAS bf16x8*)(K3T + (32 * db + r32) * 72 + 16 * ks + 8 * hi);
                    const bf16x8 bb = *(const LAS bf16x8*)(VT + (32 * eb + r32) * 72 + 16 * ks + 8 * hi);
                    sa[i] = __builtin_amdgcn_mfma_f32_32x32x16_bf16(a, bb, sa[i], 0, 0, 0);
                }
            }
        } else {
            f32x16 o;
#pragma unroll
            for (int r = 0; r < 16; ++r) o[r] = 0.f;
            if (c > 0) {
#pragma unroll
                for (int ks = 0; ks < 8; ++ks) {
                    const bf16x8 a = *(const LAS bf16x8*)(Q1 + (32 * tb + r32) * 136 + 16 * ks + 8 * hi);
                    const bf16x8 bb = *(const LAS bf16x8*)(ST + (32 * eb + r32) * 136 + 16 * ks + 8 * hi);
                    o = __builtin_amdgcn_mfma_f32_32x32x16_bf16(a, bb, o, 0, 0, 0);
                }
            }
            if (wid < 4) {
                const int stb = wid & 1, ssb = wid >> 1;
                f32x16 sc;
#pragma unroll
                for (int r = 0; r < 16; ++r) sc[r] = 0.f;
                if (!(stb == 0 && ssb == 1)) {
#pragma unroll
                    for (int ks = 0; ks < 8; ++ks) {
                        const bf16x8 a = *(const LAS bf16x8*)(Q2 + (32 * stb + r32) * 136 + 16 * ks + 8 * hi);
                        const bf16x8 bb = *(const LAS bf16x8*)(K2 + (32 * ssb + r32) * 136 + 16 * ks + 8 * hi);
                        sc = __builtin_amdgcn_mfma_f32_32x32x16_bf16(a, bb, sc, 0, 0, 0);
                    }
                }
#pragma unroll
                for (int r = 0; r < 16; ++r) { const int t = 32 * stb + crow(r, hi), s = 32 * ssb + r32;
                    const float v = (s <= t) ? sc[r] : 0.f;
                    Pm[t * 72 + s] = (bf16_t)(cvt_pk_bf16(v, 0.f) & 0xffffu); }
            }
            __syncthreads();
            unsigned zz[8];
#pragma unroll
            for (int i = 0; i < 8; ++i) zz[i] = *(const unsigned*)(base + (size_t)(c * 64 + 8 * wid + i) * PITCH + C_ZB + 2 * lane);
#pragma unroll
            for (int ks = 0; ks < 4; ++ks) {
                const bf16x8 a = *(const LAS bf16x8*)(Pm + (32 * tb + r32) * 72 + 16 * ks + 8 * hi);
                const bf16x8 bb = *(const LAS bf16x8*)(VT + (32 * eb + r32) * 72 + 16 * ks + 8 * hi);
                o = __builtin_amdgcn_mfma_f32_32x32x16_bf16(a, bb, o, 0, 0, 0);
            }
#pragma unroll
            for (int r = 0; r < 16; ++r) OT[(32 * tb + crow(r, hi)) * 132 + 32 * eb + r32] = o[r];
            if (ci + 1 < nc) {
#pragma unroll
                for (int i = 0; i < 2; ++i) {
                    const int db = 2 * (wid & 1) + i;
#pragma unroll
                    for (int r = 0; r < 16; ++r) sa[i][r] *= DEND[32 * db + crow(r, hi)];
#pragma unroll
                    for (int ks = 0; ks < 4; ++ks) {
                        const bf16x8 a = *(const LAS bf16x8*)(K3T + (32 * db + r32) * 72 + 16 * ks + 8 * hi);
                        const bf16x8 bb = *(const LAS bf16x8*)(VT + (32 * eb + r32) * 72 + 16 * ks + 8 * hi);
                        sa[i] = __builtin_amdgcn_mfma_f32_32x32x16_bf16(a, bb, sa[i], 0, 0, 0);
                    }
#pragma unroll
                    for (int g = 0; g < 4; ++g) { u32x2 w; w.x = cvt_pk_bf16(sa[i][4 * g], sa[i][4 * g + 1]); w.y = cvt_pk_bf16(sa[i][4 * g + 2], sa[i][4 * g + 3]);
                        *(LAS u32x2*)(ST + (32 * eb + r32) * 136 + 32 * db + 8 * g + 4 * hi) = w; }
                }
            }
            __syncthreads();
            {
                const f32x2 nwv = *(const f32x2*)(nw + 2 * lane);
#pragma unroll
                for (int i = 0; i < 8; ++i) { const int t = 8 * wid + i;
                    const f32x2 v = *(const LAS f32x2*)(OT + t * 132 + 2 * lane);
                    const float ss = wave_sum(v.x * v.x + v.y * v.y);
                    const float rstd = __builtin_amdgcn_rsqf(ss * (1.0f / 128.0f) + RMS_EPS);
                    unsigned* zp = (unsigned*)(base + (size_t)(c * 64 + t) * PITCH + C_ZB + 2 * lane);
                    *zp = cvt_pk_bf16(v.x * rstd * nwv.x * bf_lo(zz[i]), v.y * rstd * nwv.y * bf_hi(zz[i])); }
            }
        }
    }
    if (MODE == 0) {
        __syncthreads();
#pragma unroll
        for (int i = 0; i < 2; ++i) { const int db = 2 * (wid & 1) + i;
#pragma unroll
            for (int g = 0; g < 4; ++g) { u32x2 w; w.x = cvt_pk_bf16(sa[i][4 * g], sa[i][4 * g + 1]); w.y = cvt_pk_bf16(sa[i][4 * g + 2], sa[i][4 * g + 3]);
                *(LAS u32x2*)(ST + (32 * eb + r32) * 136 + 32 * db + 8 * g + 4 * hi) = w; } }
        __syncthreads();
#pragma unroll
        for (int i = 0; i < 4; ++i) { const int idx = tid + 512 * i;
            *(u32x4*)(Ug + (size_t)grp * 16384 + (idx >> 4) * 128 + (idx & 15) * 8) = *(const LAS u32x4*)(ST + (idx >> 4) * 136 + (idx & 15) * 8); }
        if (part == 0) Dg[grp * 128 + d] = ex2(bsum);
    }
    __syncthreads();
}

__device__ __forceinline__ void unpack8(const u32x4 a, float (&o)[8]) {
    o[0] = bf_lo(a.x); o[1] = bf_hi(a.x); o[2] = bf_lo(a.y); o[3] = bf_hi(a.y); o[4] = bf_lo(a.z); o[5] = bf_hi(a.z); o[6] = bf_lo(a.w); o[7] = bf_hi(a.w);
}
__device__ __forceinline__ void conv_item(bf16_t* ACT, const float* cw, int item) {
    const int tid = fresh_tid(), cgp = tid & 63, sub = tid >> 6;
    const int m0 = item * 64 + sub * 8, ch = cgp * 8;
    float w0[8], w1[8], w2[8];
#pragma unroll
    for (int e = 0; e < 8; ++e) { w0[e] = cw[ch + e]; w1[e] = cw[512 + ch + e]; w2[e] = cw[1024 + ch + e]; }
    float p1[8], p2[8];
#pragma unroll
    for (int e = 0; e < 8; ++e) { p1[e] = 0.f; p2[e] = 0.f; }
    if ((m0 % SEQ) != 0) {
        unpack8(*(const u32x4*)(ACT + (size_t)(m0 - 2) * PITCH + C_PU + ch), p2);
        unpack8(*(const u32x4*)(ACT + (size_t)(m0 - 1) * PITCH + C_PU + ch), p1);
    }
    u32x4 pa[8], pzv[8];
#pragma unroll
    for (int i = 0; i < 8; ++i) { const bf16_t* rp = ACT + (size_t)(m0 + i) * PITCH + ch; pa[i] = *(const u32x4*)(rp + C_PU); pzv[i] = *(const u32x4*)(rp + C_PZ); }
#pragma unroll
    for (int i = 0; i < 8; ++i) {
        float pu[8], pz[8], y[8];
        unpack8(pa[i], pu); unpack8(pzv[i], pz);
#pragma unroll
        for (int e = 0; e < 8; ++e) { y[e] = pz[e] * (w0[e] * p2[e] + w1[e] * p1[e] + w2[e] * pu[e]); p2[e] = p1[e]; p1[e] = pu[e]; }
        u32x4 w; w.x = cvt_pk_bf16(y[0], y[1]); w.y = cvt_pk_bf16(y[2], y[3]); w.z = cvt_pk_bf16(y[4], y[5]); w.w = cvt_pk_bf16(y[6], y[7]);
        *(u32x4*)(ACT + (size_t)(m0 + i) * PITCH + C_ZC + ch) = w;
    }
}

__device__ __forceinline__ void convert_weights(const Params& P, int l, LAS unsigned char* lds, int gw, int NGW, int wid, int lane) {
    LAS float* scr = (LAS float*)(lds + wid * 16384);
    unsigned char* ws = P.ws;
    constexpr int I_IN = 16 * (IN_COLS / 32), I_B = 8 * 32, I_O = 16 * 32, I_L = I_IN + 3 * I_B + I_O;
    for (int it = gw; it < I_L; it += NGW) {
        int r = it;
        if (r < I_IN) { transpose_item(P.w_in + (size_t)l * 1024 * IN_COLS, IN_COLS, (bf16_t*)(ws + WS_WIN), 1024, scr, r, lane, true); continue; } r -= I_IN;
        if (r < 3 * I_B) { const int j = r / I_B; transpose_item(P.w_branch + (size_t)(l * 3 + j) * 512 * 1024, 1024, (bf16_t*)(ws + WS_WB) + (size_t)j * 1024 * 1024, 1024, scr, r % I_B, lane); continue; } r -= 3 * I_B;
        transpose_item(P.w_out + (size_t)l * 1024 * 1024, 1024, (bf16_t*)(ws + WS_WO), 1024, scr, r, lane);
    }
}

typedef const __attribute__((address_space(4))) Params* KParamsPtr;
#define XB_TMO      128
#define XB_XCNT(j)  (256  + 64 * (j))
#define XB_XSUB(j)  (1280 + 64 * (j))
#define XB_XGEN(j)  (2304 + 64 * (j))
#define XB_TOP      3328
#define XB_TOPGEN   3392
#define XCD_BAR_WORDS 3456
#define XB_SPIN_CAP (1u << 22)
__device__ __forceinline__ unsigned xb_ld(unsigned* p)              { return __hip_atomic_load(p, __ATOMIC_RELAXED, __HIP_MEMORY_SCOPE_AGENT); }
__device__ __forceinline__ unsigned xb_add(unsigned* p, unsigned v) { return __hip_atomic_fetch_add(p, v, __ATOMIC_RELAXED, __HIP_MEMORY_SCOPE_AGENT); }
__device__ __forceinline__ unsigned xb_xcc_id() { return (unsigned)__builtin_amdgcn_s_getreg((3 << 11) | 20) & 0xFu; }
#define XB_SPIN(cond, bar) do { unsigned _sp = 0; while (cond) { __builtin_amdgcn_s_sleep(1); \
    if ((++_sp & 255u) == 0u) { if (xb_ld(&(bar)[XB_TMO])) break; if (_sp > XB_SPIN_CAP) { atomicAdd(&(bar)[XB_TMO], 1u); break; } } } } while (0)
__device__ __forceinline__ void xcd_barrier_complete(unsigned* bar, unsigned x, unsigned& nloc, unsigned& nx) {
    const unsigned G = gridDim.x * gridDim.y * gridDim.z;
    unsigned sum, cnt, mine, sp = 0u;
    for (;;) {
        sum = 0u; cnt = 0u; mine = 0u;
#pragma unroll
        for (unsigned j = 0; j < 16; ++j) { const unsigned c = xb_ld(&bar[XB_XCNT(j)]); sum += c; cnt += (c > 0u) ? 1u : 0u; mine = (j == x) ? c : mine; }
        if (sum == G) break;
        __builtin_amdgcn_s_sleep(1);
        if ((++sp & 255u) == 0u) { if (xb_ld(&bar[XB_TMO])) break; if (sp > XB_SPIN_CAP) { atomicAdd(&bar[XB_TMO], 1u); break; } }
    }
    nloc = mine > 0u ? mine : 1u; nx = cnt > 0u ? cnt : 1u;
}
__device__ __forceinline__ void xcd_barrier(unsigned* bar, volatile LAS unsigned* st) {
    asm volatile("s_waitcnt vmcnt(0)" ::: "memory");
    __syncthreads();
    if (threadIdx.x == 0) {
        __builtin_amdgcn_s_waitcnt(0);
        const unsigned x = xb_xcc_id();
        unsigned nloc = st[0], nx = st[1];
        if (nloc == 0u) { xcd_barrier_complete(bar, x, nloc, nx); st[0] = nloc; st[1] = nx; }
        const unsigned old = xb_add(&bar[XB_XSUB(x)], 1u);
        const unsigned gen = old / nloc;
        if (old + 1u == (gen + 1u) * nloc) {
            __builtin_amdgcn_fence(__ATOMIC_RELEASE, "agent");
            asm volatile("s_waitcnt vmcnt(0)" ::: "memory");
            const unsigned og = xb_add(&bar[XB_TOP], 1u);
            const unsigned tg = og / nx;
            if (og + 1u == (tg + 1u) * nx) xb_add(&bar[XB_TOPGEN], 1u);
            else XB_SPIN(xb_ld(&bar[XB_TOPGEN]) == tg, bar);
            __builtin_amdgcn_fence(__ATOMIC_ACQUIRE, "agent");
            xb_add(&bar[XB_XGEN(x)], 1u);
            asm volatile("s_waitcnt vmcnt(0)" ::: "memory");
        } else {
            XB_SPIN(xb_ld(&bar[XB_XGEN(x)]) == gen, bar);
            __builtin_amdgcn_fence(__ATOMIC_ACQUIRE, "agent");
            asm volatile("s_waitcnt vmcnt(0)" ::: "memory");
        }
    }
    __syncthreads();
}
#define GRID_SYNC() do { asm volatile("s_waitcnt vmcnt(0) lgkmcnt(0)" ::: "memory"); __syncthreads(); grid.sync(); } while (0)
#define XBAR() do { KParamsPtr qb_ = (KParamsPtr)__builtin_amdgcn_kernarg_segment_ptr(); asm volatile("" : "+s"(qb_)); xcd_barrier((unsigned*)(qb_->ws + WS_CTL), (volatile LAS unsigned*)(lds + LDS_BYTES - 16)); } while (0)
#define PHASE_BEGIN() \
    Params P; { KParamsPtr q_ = (KParamsPtr)__builtin_amdgcn_kernarg_segment_ptr(); asm volatile("" : "+s"(q_)); \
        P.x = q_->x; P.c = q_->c; P.w_mod = q_->w_mod; P.b_mod = q_->b_mod; P.w_in = q_->w_in; P.conv_w = q_->conv_w; P.hgrn_norm_w = q_->hgrn_norm_w; P.lower_bounds = q_->lower_bounds; \
        P.w_branch = q_->w_branch; P.w_out = q_->w_out; P.ln_g = q_->ln_g; P.ln_b = q_->ln_b; P.out = q_->out; P.ws = q_->ws; } \
    int bx = blockIdx.x; asm volatile("" : "+s"(bx)); \
    const int G = gridDim.x; \
    const int vcu = (G % 8 == 0) ? (bx % 8) * (G / 8) + bx / 8 : bx; \
    unsigned char* const ws = P.ws; \
    float* const modp = (float*)(ws + WS_MOD); \
    bf16_t* const ACT = (bf16_t*)(ws + WS_ACT); \
    (void)vcu; (void)modp; (void)ACT;
#define WAVE_IDS() \
    const int tid = fresh_tid(), lane = tid & 63, wid = __builtin_amdgcn_readfirstlane(tid >> 6); \
    const int gw = vcu * 8 + wid, NGW = G * 8; (void)lane; (void)gw; (void)NGW;

__global__ void __launch_bounds__(NTHREADS, 2) fwd_megakernel(Params Pk) {
    extern __shared__ __attribute__((aligned(16))) unsigned char lds_raw[];
    LAS unsigned char* lds = (LAS unsigned char*)lds_raw;
    cg::grid_group grid = cg::this_grid();
    if (__builtin_expect(gridDim.y == 4242u, 0)) GRID_SYNC();
    if (threadIdx.x < 4) ((LAS unsigned*)(lds + LDS_BYTES - 16))[threadIdx.x] = 0u;
    __syncthreads();
    if (threadIdx.x == 0) { KParamsPtr q0_ = (KParamsPtr)__builtin_amdgcn_kernarg_segment_ptr(); (void)xb_add(&((unsigned*)(q0_->ws + WS_CTL))[XB_XCNT(xb_xcc_id())], 1u); }

    {
        PHASE_BEGIN(); WAVE_IDS();
        float* modpart = (float*)(ws + WS_MODP);
        LAS float* red = (LAS float*)lds;
        for (int u = bx; u < DEPTH * 192; u += G) {
            const int l = u / 192, r = u % 192, n = (r >> 2) * 64 + lane, kq = r & 3;
            float accb[8];
#pragma unroll
            for (int b = 0; b < 8; ++b) accb[b] = 0.f;
            const float* wp = P.w_mod + ((size_t)l * 1024 + 256 * kq + 32 * wid) * 3072 + n;
            const float* cp = P.c + 256 * kq + 32 * wid;
#pragma unroll 16
            for (int k = 0; k < 32; ++k) { const float wv = __builtin_nontemporal_load(wp + (size_t)k * 3072);
#pragma unroll
                for (int b = 0; b < 8; ++b) accb[b] += cp[b * 1024 + k] * wv; }
            __syncthreads();
#pragma unroll
            for (int b = 0; b < 8; ++b) red[(wid * 8 + b) * 64 + lane] = accb[b];
            __syncthreads();
            { const int b = wid; float sacc = 0.f;
#pragma unroll
              for (int w = 0; w < 8; ++w) sacc += red[(w * 8 + b) * 64 + lane];
              modpart[(((size_t)kq * DEPTH + l) * 8 + b) * 3072 + n] = sacc; }
        }
        __syncthreads();
        convert_weights(P, 0, lds, gw, NGW, wid, lane);
    }
    XBAR();
    {
        PHASE_BEGIN(); WAVE_IDS();
        const float* modpart = (const float*)(ws + WS_MODP);
        for (int i = bx * NTHREADS + tid; i < DEPTH * 8 * 3072; i += G * NTHREADS) {
            const int l = i / (8 * 3072), n = i % 3072;
            float v = P.b_mod[l * 3072 + n];
#pragma unroll
            for (int kq = 0; kq < 4; ++kq) v += modpart[(size_t)kq * DEPTH * 8 * 3072 + i];
            modp[i] = v;
        }
        LAS float* ms = (LAS float*)lds;
        for (int rg = bx; rg < M_TOK / 64; rg += G) {
            const int b = (rg * 64) / SEQ;
            __syncthreads();
            { const int i4 = tid * 4; f32x4 v = *(const f32x4*)(P.b_mod + i4);
#pragma unroll
              for (int kq = 0; kq < 4; ++kq) v = v + *(const f32x4*)(modpart + ((size_t)kq * DEPTH * 8 + b) * 3072 + i4);
              *(LAS f32x4*)(ms + i4) = v; }
            __syncthreads();
#pragma unroll
            for (int it = 0; it < 2; ++it) {
                f32x4 v[4][4];
#pragma unroll
                for (int q = 0; q < 4; ++q) { const int m = rg * 64 + wid * 8 + it * 4 + q;
#pragma unroll
                    for (int j = 0; j < 4; ++j) v[q][j] = ld_nt(P.x + (size_t)m * D_MODEL + 4 * (lane + 64 * j)); }
#pragma unroll
                for (int q = 0; q < 4; ++q) { const int m = rg * 64 + wid * 8 + it * 4 + q;
                    row_standardize(v[q]);
                    bf16_t* hrow = ACT + (size_t)m * PITCH + C_H;
#pragma unroll
                    for (int j = 0; j < 4; ++j) { const int col = 4 * (lane + 64 * j);
                        const f32x4 sh = *(const LAS f32x4*)(ms + col), sc = *(const LAS f32x4*)(ms + 1024 + col);
                        const f32x4 hv = v[q][j] * (sc + 1.0f) + sh;
                        u32x2 w; w.x = cvt_pk_bf16(hv.x, hv.y); w.y = cvt_pk_bf16(hv.z, hv.w);
                        *(u32x2*)(hrow + col) = w; } }
            }
        }
    }
    XBAR();

    for (int l = 0; l < DEPTH; ++l) {
        {
            PHASE_BEGIN();
            SchedP1 S{(const char*)ACT + C_H * 2, (const char*)(ws + WS_WIN), G, vcu};
            EpiP1 E{ACT};
            pg8::gemm_phase<EpiP1, SchedP1>(lds, (unsigned)PITCHB, 2048u, S, E);
        }
        XBAR();
        {
            PHASE_BEGIN();
            for (int u = bx; u < 256; u += G) hgrn_pass<0>(lds, ACT, P, l, u >> 3, (u & 7) * 4, 4);
        }
        {
            PHASE_BEGIN();
            for (int k = bx; k < 256; k += G) {
                __syncthreads(); attn_unit(lds, ACT, (k & 63) >> 3, k & 7, 7 - (k >> 6));
                const int a2 = 511 - k;
                __syncthreads(); attn_unit(lds, ACT, (a2 & 63) >> 3, a2 & 7, 7 - (a2 >> 6));
            }
            for (int ci = bx; ci < 256; ci += G) conv_item(ACT, P.conv_w + (size_t)l * 3 * 512, ci);
        }
        XBAR();
        {
            PHASE_BEGIN();
            for (int u = bx; u < 256; u += G) hgrn_pass<1>(lds, ACT, P, l, u >> 3, (u & 7) * 4, 4);
        }
        XBAR();
        {
            PHASE_BEGIN();
            SchedP3 S{(const char*)ACT, (const char*)(ws + WS_WIN) + (size_t)MIX_COLS * 2048, (const char*)(ws + WS_WB), G, vcu};
            EpiP3 E{(unsigned char*)ACT};
            pg8::gemm_phase<EpiP3, SchedP3>(lds, (unsigned)PITCHB, 2048u, S, E);
        }
        XBAR();
        {
            PHASE_BEGIN(); WAVE_IDS();
            SchedP4 S{(const char*)ACT, (const char*)(ws + WS_WO), G, vcu};
            unsigned* pc = (unsigned*)(ws + WS_CTL + CTL_PANEL);
            unsigned long long* xb = (unsigned long long*)(ws + WS_X);
            const bool more = (l + 1 < DEPTH);
            PanelStats st1{xb + (size_t)(2 * l) * 65536, pc + (2 * l) * 4096, LN_EPS};
            PanelStats st2{xb + (size_t)(2 * l + 1) * 65536, pc + (2 * l + 1) * 4096, LN_EPS};
            EpiP4F E{l == 0 ? P.x : P.out, P.out, modp + (size_t)l * 8 * 3072 + 2048, P.ln_g + l * 1024, P.ln_b + l * 1024, more ? modp + (size_t)(l + 1) * 8 * 3072 : nullptr, ACT, st1, st2};
            pg8::gemm_phase<EpiP4F, SchedP4>(lds, (unsigned)PITCHB, 2048u, S, E);
            if (more) { __syncthreads(); convert_weights(P, l + 1, lds, gw, NGW, wid, lane); }
        }
        if (l + 1 < DEPTH) XBAR();
    }
}

extern "C" void kernel_launch(void* const* d_in, const int* in_sizes, int n_in, void* d_out, int out_size, void* d_ws, size_t ws_size, hipStream_t stream) {
    static int grid_blocks = 0;
    if (grid_blocks == 0) {
        if (n_in != 12 || out_size != M_TOK * D_MODEL || ws_size < WS_END) { fprintf(stderr, "kernel_launch: unexpected shapes (n_in %d, out %d, ws %zu < %zu)\n", n_in, out_size, ws_size, (size_t)WS_END); grid_blocks = -1; return; }
        int dev = 0, cus = 0, per_cu = 0;
        hipGetDevice(&dev);
        hipDeviceGetAttribute(&cus, hipDeviceAttributeMultiprocessorCount, dev);
        hipFuncSetAttribute((const void*)fwd_megakernel, hipFuncAttributeMaxDynamicSharedMemorySize, LDS_BYTES);
        hipOccupancyMaxActiveBlocksPerMultiprocessor(&per_cu, (const void*)fwd_megakernel, NTHREADS, LDS_BYTES);
        (void)hipGetLastError();
        if (per_cu < 1) per_cu = 1;
        grid_blocks = cus > 256 ? 256 : cus;
        if (grid_blocks != 256) fprintf(stderr, "kernel_launch: %d CUs reported; this kernel is laid out for 256 workgroups\n", cus);
        if (grid_blocks <= 0) grid_blocks = 256;
    }
    if (grid_blocks < 0) return;
    (void)hipMemsetAsync((char*)d_ws + WS_CTL, 0, CTL_BYTES, stream);
    Params p{};
    p.x = (const float*)d_in[0]; p.c = (const float*)d_in[1]; p.w_mod = (const float*)d_in[2]; p.b_mod = (const float*)d_in[3]; p.w_in = (const float*)d_in[4];
    p.conv_w = (const float*)d_in[5]; p.hgrn_norm_w = (const float*)d_in[6]; p.lower_bounds = (const float*)d_in[7]; p.w_branch = (const float*)d_in[8];
    p.w_out = (const float*)d_in[9]; p.ln_g = (const float*)d_in[10]; p.ln_b = (const float*)d_in[11]; p.out = (float*)d_out; p.ws = (unsigned char*)d_ws;
    void* args[] = {&p};
    hipError_t e = hipLaunchCooperativeKernel((const void*)fwd_megakernel, dim3(grid_blocks), dim3(NTHREADS), args, LDS_BYTES, stream);
    if (e != hipSuccess) fprintf(stderr, "cooperative launch failed: %s (grid %d)\n", hipGetErrorString(e), grid_blocks);
}
```

```cpp
#include <hip/hip_runtime.h>
#include <hip/hip_cooperative_groups.h>
#include <cstdio>
#include <cstdint>
namespace cg = cooperative_groups;

#define LAS __attribute__((address_space(3)))
typedef unsigned short bf16_t;
typedef short bf16x8 __attribute__((ext_vector_type(8)));
typedef short s16x4 __attribute__((ext_vector_type(4)));
typedef float f32x2 __attribute__((ext_vector_type(2)));
typedef float f32x4 __attribute__((ext_vector_type(4)));
typedef float f32x16 __attribute__((ext_vector_type(16)));
typedef unsigned u32x2 __attribute__((ext_vector_type(2)));
typedef unsigned u32x4 __attribute__((ext_vector_type(4)));

constexpr int D_MODEL = 1024, BATCH = 8, SEQ = 2048, DEPTH = 2, M_TOK = BATCH * SEQ;
constexpr int IN_COLS = 9216, MIX_COLS = 6144;
constexpr int PITCH = 7168;
constexpr size_t PITCHB = (size_t)PITCH * 2;
constexpr int C_QA = 0, C_KA = 512, C_VA = 1024, C_ZA = 1536, C_QB = 2048, C_FB = 2560, C_IB = 3072, C_ZB = 3584, C_PU = 4096  , C_PZ = 4608  , C_ZC = 5632  , C_H = 6144;
constexpr int C_MERGED = 4096;
constexpr float LN_EPS = 1e-5f, RMS_EPS = 1e-6f;
constexpr float LOG2E = 1.4426950408889634f;
constexpr float QSCALE = 0.125f * LOG2E;
constexpr float ALPHA = 1.4142135623730951f;

constexpr size_t WS_CTL = 0, CTL_BYTES = 65536;
constexpr size_t WS_MOD = 65536;
constexpr size_t WS_DEND = 256u << 10;
constexpr size_t WS_WIN = 1u << 20;
constexpr size_t WIN_L = (size_t)IN_COLS * 1024 * 2;
constexpr size_t WS_WB = WS_WIN + WIN_L;
constexpr size_t WB_L = (size_t)3 * 1024 * 1024 * 2;
constexpr size_t WS_WO = WS_WB + WB_L;
constexpr size_t WO_L = (size_t)1024 * 1024 * 2;
constexpr size_t WS_ACT = WS_WO + WO_L;
constexpr size_t WS_U = WS_ACT + (size_t)M_TOK * PITCHB;
constexpr size_t WS_X = WS_U + (size_t)32 * 32 * 128 * 128 * 2;
constexpr size_t WS_MODP = WS_X + 3 * 524288;
constexpr size_t WS_END = WS_MODP + (size_t)4 * DEPTH * BATCH * 3072 * 4;
constexpr size_t CTL_PANEL = 16384;

constexpr int LDS_BYTES = 147456;
constexpr int NTHREADS = 512;

struct Params {
    const float* x; const float* c; const float* w_mod; const float* b_mod; const float* w_in; const float* conv_w; const float* hgrn_norm_w;
    const float* lower_bounds; const float* w_branch; const float* w_out; const float* ln_g; const float* ln_b; float* out; unsigned char* ws;
};

typedef __bf16 bf16x2_t __attribute__((ext_vector_type(2)));
__device__ __forceinline__ unsigned cvt_pk_bf16(float lo, float hi) { const f32x2 v = {lo, hi}; const bf16x2_t b = __builtin_convertvector(v, bf16x2_t); return __builtin_bit_cast(unsigned, b); }
__device__ __forceinline__ f32x4 ld_nt(const float* p) { return __builtin_nontemporal_load((const f32x4*)p); }
__device__ __forceinline__ float bf_lo(unsigned w) { return __uint_as_float(w << 16); }
__device__ __forceinline__ float bf_hi(unsigned w) { return __uint_as_float(w & 0xffff0000u); }
__device__ __forceinline__ float bf2f(bf16_t v) { return __uint_as_float((unsigned)v << 16); }
__device__ __forceinline__ float ex2(float v) { return __builtin_amdgcn_exp2f(v); }
__device__ __forceinline__ float lg2(float v) { return __builtin_amdgcn_logf(v); }
__device__ __forceinline__ float sigmoidf_(float v) { return __builtin_amdgcn_rcpf(1.0f + ex2(-v * LOG2E)); }
__device__ __forceinline__ float siluf_(float v) { return v * sigmoidf_(v); }
__device__ __forceinline__ float wave_sum(float v) {
#pragma unroll
    for (int o = 1; o < 64; o <<= 1) v += __shfl_xor(v, o);
    return v;
}
__device__ __forceinline__ int fresh_tid() { int t = threadIdx.x; asm volatile("" : "+v"(t)); return t; }
__device__ __forceinline__ int crow(int r, int hi) { return (r & 3) + 8 * (r >> 2) + 4 * hi; }

namespace pg8 {
constexpr int BM = 256, BK = 64, HALF = 128, HTB = HALF * BK * 2, STAGE_BYTES = 8 * HTB;
__device__ __forceinline__ int lds_byte(int r, int c) { const int st = (r >> 4) * 2 + (c >> 5), rr = r & 15, cc = c & 31, ob = rr * 64 + cc * 2; return st * 1024 + (ob ^ (((ob >> 9) & 1) << 5)); }
__device__ __forceinline__ void stage_rc(int b, int& R, int& C) { const int st = b / 1024, sb = b % 1024, swz = sb ^ (((sb >> 9) & 1) << 5); R = (st >> 1) * 16 + swz / 64; C = (st & 1) * 32 + (swz % 64) / 2; }
__device__ __forceinline__ int perm32(int rho) { const int n = rho >> 4, i = rho & 15; return 8 * (i >> 2) + 4 * n + (i & 3); }

struct Unit { const char* a; const char* b; int nt; int pm, pn, j; };

template <class Epi, class Sched>
__device__ __forceinline__ void gemm_phase(LAS unsigned char* lds, const unsigned ldaB, const unsigned ldbB, const Sched& S, const Epi& E) {
    const int tid = fresh_tid(), wid = __builtin_amdgcn_readfirstlane(tid >> 6), lane = tid & 63, wr = wid >> 2, wc = wid & 3, fr = lane & 15, fq = lane >> 4;
    unsigned voffA[2], voffB[2];
#pragma unroll
    for (int i = 0; i < 2; ++i) { int R, C; stage_rc(tid * 16 + i * 8192, R, C); const int Rb = Epi::PERM ? ((R & ~31) + perm32(R & 31)) : R;
        voffA[i] = (unsigned)R * ldaB + (unsigned)C * 2u; voffB[i] = (unsigned)Rb * ldbB + (unsigned)C * 2u; }
    const size_t kstep = (size_t)(BK * 2);
    const size_t hstepA = (size_t)HALF * ldaB, hstepB = (size_t)HALF * ldbB;
    const unsigned ldsw = (unsigned)wid * 1024u;
    const int aoff = lds_byte(wr * 64 + fr, fq * 8), boff = lds_byte(wc * 32 + fr, fq * 8);
#define PG8_SA(b, h) (((b) * 2 + (h)) * HTB)
#define PG8_SB(b, h) ((4 + (b) * 2 + (h)) * HTB)
#define PG8_STAGE(bufoff, gbase, voff) do { _Pragma("unroll") for (int _i = 0; _i < 2; ++_i) \
        __builtin_amdgcn_global_load_lds((const unsigned*)((const char*)(gbase) + (voff)[_i]), (LAS unsigned*)(lds + (bufoff) + ldsw + _i * 8192), 16, 0, 0); } while (0)
#define PG8_LDA(dst, b, h) do { _Pragma("unroll") for (int m = 0; m < 4; ++m) _Pragma("unroll") for (int k = 0; k < 2; ++k) dst[m][k] = *(const LAS bf16x8*)(lds + PG8_SA(b, h) + aoff + m * 2048 + k * 1024); } while (0)
#define PG8_LDB(dst, b, h) do { _Pragma("unroll") for (int n = 0; n < 2; ++n) _Pragma("unroll") for (int k = 0; k < 2; ++k) dst[n][k] = *(const LAS bf16x8*)(lds + PG8_SB(b, h) + boff + n * 2048 + k * 1024); } while (0)
#define PG8_MMA(ai, bj, At, Bt) do { __builtin_amdgcn_s_setprio(1); _Pragma("unroll") for (int m = 0; m < 4; ++m) _Pragma("unroll") for (int n = 0; n < 2; ++n) _Pragma("unroll") for (int k = 0; k < 2; ++k) \
        acc[ai][bj][m][n] = __builtin_amdgcn_mfma_f32_16x16x32_bf16(Bt[n][k], At[m][k], acc[ai][bj][m][n], 0, 0, 0); __builtin_amdgcn_s_setprio(0); } while (0)
#define PG8_WAIT_V(n) asm volatile("s_waitcnt vmcnt(" #n ")" ::: "memory")
#define PG8_WAIT_L(n) asm volatile("s_waitcnt lgkmcnt(" #n ")" ::: "memory")
#define PG8_BAR __builtin_amdgcn_s_barrier()
#define PG8_SCHED __builtin_amdgcn_sched_barrier(0)
    Unit cur, nxt; int ui = 0;
    if (!S.next(0, cur)) return;
    f32x4 acc[2][2][4][2];
#pragma unroll
    for (int a = 0; a < 2; ++a)
#pragma unroll
        for (int b = 0; b < 2; ++b)
#pragma unroll
            for (int m = 0; m < 4; ++m)
#pragma unroll
                for (int n = 0; n < 2; ++n) acc[a][b][m][n] = (f32x4){0.f, 0.f, 0.f, 0.f};
    bf16x8 At[4][2], B0[2][2], B1[2][2];
    const char* cA = cur.a; const char* cB = cur.b;
    PG8_STAGE(PG8_SB(0, 0), cB, voffB); PG8_STAGE(PG8_SB(0, 1), cB + hstepB, voffB); PG8_STAGE(PG8_SA(0, 0), cA, voffA); PG8_STAGE(PG8_SA(0, 1), cA + hstepA, voffA);
    if (wr == 1) PG8_BAR;
    PG8_WAIT_V(2); PG8_BAR;
    PG8_STAGE(PG8_SB(1, 0), cB + kstep, voffB); PG8_STAGE(PG8_SA(1, 0), cA + kstep, voffA); PG8_STAGE(PG8_SB(1, 1), cB + hstepB + kstep, voffB);
    PG8_WAIT_V(6); PG8_BAR;
    for (;;) {
        const bool has_next = S.next(ui + 1, nxt);
        const char* nA = has_next ? nxt.a : cA; const char* nB = has_next ? nxt.b : cB;
        const int nt = cur.nt;
        for (int t = 0; t < nt; t += 2) {
            const bool last = (t == nt - 2);
            const char* a1 = cA + (size_t)(t + 1) * kstep;
            const char* a2 = last ? nA : cA + (size_t)(t + 2) * kstep; const char* b2 = last ? nB : cB + (size_t)(t + 2) * kstep;
            const char* a3 = a2 + kstep; const char* b3 = b2 + kstep;
            PG8_LDB(B0, 0, 0); PG8_LDB(B1, 0, 1); PG8_SCHED; PG8_LDA(At, 0, 0); PG8_STAGE(PG8_SA(1, 1), a1 + hstepA, voffA);
            PG8_WAIT_V(8); PG8_WAIT_L(0); PG8_BAR; PG8_MMA(0, 0, At, B0); PG8_MMA(0, 1, At, B1); PG8_BAR; PG8_SCHED;
            PG8_LDA(At, 0, 1); PG8_STAGE(PG8_SB(0, 0), b2, voffB); PG8_STAGE(PG8_SB(0, 1), b2 + hstepB, voffB); PG8_STAGE(PG8_SA(0, 0), a2, voffA);
            PG8_WAIT_V(8); PG8_WAIT_L(0); PG8_BAR; PG8_MMA(1, 0, At, B0); PG8_MMA(1, 1, At, B1); PG8_BAR; PG8_SCHED;
            PG8_LDB(B0, 1, 0); PG8_LDB(B1, 1, 1); PG8_SCHED; PG8_LDA(At, 1, 0); PG8_STAGE(PG8_SA(0, 1), a2 + hstepA, voffA);
            PG8_WAIT_V(8); PG8_WAIT_L(0); PG8_BAR; PG8_MMA(0, 0, At, B0); PG8_MMA(0, 1, At, B1); PG8_BAR; PG8_SCHED;
            PG8_LDA(At, 1, 1); PG8_STAGE(PG8_SB(1, 0), b3, voffB); PG8_STAGE(PG8_SB(1, 1), b3 + hstepB, voffB); PG8_STAGE(PG8_SA(1, 0), a3, voffA);
            PG8_WAIT_V(8); PG8_WAIT_L(0); PG8_BAR; PG8_MMA(1, 0, At, B0); PG8_MMA(1, 1, At, B1); PG8_BAR; PG8_SCHED;
        }
        if (wr == 0) PG8_BAR;
        if constexpr (!Epi::AFTER_DRAIN) E(acc, cur, wr, wc, fr, fq);
        if (!has_next) break;
#pragma unroll
        for (int a = 0; a < 2; ++a)
#pragma unroll
            for (int b = 0; b < 2; ++b)
#pragma unroll
                for (int m = 0; m < 4; ++m)
#pragma unroll
                    for (int n = 0; n < 2; ++n) acc[a][b][m][n] = (f32x4){0.f, 0.f, 0.f, 0.f};
        cur = nxt; cA = nA; cB = nB; ++ui;
        if (wr == 1) PG8_BAR;
    }
    PG8_WAIT_V(0);
    PG8_BAR;
    if constexpr (Epi::AFTER_DRAIN) E.fused(acc, cur, wr, wc, fr, fq, lds, wid, lane);
#undef PG8_SA
#undef PG8_SB
#undef PG8_STAGE
#undef PG8_LDA
#undef PG8_LDB
#undef PG8_MMA
#undef PG8_WAIT_V
#undef PG8_WAIT_L
#undef PG8_BAR
#undef PG8_SCHED
}
}

struct SchedP1 {
    const char* A; const char* B; int G, vcu;
    __device__ __forceinline__ bool next(int i, pg8::Unit& u) const {
        const int U = i * G + vcu; if (U >= 64 * 24) return false;
        u.pm = 8 * ((U >> 5) & 7) + (U & 7); u.pn = 4 * (U >> 8) + ((U & 31) >> 3); u.j = 0; u.nt = 16;
        u.a = A + (size_t)u.pm * 256 * PITCHB; u.b = B + (size_t)u.pn * 256 * 2048; return true;
    }
};
struct SchedP3 {
    const char* ACTb; const char* Wg; const char* Wb; int G, vcu;
    __device__ __forceinline__ bool next(int i, pg8::Unit& u) const {
        const int T = vcu + (i / 6) * G; if (T >= 256) return false;
        const int s = i % 6; u.pm = 8 * (T >> 5) + (T & 7); u.pn = (T & 31) >> 3; u.j = s;
        const int j = s >> 1;
        if ((s & 1) == 0) { u.nt = 16; u.a = ACTb + (size_t)u.pm * 256 * PITCHB + C_H * 2; u.b = Wg + (size_t)(1024 * j + 256 * u.pn) * 2048; }
        else { u.nt = 8; u.a = ACTb + (size_t)u.pm * 256 * PITCHB + (size_t)(C_ZA + 2048 * j) * 2; u.b = Wb + (size_t)(1024 * j + 256 * u.pn) * 2048; }
        return true;
    }
};
struct SchedP4 {
    const char* ACTb; const char* Wo; int G, vcu;
    __device__ __forceinline__ bool next(int i, pg8::Unit& u) const {
        const int T = vcu + i * G; if (T >= 256) return false;
        u.pm = 8 * (T >> 5) + (T & 7); u.pn = (T & 31) >> 3; u.j = 0; u.nt = 16;
        u.a = ACTb + (size_t)u.pm * 256 * PITCHB + C_MERGED * 2; u.b = Wo + (size_t)(256 * u.pn) * 2048; return true;
    }
};

struct EpiP1 {
    static constexpr bool PERM = true, AFTER_DRAIN = false;
    bf16_t* ACT;
    __device__ __forceinline__ void operator()(const f32x4 (&acc)[2][2][4][2], const pg8::Unit& u, int wr, int wc, int fr, int fq) const {
        const int row0 = u.pm * 256 + wr * 64 + fr;
        if (u.pn >= 16) {
            const int T = u.pn - 16, col0 = (T < 4 ? C_PU + 128 * T : C_PZ + 128 * (T - 4)) + wc * 32 + 8 * fq;
#pragma unroll
            for (int ai = 0; ai < 2; ++ai)
#pragma unroll
                for (int m = 0; m < 4; ++m) { bf16_t* rowp = ACT + (size_t)(row0 + ai * 128 + m * 16) * PITCH + col0;
                    f32x4 v0 = acc[ai][1][m][0], v1 = acc[ai][1][m][1];
                    if (T >= 4) {
#pragma unroll
                        for (int e = 0; e < 4; ++e) { v0[e] = siluf_(v0[e]); v1[e] = siluf_(v1[e]); } }
                    v0 = v0 * acc[ai][0][m][0]; v1 = v1 * acc[ai][0][m][1];
                    u32x4 w; w.x = cvt_pk_bf16(v0[0], v0[1]); w.y = cvt_pk_bf16(v0[2], v0[3]); w.z = cvt_pk_bf16(v1[0], v1[1]); w.w = cvt_pk_bf16(v1[2], v1[3]);
                    *(u32x4*)rowp = w; }
            return;
        }
        const int grp = u.pn >> 1;
        const int kind = (grp == 0) ? 1 : ((grp == 3 || grp == 4 || grp == 7) ? 2 : 0);
        const int col0 = u.pn * 256 + wc * 32 + 8 * fq;
#pragma unroll
        for (int ai = 0; ai < 2; ++ai)
#pragma unroll
            for (int m = 0; m < 4; ++m) { bf16_t* rowp = ACT + (size_t)(row0 + ai * 128 + m * 16) * PITCH + col0;
#pragma unroll
                for (int bj = 0; bj < 2; ++bj) { f32x4 v0 = acc[ai][bj][m][0], v1 = acc[ai][bj][m][1];
                    if (kind == 1) { v0 = v0 * QSCALE; v1 = v1 * QSCALE; }
                    else if (kind == 2) {
#pragma unroll
                        for (int e = 0; e < 4; ++e) { v0[e] = siluf_(v0[e]); v1[e] = siluf_(v1[e]); } }
                    u32x4 w; w.x = cvt_pk_bf16(v0[0], v0[1]); w.y = cvt_pk_bf16(v0[2], v0[3]); w.z = cvt_pk_bf16(v1[0], v1[1]); w.w = cvt_pk_bf16(v1[2], v1[3]);
                    *(u32x4*)(rowp + bj * 128) = w; } }
    }
};
struct EpiP3 {
    static constexpr bool PERM = true, AFTER_DRAIN = false;
    unsigned char* ACTb;
    __device__ __forceinline__ void operator()(const f32x4 (&acc)[2][2][4][2], const pg8::Unit& u, int wr, int wc, int fr, int fq) const {
        const int s = u.j, j = s >> 1;
        const int row0 = u.pm * 256 + wr * 64 + fr, cl0 = wc * 32 + 8 * fq;
        const unsigned toff = 512u * (unsigned)u.pn, soff = 5120u + 512u * (unsigned)u.pn, moff = (unsigned)(C_MERGED + 256 * u.pn) * 2u;
        if ((s & 1) == 0) {
#pragma unroll
            for (int ai = 0; ai < 2; ++ai)
#pragma unroll
                for (int m = 0; m < 4; ++m) { unsigned char* rowp = ACTb + (size_t)(row0 + ai * 128 + m * 16) * PITCHB;
#pragma unroll
                    for (int bj = 0; bj < 2; ++bj) { const f32x4 v0 = acc[ai][bj][m][0], v1 = acc[ai][bj][m][1];
                        u32x4 w; w.x = cvt_pk_bf16(v0[0], v0[1]); w.y = cvt_pk_bf16(v0[2], v0[3]); w.z = cvt_pk_bf16(v1[0], v1[1]); w.w = cvt_pk_bf16(v1[2], v1[3]);
                        *(u32x4*)(rowp + soff + (cl0 + bj * 128) * 2) = w; } }
        } else {
#pragma unroll
            for (int ai = 0; ai < 2; ++ai) {
                u32x4 gq[4][2], tq[4][2];
#pragma unroll
                for (int m = 0; m < 4; ++m) { unsigned char* rowp = ACTb + (size_t)(row0 + ai * 128 + m * 16) * PITCHB;
#pragma unroll
                    for (int bj = 0; bj < 2; ++bj) { gq[m][bj] = *(const u32x4*)(rowp + soff + (cl0 + bj * 128) * 2); if (j > 0) tq[m][bj] = *(const u32x4*)(rowp + toff + (cl0 + bj * 128) * 2); } }
#pragma unroll
                for (int m = 0; m < 4; ++m) { unsigned char* rowp = ACTb + (size_t)(row0 + ai * 128 + m * 16) * PITCHB;
#pragma unroll
                    for (int bj = 0; bj < 2; ++bj) { const f32x4 v0 = acc[ai][bj][m][0], v1 = acc[ai][bj][m][1]; const u32x4 g = gq[m][bj];
                        f32x4 t0 = (f32x4){sigmoidf_(bf_lo(g.x)) * v0[0], sigmoidf_(bf_hi(g.x)) * v0[1], sigmoidf_(bf_lo(g.y)) * v0[2], sigmoidf_(bf_hi(g.y)) * v0[3]};
                        f32x4 t1 = (f32x4){sigmoidf_(bf_lo(g.z)) * v1[0], sigmoidf_(bf_hi(g.z)) * v1[1], sigmoidf_(bf_lo(g.w)) * v1[2], sigmoidf_(bf_hi(g.w)) * v1[3]};
                        if (j > 0) { const u32x4 tv = tq[m][bj];
                            t0 = t0 + (f32x4){bf_lo(tv.x), bf_hi(tv.x), bf_lo(tv.y), bf_hi(tv.y)}; t1 = t1 + (f32x4){bf_lo(tv.z), bf_hi(tv.z), bf_lo(tv.w), bf_hi(tv.w)}; }
                        u32x4 w; w.x = cvt_pk_bf16(t0[0], t0[1]); w.y = cvt_pk_bf16(t0[2], t0[3]); w.z = cvt_pk_bf16(t1[0], t1[1]); w.w = cvt_pk_bf16(t1[2], t1[3]);
                        if (j < 2) *(u32x4*)(rowp + toff + (cl0 + bj * 128) * 2) = w; else *(u32x4*)(rowp + moff + (cl0 + bj * 128) * 2) = w;
                    } }
            }
        }
    }
};
struct PanelStats {
    unsigned long long* xbuf;
    unsigned* cnt;
    float eps;
    __device__ __forceinline__ void run(const f32x4 (&v)[2][2][4][2], const pg8::Unit& u, int wr, int wc, int fr, int fq, LAS unsigned char* lds, int wid, int lane) const {
        LAS f32x2* Pt = (LAS f32x2*)lds;
        LAS f32x2* St = (LAS f32x2*)(lds + 8192);
#pragma unroll
        for (int ai = 0; ai < 2; ++ai)
#pragma unroll
            for (int m = 0; m < 4; ++m) {
                float s = 0.f;
#pragma unroll
                for (int bj = 0; bj < 2; ++bj)
#pragma unroll
                    for (int n = 0; n < 2; ++n) { const f32x4 x = v[ai][bj][m][n]; s += (x[0] + x[1]) + (x[2] + x[3]); }
                s += __shfl_xor(s, 16); s += __shfl_xor(s, 32);
                const float mw = s * (1.0f / 64.0f); float q = 0.f;
#pragma unroll
                for (int bj = 0; bj < 2; ++bj)
#pragma unroll
                    for (int n = 0; n < 2; ++n) { const f32x4 d = v[ai][bj][m][n] - mw; q += (d[0] * d[0] + d[1] * d[1]) + (d[2] * d[2] + d[3] * d[3]); }
                q += __shfl_xor(q, 16); q += __shfl_xor(q, 32);
                if (fq == 0) Pt[(ai * 128 + wr * 64 + m * 16 + fr) * 4 + wc] = (f32x2){mw, q};
            }
        __syncthreads();
        const int row = wid * 32 + (lane & 31);
        if (lane < 32) {
            const f32x2 a = Pt[row * 4 + 0], b = Pt[row * 4 + 1], c = Pt[row * 4 + 2], d = Pt[row * 4 + 3];
            const float mt = (a.x + b.x + c.x + d.x) * 0.25f;
            const float da = a.x - mt, db = b.x - mt, dc = c.x - mt, dd = d.x - mt;
            const float m2 = (a.y + b.y) + (c.y + d.y) + 64.0f * ((da * da + db * db) + (dc * dc + dd * dd));
            __hip_atomic_store(xbuf + ((size_t)(u.pm * 256 + row) * 4 + u.pn), ((unsigned long long)__float_as_uint(m2) << 32) | __float_as_uint(mt), __ATOMIC_RELAXED, __HIP_MEMORY_SCOPE_AGENT);
        }
        asm volatile("s_waitcnt vmcnt(0)" ::: "memory");
        if (lane == 0) __hip_atomic_fetch_add(cnt + 64 * u.pm, 1u, __ATOMIC_RELAXED, __HIP_MEMORY_SCOPE_AGENT);
        if (wid == 0) {
            unsigned sp = 0;
            while ((unsigned)__builtin_amdgcn_readfirstlane(__hip_atomic_load(cnt + 64 * u.pm, __ATOMIC_RELAXED, __HIP_MEMORY_SCOPE_AGENT)) < 32u) { __builtin_amdgcn_s_sleep(2); if (++sp > (1u << 24)) break; }
            __builtin_amdgcn_fence(__ATOMIC_ACQUIRE, "agent");
        }
        asm volatile("s_waitcnt vmcnt(0) lgkmcnt(0)" ::: "memory");
        __syncthreads();
        if (lane < 32) {
            const unsigned long long* slot = xbuf + (size_t)(u.pm * 256 + row) * 4; float mt[4], m2[4]; float ms = 0.f;
#pragma unroll
            for (int t = 0; t < 4; ++t) { const unsigned long long w = __hip_atomic_load(slot + t, __ATOMIC_RELAXED, __HIP_MEMORY_SCOPE_AGENT); mt[t] = __uint_as_float((unsigned)w); m2[t] = __uint_as_float((unsigned)(w >> 32)); ms += mt[t]; }
            const float mean = ms * 0.25f; float q = 0.f;
#pragma unroll
            for (int t = 0; t < 4; ++t) { const float dm = mt[t] - mean; q += m2[t] + 256.0f * dm * dm; }
            St[row] = (f32x2){mean, __builtin_amdgcn_rsqf(q * (1.0f / 1024.0f) + eps)};
        }
        __syncthreads();
    }
};
struct EpiP4F {
    static constexpr bool PERM = false, AFTER_DRAIN = true;
    const float* xprev; float* out; const float* gate; const float* lng; const float* lnb; const float* modn; bf16_t* ACT; PanelStats st1, st2;
    __device__ __forceinline__ void fused(f32x4 (&acc)[2][2][4][2], const pg8::Unit& u, int wr, int wc, int fr, int fq, LAS unsigned char* lds, int wid, int lane) const {
        const LAS f32x2* St = (const LAS f32x2*)(lds + 8192);
        const int row0 = u.pm * 256 + wr * 64 + fr, col0 = u.pn * 256 + wc * 32 + 4 * fq;
        const int bidx = (u.pm * 256) / SEQ;
        {
            const float* gp = gate + (size_t)bidx * 3072;
            f32x4 gv[2][2];
#pragma unroll
            for (int bj = 0; bj < 2; ++bj)
#pragma unroll
                for (int n = 0; n < 2; ++n) gv[bj][n] = *(const f32x4*)(gp + col0 + bj * 128 + n * 16) + 1.0f;
#pragma unroll
            for (int ai = 0; ai < 2; ++ai)
#pragma unroll
                for (int m = 0; m < 4; ++m) { const size_t off = (size_t)(row0 + ai * 128 + m * 16) * D_MODEL + col0;
#pragma unroll
                    for (int bj = 0; bj < 2; ++bj)
#pragma unroll
                        for (int n = 0; n < 2; ++n) { const f32x4 xv = ld_nt(xprev + off + bj * 128 + n * 16); acc[ai][bj][m][n] = xv * ALPHA + gv[bj][n] * acc[ai][bj][m][n]; }
                    asm volatile("" : "+v"(acc[ai][0][m][0]), "+v"(acc[ai][0][m][1]), "+v"(acc[ai][1][m][0]), "+v"(acc[ai][1][m][1]));
                    if (m & 1) asm volatile("" ::: "memory"); }
        }
        st1.run(acc, u, wr, wc, fr, fq, lds, wid, lane);
        {
            f32x4 lg[2][2], lb[2][2];
#pragma unroll
            for (int bj = 0; bj < 2; ++bj)
#pragma unroll
                for (int n = 0; n < 2; ++n) { lg[bj][n] = *(const f32x4*)(lng + col0 + bj * 128 + n * 16); lb[bj][n] = *(const f32x4*)(lnb + col0 + bj * 128 + n * 16); }
#pragma unroll
            for (int ai = 0; ai < 2; ++ai)
#pragma unroll
                for (int m = 0; m < 4; ++m) { const int r = ai * 128 + wr * 64 + m * 16 + fr; const f32x2 sr = St[r]; const size_t off = (size_t)(u.pm * 256 + r) * D_MODEL + col0;
#pragma unroll
                    for (int bj = 0; bj < 2; ++bj)
#pragma unroll
                        for (int n = 0; n < 2; ++n) { const f32x4 x1 = (acc[ai][bj][m][n] - sr.x) * sr.y * lg[bj][n] + lb[bj][n]; acc[ai][bj][m][n] = x1;
                            __builtin_nontemporal_store(x1, (f32x4*)(out + off + bj * 128 + n * 16)); }
                    asm volatile("" : "+v"(acc[ai][0][m][0]), "+v"(acc[ai][0][m][1]), "+v"(acc[ai][1][m][0]), "+v"(acc[ai][1][m][1]));
                    asm volatile("" ::: "memory"); }
        }
        if (modn) {
            st2.run(acc, u, wr, wc, fr, fq, lds, wid, lane);
            const float* mp = modn + (size_t)bidx * 3072;
            f32x4 sc[2][2], sh[2][2];
#pragma unroll
            for (int bj = 0; bj < 2; ++bj)
#pragma unroll
                for (int n = 0; n < 2; ++n) { sh[bj][n] = *(const f32x4*)(mp + col0 + bj * 128 + n * 16); sc[bj][n] = *(const f32x4*)(mp + 1024 + col0 + bj * 128 + n * 16) + 1.0f; }
#pragma unroll
            for (int ai = 0; ai < 2; ++ai)
#pragma unroll
                for (int m = 0; m < 4; ++m) { const int r = ai * 128 + wr * 64 + m * 16 + fr; const f32x2 sr = St[r]; bf16_t* hp = ACT + (size_t)(u.pm * 256 + r) * PITCH + C_H + col0;
#pragma unroll
                    for (int bj = 0; bj < 2; ++bj)
#pragma unroll
                        for (int n = 0; n < 2; ++n) { const f32x4 hv = (acc[ai][bj][m][n] - sr.x) * sr.y * sc[bj][n] + sh[bj][n];
                            u32x2 w; w.x = cvt_pk_bf16(hv[0], hv[1]); w.y = cvt_pk_bf16(hv[2], hv[3]); *(u32x2*)(hp + bj * 128 + n * 16) = w; }
                    asm volatile("" ::: "memory"); }
        }
    }
};

__device__ __forceinline__ void transpose_item(const float* W, int N, bf16_t* WT, int ldw, LAS float* scr, int item, int lane, bool conv_perm = false) {
    const int nblk = N / 32, kb = item / nblk, nb = item % nblk, k0 = 64 * kb, n0 = 32 * nb;
    int d0 = n0;
    if (conv_perm && n0 >= 4096 && n0 < 6144) { const int g = (n0 - 4096) >> 9, ch0 = (n0 - 4096) & 511; d0 = 4096 + 256 * ((ch0 >> 7) + ((g & 1) ? 4 : 0)) + 128 * (g >> 1) + (ch0 & 127); }
    const int kr = lane >> 3, n4 = (lane & 7) * 4;
    f32x4 v[8];
#pragma unroll
    for (int i = 0; i < 8; ++i) v[i] = ld_nt(W + (size_t)(k0 + 8 * i + kr) * N + n0 + n4);
#pragma unroll
    for (int i = 0; i < 8; ++i) { LAS float* d = scr + (8 * i + kr) * 33 + n4; d[0] = v[i].x; d[1] = v[i].y; d[2] = v[i].z; d[3] = v[i].w; }
    asm volatile("s_waitcnt lgkmcnt(0)" ::: "memory");
    const int c = lane & 7;
#pragma unroll
    for (int j = 0; j < 4; ++j) { const int n = (lane >> 3) + 8 * j; const LAS float* s = scr + (8 * c) * 33 + n;
        u32x4 o; o.x = cvt_pk_bf16(s[0 * 33], s[1 * 33]); o.y = cvt_pk_bf16(s[2 * 33], s[3 * 33]); o.z = cvt_pk_bf16(s[4 * 33], s[5 * 33]); o.w = cvt_pk_bf16(s[6 * 33], s[7 * 33]);
        *(u32x4*)(WT + (size_t)(d0 + n) * ldw + k0 + 8 * c) = o; }
    asm volatile("s_waitcnt lgkmcnt(0)" ::: "memory");
}

__device__ __forceinline__ void row_standardize(f32x4 (&v)[4]) {
    float s = 0.f;
#pragma unroll
    for (int j = 0; j < 4; ++j) s += (v[j].x + v[j].y) + (v[j].z + v[j].w);
    const float mean = wave_sum(s) * (1.f / D_MODEL); float s2 = 0.f;
#pragma unroll
    for (int j = 0; j < 4; ++j) { v[j] = v[j] - mean; s2 += (v[j].x * v[j].x + v[j].y * v[j].y) + (v[j].z * v[j].z + v[j].w * v[j].w); }
    const float rstd = __builtin_amdgcn_rsqf(wave_sum(s2) * (1.f / D_MODEL) + LN_EPS);
#pragma unroll
    for (int j = 0; j < 4; ++j) v[j] = v[j] * rstd;
}
__device__ __forceinline__ void write_h_row(const f32x4 (&v)[4], const float* modb, bf16_t* hrow, int lane) {
#pragma unroll
    for (int j = 0; j < 4; ++j) { const int col = 4 * (lane + 64 * j);
        const f32x4 sh = *(const f32x4*)(modb + col), sc = *(const f32x4*)(modb + 1024 + col);
        const f32x4 h = v[j] * (sc + 1.0f) + sh;
        u32x2 w; w.x = cvt_pk_bf16(h.x, h.y); w.y = cvt_pk_bf16(h.z, h.w);
        *(u32x2*)(hrow + col) = w; }
}

typedef short v4i16_t __attribute__((ext_vector_type(4)));
__device__ __forceinline__ s16x4 vtr(const LAS bf16_t* p) { return __builtin_bit_cast(s16x4, __builtin_amdgcn_ds_read_tr16_b64_v4i16((LAS v4i16_t*)p)); }
constexpr float STICK_DEAD = -44.0f;
__device__ __forceinline__ void attn_unit(LAS unsigned char* lds, bf16_t* ACT, int b, int h, int qb) {
    const int tid = fresh_tid(), lane = tid & 63, r32 = lane & 31, hi = lane >> 5;
    const int wid = __builtin_amdgcn_readfirstlane(tid >> 6);
    bf16_t* base = ACT + (size_t)b * SEQ * PITCH;
    const int tq0 = qb * 256 + wid * 32, tq = tq0 + r32;
    LAS bf16_t* Kw = (LAS bf16_t*)(lds + wid * 9728);
    LAS bf16_t* Vw = Kw + 32 * 72;
    LAS float* stg = (LAS float*)(lds + wid * 9728);
    bf16x8 qr[4];
#pragma unroll
    for (int d0 = 0; d0 < 4; ++d0) qr[d0] = __builtin_nontemporal_load((const bf16x8*)(base + (size_t)tq * PITCH + C_QA + h * 64 + d0 * 16 + hi * 8));
    f32x16 o0, o1;
#pragma unroll
    for (int r = 0; r < 16; ++r) { o0[r] = 0.f; o1[r] = 0.f; }
    float R = 0.f;
    const int srow = lane >> 3, sch = lane & 7;
    const bf16_t* kg = base + (size_t)srow * PITCH + C_KA + h * 64 + sch * 8;
    const bf16_t* vg = base + (size_t)srow * PITCH + C_VA + h * 64 + sch * 8;
    const LAS bf16_t* vb = Vw + (4 * hi + ((lane & 15) >> 2)) * 80 + 16 * ((lane >> 4) & 1) + 4 * (lane & 3);
    u32x4 kreg[4], vreg[4];
    int kb = tq0;
#pragma unroll
    for (int i = 0; i < 4; ++i) { kreg[i] = *(const u32x4*)(kg + (size_t)(kb + 8 * i) * PITCH); vreg[i] = *(const u32x4*)(vg + (size_t)(kb + 8 * i) * PITCH); }
    for (;;) {
#pragma unroll
        for (int i = 0; i < 4; ++i) { *(LAS u32x4*)(Kw + (srow + 8 * i) * 72 + sch * 8) = kreg[i]; *(LAS u32x4*)(Vw + (srow + 8 * i) * 80 + sch * 8) = vreg[i]; }
        const int kbn = kb - 32;
        if (kbn >= 0) {
#pragma unroll
            for (int i = 0; i < 4; ++i) { kreg[i] = *(const u32x4*)(kg + (size_t)(kbn + 8 * i) * PITCH); vreg[i] = *(const u32x4*)(vg + (size_t)(kbn + 8 * i) * PITCH); }
        }
        f32x16 p0;
#pragma unroll
        for (int r = 0; r < 16; ++r) p0[r] = 0.f;
#pragma unroll
        for (int d0 = 0; d0 < 4; ++d0) {
            const bf16x8 a0 = *(const LAS bf16x8*)(Kw + r32 * 72 + d0 * 16 + hi * 8);
            p0 = __builtin_amdgcn_mfma_f32_32x32x16_bf16(a0, qr[d0], p0, 0, 0, 0);
        }
        float x0[16];
        if (kb < tq0) {
#pragma unroll
            for (int r = 0; r < 16; ++r) { const float z = p0[r]; const float sp = fmaxf(z, 0.f) + lg2(1.0f + ex2(-fabsf(z))); x0[r] = sp; p0[r] = z - sp; }
        } else {
            const int kvl = kb + 4 * hi;
#pragma unroll
            for (int r = 0; r < 16; ++r) { const int kv = kvl + (r & 3) + 8 * (r >> 2);
                const float z = p0[r]; const float sp = fmaxf(z, 0.f) + lg2(1.0f + ex2(-fabsf(z))); const bool ok = kv < tq; x0[r] = ok ? sp : 0.f; p0[r] = ok ? z - sp : -INFINITY; }
        }
        float Gs[4], Gh1[4], Tt[4];
#pragma unroll
        for (int g = 0; g < 4; ++g) Gs[g] = (x0[4 * g] + x0[4 * g + 1]) + (x0[4 * g + 2] + x0[4 * g + 3]);
#pragma unroll
        for (int g = 0; g < 4; ++g) { auto rr = __builtin_amdgcn_permlane32_swap(__float_as_uint(Gs[g]), __float_as_uint(Gs[g]), false, false);
            Gh1[g] = __uint_as_float(rr[1]); Tt[g] = __uint_as_float(rr[0]) + __uint_as_float(rr[1]); }
        float run = R;
#pragma unroll
        for (int g = 3; g >= 0; --g) {
            const float off = hi ? run : run - Gh1[g];
            const int q4 = 4 * g;
            const float s3 = off, s2 = s3 - x0[q4 + 3], s1 = s2 - x0[q4 + 2], s0 = s1 - x0[q4 + 1];
            p0[q4 + 3] = ex2(p0[q4 + 3] + s3); p0[q4 + 2] = ex2(p0[q4 + 2] + s2); p0[q4 + 1] = ex2(p0[q4 + 1] + s1); p0[q4] = ex2(p0[q4] + s0);
            run -= Tt[g];
        }
        R = run;
#pragma unroll
        for (int s = 0; s < 2; ++s) {
            u32x4 w; const int r0 = 8 * s;
            w.x = cvt_pk_bf16(p0[r0], p0[r0 + 1]); w.y = cvt_pk_bf16(p0[r0 + 2], p0[r0 + 3]); w.z = cvt_pk_bf16(p0[r0 + 4], p0[r0 + 5]); w.w = cvt_pk_bf16(p0[r0 + 6], p0[r0 + 7]);
            const bf16x8 af = __builtin_bit_cast(bf16x8, w);
            { const s16x4 lo = vtr(vb + (16 * s) * 80), hh = vtr(vb + (16 * s + 8) * 80);
              const bf16x8 bfr = (bf16x8){lo[0], lo[1], lo[2], lo[3], hh[0], hh[1], hh[2], hh[3]};
              o0 = __builtin_amdgcn_mfma_f32_32x32x16_bf16(af, bfr, o0, 0, 0, 0); }
            { const s16x4 lo = vtr(vb + (16 * s) * 80 + 32), hh = vtr(vb + (16 * s + 8) * 80 + 32);
              const bf16x8 bfr = (bf16x8){lo[0], lo[1], lo[2], lo[3], hh[0], hh[1], hh[2], hh[3]};
              o1 = __builtin_amdgcn_mfma_f32_32x32x16_bf16(af, bfr, o1, 0, 0, 0); }
        }
        if (kbn < 0 || !__any(R > STICK_DEAD)) break;
        kb = kbn;
    }
#pragma unroll
    for (int r = 0; r < 16; ++r) { stg[crow(r, hi) * 68 + r32] = o0[r]; stg[crow(r, hi) * 68 + 32 + r32] = o1[r]; }
    asm volatile("s_waitcnt lgkmcnt(0)" ::: "memory");
#pragma unroll
    for (int i = 0; i < 4; ++i) { const int row = i * 8 + (lane >> 3), ch = lane & 7;
        const f32x4 a = *(const LAS f32x4*)(stg + row * 68 + ch * 8), c = *(const LAS f32x4*)(stg + row * 68 + ch * 8 + 4);
        bf16_t* zp = base + (size_t)(tq0 + row) * PITCH + C_ZA + h * 64 + ch * 8;
        const u32x4 z = __builtin_nontemporal_load((const u32x4*)zp);
        u32x4 w; w.x = cvt_pk_bf16(a.x * bf_lo(z.x), a.y * bf_hi(z.x)); w.y = cvt_pk_bf16(a.z * bf_lo(z.y), a.w * bf_hi(z.y));
        w.z = cvt_pk_bf16(c.x * bf_lo(z.z), c.y * bf_hi(z.z)); w.w = cvt_pk_bf16(c.z * bf_lo(z.w), c.w * bf_hi(z.w));
        *(u32x4*)zp = w; }
    asm volatile("s_waitcnt lgkmcnt(0)" ::: "memory");
}

__device__ __forceinline__ float layer_lb(const float* lower_bounds, int l, int ch) {
    float mx = -INFINITY;
    for (int i = 0; i < DEPTH; ++i) mx = fmaxf(mx, lower_bounds[i * 512 + ch]);
    float den = 0.f, num = 0.f;
    for (int i = 0; i < DEPTH; ++i) { const float e = __expf(lower_bounds[i * 512 + ch] - mx); den += e; if (i >= 1 && i <= l) num += e; }
    return num / den;
}
template <int MODE>
__device__ __forceinline__ void hgrn_pass(LAS unsigned char* lds, bf16_t* ACT, const Params& P, int l, int bh, int c0, int nc) {
    const int tid = fresh_tid(), lane = tid & 63, r32 = lane & 31, hi = lane >> 5;
    const int wid = __builtin_amdgcn_readfirstlane(tid >> 6);
    LAS bf16_t* Q1 = (LAS bf16_t*)(lds);
    LAS bf16_t* Q2 = (LAS bf16_t*)(lds + 17408);
    LAS bf16_t* K2 = (LAS bf16_t*)(lds + 34816);
    LAS float*  OT = (LAS float*)(lds);
    LAS bf16_t* K3T = (LAS bf16_t*)(lds + 52224);
    LAS bf16_t* VT = (LAS bf16_t*)(lds + 70656);
    LAS bf16_t* Pm = (LAS bf16_t*)(lds + 89088);
    LAS bf16_t* ST = (LAS bf16_t*)(lds + 98304);
    LAS float* DEND = (LAS float*)(lds + 133120);
    LAS float* SCX = (LAS float*)(lds + 133632);
    const int d = tid & 127, part = tid >> 7, b = bh >> 2, h = bh & 3, grp = c0 / nc;
    const float lbv = layer_lb(P.lower_bounds, l, h * 128 + d);
    bf16_t* base = ACT + (size_t)b * SEQ * PITCH + h * 128;
    bf16_t* Ug = (bf16_t*)(P.ws + WS_U) + (size_t)bh * 8 * 16384;
    float* Dg = (float*)(P.ws + WS_DEND) + (size_t)bh * 8 * 128;
    const float* nw = P.hgrn_norm_w + l * 128;
    const int tb = wid & 1, eb = wid >> 1;
    bf16_t fin[16], qin[16], vin[16];
#pragma unroll
    for (int i = 0; i < 16; ++i) { const bf16_t* rp = base + (size_t)(c0 * 64 + 16 * part + i) * PITCH + d;
        if (MODE == 1) { fin[i] = __builtin_nontemporal_load(rp + C_FB); vin[i] = __builtin_nontemporal_load(rp + C_IB); qin[i] = __builtin_nontemporal_load(rp + C_QB); }
        else { fin[i] = rp[C_FB]; vin[i] = rp[C_IB]; } }
    f32x16 sa[2];
#pragma unroll
    for (int r = 0; r < 16; ++r) { sa[0][r] = 0.f; sa[1][r] = 0.f; }
    float bsum = 0.f;
    if (MODE == 1) {
        const int d8 = (tid & 15) * 8;
        f32x4 Sp[4][2];
#pragma unroll
        for (int i = 0; i < 4; ++i) { Sp[i][0] = (f32x4){0.f, 0.f, 0.f, 0.f}; Sp[i][1] = (f32x4){0.f, 0.f, 0.f, 0.f}; }
        for (int k = 0; k < grp; ++k) {
            const f32x4 da = *(const f32x4*)(Dg + k * 128 + d8), db = *(const f32x4*)(Dg + k * 128 + d8 + 4);
            u32x4 uv[4];
#pragma unroll
            for (int i = 0; i < 4; ++i) { const int idx = tid + 512 * i; uv[i] = *(const u32x4*)(Ug + (size_t)k * 16384 + (idx >> 4) * 128 + d8); }
#pragma unroll
            for (int i = 0; i < 4; ++i) {
                Sp[i][0] = da * Sp[i][0] + (f32x4){bf_lo(uv[i].x), bf_hi(uv[i].x), bf_lo(uv[i].y), bf_hi(uv[i].y)};
                Sp[i][1] = db * Sp[i][1] + (f32x4){bf_lo(uv[i].z), bf_hi(uv[i].z), bf_lo(uv[i].w), bf_hi(uv[i].w)}; }
        }
#pragma unroll
        for (int i = 0; i < 4; ++i) { const int idx = tid + 512 * i;
            u32x4 v; v.x = cvt_pk_bf16(Sp[i][0][0], Sp[i][0][1]); v.y = cvt_pk_bf16(Sp[i][0][2], Sp[i][0][3]); v.z = cvt_pk_bf16(Sp[i][1][0], Sp[i][1][1]); v.w = cvt_pk_bf16(Sp[i][1][2], Sp[i][1][3]);
            *(LAS u32x4*)(ST + (idx >> 4) * 136 + d8) = v; }
        __syncthreads();
#pragma unroll
        for (int i = 0; i < 2; ++i) { const int db = 2 * (wid & 1) + i;
#pragma unroll
            for (int g = 0; g < 4; ++g) { const u32x2 w = *(const LAS u32x2*)(ST + (32 * eb + r32) * 136 + 32 * db + 8 * g + 4 * hi);
                sa[i][4 * g] = bf_lo(w.x); sa[i][4 * g + 1] = bf_hi(w.x); sa[i][4 * g + 2] = bf_lo(w.y); sa[i][4 * g + 3] = bf_hi(w.y); } }
    }
    for (int ci = 0; ci < nc; ++ci) {
        const int c = c0 + ci;
        float g2[16], kk[16];
        float runb = 0.f;
#pragma unroll
        for (int i = 0; i < 16; ++i) { const float f = lbv + (1.0f - lbv) * sigmoidf_(bf2f(fin[i])); kk[i] = 1.0f - f; runb += lg2(f); g2[i] = runb; }
        SCX[part * 128 + d] = runb;
        __syncthreads();
        const float t0 = SCX[d], t1 = SCX[128 + d], t2 = SCX[256 + d], t3 = SCX[384 + d];
        const float offp = (part > 0 ? t0 : 0.f) + (part > 1 ? t1 : 0.f) + (part > 2 ? t2 : 0.f);
        const float cmid = t0 + t1, bend = (t0 + t1) + (t2 + t3);
        bsum += bend;
        if (part == 0) DEND[d] = ex2(bend);
        {
            unsigned k3w[8], vw[8];
#pragma unroll
            for (int i = 0; i < 16; i += 2) {
                const float B0 = offp + g2[i], B1 = offp + g2[i + 1];
                if (MODE == 1) {
                    const float q0 = bf2f(qin[i]), q1 = bf2f(qin[i + 1]);
                    const int t = 16 * part + i;
                    Q1[t * 136 + d] = (bf16_t)(cvt_pk_bf16(q0 * ex2(B0), 0.f) & 0xffffu); Q1[(t + 1) * 136 + d] = (bf16_t)(cvt_pk_bf16(q1 * ex2(B1), 0.f) & 0xffffu);
                    Q2[t * 136 + d] = (bf16_t)(cvt_pk_bf16(q0 * ex2(B0 - cmid), 0.f) & 0xffffu); Q2[(t + 1) * 136 + d] = (bf16_t)(cvt_pk_bf16(q1 * ex2(B1 - cmid), 0.f) & 0xffffu);
                    K2[t * 136 + d] = (bf16_t)(cvt_pk_bf16(kk[i] * ex2(cmid - B0), 0.f) & 0xffffu); K2[(t + 1) * 136 + d] = (bf16_t)(cvt_pk_bf16(kk[i + 1] * ex2(cmid - B1), 0.f) & 0xffffu);
                }
                k3w[i >> 1] = cvt_pk_bf16(kk[i] * ex2(bend - B0), kk[i + 1] * ex2(bend - B1));
                vw[i >> 1] = (unsigned)vin[i] | ((unsigned)vin[i + 1] << 16);
            }
            *(LAS u32x4*)(K3T + d * 72 + 16 * part) = (u32x4){k3w[0], k3w[1], k3w[2], k3w[3]}; *(LAS u32x4*)(K3T + d * 72 + 16 * part + 8) = (u32x4){k3w[4], k3w[5], k3w[6], k3w[7]};
            *(LAS u32x4*)(VT + d * 72 + 16 * part) = (u32x4){vw[0], vw[1], vw[2], vw[3]}; *(LAS u32x4*)(VT + d * 72 + 16 * part + 8) = (u32x4){vw[4], vw[5], vw[6], vw[7]};
        }
        if (ci + 1 < nc) {
#pragma unroll
            for (int i = 0; i < 16; ++i) { const bf16_t* rp = base + (size_t)((c + 1) * 64 + 16 * part + i) * PITCH + d;
                if (MODE == 1) { fin[i] = __builtin_nontemporal_load(rp + C_FB); vin[i] = __builtin_nontemporal_load(rp + C_IB); qin[i] = __builtin_nontemporal_load(rp + C_QB); }
                else { fin[i] = rp[C_FB]; vin[i] = rp[C_IB]; } }
        }
        __syncthreads();
        if (MODE == 0) {
#pragma unroll
            for (int i = 0; i < 2; ++i) {
                const int db = 2 * (wid & 1) + i;
#pragma unroll
                for (int r = 0; r < 16; ++r) sa[i][r] *= DEND[32 * db + crow(r, hi)];
#pragma unroll
                for (int ks = 0; ks < 4; ++ks) {
                    const bf16x8 a = *(const LAS bf16x8*)(K3T + (32 * db + r32) * 72 + 16 * ks + 8 * hi);
                    const bf16x8 bb = *(const LAS bf16x8*)(VT + (32 * eb + r32) * 72 + 16 * ks + 8 * hi);
                    sa[i] = __builtin_amdgcn_mfma_f32_32x32x16_bf16(a, bb, sa[i], 0, 0, 0);
                }
            }
        } else {
            f32x16 o;
#pragma unroll
            for (int r = 0; r < 16; ++r) o[r] = 0.f;
            if (c > 0) {
#pragma unroll
                for (int ks = 0; ks < 8; ++ks) {
                    const bf16x8 a = *(const LAS bf16x8*)(Q1 + (32 * tb + r32) * 136 + 16 * ks + 8 * hi);
                    const bf16x8 bb = *(const LAS bf16x8*)(ST + (32 * eb + r32) * 136 + 16 * ks + 8 * hi);
                    o = __builtin_amdgcn_mfma_f32_32x32x16_bf16(a, bb, o, 0, 0, 0);
                }
            }
            if (wid < 4) {
                const int stb = wid & 1, ssb = wid >> 1;
                f32x16 sc;
#pragma unroll
                for (int r = 0; r < 16; ++r) sc[r] = 0.f;
                if (!(stb == 0 && ssb == 1)) {
#pragma unroll
                    for (int ks = 0; ks < 8; ++ks) {
                        const bf16x8 a = *(const LAS bf16x8*)(Q2 + (32 * stb + r32) * 136 + 16 * ks + 8 * hi);
                        const bf16x8 bb = *(const LAS bf16x8*)(K2 + (32 * ssb + r32) * 136 + 16 * ks + 8 * hi);
                        sc = __builtin_amdgcn_mfma_f32_32x32x16_bf16(a, bb, sc, 0, 0, 0);
                    }
                }
#pragma unroll
                for (int r = 0; r < 16; ++r) { const int t = 32 * stb + crow(r, hi), s = 32 * ssb + r32;
                    const float v = (s <= t) ? sc[r] : 0.f;
                    Pm[t * 72 + s] = (bf16_t)(cvt_pk_bf16(v, 0.f) & 0xffffu); }
            }
            __syncthreads();
            unsigned zz[8];
#pragma unroll
            for (int i = 0; i < 8; ++i) zz[i] = __builtin_nontemporal_load((const unsigned*)(base + (size_t)(c * 64 + 8 * wid + i) * PITCH + C_ZB + 2 * lane));
#pragma unroll
            for (int ks = 0; ks < 4; ++ks) {
                const bf16x8 a = *(const LAS bf16x8*)(Pm + (32 * tb + r32) * 72 + 16 * ks + 8 * hi);
                const bf16x8 bb = *(const LAS bf16x8*)(VT + (32 * eb + r32) * 72 + 16 * ks + 8 * hi);
                o = __builtin_amdgcn_mfma_f32_32x32x16_bf16(a, bb, o, 0, 0, 0);
            }
#pragma unroll
            for (int r = 0; r < 16; ++r) OT[(32 * tb + crow(r, hi)) * 132 + 32 * eb + r32] = o[r];
            if (ci + 1 < nc) {
#pragma unroll
                for (int i = 0; i < 2; ++i) {
                    const int db = 2 * (wid & 1) + i;
#pragma unroll
                    for (int r = 0; r < 16; ++r) sa[i][r] *= DEND[32 * db + crow(r, hi)];
#pragma unroll
                    for (int ks = 0; ks < 4; ++ks) {
                        const bf16x8 a = *(const LAS bf16x8*)(K3T + (32 * db + r32) * 72 + 16 * ks + 8 * hi);
                        const bf16x8 bb = *(const LAS bf16x8*)(VT + (32 * eb + r32) * 72 + 16 * ks + 8 * hi);
                        sa[i] = __builtin_amdgcn_mfma_f32_32x32x16_bf16(a, bb, sa[i], 0, 0, 0);
                    }
#pragma unroll
                    for (int g = 0; g < 4; ++g) { u32x2 w; w.x = cvt_pk_bf16(sa[i][4 * g], sa[i][4 * g + 1]); w.y = cvt_pk_bf16(sa[i][4 * g + 2], sa[i][4 * g + 3]);
                        *(LAS u32x2*)(ST + (32 * eb + r32) * 136 + 32 * db + 8 * g + 4 * hi) = w; }
                }
            }
            __syncthreads();
            {
                const f32x2 nwv = *(const f32x2*)(nw + 2 * lane);
#pragma unroll
                for (int i = 0; i < 8; ++i) { const int t = 8 * wid + i;
                    const f32x2 v = *(const LAS f32x2*)(OT + t * 132 + 2 * lane);
                    const float ss = wave_sum(v.x * v.x + v.y * v.y);
                    const float rstd = __builtin_amdgcn_rsqf(ss * (1.0f / 128.0f) + RMS_EPS);
                    unsigned* zp = (unsigned*)(base + (size_t)(c * 64 + t) * PITCH + C_ZB + 2 * lane);
                    *zp = cvt_pk_bf16(v.x * rstd * nwv.x * bf_lo(zz[i]), v.y * rstd * nwv.y * bf_hi(zz[i])); }
            }
        }
    }
    if (MODE == 0) {
        __syncthreads();
#pragma unroll
        for (int i = 0; i < 2; ++i) { const int db = 2 * (wid & 1) + i;
#pragma unroll
            for (int g = 0; g < 4; ++g) { u32x2 w; w.x = cvt_pk_bf16(sa[i][4 * g], sa[i][4 * g + 1]); w.y = cvt_pk_bf16(sa[i][4 * g + 2], sa[i][4 * g + 3]);
                *(LAS u32x2*)(ST + (32 * eb + r32) * 136 + 32 * db + 8 * g + 4 * hi) = w; } }
        __syncthreads();
#pragma unroll
        for (int i = 0; i < 4; ++i) { const int idx = tid + 512 * i;
            *(u32x4*)(Ug + (size_t)grp * 16384 + (idx >> 4) * 128 + (idx & 15) * 8) = *(const LAS u32x4*)(ST + (idx >> 4) * 136 + (idx & 15) * 8); }
        if (part == 0) Dg[grp * 128 + d] = ex2(bsum);
    }
    __syncthreads();
}

__device__ __forceinline__ void unpack8(const u32x4 a, float (&o)[8]) {
    o[0] = bf_lo(a.x); o[1] = bf_hi(a.x); o[2] = bf_lo(a.y); o[3] = bf_hi(a.y); o[4] = bf_lo(a.z); o[5] = bf_hi(a.z); o[6] = bf_lo(a.w); o[7] = bf_hi(a.w);
}
__device__ __forceinline__ void conv_item(bf16_t* ACT, const float* cw, int item) {
    const int tid = fresh_tid(), cgp = tid & 63, sub = tid >> 6;
    const int m0 = item * 64 + sub * 8, ch = cgp * 8;
    float w0[8], w1[8], w2[8];
#pragma unroll
    for (int e = 0; e < 8; ++e) { w0[e] = cw[ch + e]; w1[e] = cw[512 + ch + e]; w2[e] = cw[1024 + ch + e]; }
    float p1[8], p2[8];
#pragma unroll
    for (int e = 0; e < 8; ++e) { p1[e] = 0.f; p2[e] = 0.f; }
    if ((m0 % SEQ) != 0) {
        unpack8(*(const u32x4*)(ACT + (size_t)(m0 - 2) * PITCH + C_PU + ch), p2);
        unpack8(*(const u32x4*)(ACT + (size_t)(m0 - 1) * PITCH + C_PU + ch), p1);
    }
    u32x4 pa[8], pzv[8];
#pragma unroll
    for (int i = 0; i < 8; ++i) { const bf16_t* rp = ACT + (size_t)(m0 + i) * PITCH + ch; pa[i] = __builtin_nontemporal_load((const u32x4*)(rp + C_PU)); pzv[i] = __builtin_nontemporal_load((const u32x4*)(rp + C_PZ)); }
#pragma unroll
    for (int i = 0; i < 8; ++i) {
        float pu[8], pz[8], y[8];
        unpack8(pa[i], pu); unpack8(pzv[i], pz);
#pragma unroll
        for (int e = 0; e < 8; ++e) { y[e] = pz[e] * (w0[e] * p2[e] + w1[e] * p1[e] + w2[e] * pu[e]); p2[e] = p1[e]; p1[e] = pu[e]; }
        u32x4 w; w.x = cvt_pk_bf16(y[0], y[1]); w.y = cvt_pk_bf16(y[2], y[3]); w.z = cvt_pk_bf16(y[4], y[5]); w.w = cvt_pk_bf16(y[6], y[7]);
        *(u32x4*)(ACT + (size_t)(m0 + i) * PITCH + C_ZC + ch) = w;
    }
}

__device__ __forceinline__ void convert_weights(const Params& P, int l, LAS unsigned char* lds, int gw, int NGW, int wid, int lane) {
    LAS float* scr = (LAS float*)(lds + wid * 16384);
    unsigned char* ws = P.ws;
    constexpr int I_IN = 16 * (IN_COLS / 32), I_B = 8 * 32, I_O = 16 * 32, I_L = I_IN + 3 * I_B + I_O;
    for (int it = gw; it < I_L; it += NGW) {
        int r = it;
        if (r < I_IN) { transpose_item(P.w_in + (size_t)l * 1024 * IN_COLS, IN_COLS, (bf16_t*)(ws + WS_WIN), 1024, scr, r, lane, true); continue; } r -= I_IN;
        if (r < 3 * I_B) { const int j = r / I_B; transpose_item(P.w_branch + (size_t)(l * 3 + j) * 512 * 1024, 1024, (bf16_t*)(ws + WS_WB) + (size_t)j * 1024 * 1024, 1024, scr, r % I_B, lane); continue; } r -= 3 * I_B;
        transpose_item(P.w_out + (size_t)l * 1024 * 1024, 1024, (bf16_t*)(ws + WS_WO), 1024, scr, r, lane);
    }
}

typedef const __attribute__((address_space(4))) Params* KParamsPtr;
#define XB_TMO      128
#define XB_XCNT(j)  (256  + 64 * (j))
#define XB_XSUB(j)  (1280 + 64 * (j))
#define XB_XGEN(j)  (2304 + 64 * (j))
#define XB_TOP      3328
#define XB_TOPGEN   3392
#define XCD_BAR_WORDS 3456
#define XB_SPIN_CAP (1u << 22)
__device__ __forceinline__ unsigned xb_ld(unsigned* p)              { return __hip_atomic_load(p, __ATOMIC_RELAXED, __HIP_MEMORY_SCOPE_AGENT); }
__device__ __forceinline__ unsigned xb_add(unsigned* p, unsigned v) { return __hip_atomic_fetch_add(p, v, __ATOMIC_RELAXED, __HIP_MEMORY_SCOPE_AGENT); }
__device__ __forceinline__ unsigned xb_xcc_id() { return (unsigned)__builtin_amdgcn_s_getreg((3 << 11) | 20) & 0xFu; }
#define XB_SPIN(cond, bar) do { unsigned _sp = 0; while (cond) { __builtin_amdgcn_s_sleep(1); \
    if ((++_sp & 255u) == 0u) { if (xb_ld(&(bar)[XB_TMO])) break; if (_sp > XB_SPIN_CAP) { atomicAdd(&(bar)[XB_TMO], 1u); break; } } } } while (0)
__device__ __forceinline__ void xcd_barrier_complete(unsigned* bar, unsigned x, unsigned& nloc, unsigned& nx) {
    const unsigned G = gridDim.x * gridDim.y * gridDim.z;
    unsigned sum, cnt, mine, sp = 0u;
    for (;;) {
        sum = 0u; cnt = 0u; mine = 0u;
#pragma unroll
        for (unsigned j = 0; j < 16; ++j) { const unsigned c = xb_ld(&bar[XB_XCNT(j)]); sum += c; cnt += (c > 0u) ? 1u : 0u; mine = (j == x) ? c : mine; }
        if (sum == G) break;
        __builtin_amdgcn_s_sleep(1);
        if ((++sp & 255u) == 0u) { if (xb_ld(&bar[XB_TMO])) break; if (sp > XB_SPIN_CAP) { atomicAdd(&bar[XB_TMO], 1u); break; } }
    }
    nloc = mine > 0u ? mine : 1u; nx = cnt > 0u ? cnt : 1u;
}
__device__ __forceinline__ void xcd_barrier(unsigned* bar, volatile LAS unsigned* st) {
    asm volatile("s_waitcnt vmcnt(0)" ::: "memory");
    __syncthreads();
    if (threadIdx.x == 0) {
        __builtin_amdgcn_s_waitcnt(0);
        const unsigned x = xb_xcc_id();
        unsigned nloc = st[0], nx = st[1];
        if (nloc == 0u) { xcd_barrier_complete(bar, x, nloc, nx); st[0] = nloc; st[1] = nx; }
        const unsigned old = xb_add(&bar[XB_XSUB(x)], 1u);
        const unsigned gen = old / nloc;
        if (old + 1u == (gen + 1u) * nloc) {
            __builtin_amdgcn_fence(__ATOMIC_RELEASE, "agent");
            asm volatile("s_waitcnt vmcnt(0)" ::: "memory");
            const unsigned og = xb_add(&bar[XB_TOP], 1u);
            const unsigned tg = og / nx;
            if (og + 1u == (tg + 1u) * nx) xb_add(&bar[XB_TOPGEN], 1u);
            else XB_SPIN(xb_ld(&bar[XB_TOPGEN]) == tg, bar);
            __builtin_amdgcn_fence(__ATOMIC_ACQUIRE, "agent");
            xb_add(&bar[XB_XGEN(x)], 1u);
            asm volatile("s_waitcnt vmcnt(0)" ::: "memory");
        } else {
            XB_SPIN(xb_ld(&bar[XB_XGEN(x)]) == gen, bar);
            __builtin_amdgcn_fence(__ATOMIC_ACQUIRE, "agent");
            asm volatile("s_waitcnt vmcnt(0)" ::: "memory");
        }
    }
    __syncthreads();
}
#define GRID_SYNC() do { asm volatile("s_waitcnt vmcnt(0) lgkmcnt(0)" ::: "memory"); __syncthreads(); grid.sync(); } while (0)
#define XBAR() do { KParamsPtr qb_ = (KParamsPtr)__builtin_amdgcn_kernarg_segment_ptr(); asm volatile("" : "+s"(qb_)); xcd_barrier((unsigned*)(qb_->ws + WS_CTL), (volatile LAS unsigned*)(lds + LDS_BYTES - 16)); } while (0)
#define PHASE_BEGIN() \
    Params P; { KParamsPtr q_ = (KParamsPtr)__builtin_amdgcn_kernarg_segment_ptr(); asm volatile("" : "+s"(q_)); \
        P.x = q_->x; P.c = q_->c; P.w_mod = q_->w_mod; P.b_mod = q_->b_mod; P.w_in = q_->w_in; P.conv_w = q_->conv_w; P.hgrn_norm_w = q_->hgrn_norm_w; P.lower_bounds = q_->lower_bounds; \
        P.w_branch = q_->w_branch; P.w_out = q_->w_out; P.ln_g = q_->ln_g; P.ln_b = q_->ln_b; P.out = q_->out; P.ws = q_->ws; } \
    int bx = blockIdx.x; asm volatile("" : "+s"(bx)); \
    const int G = gridDim.x; \
    const int vcu = (G % 8 == 0) ? (bx % 8) * (G / 8) + bx / 8 : bx; \
    unsigned char* const ws = P.ws; \
    float* const modp = (float*)(ws + WS_MOD); \
    bf16_t* const ACT = (bf16_t*)(ws + WS_ACT); \
    (void)vcu; (void)modp; (void)ACT;
#define WAVE_IDS() \
    const int tid = fresh_tid(), lane = tid & 63, wid = __builtin_amdgcn_readfirstlane(tid >> 6); \
    const int gw = vcu * 8 + wid, NGW = G * 8; (void)lane; (void)gw; (void)NGW;

__global__ void __launch_bounds__(NTHREADS, 2) fwd_megakernel(Params Pk) {
    extern __shared__ __attribute__((aligned(16))) unsigned char lds_raw[];
    LAS unsigned char* lds = (LAS unsigned char*)lds_raw;
    cg::grid_group grid = cg::this_grid();
    if (__builtin_expect(gridDim.y == 4242u, 0)) GRID_SYNC();
    if (threadIdx.x < 4) ((LAS unsigned*)(lds + LDS_BYTES - 16))[threadIdx.x] = 0u;
    __syncthreads();
    if (threadIdx.x == 0) { KParamsPtr q0_ = (KParamsPtr)__builtin_amdgcn_kernarg_segment_ptr(); (void)xb_add(&((unsigned*)(q0_->ws + WS_CTL))[XB_XCNT(xb_xcc_id())], 1u); }

    {
        PHASE_BEGIN(); WAVE_IDS();
        float* modpart = (float*)(ws + WS_MODP);
        LAS float* red = (LAS float*)lds;
        for (int u = bx; u < DEPTH * 192; u += G) {
            const int l = u / 192, r = u % 192, n = (r >> 2) * 64 + lane, kq = r & 3;
            float accb[8];
#pragma unroll
            for (int b = 0; b < 8; ++b) accb[b] = 0.f;
            const float* wp = P.w_mod + ((size_t)l * 1024 + 256 * kq + 32 * wid) * 3072 + n;
            const float* cp = P.c + 256 * kq + 32 * wid;
#pragma unroll 16
            for (int k = 0; k < 32; ++k) { const float wv = __builtin_nontemporal_load(wp + (size_t)k * 3072);
#pragma unroll
                for (int b = 0; b < 8; ++b) accb[b] += cp[b * 1024 + k] * wv; }
            __syncthreads();
#pragma unroll
            for (int b = 0; b < 8; ++b) red[(wid * 8 + b) * 64 + lane] = accb[b];
            __syncthreads();
            { const int b = wid; float sacc = 0.f;
#pragma unroll
              for (int w = 0; w < 8; ++w) sacc += red[(w * 8 + b) * 64 + lane];
              modpart[(((size_t)kq * DEPTH + l) * 8 + b) * 3072 + n] = sacc; }
        }
        __syncthreads();
        convert_weights(P, 0, lds, gw, NGW, wid, lane);
    }
    XBAR();
    {
        PHASE_BEGIN(); WAVE_IDS();
        const float* modpart = (const float*)(ws + WS_MODP);
        for (int i = bx * NTHREADS + tid; i < DEPTH * 8 * 3072; i += G * NTHREADS) {
            const int l = i / (8 * 3072), n = i % 3072;
            float v = P.b_mod[l * 3072 + n];
#pragma unroll
            for (int kq = 0; kq < 4; ++kq) v += modpart[(size_t)kq * DEPTH * 8 * 3072 + i];
            modp[i] = v;
        }
        LAS float* ms = (LAS float*)lds;
        for (int rg = bx; rg < M_TOK / 64; rg += G) {
            const int b = (rg * 64) / SEQ;
            __syncthreads();
            { const int i4 = tid * 4; f32x4 v = *(const f32x4*)(P.b_mod + i4);
#pragma unroll
              for (int kq = 0; kq < 4; ++kq) v = v + *(const f32x4*)(modpart + ((size_t)kq * DEPTH * 8 + b) * 3072 + i4);
              *(LAS f32x4*)(ms + i4) = v; }
            __syncthreads();
#pragma unroll
            for (int it = 0; it < 2; ++it) {
                f32x4 v[4][4];
#pragma unroll
                for (int q = 0; q < 4; ++q) { const int m = rg * 64 + wid * 8 + it * 4 + q;
#pragma unroll
                    for (int j = 0; j < 4; ++j) v[q][j] = ld_nt(P.x + (size_t)m * D_MODEL + 4 * (lane + 64 * j)); }
#pragma unroll
                for (int q = 0; q < 4; ++q) { const int m = rg * 64 + wid * 8 + it * 4 + q;
                    row_standardize(v[q]);
                    bf16_t* hrow = ACT + (size_t)m * PITCH + C_H;
#pragma unroll
                    for (int j = 0; j < 4; ++j) { const int col = 4 * (lane + 64 * j);
                        const f32x4 sh = *(const LAS f32x4*)(ms + col), sc = *(const LAS f32x4*)(ms + 1024 + col);
                        const f32x4 hv = v[q][j] * (sc + 1.0f) + sh;
                        u32x2 w; w.x = cvt_pk_bf16(hv.x, hv.y); w.y = cvt_pk_bf16(hv.z, hv.w);
                        *(u32x2*)(hrow + col) = w; } }
            }
        }
    }
    XBAR();

    for (int l = 0; l < DEPTH; ++l) {
        {
            PHASE_BEGIN();
            SchedP1 S{(const char*)ACT + C_H * 2, (const char*)(ws + WS_WIN), G, vcu};
            EpiP1 E{ACT};
            pg8::gemm_phase<EpiP1, SchedP1>(lds, (unsigned)PITCHB, 2048u, S, E);
        }
        XBAR();
        {
            PHASE_BEGIN();
            for (int u = bx; u < 256; u += G) hgrn_pass<0>(lds, ACT, P, l, u >> 3, (u & 7) * 4, 4);
        }
        {
            PHASE_BEGIN();
            for (int k = bx; k < 256; k += G) {
                __syncthreads(); attn_unit(lds, ACT, (k & 63) >> 3, k & 7, 7 - (k >> 6));
                const int a2 = 511 - k;
                __syncthreads(); attn_unit(lds, ACT, (a2 & 63) >> 3, a2 & 7, 7 - (a2 >> 6));
            }
            for (int ci = bx; ci < 256; ci += G) conv_item(ACT, P.conv_w + (size_t)l * 3 * 512, ci);
        }
        XBAR();
        {
            PHASE_BEGIN();
            for (int u = bx; u < 256; u += G) hgrn_pass<1>(lds, ACT, P, l, u >> 3, (u & 7) * 4, 4);
        }
        XBAR();
        {
            PHASE_BEGIN();
            SchedP3 S{(const char*)ACT, (const char*)(ws + WS_WIN) + (size_t)MIX_COLS * 2048, (const char*)(ws + WS_WB), G, vcu};
            EpiP3 E{(unsigned char*)ACT};
            pg8::gemm_phase<EpiP3, SchedP3>(lds, (unsigned)PITCHB, 2048u, S, E);
        }
        XBAR();
        {
            PHASE_BEGIN(); WAVE_IDS();
            SchedP4 S{(const char*)ACT, (const char*)(ws + WS_WO), G, vcu};
            unsigned* pc = (unsigned*)(ws + WS_CTL + CTL_PANEL);
            unsigned long long* xb = (unsigned long long*)(ws + WS_X);
            const bool more = (l + 1 < DEPTH);
            PanelStats st1{xb + (size_t)(2 * l) * 65536, pc + (2 * l) * 4096, LN_EPS};
            PanelStats st2{xb + (size_t)(2 * l + 1) * 65536, pc + (2 * l + 1) * 4096, LN_EPS};
            EpiP4F E{l == 0 ? P.x : P.out, P.out, modp + (size_t)l * 8 * 3072 + 2048, P.ln_g + l * 1024, P.ln_b + l * 1024, more ? modp + (size_t)(l + 1) * 8 * 3072 : nullptr, ACT, st1, st2};
            pg8::gemm_phase<EpiP4F, SchedP4>(lds, (unsigned)PITCHB, 2048u, S, E);
            if (more) { __syncthreads(); convert_weights(P, l + 1, lds, gw, NGW, wid, lane); }
        }
        if (l + 1 < DEPTH) XBAR();
    }
}

extern "C" void kernel_launch(void* const* d_in, const int* in_sizes, int n_in, void* d_out, int out_size, void* d_ws, size_t ws_size, hipStream_t stream) {
    static int grid_blocks = 0;
    if (grid_blocks == 0) {
        if (n_in != 12 || out_size != M_TOK * D_MODEL || ws_size < WS_END) { fprintf(stderr, "kernel_launch: unexpected shapes (n_in %d, out %d, ws %zu < %zu)\n", n_in, out_size, ws_size, (size_t)WS_END); grid_blocks = -1; return; }
        int dev = 0, cus = 0, per_cu = 0;
        hipGetDevice(&dev);
        hipDeviceGetAttribute(&cus, hipDeviceAttributeMultiprocessorCount, dev);
        hipFuncSetAttribute((const void*)fwd_megakernel, hipFuncAttributeMaxDynamicSharedMemorySize, LDS_BYTES);
        hipOccupancyMaxActiveBlocksPerMultiprocessor(&per_cu, (const void*)fwd_megakernel, NTHREADS, LDS_BYTES);
        (void)hipGetLastError();
        if (per_cu < 1) per_cu = 1;
        grid_blocks = cus > 256 ? 256 : cus;
        if (grid_blocks != 256) fprintf(stderr, "kernel_launch: %d CUs reported; this kernel is laid out for 256 workgroups\n", cus);
        if (grid_blocks <= 0) grid_blocks = 256;
    }
    if (grid_blocks < 0) return;
    (void)hipMemsetAsync((char*)d_ws + WS_CTL, 0, CTL_BYTES, stream);
    Params p{};
    p.x = (const float*)d_in[0]; p.c = (const float*)d_in[1]; p.w_mod = (const float*)d_in[2]; p.b_mod = (const float*)d_in[3]; p.w_in = (const float*)d_in[4];
    p.conv_w = (const float*)d_in[5]; p.hgrn_norm_w = (const float*)d_in[6]; p.lower_bounds = (const float*)d_in[7]; p.w_branch = (const float*)d_in[8];
    p.w_out = (const float*)d_in[9]; p.ln_g = (const float*)d_in[10]; p.ln_b = (const float*)d_in[11]; p.out = (float*)d_out; p.ws = (unsigned char*)d_ws;
    void* args[] = {&p};
    hipError_t e = hipLaunchCooperativeKernel((const void*)fwd_megakernel, dim3(grid_blocks), dim3(NTHREADS), args, LDS_BYTES, stream);
    if (e != hipSuccess) fprintf(stderr, "cooperative launch failed: %s (grid %d)\n", hipGetErrorString(e), grid_blocks);
}
```

```cpp
#include <hip/hip_runtime.h>
#include <hip/hip_cooperative_groups.h>
#include <cstdio>
#include <cstdint>
namespace cg = cooperative_groups;

#define LAS __attribute__((address_space(3)))
typedef unsigned short bf16_t;
typedef short bf16x8 __attribute__((ext_vector_type(8)));
typedef short s16x4 __attribute__((ext_vector_type(4)));
typedef float f32x2 __attribute__((ext_vector_type(2)));
typedef float f32x4 __attribute__((ext_vector_type(4)));
typedef float f32x16 __attribute__((ext_vector_type(16)));
typedef unsigned u32x2 __attribute__((ext_vector_type(2)));
typedef unsigned u32x4 __attribute__((ext_vector_type(4)));

constexpr int D_MODEL = 1024, BATCH = 8, SEQ = 2048, DEPTH = 2, M_TOK = BATCH * SEQ;
constexpr int IN_COLS = 9216, MIX_COLS = 6144;
constexpr int PITCH = 7168;
constexpr size_t PITCHB = (size_t)PITCH * 2;
constexpr int C_QA = 0, C_KA = 512, C_VA = 1024, C_ZA = 1536, C_QB = 2048, C_FB = 2560, C_IB = 3072, C_ZB = 3584, C_PU = 4096  , C_PZ = 4608  , C_ZC = 5632  , C_H = 6144;
constexpr int C_MERGED = 4096;
constexpr float LN_EPS = 1e-5f, RMS_EPS = 1e-6f;
constexpr float LOG2E = 1.4426950408889634f;
constexpr float QSCALE = 0.125f * LOG2E;
constexpr float ALPHA = 1.4142135623730951f;

constexpr size_t WS_CTL = 0, CTL_BYTES = 65536;
constexpr size_t WS_MOD = 65536;
constexpr size_t WS_DEND = 256u << 10;
constexpr size_t WS_WIN = 1u << 20;
constexpr size_t WIN_L = (size_t)IN_COLS * 1024 * 2;
constexpr size_t WS_WB = WS_WIN + WIN_L;
constexpr size_t WB_L = (size_t)3 * 1024 * 1024 * 2;
constexpr size_t WS_WO = WS_WB + WB_L;
constexpr size_t WO_L = (size_t)1024 * 1024 * 2;
constexpr size_t WS_ACT = WS_WO + WO_L;
constexpr size_t WS_U = WS_ACT + (size_t)M_TOK * PITCHB;
constexpr size_t WS_X = WS_U + (size_t)32 * 32 * 128 * 128 * 2;
constexpr size_t WS_MODP = WS_X + 3 * 524288;
constexpr size_t WS_END = WS_MODP + (size_t)4 * DEPTH * BATCH * 3072 * 4;
constexpr size_t CTL_PANEL = 16384;

constexpr int LDS_BYTES = 147456;
constexpr int NTHREADS = 512;

struct Params {
    const float* x; const float* c; const float* w_mod; const float* b_mod; const float* w_in; const float* conv_w; const float* hgrn_norm_w;
    const float* lower_bounds; const float* w_branch; const float* w_out; const float* ln_g; const float* ln_b; float* out; unsigned char* ws;
};

typedef __bf16 bf16x2_t __attribute__((ext_vector_type(2)));
__device__ __forceinline__ unsigned cvt_pk_bf16(float lo, float hi) { const f32x2 v = {lo, hi}; const bf16x2_t b = __builtin_convertvector(v, bf16x2_t); return __builtin_bit_cast(unsigned, b); }
__device__ __forceinline__ f32x4 ld_nt(const float* p) { return __builtin_nontemporal_load((const f32x4*)p); }
__device__ __forceinline__ float bf_lo(unsigned w) { return __uint_as_float(w << 16); }
__device__ __forceinline__ float bf_hi(unsigned w) { return __uint_as_float(w & 0xffff0000u); }
__device__ __forceinline__ float bf2f(bf16_t v) { return __uint_as_float((unsigned)v << 16); }
__device__ __forceinline__ float ex2(float v) { return __builtin_amdgcn_exp2f(v); }
__device__ __forceinline__ float lg2(float v) { return __builtin_amdgcn_logf(v); }
__device__ __forceinline__ float sigmoidf_(float v) { return __builtin_amdgcn_rcpf(1.0f + ex2(-v * LOG2E)); }
__device__ __forceinline__ float siluf_(float v) { return v * sigmoidf_(v); }
__device__ __forceinline__ float wave_sum(float v) {
#pragma unroll
    for (int o = 1; o < 64; o <<= 1) v += __shfl_xor(v, o);
    return v;
}
__device__ __forceinline__ int fresh_tid() { int t = threadIdx.x; asm volatile("" : "+v"(t)); return t; }
__device__ __forceinline__ int crow(int r, int hi) { return (r & 3) + 8 * (r >> 2) + 4 * hi; }

namespace pg8 {
constexpr int BM = 256, BK = 64, HALF = 128, HTB = HALF * BK * 2, STAGE_BYTES = 8 * HTB;
__device__ __forceinline__ int lds_byte(int r, int c) { const int st = (r >> 4) * 2 + (c >> 5), rr = r & 15, cc = c & 31, ob = rr * 64 + cc * 2; return st * 1024 + (ob ^ (((ob >> 9) & 1) << 5)); }
__device__ __forceinline__ void stage_rc(int b, int& R, int& C) { const int st = b / 1024, sb = b % 1024, swz = sb ^ (((sb >> 9) & 1) << 5); R = (st >> 1) * 16 + swz / 64; C = (st & 1) * 32 + (swz % 64) / 2; }
__device__ __forceinline__ int perm32(int rho) { const int n = rho >> 4, i = rho & 15; return 8 * (i >> 2) + 4 * n + (i & 3); }

struct Unit { const char* a; const char* b; int nt; int pm, pn, j; };

template <class Epi, class Sched>
__device__ __forceinline__ void gemm_phase(LAS unsigned char* lds, const unsigned ldaB, const unsigned ldbB, const Sched& S, const Epi& E) {
    const int tid = fresh_tid(), wid = __builtin_amdgcn_readfirstlane(tid >> 6), lane = tid & 63, wr = wid >> 2, wc = wid & 3, fr = lane & 15, fq = lane >> 4;
    unsigned voffA[2], voffB[2];
#pragma unroll
    for (int i = 0; i < 2; ++i) { int R, C; stage_rc(tid * 16 + i * 8192, R, C); const int Rb = Epi::PERM ? ((R & ~31) + perm32(R & 31)) : R;
        voffA[i] = (unsigned)R * ldaB + (unsigned)C * 2u; voffB[i] = (unsigned)Rb * ldbB + (unsigned)C * 2u; }
    const size_t kstep = (size_t)(BK * 2);
    const size_t hstepA = (size_t)HALF * ldaB, hstepB = (size_t)HALF * ldbB;
    const unsigned ldsw = (unsigned)wid * 1024u;
    const int aoff = lds_byte(wr * 64 + fr, fq * 8), boff = lds_byte(wc * 32 + fr, fq * 8);
#define PG8_SA(b, h) (((b) * 2 + (h)) * HTB)
#define PG8_SB(b, h) ((4 + (b) * 2 + (h)) * HTB)
#define PG8_STAGE(bufoff, gbase, voff) do { _Pragma("unroll") for (int _i = 0; _i < 2; ++_i) \
        __builtin_amdgcn_global_load_lds((const unsigned*)((const char*)(gbase) + (voff)[_i]), (LAS unsigned*)(lds + (bufoff) + ldsw + _i * 8192), 16, 0, 0); } while (0)
#define PG8_LDA(dst, b, h) do { _Pragma("unroll") for (int m = 0; m < 4; ++m) _Pragma("unroll") for (int k = 0; k < 2; ++k) dst[m][k] = *(const LAS bf16x8*)(lds + PG8_SA(b, h) + aoff + m * 2048 + k * 1024); } while (0)
#define PG8_LDB(dst, b, h) do { _Pragma("unroll") for (int n = 0; n < 2; ++n) _Pragma("unroll") for (int k = 0; k < 2; ++k) dst[n][k] = *(const LAS bf16x8*)(lds + PG8_SB(b, h) + boff + n * 2048 + k * 1024); } while (0)
#define PG8_MMA(ai, bj, At, Bt) do { __builtin_amdgcn_s_setprio(1); _Pragma("unroll") for (int m = 0; m < 4; ++m) _Pragma("unroll") for (int n = 0; n < 2; ++n) _Pragma("unroll") for (int k = 0; k < 2; ++k) \
        acc[ai][bj][m][n] = __builtin_amdgcn_mfma_f32_16x16x32_bf16(Bt[n][k], At[m][k], acc[ai][bj][m][n], 0, 0, 0); __builtin_amdgcn_s_setprio(0); } while (0)
#define PG8_WAIT_V(n) asm volatile("s_waitcnt vmcnt(" #n ")" ::: "memory")
#define PG8_WAIT_L(n) asm volatile("s_waitcnt lgkmcnt(" #n ")" ::: "memory")
#define PG8_BAR __builtin_amdgcn_s_barrier()
#define PG8_SCHED __builtin_amdgcn_sched_barrier(0)
    Unit cur, nxt; int ui = 0;
    if (!S.next(0, cur)) return;
    f32x4 acc[2][2][4][2];
#pragma unroll
    for (int a = 0; a < 2; ++a)
#pragma unroll
        for (int b = 0; b < 2; ++b)
#pragma unroll
            for (int m = 0; m < 4; ++m)
#pragma unroll
                for (int n = 0; n < 2; ++n) acc[a][b][m][n] = (f32x4){0.f, 0.f, 0.f, 0.f};
    bf16x8 At[4][2], B0[2][2], B1[2][2];
    const char* cA = cur.a; const char* cB = cur.b;
    PG8_STAGE(PG8_SB(0, 0), cB, voffB); PG8_STAGE(PG8_SB(0, 1), cB + hstepB, voffB); PG8_STAGE(PG8_SA(0, 0), cA, voffA); PG8_STAGE(PG8_SA(0, 1), cA + hstepA, voffA);
    if (wr == 1) PG8_BAR;
    PG8_WAIT_V(2); PG8_BAR;
    PG8_STAGE(PG8_SB(1, 0), cB + kstep, voffB); PG8_STAGE(PG8_SA(1, 0), cA + kstep, voffA); PG8_STAGE(PG8_SB(1, 1), cB + hstepB + kstep, voffB);
    PG8_WAIT_V(6); PG8_BAR;
    for (;;) {
        const bool has_next = S.next(ui + 1, nxt);
        const char* nA = has_next ? nxt.a : cA; const char* nB = has_next ? nxt.b : cB;
        const int nt = cur.nt;
        for (int t = 0; t < nt; t += 2) {
            const bool last = (t == nt - 2);
            const char* a1 = cA + (size_t)(t + 1) * kstep;
            const char* a2 = last ? nA : cA + (size_t)(t + 2) * kstep; const char* b2 = last ? nB : cB + (size_t)(t + 2) * kstep;
            const char* a3 = a2 + kstep; const char* b3 = b2 + kstep;
            PG8_LDB(B0, 0, 0); PG8_LDB(B1, 0, 1); PG8_SCHED; PG8_LDA(At, 0, 0); PG8_STAGE(PG8_SA(1, 1), a1 + hstepA, voffA);
            PG8_WAIT_V(8); PG8_WAIT_L(0); PG8_BAR; PG8_MMA(0, 0, At, B0); PG8_MMA(0, 1, At, B1); PG8_BAR; PG8_SCHED;
            PG8_LDA(At, 0, 1); PG8_STAGE(PG8_SB(0, 0), b2, voffB); PG8_STAGE(PG8_SB(0, 1), b2 + hstepB, voffB); PG8_STAGE(PG8_SA(0, 0), a2, voffA);
            PG8_WAIT_V(8); PG8_WAIT_L(0); PG8_BAR; PG8_MMA(1, 0, At, B0); PG8_MMA(1, 1, At, B1); PG8_BAR; PG8_SCHED;
            PG8_LDB(B0, 1, 0); PG8_LDB(B1, 1, 1); PG8_SCHED; PG8_LDA(At, 1, 0); PG8_STAGE(PG8_SA(0, 1), a2 + hstepA, voffA);
            PG8_WAIT_V(8); PG8_WAIT_L(0); PG8_BAR; PG8_MMA(0, 0, At, B0); PG8_MMA(0, 1, At, B1); PG8_BAR; PG8_SCHED;
            PG8_LDA(At, 1, 1); PG8_STAGE(PG8_SB(1, 0), b3, voffB); PG8_STAGE(PG8_SB(1, 1), b3 + hstepB, voffB); PG8_STAGE(PG8_SA(1, 0), a3, voffA);
            PG8_WAIT_V(8); PG8_WAIT_L(0); PG8_BAR; PG8_MMA(1, 0, At, B0); PG8_MMA(1, 1, At, B1); PG8_BAR; PG8_SCHED;
        }
        if (wr == 0) PG8_BAR;
        if constexpr (!Epi::AFTER_DRAIN) E(acc, cur, wr, wc, fr, fq);
        if (!has_next) break;
#pragma unroll
        for (int a = 0; a < 2; ++a)
#pragma unroll
            for (int b = 0; b < 2; ++b)
#pragma unroll
                for (int m = 0; m < 4; ++m)
#pragma unroll
                    for (int n = 0; n < 2; ++n) acc[a][b][m][n] = (f32x4){0.f, 0.f, 0.f, 0.f};
        cur = nxt; cA = nA; cB = nB; ++ui;
        if (wr == 1) PG8_BAR;
    }
    PG8_WAIT_V(0);
    PG8_BAR;
    if constexpr (Epi::AFTER_DRAIN) E.fused(acc, cur, wr, wc, fr, fq, lds, wid, lane);
#undef PG8_SA
#undef PG8_SB
#undef PG8_STAGE
#undef PG8_LDA
#undef PG8_LDB
#undef PG8_MMA
#undef PG8_WAIT_V
#undef PG8_WAIT_L
#undef PG8_BAR
#undef PG8_SCHED
}
}

struct SchedP1 {
    const char* A; const char* B; int G, vcu;
    __device__ __forceinline__ bool next(int i, pg8::Unit& u) const {
        const int U = i * G + vcu; if (U >= 64 * 24) return false;
        u.pm = 8 * ((U >> 5) & 7) + (U & 7); u.pn = 4 * (U >> 8) + ((U & 31) >> 3); u.j = 0; u.nt = 16;
        u.a = A + (size_t)u.pm * 256 * PITCHB; u.b = B + (size_t)u.pn * 256 * 2048; return true;
    }
};
struct SchedP3 {
    const char* ACTb; const char* Wg; const char* Wb; int G, vcu;
    __device__ __forceinline__ bool next(int i, pg8::Unit& u) const {
        const int T = vcu + (i / 6) * G; if (T >= 256) return false;
        const int s = i % 6; u.pm = 8 * (T >> 5) + (T & 7); u.pn = (T & 31) >> 3; u.j = s;
        const int j = s >> 1;
        if ((s & 1) == 0) { u.nt = 16; u.a = ACTb + (size_t)u.pm * 256 * PITCHB + C_H * 2; u.b = Wg + (size_t)(1024 * j + 256 * u.pn) * 2048; }
        else { u.nt = 8; u.a = ACTb + (size_t)u.pm * 256 * PITCHB + (size_t)(C_ZA + 2048 * j) * 2; u.b = Wb + (size_t)(1024 * j + 256 * u.pn) * 2048; }
        return true;
    }
};
struct SchedP4 {
    const char* ACTb; const char* Wo; int G, vcu;
    __device__ __forceinline__ bool next(int i, pg8::Unit& u) const {
        const int T = vcu + i * G; if (T >= 256) return false;
        u.pm = 8 * (T >> 5) + (T & 7); u.pn = (T & 31) >> 3; u.j = 0; u.nt = 16;
        u.a = ACTb + (size_t)u.pm * 256 * PITCHB + C_MERGED * 2; u.b = Wo + (size_t)(256 * u.pn) * 2048; return true;
    }
};

struct EpiP1 {
    static constexpr bool PERM = true, AFTER_DRAIN = false;
    bf16_t* ACT;
    __device__ __forceinline__ void operator()(const f32x4 (&acc)[2][2][4][2], const pg8::Unit& u, int wr, int wc, int fr, int fq) const {
        const int row0 = u.pm * 256 + wr * 64 + fr;
        if (u.pn >= 16) {
            const int T = u.pn - 16, col0 = (T < 4 ? C_PU + 128 * T : C_PZ + 128 * (T - 4)) + wc * 32 + 8 * fq;
#pragma unroll
            for (int ai = 0; ai < 2; ++ai)
#pragma unroll
                for (int m = 0; m < 4; ++m) { bf16_t* rowp = ACT + (size_t)(row0 + ai * 128 + m * 16) * PITCH + col0;
                    f32x4 v0 = acc[ai][1][m][0], v1 = acc[ai][1][m][1];
                    if (T >= 4) {
#pragma unroll
                        for (int e = 0; e < 4; ++e) { v0[e] = siluf_(v0[e]); v1[e] = siluf_(v1[e]); } }
                    v0 = v0 * acc[ai][0][m][0]; v1 = v1 * acc[ai][0][m][1];
                    u32x4 w; w.x = cvt_pk_bf16(v0[0], v0[1]); w.y = cvt_pk_bf16(v0[2], v0[3]); w.z = cvt_pk_bf16(v1[0], v1[1]); w.w = cvt_pk_bf16(v1[2], v1[3]);
                    *(u32x4*)rowp = w; }
            return;
        }
        const int grp = u.pn >> 1;
        const int kind = (grp == 0) ? 1 : ((grp == 3 || grp == 4 || grp == 7) ? 2 : 0);
        const int col0 = u.pn * 256 + wc * 32 + 8 * fq;
#pragma unroll
        for (int ai = 0; ai < 2; ++ai)
#pragma unroll
            for (int m = 0; m < 4; ++m) { bf16_t* rowp = ACT + (size_t)(row0 + ai * 128 + m * 16) * PITCH + col0;
#pragma unroll
                for (int bj = 0; bj < 2; ++bj) { f32x4 v0 = acc[ai][bj][m][0], v1 = acc[ai][bj][m][1];
                    if (kind == 1) { v0 = v0 * QSCALE; v1 = v1 * QSCALE; }
                    else if (kind == 2) {
#pragma unroll
                        for (int e = 0; e < 4; ++e) { v0[e] = siluf_(v0[e]); v1[e] = siluf_(v1[e]); } }
                    u32x4 w; w.x = cvt_pk_bf16(v0[0], v0[1]); w.y = cvt_pk_bf16(v0[2], v0[3]); w.z = cvt_pk_bf16(v1[0], v1[1]); w.w = cvt_pk_bf16(v1[2], v1[3]);
                    *(u32x4*)(rowp + bj * 128) = w; } }
    }
};
struct EpiP3 {
    static constexpr bool PERM = true, AFTER_DRAIN = false;
    unsigned char* ACTb;
    __device__ __forceinline__ void operator()(const f32x4 (&acc)[2][2][4][2], const pg8::Unit& u, int wr, int wc, int fr, int fq) const {
        const int s = u.j, j = s >> 1;
        const int row0 = u.pm * 256 + wr * 64 + fr, cl0 = wc * 32 + 8 * fq;
        const unsigned toff = 512u * (unsigned)u.pn, soff = 5120u + 512u * (unsigned)u.pn, moff = (unsigned)(C_MERGED + 256 * u.pn) * 2u;
        if ((s & 1) == 0) {
#pragma unroll
            for (int ai = 0; ai < 2; ++ai)
#pragma unroll
                for (int m = 0; m < 4; ++m) { unsigned char* rowp = ACTb + (size_t)(row0 + ai * 128 + m * 16) * PITCHB;
#pragma unroll
                    for (int bj = 0; bj < 2; ++bj) { const f32x4 v0 = acc[ai][bj][m][0], v1 = acc[ai][bj][m][1];
                        u32x4 w; w.x = cvt_pk_bf16(v0[0], v0[1]); w.y = cvt_pk_bf16(v0[2], v0[3]); w.z = cvt_pk_bf16(v1[0], v1[1]); w.w = cvt_pk_bf16(v1[2], v1[3]);
                        *(u32x4*)(rowp + soff + (cl0 + bj * 128) * 2) = w; } }
        } else {
#pragma unroll
            for (int ai = 0; ai < 2; ++ai) {
                u32x4 gq[4][2], tq[4][2];
#pragma unroll
                for (int m = 0; m < 4; ++m) { unsigned char* rowp = ACTb + (size_t)(row0 + ai * 128 + m * 16) * PITCHB;
#pragma unroll
                    for (int bj = 0; bj < 2; ++bj) { gq[m][bj] = *(const u32x4*)(rowp + soff + (cl0 + bj * 128) * 2); if (j > 0) tq[m][bj] = *(const u32x4*)(rowp + toff + (cl0 + bj * 128) * 2); } }
#pragma unroll
                for (int m = 0; m < 4; ++m) { unsigned char* rowp = ACTb + (size_t)(row0 + ai * 128 + m * 16) * PITCHB;
#pragma unroll
                    for (int bj = 0; bj < 2; ++bj) { const f32x4 v0 = acc[ai][bj][m][0], v1 = acc[ai][bj][m][1]; const u32x4 g = gq[m][bj];
                        f32x4 t0 = (f32x4){sigmoidf_(bf_lo(g.x)) * v0[0], sigmoidf_(bf_hi(g.x)) * v0[1], sigmoidf_(bf_lo(g.y)) * v0[2], sigmoidf_(bf_hi(g.y)) * v0[3]};
                        f32x4 t1 = (f32x4){sigmoidf_(bf_lo(g.z)) * v1[0], sigmoidf_(bf_hi(g.z)) * v1[1], sigmoidf_(bf_lo(g.w)) * v1[2], sigmoidf_(bf_hi(g.w)) * v1[3]};
                        if (j > 0) { const u32x4 tv = tq[m][bj];
                            t0 = t0 + (f32x4){bf_lo(tv.x), bf_hi(tv.x), bf_lo(tv.y), bf_hi(tv.y)}; t1 = t1 + (f32x4){bf_lo(tv.z), bf_hi(tv.z), bf_lo(tv.w), bf_hi(tv.w)}; }
                        u32x4 w; w.x = cvt_pk_bf16(t0[0], t0[1]); w.y = cvt_pk_bf16(t0[2], t0[3]); w.z = cvt_pk_bf16(t1[0], t1[1]); w.w = cvt_pk_bf16(t1[2], t1[3]);
                        if (j < 2) *(u32x4*)(rowp + toff + (cl0 + bj * 128) * 2) = w; else *(u32x4*)(rowp + moff + (cl0 + bj * 128) * 2) = w;
                    } }
            }
        }
    }
};
struct PanelStats {
    unsigned long long* xbuf;
    unsigned* cnt;
    float eps;
    __device__ __forceinline__ void run(const f32x4 (&v)[2][2][4][2], const pg8::Unit& u, int wr, int wc, int fr, int fq, LAS unsigned char* lds, int wid, int lane) const {
        LAS f32x2* Pt = (LAS f32x2*)lds;
        LAS f32x2* St = (LAS f32x2*)(lds + 8192);
#pragma unroll
        for (int ai = 0; ai < 2; ++ai)
#pragma unroll
            for (int m = 0; m < 4; ++m) {
                float s = 0.f;
#pragma unroll
                for (int bj = 0; bj < 2; ++bj)
#pragma unroll
                    for (int n = 0; n < 2; ++n) { const f32x4 x = v[ai][bj][m][n]; s += (x[0] + x[1]) + (x[2] + x[3]); }
                s += __shfl_xor(s, 16); s += __shfl_xor(s, 32);
                const float mw = s * (1.0f / 64.0f); float q = 0.f;
#pragma unroll
                for (int bj = 0; bj < 2; ++bj)
#pragma unroll
                    for (int n = 0; n < 2; ++n) { const f32x4 d = v[ai][bj][m][n] - mw; q += (d[0] * d[0] + d[1] * d[1]) + (d[2] * d[2] + d[3] * d[3]); }
                q += __shfl_xor(q, 16); q += __shfl_xor(q, 32);
                if (fq == 0) Pt[(ai * 128 + wr * 64 + m * 16 + fr) * 4 + wc] = (f32x2){mw, q};
            }
        __syncthreads();
        const int row = wid * 32 + (lane & 31);
        if (lane < 32) {
            const f32x2 a = Pt[row * 4 + 0], b = Pt[row * 4 + 1], c = Pt[row * 4 + 2], d = Pt[row * 4 + 3];
            const float mt = (a.x + b.x + c.x + d.x) * 0.25f;
            const float da = a.x - mt, db = b.x - mt, dc = c.x - mt, dd = d.x - mt;
            const float m2 = (a.y + b.y) + (c.y + d.y) + 64.0f * ((da * da + db * db) + (dc * dc + dd * dd));
            __hip_atomic_store(xbuf + ((size_t)(u.pm * 256 + row) * 4 + u.pn), ((unsigned long long)__float_as_uint(m2) << 32) | __float_as_uint(mt), __ATOMIC_RELAXED, __HIP_MEMORY_SCOPE_AGENT);
        }
        asm volatile("s_waitcnt vmcnt(0)" ::: "memory");
        if (lane == 0) __hip_atomic_fetch_add(cnt + 64 * u.pm, 1u, __ATOMIC_RELAXED, __HIP_MEMORY_SCOPE_AGENT);
        if (wid == 0) {
            unsigned sp = 0;
            while ((unsigned)__builtin_amdgcn_readfirstlane(__hip_atomic_load(cnt + 64 * u.pm, __ATOMIC_RELAXED, __HIP_MEMORY_SCOPE_AGENT)) < 32u) { __builtin_amdgcn_s_sleep(2); if (++sp > (1u << 24)) break; }
            __builtin_amdgcn_fence(__ATOMIC_ACQUIRE, "agent");
        }
        asm volatile("s_waitcnt vmcnt(0) lgkmcnt(0)" ::: "memory");
        __syncthreads();
        if (lane < 32) {
            const unsigned long long* slot = xbuf + (size_t)(u.pm * 256 + row) * 4; float mt[4], m2[4]; float ms = 0.f;
#pragma unroll
            for (int t = 0; t < 4; ++t) { const unsigned long long w = __hip_atomic_load(slot + t, __ATOMIC_RELAXED, __HIP_MEMORY_SCOPE_AGENT); mt[t] = __uint_as_float((unsigned)w); m2[t] = __uint_as_float((unsigned)(w >> 32)); ms += mt[t]; }
            const float mean = ms * 0.25f; float q = 0.f;
#pragma unroll
            for (int t = 0; t < 4; ++t) { const float dm = mt[t] - mean; q += m2[t] + 256.0f * dm * dm; }
            St[row] = (f32x2){mean, __builtin_amdgcn_rsqf(q * (1.0f / 1024.0f) + eps)};
        }
        __syncthreads();
    }
};
struct EpiP4F {
    static constexpr bool PERM = false, AFTER_DRAIN = true;
    const float* xprev; float* out; const float* gate; const float* lng; const float* lnb; const float* modn; bf16_t* ACT; PanelStats st1, st2;
    __device__ __forceinline__ void fused(f32x4 (&acc)[2][2][4][2], const pg8::Unit& u, int wr, int wc, int fr, int fq, LAS unsigned char* lds, int wid, int lane) const {
        const LAS f32x2* St = (const LAS f32x2*)(lds + 8192);
        const int row0 = u.pm * 256 + wr * 64 + fr, col0 = u.pn * 256 + wc * 32 + 4 * fq;
        const int bidx = (u.pm * 256) / SEQ;
        {
            const float* gp = gate + (size_t)bidx * 3072;
            f32x4 gv[2][2];
#pragma unroll
            for (int bj = 0; bj < 2; ++bj)
#pragma unroll
                for (int n = 0; n < 2; ++n) gv[bj][n] = *(const f32x4*)(gp + col0 + bj * 128 + n * 16) + 1.0f;
#pragma unroll
            for (int ai = 0; ai < 2; ++ai)
#pragma unroll
                for (int m = 0; m < 4; ++m) { const size_t off = (size_t)(row0 + ai * 128 + m * 16) * D_MODEL + col0;
#pragma unroll
                    for (int bj = 0; bj < 2; ++bj)
#pragma unroll
                        for (int n = 0; n < 2; ++n) { const f32x4 xv = ld_nt(xprev + off + bj * 128 + n * 16); acc[ai][bj][m][n] = xv * ALPHA + gv[bj][n] * acc[ai][bj][m][n]; }
                    asm volatile("" : "+v"(acc[ai][0][m][0]), "+v"(acc[ai][0][m][1]), "+v"(acc[ai][1][m][0]), "+v"(acc[ai][1][m][1]));
                    if (m == 3) asm volatile("" ::: "memory"); }
        }
        st1.run(acc, u, wr, wc, fr, fq, lds, wid, lane);
        {
            f32x4 lg[2][2], lb[2][2];
#pragma unroll
            for (int bj = 0; bj < 2; ++bj)
#pragma unroll
                for (int n = 0; n < 2; ++n) { lg[bj][n] = *(const f32x4*)(lng + col0 + bj * 128 + n * 16); lb[bj][n] = *(const f32x4*)(lnb + col0 + bj * 128 + n * 16); }
#pragma unroll
            for (int ai = 0; ai < 2; ++ai)
#pragma unroll
                for (int m = 0; m < 4; ++m) { const int r = ai * 128 + wr * 64 + m * 16 + fr; const f32x2 sr = St[r]; const size_t off = (size_t)(u.pm * 256 + r) * D_MODEL + col0;
#pragma unroll
                    for (int bj = 0; bj < 2; ++bj)
#pragma unroll
                        for (int n = 0; n < 2; ++n) { const f32x4 x1 = (acc[ai][bj][m][n] - sr.x) * sr.y * lg[bj][n] + lb[bj][n]; acc[ai][bj][m][n] = x1;
                            __builtin_nontemporal_store(x1, (f32x4*)(out + off + bj * 128 + n * 16)); }
                    asm volatile("" : "+v"(acc[ai][0][m][0]), "+v"(acc[ai][0][m][1]), "+v"(acc[ai][1][m][0]), "+v"(acc[ai][1][m][1]));
                    asm volatile("" ::: "memory"); }
        }
        if (modn) {
            st2.run(acc, u, wr, wc, fr, fq, lds, wid, lane);
            const float* mp = modn + (size_t)bidx * 3072;
            f32x4 sc[2][2], sh[2][2];
#pragma unroll
            for (int bj = 0; bj < 2; ++bj)
#pragma unroll
                for (int n = 0; n < 2; ++n) { sh[bj][n] = *(const f32x4*)(mp + col0 + bj * 128 + n * 16); sc[bj][n] = *(const f32x4*)(mp + 1024 + col0 + bj * 128 + n * 16) + 1.0f; }
#pragma unroll
            for (int ai = 0; ai < 2; ++ai)
#pragma unroll
                for (int m = 0; m < 4; ++m) { const int r = ai * 128 + wr * 64 + m * 16 + fr; const f32x2 sr = St[r]; bf16_t* hp = ACT + (size_t)(u.pm * 256 + r) * PITCH + C_H + col0;
#pragma unroll
                    for (int bj = 0; bj < 2; ++bj)
#pragma unroll
                        for (int n = 0; n < 2; ++n) { const f32x4 hv = (acc[ai][bj][m][n] - sr.x) * sr.y * sc[bj][n] + sh[bj][n];
                            u32x2 w; w.x = cvt_pk_bf16(hv[0], hv[1]); w.y = cvt_pk_bf16(hv[2], hv[3]); *(u32x2*)(hp + bj * 128 + n * 16) = w; }
                    asm volatile("" ::: "memory"); }
        }
    }
};

__device__ __forceinline__ void transpose_item(const float* W, int N, bf16_t* WT, int ldw, LAS float* scr, int item, int lane, bool conv_perm = false) {
    const int nblk = N / 32, kb = item / nblk, nb = item % nblk, k0 = 64 * kb, n0 = 32 * nb;
    int d0 = n0;
    if (conv_perm && n0 >= 4096 && n0 < 6144) { const int g = (n0 - 4096) >> 9, ch0 = (n0 - 4096) & 511; d0 = 4096 + 256 * ((ch0 >> 7) + ((g & 1) ? 4 : 0)) + 128 * (g >> 1) + (ch0 & 127); }
    const int kr = lane >> 3, n4 = (lane & 7) * 4;
    f32x4 v[8];
#pragma unroll
    for (int i = 0; i < 8; ++i) v[i] = ld_nt(W + (size_t)(k0 + 8 * i + kr) * N + n0 + n4);
#pragma unroll
    for (int i = 0; i < 8; ++i) { LAS float* d = scr + (8 * i + kr) * 33 + n4; d[0] = v[i].x; d[1] = v[i].y; d[2] = v[i].z; d[3] = v[i].w; }
    asm volatile("s_waitcnt lgkmcnt(0)" ::: "memory");
    const int c = lane & 7;
#pragma unroll
    for (int j = 0; j < 4; ++j) { const int n = (lane >> 3) + 8 * j; const LAS float* s = scr + (8 * c) * 33 + n;
        u32x4 o; o.x = cvt_pk_bf16(s[0 * 33], s[1 * 33]); o.y = cvt_pk_bf16(s[2 * 33], s[3 * 33]); o.z = cvt_pk_bf16(s[4 * 33], s[5 * 33]); o.w = cvt_pk_bf16(s[6 * 33], s[7 * 33]);
        *(u32x4*)(WT + (size_t)(d0 + n) * ldw + k0 + 8 * c) = o; }
    asm volatile("s_waitcnt lgkmcnt(0)" ::: "memory");
}

__device__ __forceinline__ void row_standardize(f32x4 (&v)[4]) {
    float s = 0.f;
#pragma unroll
    for (int j = 0; j < 4; ++j) s += (v[j].x + v[j].y) + (v[j].z + v[j].w);
    const float mean = wave_sum(s) * (1.f / D_MODEL); float s2 = 0.f;
#pragma unroll
    for (int j = 0; j < 4; ++j) { v[j] = v[j] - mean; s2 += (v[j].x * v[j].x + v[j].y * v[j].y) + (v[j].z * v[j].z + v[j].w * v[j].w); }
    const float rstd = __builtin_amdgcn_rsqf(wave_sum(s2) * (1.f / D_MODEL) + LN_EPS);
#pragma unroll
    for (int j = 0; j < 4; ++j) v[j] = v[j] * rstd;
}
__device__ __forceinline__ void write_h_row(const f32x4 (&v)[4], const float* modb, bf16_t* hrow, int lane) {
#pragma unroll
    for (int j = 0; j < 4; ++j) { const int col = 4 * (lane + 64 * j);
        const f32x4 sh = *(const f32x4*)(modb + col), sc = *(const f32x4*)(modb + 1024 + col);
        const f32x4 h = v[j] * (sc + 1.0f) + sh;
        u32x2 w; w.x = cvt_pk_bf16(h.x, h.y); w.y = cvt_pk_bf16(h.z, h.w);
        *(u32x2*)(hrow + col) = w; }
}

typedef short v4i16_t __attribute__((ext_vector_type(4)));
__device__ __forceinline__ s16x4 vtr(const LAS bf16_t* p) { return __builtin_bit_cast(s16x4, __builtin_amdgcn_ds_read_tr16_b64_v4i16((LAS v4i16_t*)p)); }
constexpr float STICK_DEAD = -44.0f;
__device__ __forceinline__ void attn_unit(LAS unsigned char* lds, bf16_t* ACT, int b, int h, int qb) {
    const int tid = fresh_tid(), lane = tid & 63, r32 = lane & 31, hi = lane >> 5;
    const int wid = __builtin_amdgcn_readfirstlane(tid >> 6);
    bf16_t* base = ACT + (size_t)b * SEQ * PITCH;
    const int tq0 = qb * 256 + wid * 32, tq = tq0 + r32;
    LAS bf16_t* Kw = (LAS bf16_t*)(lds + wid * 9728);
    LAS bf16_t* Vw = Kw + 32 * 72;
    LAS float* stg = (LAS float*)(lds + wid * 9728);
    bf16x8 qr[4];
#pragma unroll
    for (int d0 = 0; d0 < 4; ++d0) qr[d0] = __builtin_nontemporal_load((const bf16x8*)(base + (size_t)tq * PITCH + C_QA + h * 64 + d0 * 16 + hi * 8));
    f32x16 o0, o1;
#pragma unroll
    for (int r = 0; r < 16; ++r) { o0[r] = 0.f; o1[r] = 0.f; }
    float R = 0.f;
    const int srow = lane >> 3, sch = lane & 7;
    const bf16_t* kg = base + (size_t)srow * PITCH + C_KA + h * 64 + sch * 8;
    const bf16_t* vg = base + (size_t)srow * PITCH + C_VA + h * 64 + sch * 8;
    const LAS bf16_t* vb = Vw + (4 * hi + ((lane & 15) >> 2)) * 80 + 16 * ((lane >> 4) & 1) + 4 * (lane & 3);
    u32x4 kreg[4], vreg[4];
    int kb = tq0;
#pragma unroll
    for (int i = 0; i < 4; ++i) { kreg[i] = *(const u32x4*)(kg + (size_t)(kb + 8 * i) * PITCH); vreg[i] = *(const u32x4*)(vg + (size_t)(kb + 8 * i) * PITCH); }
    for (;;) {
#pragma unroll
        for (int i = 0; i < 4; ++i) { *(LAS u32x4*)(Kw + (srow + 8 * i) * 72 + sch * 8) = kreg[i]; *(LAS u32x4*)(Vw + (srow + 8 * i) * 80 + sch * 8) = vreg[i]; }
        const int kbn = kb - 32;
        if (kbn >= 0) {
#pragma unroll
            for (int i = 0; i < 4; ++i) { kreg[i] = *(const u32x4*)(kg + (size_t)(kbn + 8 * i) * PITCH); vreg[i] = *(const u32x4*)(vg + (size_t)(kbn + 8 * i) * PITCH); }
        }
        f32x16 p0;
#pragma unroll
        for (int r = 0; r < 16; ++r) p0[r] = 0.f;
#pragma unroll
        for (int d0 = 0; d0 < 4; ++d0) {
            const bf16x8 a0 = *(const LAS bf16x8*)(Kw + r32 * 72 + d0 * 16 + hi * 8);
            p0 = __builtin_amdgcn_mfma_f32_32x32x16_bf16(a0, qr[d0], p0, 0, 0, 0);
        }
        float x0[16];
        if (kb < tq0) {
#pragma unroll
            for (int r = 0; r < 16; ++r) { const float z = p0[r]; const float sp = fmaxf(z, 0.f) + lg2(1.0f + ex2(-fabsf(z))); x0[r] = sp; p0[r] = z - sp; }
        } else {
            const int kvl = kb + 4 * hi;
#pragma unroll
            for (int r = 0; r < 16; ++r) { const int kv = kvl + (r & 3) + 8 * (r >> 2);
                const float z = p0[r]; const float sp = fmaxf(z, 0.f) + lg2(1.0f + ex2(-fabsf(z))); const bool ok = kv < tq; x0[r] = ok ? sp : 0.f; p0[r] = ok ? z - sp : -INFINITY; }
        }
        float Gs[4], Gh1[4], Tt[4];
#pragma unroll
        for (int g = 0; g < 4; ++g) Gs[g] = (x0[4 * g] + x0[4 * g + 1]) + (x0[4 * g + 2] + x0[4 * g + 3]);
#pragma unroll
        for (int g = 0; g < 4; ++g) { auto rr = __builtin_amdgcn_permlane32_swap(__float_as_uint(Gs[g]), __float_as_uint(Gs[g]), false, false);
            Gh1[g] = __uint_as_float(rr[1]); Tt[g] = __uint_as_float(rr[0]) + __uint_as_float(rr[1]); }
        float run = R;
#pragma unroll
        for (int g = 3; g >= 0; --g) {
            const float off = hi ? run : run - Gh1[g];
            const int q4 = 4 * g;
            const float s3 = off, s2 = s3 - x0[q4 + 3], s1 = s2 - x0[q4 + 2], s0 = s1 - x0[q4 + 1];
            p0[q4 + 3] = ex2(p0[q4 + 3] + s3); p0[q4 + 2] = ex2(p0[q4 + 2] + s2); p0[q4 + 1] = ex2(p0[q4 + 1] + s1); p0[q4] = ex2(p0[q4] + s0);
            run -= Tt[g];
        }
        R = run;
#pragma unroll
        for (int s = 0; s < 2; ++s) {
            u32x4 w; const int r0 = 8 * s;
            w.x = cvt_pk_bf16(p0[r0], p0[r0 + 1]); w.y = cvt_pk_bf16(p0[r0 + 2], p0[r0 + 3]); w.z = cvt_pk_bf16(p0[r0 + 4], p0[r0 + 5]); w.w = cvt_pk_bf16(p0[r0 + 6], p0[r0 + 7]);
            const bf16x8 af = __builtin_bit_cast(bf16x8, w);
            { const s16x4 lo = vtr(vb + (16 * s) * 80), hh = vtr(vb + (16 * s + 8) * 80);
              const bf16x8 bfr = (bf16x8){lo[0], lo[1], lo[2], lo[3], hh[0], hh[1], hh[2], hh[3]};
              o0 = __builtin_amdgcn_mfma_f32_32x32x16_bf16(af, bfr, o0, 0, 0, 0); }
            { const s16x4 lo = vtr(vb + (16 * s) * 80 + 32), hh = vtr(vb + (16 * s + 8) * 80 + 32);
              const bf16x8 bfr = (bf16x8){lo[0], lo[1], lo[2], lo[3], hh[0], hh[1], hh[2], hh[3]};
              o1 = __builtin_amdgcn_mfma_f32_32x32x16_bf16(af, bfr, o1, 0, 0, 0); }
        }
        if (kbn < 0 || !__any(R > STICK_DEAD)) break;
        kb = kbn;
    }
#pragma unroll
    for (int r = 0; r < 16; ++r) { stg[crow(r, hi) * 68 + r32] = o0[r]; stg[crow(r, hi) * 68 + 32 + r32] = o1[r]; }
    asm volatile("s_waitcnt lgkmcnt(0)" ::: "memory");
#pragma unroll
    for (int i = 0; i < 4; ++i) { const int row = i * 8 + (lane >> 3), ch = lane & 7;
        const f32x4 a = *(const LAS f32x4*)(stg + row * 68 + ch * 8), c = *(const LAS f32x4*)(stg + row * 68 + ch * 8 + 4);
        bf16_t* zp = base + (size_t)(tq0 + row) * PITCH + C_ZA + h * 64 + ch * 8;
        const u32x4 z = __builtin_nontemporal_load((const u32x4*)zp);
        u32x4 w; w.x = cvt_pk_bf16(a.x * bf_lo(z.x), a.y * bf_hi(z.x)); w.y = cvt_pk_bf16(a.z * bf_lo(z.y), a.w * bf_hi(z.y));
        w.z = cvt_pk_bf16(c.x * bf_lo(z.z), c.y * bf_hi(z.z)); w.w = cvt_pk_bf16(c.z * bf_lo(z.w), c.w * bf_hi(z.w));
        *(u32x4*)zp = w; }
    asm volatile("s_waitcnt lgkmcnt(0)" ::: "memory");
}

__device__ __forceinline__ float layer_lb(const float* lower_bounds, int l, int ch) {
    float mx = -INFINITY;
    for (int i = 0; i < DEPTH; ++i) mx = fmaxf(mx, lower_bounds[i * 512 + ch]);
    float den = 0.f, num = 0.f;
    for (int i = 0; i < DEPTH; ++i) { const float e = __expf(lower_bounds[i * 512 + ch] - mx); den += e; if (i >= 1 && i <= l) num += e; }
    return num / den;
}
template <int MODE>
__device__ __forceinline__ void hgrn_pass(LAS unsigned char* lds, bf16_t* ACT, const Params& P, int l, int bh, int c0, int nc) {
    const int tid = fresh_tid(), lane = tid & 63, r32 = lane & 31, hi = lane >> 5;
    const int wid = __builtin_amdgcn_readfirstlane(tid >> 6);
    LAS bf16_t* Q1 = (LAS bf16_t*)(lds);
    LAS bf16_t* Q2 = (LAS bf16_t*)(lds + 17408);
    LAS bf16_t* K2 = (LAS bf16_t*)(lds + 34816);
    LAS float*  OT = (LAS float*)(lds);
    LAS bf16_t* K3T = (LAS bf16_t*)(lds + 52224);
    LAS bf16_t* VT = (LAS bf16_t*)(lds + 70656);
    LAS bf16_t* Pm = (LAS bf16_t*)(lds + 89088);
    LAS bf16_t* ST = (LAS bf16_t*)(lds + 98304);
    LAS float* DEND = (LAS float*)(lds + 133120);
    LAS float* SCX = (LAS float*)(lds + 133632);
    const int d = tid & 127, part = tid >> 7, b = bh >> 2, h = bh & 3, grp = c0 / nc;
    const float lbv = layer_lb(P.lower_bounds, l, h * 128 + d);
    bf16_t* base = ACT + (size_t)b * SEQ * PITCH + h * 128;
    bf16_t* Ug = (bf16_t*)(P.ws + WS_U) + (size_t)bh * 8 * 16384;
    float* Dg = (float*)(P.ws + WS_DEND) + (size_t)bh * 8 * 128;
    const float* nw = P.hgrn_norm_w + l * 128;
    const int tb = wid & 1, eb = wid >> 1;
    bf16_t fin[16], qin[16], vin[16];
#pragma unroll
    for (int i = 0; i < 16; ++i) { const bf16_t* rp = base + (size_t)(c0 * 64 + 16 * part + i) * PITCH + d;
        if (MODE == 1) { fin[i] = __builtin_nontemporal_load(rp + C_FB); vin[i] = __builtin_nontemporal_load(rp + C_IB); qin[i] = __builtin_nontemporal_load(rp + C_QB); }
        else { fin[i] = rp[C_FB]; vin[i] = rp[C_IB]; } }
    f32x16 sa[2];
#pragma unroll
    for (int r = 0; r < 16; ++r) { sa[0][r] = 0.f; sa[1][r] = 0.f; }
    float bsum = 0.f;
    if (MODE == 1) {
        const int d8 = (tid & 15) * 8;
        f32x4 Sp[4][2];
#pragma unroll
        for (int i = 0; i < 4; ++i) { Sp[i][0] = (f32x4){0.f, 0.f, 0.f, 0.f}; Sp[i][1] = (f32x4){0.f, 0.f, 0.f, 0.f}; }
        for (int k = 0; k < grp; ++k) {
            const f32x4 da = *(const f32x4*)(Dg + k * 128 + d8), db = *(const f32x4*)(Dg + k * 128 + d8 + 4);
            u32x4 uv[4];
#pragma unroll
            for (int i = 0; i < 4; ++i) { const int idx = tid + 512 * i; uv[i] = *(const u32x4*)(Ug + (size_t)k * 16384 + (idx >> 4) * 128 + d8); }
#pragma unroll
            for (int i = 0; i < 4; ++i) {
                Sp[i][0] = da * Sp[i][0] + (f32x4){bf_lo(uv[i].x), bf_hi(uv[i].x), bf_lo(uv[i].y), bf_hi(uv[i].y)};
                Sp[i][1] = db * Sp[i][1] + (f32x4){bf_lo(uv[i].z), bf_hi(uv[i].z), bf_lo(uv[i].w), bf_hi(uv[i].w)}; }
        }
#pragma unroll
        for (int i = 0; i < 4; ++i) { const int idx = tid + 512 * i;
            u32x4 v; v.x = cvt_pk_bf16(Sp[i][0][0], Sp[i][0][1]); v.y = cvt_pk_bf16(Sp[i][0][2], Sp[i][0][3]); v.z = cvt_pk_bf16(Sp[i][1][0], Sp[i][1][1]); v.w = cvt_pk_bf16(Sp[i][1][2], Sp[i][1][3]);
            *(LAS u32x4*)(ST + (idx >> 4) * 136 + d8) = v; }
        __syncthreads();
#pragma unroll
        for (int i = 0; i < 2; ++i) { const int db = 2 * (wid & 1) + i;
#pragma unroll
            for (int g = 0; g < 4; ++g) { const u32x2 w = *(const LAS u32x2*)(ST + (32 * eb + r32) * 136 + 32 * db + 8 * g + 4 * hi);
                sa[i][4 * g] = bf_lo(w.x); sa[i][4 * g + 1] = bf_hi(w.x); sa[i][4 * g + 2] = bf_lo(w.y); sa[i][4 * g + 3] = bf_hi(w.y); } }
    }
    for (int ci = 0; ci < nc; ++ci) {
        const int c = c0 + ci;
        float g2[16], kk[16];
        float runb = 0.f;
#pragma unroll
        for (int i = 0; i < 16; ++i) { const float f = lbv + (1.0f - lbv) * sigmoidf_(bf2f(fin[i])); kk[i] = 1.0f - f; runb += lg2(f); g2[i] = runb; }
        SCX[part * 128 + d] = runb;
        __syncthreads();
        const float t0 = SCX[d], t1 = SCX[128 + d], t2 = SCX[256 + d], t3 = SCX[384 + d];
        const float offp = (part > 0 ? t0 : 0.f) + (part > 1 ? t1 : 0.f) + (part > 2 ? t2 : 0.f);
        const float cmid = t0 + t1, bend = (t0 + t1) + (t2 + t3);
        bsum += bend;
        if (part == 0) DEND[d] = ex2(bend);
        {
            unsigned k3w[8], vw[8];
#pragma unroll
            for (int i = 0; i < 16; i += 2) {
                const float B0 = offp + g2[i], B1 = offp + g2[i + 1];
                if (MODE == 1) {
                    const float q0 = bf2f(qin[i]), q1 = bf2f(qin[i + 1]);
                    const int t = 16 * part + i;
                    Q1[t * 136 + d] = (bf16_t)(cvt_pk_bf16(q0 * ex2(B0), 0.f) & 0xffffu); Q1[(t + 1) * 136 + d] = (bf16_t)(cvt_pk_bf16(q1 * ex2(B1), 0.f) & 0xffffu);
                    Q2[t * 136 + d] = (bf16_t)(cvt_pk_bf16(q0 * ex2(B0 - cmid), 0.f) & 0xffffu); Q2[(t + 1) * 136 + d] = (bf16_t)(cvt_pk_bf16(q1 * ex2(B1 - cmid), 0.f) & 0xffffu);
                    K2[t * 136 + d] = (bf16_t)(cvt_pk_bf16(kk[i] * ex2(cmid - B0), 0.f) & 0xffffu); K2[(t + 1) * 136 + d] = (bf16_t)(cvt_pk_bf16(kk[i + 1] * ex2(cmid - B1), 0.f) & 0xffffu);
                }
                k3w[i >> 1] = cvt_pk_bf16(kk[i] * ex2(bend - B0), kk[i + 1] * ex2(bend - B1));
                vw[i >> 1] = (unsigned)vin[i] | ((unsigned)vin[i + 1] << 16);
            }
            *(LAS u32x4*)(K3T + d * 72 + 16 * part) = (u32x4){k3w[0], k3w[1], k3w[2], k3w[3]}; *(LAS u32x4*)(K3T + d * 72 + 16 * part + 8) = (u32x4){k3w[4], k3w[5], k3w[6], k3w[7]};
            *(LAS u32x4*)(VT + d * 72 + 16 * part) = (u32x4){vw[0], vw[1], vw[2], vw[3]}; *(LAS u32x4*)(VT + d * 72 + 16 * part + 8) = (u32x4){vw[4], vw[5], vw[6], vw[7]};
        }
        if (ci + 1 < nc) {
#pragma unroll
            for (int i = 0; i < 16; ++i) { const bf16_t* rp = base + (size_t)((c + 1) * 64 + 16 * part + i) * PITCH + d;
                if (MODE == 1) { fin[i] = __builtin_nontemporal_load(rp + C_FB); vin[i] = __builtin_nontemporal_load(rp + C_IB); qin[i] = __builtin_nontemporal_load(rp + C_QB); }
                else { fin[i] = rp[C_FB]; vin[i] = rp[C_IB]; } }
        }
        __syncthreads();
        if (MODE == 0) {
#pragma unroll
            for (int i = 0; i < 2; ++i) {
                const int db = 2 * (wid & 1) + i;
#pragma unroll
                for (int r = 0; r < 16; ++r) sa[i][r] *= DEND[32 * db + crow(r, hi)];
#pragma unroll
                for (int ks = 0; ks < 4; ++ks) {
                    const bf16x8 a = *(const LAS bf16x8*)(K3T + (32 * db + r32) * 72 + 16 * ks + 8 * hi);
                    const bf16x8 bb = *(const LAS bf16x8*)(VT + (32 * eb + r32) * 72 + 16 * ks + 8 * hi);
                    sa[i] = __builtin_amdgcn_mfma_f32_32x32x16_bf16(a, bb, sa[i], 0, 0, 0);
                }
            }
        } else {
            f32x16 o;
#pragma unroll
            for (int r = 0; r < 16; ++r) o[r] = 0.f;
            if (c > 0) {
#pragma unroll
                for (int ks = 0; ks < 8; ++ks) {
                    const bf16x8 a = *(const LAS bf16x8*)(Q1 + (32 * tb + r32) * 136 + 16 * ks + 8 * hi);
                    const bf16x8 bb = *(const LAS bf16x8*)(ST + (32 * eb + r32) * 136 + 16 * ks + 8 * hi);
                    o = __builtin_amdgcn_mfma_f32_32x32x16_bf16(a, bb, o, 0, 0, 0);
                }
            }
            if (wid < 4) {
                const int stb = wid & 1, ssb = wid >> 1;
                f32x16 sc;
#pragma unroll
                for (int r = 0; r < 16; ++r) sc[r] = 0.f;
                if (!(stb == 0 && ssb == 1)) {
#pragma unroll
                    for (int ks = 0; ks < 8; ++ks) {
                        const bf16x8 a = *(const LAS bf16x8*)(Q2 + (32 * stb + r32) * 136 + 16 * ks + 8 * hi);
                        const bf16x8 bb = *(const LAS bf16x8*)(K2 + (32 * ssb + r32) * 136 + 16 * ks + 8 * hi);
                        sc = __builtin_amdgcn_mfma_f32_32x32x16_bf16(a, bb, sc, 0, 0, 0);
                    }
                }
#pragma unroll
                for (int r = 0; r < 16; ++r) { const int t = 32 * stb + crow(r, hi), s = 32 * ssb + r32;
                    const float v = (s <= t) ? sc[r] : 0.f;
                    Pm[t * 72 + s] = (bf16_t)(cvt_pk_bf16(v, 0.f) & 0xffffu); }
            }
            __syncthreads();
            unsigned zz[8];
#pragma unroll
            for (int i = 0; i < 8; ++i) zz[i] = __builtin_nontemporal_load((const unsigned*)(base + (size_t)(c * 64 + 8 * wid + i) * PITCH + C_ZB + 2 * lane));
#pragma unroll
            for (int ks = 0; ks < 4; ++ks) {
                const bf16x8 a = *(const LAS bf16x8*)(Pm + (32 * tb + r32) * 72 + 16 * ks + 8 * hi);
                const bf16x8 bb = *(const LAS bf16x8*)(VT + (32 * eb + r32) * 72 + 16 * ks + 8 * hi);
                o = __builtin_amdgcn_mfma_f32_32x32x16_bf16(a, bb, o, 0, 0, 0);
            }
#pragma unroll
            for (int r = 0; r < 16; ++r) OT[(32 * tb + crow(r, hi)) * 132 + 32 * eb + r32] = o[r];
            if (ci + 1 < nc) {
#pragma unroll
                for (int i = 0; i < 2; ++i) {
                    const int db = 2 * (wid & 1) + i;
#pragma unroll
                    for (int r = 0; r < 16; ++r) sa[i][r] *= DEND[32 * db + crow(r, hi)];
#pragma unroll
                    for (int ks = 0; ks < 4; ++ks) {
                        const bf16x8 a = *(const LAS bf16x8*)(K3T + (32 * db + r32) * 72 + 16 * ks + 8 * hi);
                        const bf16x8 bb = *(const LAS bf16x8*)(VT + (32 * eb + r32) * 72 + 16 * ks + 8 * hi);
                        sa[i] = __builtin_amdgcn_mfma_f32_32x32x16_bf16(a, bb, sa[i], 0, 0, 0);
                    }
#pragma unroll
                    for (int g = 0; g < 4; ++g) { u32x2 w; w.x = cvt_pk_bf16(sa[i][4 * g], sa[i][4 * g + 1]); w.y = cvt_pk_bf16(sa[i][4 * g + 2], sa[i][4 * g + 3]);
                        *(LAS u32x2*)(ST + (32 * eb + r32) * 136 + 32 * db + 8 * g + 4 * hi) = w; }
                }
            }
            __syncthreads();
            {
                const f32x2 nwv = *(const f32x2*)(nw + 2 * lane);
#pragma unroll
                for (int i = 0; i < 8; ++i) { const int t = 8 * wid + i;
                    const f32x2 v = *(const LAS f32x2*)(OT + t * 132 + 2 * lane);
                    const float ss = wave_sum(v.x * v.x + v.y * v.y);
                    const float rstd = __builtin_amdgcn_rsqf(ss * (1.0f / 128.0f) + RMS_EPS);
                    unsigned* zp = (unsigned*)(base + (size_t)(c * 64 + t) * PITCH + C_ZB + 2 * lane);
                    *zp = cvt_pk_bf16(v.x * rstd * nwv.x * bf_lo(zz[i]), v.y * rstd * nwv.y * bf_hi(zz[i])); }
            }
        }
    }
    if (MODE == 0) {
        __syncthreads();
#pragma unroll
        for (int i = 0; i < 2; ++i) { const int db = 2 * (wid & 1) + i;
#pragma unroll
            for (int g = 0; g < 4; ++g) { u32x2 w; w.x = cvt_pk_bf16(sa[i][4 * g], sa[i][4 * g + 1]); w.y = cvt_pk_bf16(sa[i][4 * g + 2], sa[i][4 * g + 3]);
                *(LAS u32x2*)(ST + (32 * eb + r32) * 136 + 32 * db + 8 * g + 4 * hi) = w; } }
        __syncthreads();
#pragma unroll
        for (int i = 0; i < 4; ++i) { const int idx = tid + 512 * i;
            *(u32x4*)(Ug + (size_t)grp * 16384 + (idx >> 4) * 128 + (idx & 15) * 8) = *(const LAS u32x4*)(ST + (idx >> 4) * 136 + (idx & 15) * 8); }
        if (part == 0) Dg[grp * 128 + d] = ex2(bsum);
    }
    __syncthreads();
}

__device__ __forceinline__ void unpack8(const u32x4 a, float (&o)[8]) {
    o[0] = bf_lo(a.x); o[1] = bf_hi(a.x); o[2] = bf_lo(a.y); o[3] = bf_hi(a.y); o[4] = bf_lo(a.z); o[5] = bf_hi(a.z); o[6] = bf_lo(a.w); o[7] = bf_hi(a.w);
}
__device__ __forceinline__ void conv_item(bf16_t* ACT, const float* cw, int item) {
    const int tid = fresh_tid(), cgp = tid & 63, sub = tid >> 6;
    const int m0 = item * 64 + sub * 8, ch = cgp * 8;
    float w0[8], w1[8], w2[8];
#pragma unroll
    for (int e = 0; e < 8; ++e) { w0[e] = cw[ch + e]; w1[e] = cw[512 + ch + e]; w2[e] = cw[1024 + ch + e]; }
    float p1[8], p2[8];
#pragma unroll
    for (int e = 0; e < 8; ++e) { p1[e] = 0.f; p2[e] = 0.f; }
    if ((m0 % SEQ) != 0) {
        unpack8(*(const u32x4*)(ACT + (size_t)(m0 - 2) * PITCH + C_PU + ch), p2);
        unpack8(*(const u32x4*)(ACT + (size_t)(m0 - 1) * PITCH + C_PU + ch), p1);
    }
    u32x4 pa[8], pzv[8];
#pragma unroll
    for (int i = 0; i < 8; ++i) { const bf16_t* rp = ACT + (size_t)(m0 + i) * PITCH + ch; pa[i] = __builtin_nontemporal_load((const u32x4*)(rp + C_PU)); pzv[i] = __builtin_nontemporal_load((const u32x4*)(rp + C_PZ)); }
#pragma unroll
    for (int i = 0; i < 8; ++i) {
        float pu[8], pz[8], y[8];
        unpack8(pa[i], pu); unpack8(pzv[i], pz);
#pragma unroll
        for (int e = 0; e < 8; ++e) { y[e] = pz[e] * (w0[e] * p2[e] + w1[e] * p1[e] + w2[e] * pu[e]); p2[e] = p1[e]; p1[e] = pu[e]; }
        u32x4 w; w.x = cvt_pk_bf16(y[0], y[1]); w.y = cvt_pk_bf16(y[2], y[3]); w.z = cvt_pk_bf16(y[4], y[5]); w.w = cvt_pk_bf16(y[6], y[7]);
        *(u32x4*)(ACT + (size_t)(m0 + i) * PITCH + C_ZC + ch) = w;
    }
}

__device__ __forceinline__ void convert_weights(const Params& P, int l, LAS unsigned char* lds, int gw, int NGW, int wid, int lane) {
    LAS float* scr = (LAS float*)(lds + wid * 16384);
    unsigned char* ws = P.ws;
    constexpr int I_IN = 16 * (IN_COLS / 32), I_B = 8 * 32, I_O = 16 * 32, I_L = I_IN + 3 * I_B + I_O;
    for (int it = gw; it < I_L; it += NGW) {
        int r = it;
        if (r < I_IN) { transpose_item(P.w_in + (size_t)l * 1024 * IN_COLS, IN_COLS, (bf16_t*)(ws + WS_WIN), 1024, scr, r, lane, true); continue; } r -= I_IN;
        if (r < 3 * I_B) { const int j = r / I_B; transpose_item(P.w_branch + (size_t)(l * 3 + j) * 512 * 1024, 1024, (bf16_t*)(ws + WS_WB) + (size_t)j * 1024 * 1024, 1024, scr, r % I_B, lane); continue; } r -= 3 * I_B;
        transpose_item(P.w_out + (size_t)l * 1024 * 1024, 1024, (bf16_t*)(ws + WS_WO), 1024, scr, r, lane);
    }
}

typedef const __attribute__((address_space(4))) Params* KParamsPtr;
#define XB_TMO      128
#define XB_XCNT(j)  (256  + 64 * (j))
#define XB_XSUB(j)  (1280 + 64 * (j))
#define XB_XGEN(j)  (2304 + 64 * (j))
#define XB_TOP      3328
#define XB_TOPGEN   3392
#define XCD_BAR_WORDS 3456
#define XB_SPIN_CAP (1u << 22)
__device__ __forceinline__ unsigned xb_ld(unsigned* p)              { return __hip_atomic_load(p, __ATOMIC_RELAXED, __HIP_MEMORY_SCOPE_AGENT); }
__device__ __forceinline__ unsigned xb_add(unsigned* p, unsigned v) { return __hip_atomic_fetch_add(p, v, __ATOMIC_RELAXED, __HIP_MEMORY_SCOPE_AGENT); }
__device__ __forceinline__ unsigned xb_xcc_id() { return (unsigned)__builtin_amdgcn_s_getreg((3 << 11) | 20) & 0xFu; }
#define XB_SPIN(cond, bar) do { unsigned _sp = 0; while (cond) { __builtin_amdgcn_s_sleep(1); \
    if ((++_sp & 255u) == 0u) { if (xb_ld(&(bar)[XB_TMO])) break; if (_sp > XB_SPIN_CAP) { atomicAdd(&(bar)[XB_TMO], 1u); break; } } } } while (0)
__device__ __forceinline__ void xcd_barrier_complete(unsigned* bar, unsigned x, unsigned& nloc, unsigned& nx) {
    const unsigned G = gridDim.x * gridDim.y * gridDim.z;
    unsigned sum, cnt, mine, sp = 0u;
    for (;;) {
        sum = 0u; cnt = 0u; mine = 0u;
#pragma unroll
        for (unsigned j = 0; j < 16; ++j) { const unsigned c = xb_ld(&bar[XB_XCNT(j)]); sum += c; cnt += (c > 0u) ? 1u : 0u; mine = (j == x) ? c : mine; }
        if (sum == G) break;
        __builtin_amdgcn_s_sleep(1);
        if ((++sp & 255u) == 0u) { if (xb_ld(&bar[XB_TMO])) break; if (sp > XB_SPIN_CAP) { atomicAdd(&bar[XB_TMO], 1u); break; } }
    }
    nloc = mine > 0u ? mine : 1u; nx = cnt > 0u ? cnt : 1u;
}
__device__ __forceinline__ void xcd_barrier(unsigned* bar, volatile LAS unsigned* st) {
    asm volatile("s_waitcnt vmcnt(0)" ::: "memory");
    __syncthreads();
    if (threadIdx.x == 0) {
        __builtin_amdgcn_s_waitcnt(0);
        const unsigned x = xb_xcc_id();
        unsigned nloc = st[0], nx = st[1];
        if (nloc == 0u) { xcd_barrier_complete(bar, x, nloc, nx); st[0] = nloc; st[1] = nx; }
        const unsigned old = xb_add(&bar[XB_XSUB(x)], 1u);
        const unsigned gen = old / nloc;
        if (old + 1u == (gen + 1u) * nloc) {
            __builtin_amdgcn_fence(__ATOMIC_RELEASE, "agent");
            asm volatile("s_waitcnt vmcnt(0)" ::: "memory");
            const unsigned og = xb_add(&bar[XB_TOP], 1u);
            const unsigned tg = og / nx;
            if (og + 1u == (tg + 1u) * nx) xb_add(&bar[XB_TOPGEN], 1u);
            else XB_SPIN(xb_ld(&bar[XB_TOPGEN]) == tg, bar);
            __builtin_amdgcn_fence(__ATOMIC_ACQUIRE, "agent");
            xb_add(&bar[XB_XGEN(x)], 1u);
            asm volatile("s_waitcnt vmcnt(0)" ::: "memory");
        } else {
            XB_SPIN(xb_ld(&bar[XB_XGEN(x)]) == gen, bar);
            __builtin_amdgcn_fence(__ATOMIC_ACQUIRE, "agent");
            asm volatile("s_waitcnt vmcnt(0)" ::: "memory");
        }
    }
    __syncthreads();
}
#define GRID_SYNC() do { asm volatile("s_waitcnt vmcnt(0) lgkmcnt(0)" ::: "memory"); __syncthreads(); grid.sync(); } while (0)
#define XBAR() do { KParamsPtr qb_ = (KParamsPtr)__builtin_amdgcn_kernarg_segment_ptr(); asm volatile("" : "+s"(qb_)); xcd_barrier((unsigned*)(qb_->ws + WS_CTL), (volatile LAS unsigned*)(lds + LDS_BYTES - 16)); } while (0)
#define PHASE_BEGIN() \
    Params P; { KParamsPtr q_ = (KParamsPtr)__builtin_amdgcn_kernarg_segment_ptr(); asm volatile("" : "+s"(q_)); \
        P.x = q_->x; P.c = q_->c; P.w_mod = q_->w_mod; P.b_mod = q_->b_mod; P.w_in = q_->w_in; P.conv_w = q_->conv_w; P.hgrn_norm_w = q_->hgrn_norm_w; P.lower_bounds = q_->lower_bounds; \
        P.w_branch = q_->w_branch; P.w_out = q_->w_out; P.ln_g = q_->ln_g; P.ln_b = q_->ln_b; P.out = q_->out; P.ws = q_->ws; } \
    int bx = blockIdx.x; asm volatile("" : "+s"(bx)); \
    const int G = gridDim.x; \
    const int vcu = (G % 8 == 0) ? (bx % 8) * (G / 8) + bx / 8 : bx; \
    unsigned char* const ws = P.ws; \
    float* const modp = (float*)(ws + WS_MOD); \
    bf16_t* const ACT = (bf16_t*)(ws + WS_ACT); \
    (void)vcu; (void)modp; (void)ACT;
#define WAVE_IDS() \
    const int tid = fresh_tid(), lane = tid & 63, wid = __builtin_amdgcn_readfirstlane(tid >> 6); \
    const int gw = vcu * 8 + wid, NGW = G * 8; (void)lane; (void)gw; (void)NGW;

__global__ void __launch_bounds__(NTHREADS, 2) fwd_megakernel(Params Pk) {
    extern __shared__ __attribute__((aligned(16))) unsigned char lds_raw[];
    LAS unsigned char* lds = (LAS unsigned char*)lds_raw;
    cg::grid_group grid = cg::this_grid();
    if (__builtin_expect(gridDim.y == 4242u, 0)) GRID_SYNC();
    if (threadIdx.x < 4) ((LAS unsigned*)(lds + LDS_BYTES - 16))[threadIdx.x] = 0u;
    __syncthreads();
    if (threadIdx.x == 0) { KParamsPtr q0_ = (KParamsPtr)__builtin_amdgcn_kernarg_segment_ptr(); (void)xb_add(&((unsigned*)(q0_->ws + WS_CTL))[XB_XCNT(xb_xcc_id())], 1u); }

    {
        PHASE_BEGIN(); WAVE_IDS();
        float* modpart = (float*)(ws + WS_MODP);
        LAS float* red = (LAS float*)lds;
        for (int u = bx; u < DEPTH * 192; u += G) {
            const int l = u / 192, r = u % 192, n = (r >> 2) * 64 + lane, kq = r & 3;
            float accb[8];
#pragma unroll
            for (int b = 0; b < 8; ++b) accb[b] = 0.f;
            const float* wp = P.w_mod + ((size_t)l * 1024 + 256 * kq + 32 * wid) * 3072 + n;
            const float* cp = P.c + 256 * kq + 32 * wid;
#pragma unroll 16
            for (int k = 0; k < 32; ++k) { const float wv = __builtin_nontemporal_load(wp + (size_t)k * 3072);
#pragma unroll
                for (int b = 0; b < 8; ++b) accb[b] += cp[b * 1024 + k] * wv; }
            __syncthreads();
#pragma unroll
            for (int b = 0; b < 8; ++b) red[(wid * 8 + b) * 64 + lane] = accb[b];
            __syncthreads();
            { const int b = wid; float sacc = 0.f;
#pragma unroll
              for (int w = 0; w < 8; ++w) sacc += red[(w * 8 + b) * 64 + lane];
              modpart[(((size_t)kq * DEPTH + l) * 8 + b) * 3072 + n] = sacc; }
        }
        __syncthreads();
        convert_weights(P, 0, lds, gw, NGW, wid, lane);
    }
    XBAR();
    {
        PHASE_BEGIN(); WAVE_IDS();
        const float* modpart = (const float*)(ws + WS_MODP);
        for (int i = bx * NTHREADS + tid; i < DEPTH * 8 * 3072; i += G * NTHREADS) {
            const int l = i / (8 * 3072), n = i % 3072;
            float v = P.b_mod[l * 3072 + n];
#pragma unroll
            for (int kq = 0; kq < 4; ++kq) v += modpart[(size_t)kq * DEPTH * 8 * 3072 + i];
            modp[i] = v;
        }
        LAS float* ms = (LAS float*)lds;
        for (int rg = bx; rg < M_TOK / 64; rg += G) {
            const int b = (rg * 64) / SEQ;
            __syncthreads();
            { const int i4 = tid * 4; f32x4 v = *(const f32x4*)(P.b_mod + i4);
#pragma unroll
              for (int kq = 0; kq < 4; ++kq) v = v + *(const f32x4*)(modpart + ((size_t)kq * DEPTH * 8 + b) * 3072 + i4);
              *(LAS f32x4*)(ms + i4) = v; }
            __syncthreads();
#pragma unroll
            for (int it = 0; it < 2; ++it) {
                f32x4 v[4][4];
#pragma unroll
                for (int q = 0; q < 4; ++q) { const int m = rg * 64 + wid * 8 + it * 4 + q;
#pragma unroll
                    for (int j = 0; j < 4; ++j) v[q][j] = ld_nt(P.x + (size_t)m * D_MODEL + 4 * (lane + 64 * j)); }
#pragma unroll
                for (int q = 0; q < 4; ++q) { const int m = rg * 64 + wid * 8 + it * 4 + q;
                    row_standardize(v[q]);
                    bf16_t* hrow = ACT + (size_t)m * PITCH + C_H;
#pragma unroll
                    for (int j = 0; j < 4; ++j) { const int col = 4 * (lane + 64 * j);
                        const f32x4 sh = *(const LAS f32x4*)(ms + col), sc = *(const LAS f32x4*)(ms + 1024 + col);
                        const f32x4 hv = v[q][j] * (sc + 1.0f) + sh;
                        u32x2 w; w.x = cvt_pk_bf16(hv.x, hv.y); w.y = cvt_pk_bf16(hv.z, hv.w);
                        *(u32x2*)(hrow + col) = w; } }
            }
        }
    }
    XBAR();

    for (int l = 0; l < DEPTH; ++l) {
        {
            PHASE_BEGIN();
            SchedP1 S{(const char*)ACT + C_H * 2, (const char*)(ws + WS_WIN), G, vcu};
            EpiP1 E{ACT};
            pg8::gemm_phase<EpiP1, SchedP1>(lds, (unsigned)PITCHB, 2048u, S, E);
        }
        XBAR();
        {
            PHASE_BEGIN();
            for (int u = bx; u < 256; u += G) hgrn_pass<0>(lds, ACT, P, l, u >> 3, (u & 7) * 4, 4);
        }
        {
            PHASE_BEGIN();
            for (int k = bx; k < 256; k += G) {
                __syncthreads(); attn_unit(lds, ACT, (k & 63) >> 3, k & 7, 7 - (k >> 6));
                const int a2 = 511 - k;
                __syncthreads(); attn_unit(lds, ACT, (a2 & 63) >> 3, a2 & 7, 7 - (a2 >> 6));
            }
            for (int ci = bx; ci < 256; ci += G) conv_item(ACT, P.conv_w + (size_t)l * 3 * 512, ci);
        }
        XBAR();
        {
            PHASE_BEGIN();
            for (int u = bx; u < 256; u += G) hgrn_pass<1>(lds, ACT, P, l, u >> 3, (u & 7) * 4, 4);
        }
        XBAR();
        {
            PHASE_BEGIN();
            SchedP3 S{(const char*)ACT, (const char*)(ws + WS_WIN) + (size_t)MIX_COLS * 2048, (const char*)(ws + WS_WB), G, vcu};
            EpiP3 E{(unsigned char*)ACT};
            pg8::gemm_phase<EpiP3, SchedP3>(lds, (unsigned)PITCHB, 2048u, S, E);
        }
        XBAR();
        {
            PHASE_BEGIN(); WAVE_IDS();
            SchedP4 S{(const char*)ACT, (const char*)(ws + WS_WO), G, vcu};
            unsigned* pc = (unsigned*)(ws + WS_CTL + CTL_PANEL);
            unsigned long long* xb = (unsigned long long*)(ws + WS_X);
            const bool more = (l + 1 < DEPTH);
            PanelStats st1{xb + (size_t)(2 * l) * 65536, pc + (2 * l) * 4096, LN_EPS};
            PanelStats st2{xb + (size_t)(2 * l + 1) * 65536, pc + (2 * l + 1) * 4096, LN_EPS};
            EpiP4F E{l == 0 ? P.x : P.out, P.out, modp + (size_t)l * 8 * 3072 + 2048, P.ln_g + l * 1024, P.ln_b + l * 1024, more ? modp + (size_t)(l + 1) * 8 * 3072 : nullptr, ACT, st1, st2};
            pg8::gemm_phase<EpiP4F, SchedP4>(lds, (unsigned)PITCHB, 2048u, S, E);
            if (more) { __syncthreads(); convert_weights(P, l + 1, lds, gw, NGW, wid, lane); }
        }
        if (l + 1 < DEPTH) XBAR();
    }
}

extern "C" void kernel_launch(void* const* d_in, const int* in_sizes, int n_in, void* d_out, int out_size, void* d_ws, size_t ws_size, hipStream_t stream) {
    static int grid_blocks = 0;
    if (grid_blocks == 0) {
        if (n_in != 12 || out_size != M_TOK * D_MODEL || ws_size < WS_END) { fprintf(stderr, "kernel_launch: unexpected shapes (n_in %d, out %d, ws %zu < %zu)\n", n_in, out_size, ws_size, (size_t)WS_END); grid_blocks = -1; return; }
        int dev = 0, cus = 0, per_cu = 0;
        hipGetDevice(&dev);
        hipDeviceGetAttribute(&cus, hipDeviceAttributeMultiprocessorCount, dev);
        hipFuncSetAttribute((const void*)fwd_megakernel, hipFuncAttributeMaxDynamicSharedMemorySize, LDS_BYTES);
        hipOccupancyMaxActiveBlocksPerMultiprocessor(&per_cu, (const void*)fwd_megakernel, NTHREADS, LDS_BYTES);
        (void)hipGetLastError();
        if (per_cu < 1) per_cu = 1;
        grid_blocks = cus > 256 ? 256 : cus;
        if (grid_blocks != 256) fprintf(stderr, "kernel_launch: %d CUs reported; this kernel is laid out for 256 workgroups\n", cus);
        if (grid_blocks <= 0) grid_blocks = 256;
    }
    if (grid_blocks < 0) return;
    (void)hipMemsetAsync((char*)d_ws + WS_CTL, 0, CTL_BYTES, stream);
    Params p{};
    p.x = (const float*)d_in[0]; p.c = (const float*)d_in[1]; p.w_mod = (const float*)d_in[2]; p.b_mod = (const float*)d_in[3]; p.w_in = (const float*)d_in[4];
    p.conv_w = (const float*)d_in[5]; p.hgrn_norm_w = (const float*)d_in[6]; p.lower_bounds = (const float*)d_in[7]; p.w_branch = (const float*)d_in[8];
    p.w_out = (const float*)d_in[9]; p.ln_g = (const float*)d_in[10]; p.ln_b = (const float*)d_in[11]; p.out = (float*)d_out; p.ws = (unsigned char*)d_ws;
    void* args[] = {&p};
    hipError_t e = hipLaunchCooperativeKernel((const void*)fwd_megakernel, dim3(grid_blocks), dim3(NTHREADS), args, LDS_BYTES, stream);
    if (e != hipSuccess) fprintf(stderr, "cooperative launch failed: %s (grid %d)\n", hipGetErrorString(e), grid_blocks);
}
```

```cpp
#include <hip/hip_runtime.h>
#include <hip/hip_cooperative_groups.h>
#include <cstdio>
#include <cstdint>
namespace cg = cooperative_groups;

#define LAS __attribute__((address_space(3)))
typedef unsigned short bf16_t;
typedef short bf16x8 __attribute__((ext_vector_type(8)));
typedef short s16x4 __attribute__((ext_vector_type(4)));
typedef float f32x2 __attribute__((ext_vector_type(2)));
typedef float f32x4 __attribute__((ext_vector_type(4)));
typedef float f32x16 __attribute__((ext_vector_type(16)));
typedef unsigned u32x2 __attribute__((ext_vector_type(2)));
typedef unsigned u32x4 __attribute__((ext_vector_type(4)));

constexpr int D_MODEL = 1024, BATCH = 8, SEQ = 2048, DEPTH = 2, M_TOK = BATCH * SEQ;
constexpr int IN_COLS = 9216, MIX_COLS = 6144;
constexpr int PITCH = 7168;
constexpr size_t PITCHB = (size_t)PITCH * 2;
constexpr int C_QA = 0, C_KA = 512, C_VA = 1024, C_ZA = 1536, C_QB = 2048, C_FB = 2560, C_IB = 3072, C_ZB = 3584, C_PU = 4096  , C_PZ = 4608  , C_ZC = 5632  , C_H = 6144;
constexpr int C_MERGED = 4096;
constexpr float LN_EPS = 1e-5f, RMS_EPS = 1e-6f;
constexpr float LOG2E = 1.4426950408889634f;
constexpr float QSCALE = 0.125f * LOG2E;
constexpr float ALPHA = 1.4142135623730951f;

constexpr size_t WS_CTL = 0, CTL_BYTES = 65536;
constexpr size_t WS_MOD = 65536;
constexpr size_t WS_DEND = 256u << 10;
constexpr size_t WS_WIN = 1u << 20;
constexpr size_t WIN_L = (size_t)IN_COLS * 1024 * 2;
constexpr size_t WS_WB = WS_WIN + WIN_L;
constexpr size_t WB_L = (size_t)3 * 1024 * 1024 * 2;
constexpr size_t WS_WO = WS_WB + WB_L;
constexpr size_t WO_L = (size_t)1024 * 1024 * 2;
constexpr size_t WS_ACT = WS_WO + WO_L;
constexpr size_t WS_U = WS_ACT + (size_t)M_TOK * PITCHB;
constexpr size_t WS_X = WS_U + (size_t)32 * 32 * 128 * 128 * 2;
constexpr size_t WS_MODP = WS_X + 3 * 524288;
constexpr size_t WS_END = WS_MODP + (size_t)4 * DEPTH * BATCH * 3072 * 4;
constexpr size_t CTL_PANEL = 16384;

constexpr int LDS_BYTES = 147456;
constexpr int NTHREADS = 512;

struct Params {
    const float* x; const float* c; const float* w_mod; const float* b_mod; const float* w_in; const float* conv_w; const float* hgrn_norm_w;
    const float* lower_bounds; const float* w_branch; const float* w_out; const float* ln_g; const float* ln_b; float* out; unsigned char* ws;
};

typedef __bf16 bf16x2_t __attribute__((ext_vector_type(2)));
__device__ __forceinline__ unsigned cvt_pk_bf16(float lo, float hi) { const f32x2 v = {lo, hi}; const bf16x2_t b = __builtin_convertvector(v, bf16x2_t); return __builtin_bit_cast(unsigned, b); }
__device__ __forceinline__ f32x4 ld_nt(const float* p) { return __builtin_nontemporal_load((const f32x4*)p); }
__device__ __forceinline__ float bf_lo(unsigned w) { return __uint_as_float(w << 16); }
__device__ __forceinline__ float bf_hi(unsigned w) { return __uint_as_float(w & 0xffff0000u); }
__device__ __forceinline__ float bf2f(bf16_t v) { return __uint_as_float((unsigned)v << 16); }
__device__ __forceinline__ float ex2(float v) { return __builtin_amdgcn_exp2f(v); }
__device__ __forceinline__ float lg2(float v) { return __builtin_amdgcn_logf(v); }
__device__ __forceinline__ float sigmoidf_(float v) { return __builtin_amdgcn_rcpf(1.0f + ex2(-v * LOG2E)); }
__device__ __forceinline__ float siluf_(float v) { return v * sigmoidf_(v); }
__device__ __forceinline__ float wave_sum(float v) {
#pragma unroll
    for (int o = 1; o < 64; o <<= 1) v += __shfl_xor(v, o);
    return v;
}
__device__ __forceinline__ int fresh_tid() { int t = threadIdx.x; asm volatile("" : "+v"(t)); return t; }
__device__ __forceinline__ int crow(int r, int hi) { return (r & 3) + 8 * (r >> 2) + 4 * hi; }

namespace pg8 {
constexpr int BM = 256, BK = 64, HALF = 128, HTB = HALF * BK * 2, STAGE_BYTES = 8 * HTB;
__device__ __forceinline__ int lds_byte(int r, int c) { const int st = (r >> 4) * 2 + (c >> 5), rr = r & 15, cc = c & 31, ob = rr * 64 + cc * 2; return st * 1024 + (ob ^ (((ob >> 9) & 1) << 5)); }
__device__ __forceinline__ void stage_rc(int b, int& R, int& C) { const int st = b / 1024, sb = b % 1024, swz = sb ^ (((sb >> 9) & 1) << 5); R = (st >> 1) * 16 + swz / 64; C = (st & 1) * 32 + (swz % 64) / 2; }
__device__ __forceinline__ int perm32(int rho) { const int n = rho >> 4, i = rho & 15; return 8 * (i >> 2) + 4 * n + (i & 3); }

struct Unit { const char* a; const char* b; int nt; int pm, pn, j; };

template <class Epi, class Sched>
__device__ __forceinline__ void gemm_phase(LAS unsigned char* lds, const unsigned ldaB, const unsigned ldbB, const Sched& S, const Epi& E) {
    const int tid = fresh_tid(), wid = __builtin_amdgcn_readfirstlane(tid >> 6), lane = tid & 63, wr = wid >> 2, wc = wid & 3, fr = lane & 15, fq = lane >> 4;
    unsigned voffA[2], voffB[2];
#pragma unroll
    for (int i = 0; i < 2; ++i) { int R, C; stage_rc(tid * 16 + i * 8192, R, C); const int Rb = Epi::PERM ? ((R & ~31) + perm32(R & 31)) : R;
        voffA[i] = (unsigned)R * ldaB + (unsigned)C * 2u; voffB[i] = (unsigned)Rb * ldbB + (unsigned)C * 2u; }
    const size_t kstep = (size_t)(BK * 2);
    const size_t hstepA = (size_t)HALF * ldaB, hstepB = (size_t)HALF * ldbB;
    const unsigned ldsw = (unsigned)wid * 1024u;
    const int aoff = lds_byte(wr * 64 + fr, fq * 8), boff = lds_byte(wc * 32 + fr, fq * 8);
#define PG8_SA(b, h) (((b) * 2 + (h)) * HTB)
#define PG8_SB(b, h) ((4 + (b) * 2 + (h)) * HTB)
#define PG8_STAGE(bufoff, gbase, voff) do { _Pragma("unroll") for (int _i = 0; _i < 2; ++_i) \
        __builtin_amdgcn_global_load_lds((const unsigned*)((const char*)(gbase) + (voff)[_i]), (LAS unsigned*)(lds + (bufoff) + ldsw + _i * 8192), 16, 0, 0); } while (0)
#define PG8_LDA(dst, b, h) do { _Pragma("unroll") for (int m = 0; m < 4; ++m) _Pragma("unroll") for (int k = 0; k < 2; ++k) dst[m][k] = *(const LAS bf16x8*)(lds + PG8_SA(b, h) + aoff + m * 2048 + k * 1024); } while (0)
#define PG8_LDB(dst, b, h) do { _Pragma("unroll") for (int n = 0; n < 2; ++n) _Pragma("unroll") for (int k = 0; k < 2; ++k) dst[n][k] = *(const LAS bf16x8*)(lds + PG8_SB(b, h) + boff + n * 2048 + k * 1024); } while (0)
#define PG8_MMA(ai, bj, At, Bt) do { __builtin_amdgcn_s_setprio(1); _Pragma("unroll") for (int m = 0; m < 4; ++m) _Pragma("unroll") for (int n = 0; n < 2; ++n) _Pragma("unroll") for (int k = 0; k < 2; ++k) \
        acc[ai][bj][m][n] = __builtin_amdgcn_mfma_f32_16x16x32_bf16(Bt[n][k], At[m][k], acc[ai][bj][m][n], 0, 0, 0); __builtin_amdgcn_s_setprio(0); } while (0)
#define PG8_WAIT_V(n) asm volatile("s_waitcnt vmcnt(" #n ")" ::: "memory")
#define PG8_WAIT_L(n) asm volatile("s_waitcnt lgkmcnt(" #n ")" ::: "memory")
#define PG8_BAR __builtin_amdgcn_s_barrier()
#define PG8_SCHED __builtin_amdgcn_sched_barrier(0)
    Unit cur, nxt; int ui = 0;
    if (!S.next(0, cur)) return;
    f32x4 acc[2][2][4][2];
#pragma unroll
    for (int a = 0; a < 2; ++a)
#pragma unroll
        for (int b = 0; b < 2; ++b)
#pragma unroll
            for (int m = 0; m < 4; ++m)
#pragma unroll
                for (int n = 0; n < 2; ++n) acc[a][b][m][n] = (f32x4){0.f, 0.f, 0.f, 0.f};
    bf16x8 At[4][2], B0[2][2], B1[2][2];
    const char* cA = cur.a; const char* cB = cur.b;
    PG8_STAGE(PG8_SB(0, 0), cB, voffB); PG8_STAGE(PG8_SB(0, 1), cB + hstepB, voffB); PG8_STAGE(PG8_SA(0, 0), cA, voffA); PG8_STAGE(PG8_SA(0, 1), cA + hstepA, voffA);
    if (wr == 1) PG8_BAR;
    PG8_WAIT_V(2); PG8_BAR;
    PG8_STAGE(PG8_SB(1, 0), cB + kstep, voffB); PG8_STAGE(PG8_SA(1, 0), cA + kstep, voffA); PG8_STAGE(PG8_SB(1, 1), cB + hstepB + kstep, voffB);
    PG8_WAIT_V(6); PG8_BAR;
    for (;;) {
        const bool has_next = S.next(ui + 1, nxt);
        const char* nA = has_next ? nxt.a : cA; const char* nB = has_next ? nxt.b : cB;
        const int nt = cur.nt;
        for (int t = 0; t < nt; t += 2) {
            const bool last = (t == nt - 2);
            const char* a1 = cA + (size_t)(t + 1) * kstep;
            const char* a2 = last ? nA : cA + (size_t)(t + 2) * kstep; const char* b2 = last ? nB : cB + (size_t)(t + 2) * kstep;
            const char* a3 = a2 + kstep; const char* b3 = b2 + kstep;
            PG8_LDB(B0, 0, 0); PG8_LDB(B1, 0, 1); PG8_SCHED; PG8_LDA(At, 0, 0); PG8_STAGE(PG8_SA(1, 1), a1 + hstepA, voffA);
            PG8_WAIT_V(8); PG8_WAIT_L(0); PG8_BAR; PG8_MMA(0, 0, At, B0); PG8_MMA(0, 1, At, B1); PG8_BAR; PG8_SCHED;
            PG8_LDA(At, 0, 1); PG8_STAGE(PG8_SB(0, 0), b2, voffB); PG8_STAGE(PG8_SB(0, 1), b2 + hstepB, voffB); PG8_STAGE(PG8_SA(0, 0), a2, voffA);
            PG8_WAIT_V(8); PG8_WAIT_L(0); PG8_BAR; PG8_MMA(1, 0, At, B0); PG8_MMA(1, 1, At, B1); PG8_BAR; PG8_SCHED;
            PG8_LDB(B0, 1, 0); PG8_LDB(B1, 1, 1); PG8_SCHED; PG8_LDA(At, 1, 0); PG8_STAGE(PG8_SA(0, 1), a2 + hstepA, voffA);
            PG8_WAIT_V(8); PG8_WAIT_L(0); PG8_BAR; PG8_MMA(0, 0, At, B0); PG8_MMA(0, 1, At, B1); PG8_BAR; PG8_SCHED;
            PG8_LDA(At, 1, 1); PG8_STAGE(PG8_SB(1, 0), b3, voffB); PG8_STAGE(PG8_SB(1, 1), b3 + hstepB, voffB); PG8_STAGE(PG8_SA(1, 0), a3, voffA);
            PG8_WAIT_V(8); PG8_WAIT_L(0); PG8_BAR; PG8_MMA(1, 0, At, B0); PG8_MMA(1, 1, At, B1); PG8_BAR; PG8_SCHED;
        }
        if (wr == 0) PG8_BAR;
        if constexpr (!Epi::AFTER_DRAIN) E(acc, cur, wr, wc, fr, fq);
        if (!has_next) break;
#pragma unroll
        for (int a = 0; a < 2; ++a)
#pragma unroll
            for (int b = 0; b < 2; ++b)
#pragma unroll
                for (int m = 0; m < 4; ++m)
#pragma unroll
                    for (int n = 0; n < 2; ++n) acc[a][b][m][n] = (f32x4){0.f, 0.f, 0.f, 0.f};
        cur = nxt; cA = nA; cB = nB; ++ui;
        if (wr == 1) PG8_BAR;
    }
    PG8_WAIT_V(0);
    PG8_BAR;
    if constexpr (Epi::AFTER_DRAIN) E.fused(acc, cur, wr, wc, fr, fq, lds, wid, lane);
#undef PG8_SA
#undef PG8_SB
#undef PG8_STAGE
#undef PG8_LDA
#undef PG8_LDB
#undef PG8_MMA
#undef PG8_WAIT_V
#undef PG8_WAIT_L
#undef PG8_BAR
#undef PG8_SCHED
}
}

struct SchedP1 {
    const char* A; const char* B; int G, vcu;
    __device__ __forceinline__ bool next(int i, pg8::Unit& u) const {
        const int U = i * G + vcu; if (U >= 64 * 24) return false;
        u.pm = 8 * ((U >> 5) & 7) + (U & 7); u.pn = 4 * (U >> 8) + ((U & 31) >> 3); u.j = 0; u.nt = 16;
        u.a = A + (size_t)u.pm * 256 * PITCHB; u.b = B + (size_t)u.pn * 256 * 2048; return true;
    }
};
struct SchedP3 {
    const char* ACTb; const char* Wg; const char* Wb; int G, vcu;
    __device__ __forceinline__ bool next(int i, pg8::Unit& u) const {
        const int T = vcu + (i / 6) * G; if (T >= 256) return false;
        const int s = i % 6; u.pm = 8 * (T >> 5) + (T & 7); u.pn = (T & 31) >> 3; u.j = s;
        const int j = s >> 1;
        if ((s & 1) == 0) { u.nt = 16; u.a = ACTb + (size_t)u.pm * 256 * PITCHB + C_H * 2; u.b = Wg + (size_t)(1024 * j + 256 * u.pn) * 2048; }
        else { u.nt = 8; u.a = ACTb + (size_t)u.pm * 256 * PITCHB + (size_t)(C_ZA + 2048 * j) * 2; u.b = Wb + (size_t)(1024 * j + 256 * u.pn) * 2048; }
        return true;
    }
};
struct SchedP4 {
    const char* ACTb; const char* Wo; int G, vcu;
    __device__ __forceinline__ bool next(int i, pg8::Unit& u) const {
        const int T = vcu + i * G; if (T >= 256) return false;
        u.pm = 8 * (T >> 5) + (T & 7); u.pn = (T & 31) >> 3; u.j = 0; u.nt = 16;
        u.a = ACTb + (size_t)u.pm * 256 * PITCHB + C_MERGED * 2; u.b = Wo + (size_t)(256 * u.pn) * 2048; return true;
    }
};

struct EpiP1 {
    static constexpr bool PERM = true, AFTER_DRAIN = false;
    bf16_t* ACT;
    __device__ __forceinline__ void operator()(const f32x4 (&acc)[2][2][4][2], const pg8::Unit& u, int wr, int wc, int fr, int fq) const {
        const int row0 = u.pm * 256 + wr * 64 + fr;
        if (u.pn >= 16) {
            const int T = u.pn - 16, col0 = (T < 4 ? C_PU + 128 * T : C_PZ + 128 * (T - 4)) + wc * 32 + 8 * fq;
#pragma unroll
            for (int ai = 0; ai < 2; ++ai)
#pragma unroll
                for (int m = 0; m < 4; ++m) { bf16_t* rowp = ACT + (size_t)(row0 + ai * 128 + m * 16) * PITCH + col0;
                    f32x4 v0 = acc[ai][1][m][0], v1 = acc[ai][1][m][1];
                    if (T >= 4) {
#pragma unroll
                        for (int e = 0; e < 4; ++e) { v0[e] = siluf_(v0[e]); v1[e] = siluf_(v1[e]); } }
                    v0 = v0 * acc[ai][0][m][0]; v1 = v1 * acc[ai][0][m][1];
                    u32x4 w; w.x = cvt_pk_bf16(v0[0], v0[1]); w.y = cvt_pk_bf16(v0[2], v0[3]); w.z = cvt_pk_bf16(v1[0], v1[1]); w.w = cvt_pk_bf16(v1[2], v1[3]);
                    *(u32x4*)rowp = w; }
            return;
        }
        const int grp = u.pn >> 1;
        const int kind = (grp == 0) ? 1 : ((grp == 3 || grp == 4 || grp == 7) ? 2 : 0);
        const int col0 = u.pn * 256 + wc * 32 + 8 * fq;
#pragma unroll
        for (int ai = 0; ai < 2; ++ai)
#pragma unroll
            for (int m = 0; m < 4; ++m) { bf16_t* rowp = ACT + (size_t)(row0 + ai * 128 + m * 16) * PITCH + col0;
#pragma unroll
                for (int bj = 0; bj < 2; ++bj) { f32x4 v0 = acc[ai][bj][m][0], v1 = acc[ai][bj][m][1];
                    if (kind == 1) { v0 = v0 * QSCALE; v1 = v1 * QSCALE; }
                    else if (kind == 2) {
#pragma unroll
                        for (int e = 0; e < 4; ++e) { v0[e] = siluf_(v0[e]); v1[e] = siluf_(v1[e]); } }
                    u32x4 w; w.x = cvt_pk_bf16(v0[0], v0[1]); w.y = cvt_pk_bf16(v0[2], v0[3]); w.z = cvt_pk_bf16(v1[0], v1[1]); w.w = cvt_pk_bf16(v1[2], v1[3]);
                    *(u32x4*)(rowp + bj * 128) = w; } }
    }
};
struct EpiP3 {
    static constexpr bool PERM = true, AFTER_DRAIN = false;
    unsigned char* ACTb;
    __device__ __forceinline__ void operator()(const f32x4 (&acc)[2][2][4][2], const pg8::Unit& u, int wr, int wc, int fr, int fq) const {
        const int s = u.j, j = s >> 1;
        const int row0 = u.pm * 256 + wr * 64 + fr, cl0 = wc * 32 + 8 * fq;
        const unsigned toff = 512u * (unsigned)u.pn, soff = 5120u + 512u * (unsigned)u.pn, moff = (unsigned)(C_MERGED + 256 * u.pn) * 2u;
        if ((s & 1) == 0) {
#pragma unroll
            for (int ai = 0; ai < 2; ++ai)
#pragma unroll
                for (int m = 0; m < 4; ++m) { unsigned char* rowp = ACTb + (size_t)(row0 + ai * 128 + m * 16) * PITCHB;
#pragma unroll
                    for (int bj = 0; bj < 2; ++bj) { const f32x4 v0 = acc[ai][bj][m][0], v1 = acc[ai][bj][m][1];
                        u32x4 w; w.x = cvt_pk_bf16(v0[0], v0[1]); w.y = cvt_pk_bf16(v0[2], v0[3]); w.z = cvt_pk_bf16(v1[0], v1[1]); w.w = cvt_pk_bf16(v1[2], v1[3]);
                        *(u32x4*)(rowp + soff + (cl0 + bj * 128) * 2) = w; } }
        } else {
#pragma unroll
            for (int ai = 0; ai < 2; ++ai) {
                u32x4 gq[4][2], tq[4][2];
#pragma unroll
                for (int m = 0; m < 4; ++m) { unsigned char* rowp = ACTb + (size_t)(row0 + ai * 128 + m * 16) * PITCHB;
#pragma unroll
                    for (int bj = 0; bj < 2; ++bj) { gq[m][bj] = *(const u32x4*)(rowp + soff + (cl0 + bj * 128) * 2); if (j > 0) tq[m][bj] = *(const u32x4*)(rowp + toff + (cl0 + bj * 128) * 2); } }
#pragma unroll
                for (int m = 0; m < 4; ++m) { unsigned char* rowp = ACTb + (size_t)(row0 + ai * 128 + m * 16) * PITCHB;
#pragma unroll
                    for (int bj = 0; bj < 2; ++bj) { const f32x4 v0 = acc[ai][bj][m][0], v1 = acc[ai][bj][m][1]; const u32x4 g = gq[m][bj];
                        f32x4 t0 = (f32x4){sigmoidf_(bf_lo(g.x)) * v0[0], sigmoidf_(bf_hi(g.x)) * v0[1], sigmoidf_(bf_lo(g.y)) * v0[2], sigmoidf_(bf_hi(g.y)) * v0[3]};
                        f32x4 t1 = (f32x4){sigmoidf_(bf_lo(g.z)) * v1[0], sigmoidf_(bf_hi(g.z)) * v1[1], sigmoidf_(bf_lo(g.w)) * v1[2], sigmoidf_(bf_hi(g.w)) * v1[3]};
                        if (j > 0) { const u32x4 tv = tq[m][bj];
                            t0 = t0 + (f32x4){bf_lo(tv.x), bf_hi(tv.x), bf_lo(tv.y), bf_hi(tv.y)}; t1 = t1 + (f32x4){bf_lo(tv.z), bf_hi(tv.z), bf_lo(tv.w), bf_hi(tv.w)}; }
                        u32x4 w; w.x = cvt_pk_bf16(t0[0], t0[1]); w.y = cvt_pk_bf16(t0[2], t0[3]); w.z = cvt_pk_bf16(t1[0], t1[1]); w.w = cvt_pk_bf16(t1[2], t1[3]);
                        if (j < 2) *(u32x4*)(rowp + toff + (cl0 + bj * 128) * 2) = w; else *(u32x4*)(rowp + moff + (cl0 + bj * 128) * 2) = w;
                    } }
            }
        }
    }
};
struct PanelStats {
    unsigned long long* xbuf;
    unsigned* cnt;
    float eps;
    __device__ __forceinline__ void run(const f32x4 (&v)[2][2][4][2], const pg8::Unit& u, int wr, int wc, int fr, int fq, LAS unsigned char* lds, int wid, int lane) const {
        LAS f32x2* Pt = (LAS f32x2*)lds;
        LAS f32x2* St = (LAS f32x2*)(lds + 8192);
#pragma unroll
        for (int ai = 0; ai < 2; ++ai)
#pragma unroll
            for (int m = 0; m < 4; ++m) {
                float s = 0.f;
#pragma unroll
                for (int bj = 0; bj < 2; ++bj)
#pragma unroll
                    for (int n = 0; n < 2; ++n) { const f32x4 x = v[ai][bj][m][n]; s += (x[0] + x[1]) + (x[2] + x[3]); }
                s += __shfl_xor(s, 16); s += __shfl_xor(s, 32);
                const float mw = s * (1.0f / 64.0f); float q = 0.f;
#pragma unroll
                for (int bj = 0; bj < 2; ++bj)
#pragma unroll
                    for (int n = 0; n < 2; ++n) { const f32x4 d = v[ai][bj][m][n] - mw; q += (d[0] * d[0] + d[1] * d[1]) + (d[2] * d[2] + d[3] * d[3]); }
                q += __shfl_xor(q, 16); q += __shfl_xor(q, 32);
                if (fq == 0) Pt[(ai * 128 + wr * 64 + m * 16 + fr) * 4 + wc] = (f32x2){mw, q};
            }
        __syncthreads();
        const int row = wid * 32 + (lane & 31);
        if (lane < 32) {
            const f32x2 a = Pt[row * 4 + 0], b = Pt[row * 4 + 1], c = Pt[row * 4 + 2], d = Pt[row * 4 + 3];
            const float mt = (a.x + b.x + c.x + d.x) * 0.25f;
            const float da = a.x - mt, db = b.x - mt, dc = c.x - mt, dd = d.x - mt;
            const float m2 = (a.y + b.y) + (c.y + d.y) + 64.0f * ((da * da + db * db) + (dc * dc + dd * dd));
            __hip_atomic_store(xbuf + ((size_t)(u.pm * 256 + row) * 4 + u.pn), ((unsigned long long)__float_as_uint(m2) << 32) | __float_as_uint(mt), __ATOMIC_RELAXED, __HIP_MEMORY_SCOPE_AGENT);
        }
        asm volatile("s_waitcnt vmcnt(0)" ::: "memory");
        if (lane == 0) __hip_atomic_fetch_add(cnt + 64 * u.pm, 1u, __ATOMIC_RELAXED, __HIP_MEMORY_SCOPE_AGENT);
        if (wid == 0) {
            unsigned sp = 0;
            while ((unsigned)__builtin_amdgcn_readfirstlane(__hip_atomic_load(cnt + 64 * u.pm, __ATOMIC_RELAXED, __HIP_MEMORY_SCOPE_AGENT)) < 32u) { __builtin_amdgcn_s_sleep(2); if (++sp > (1u << 24)) break; }
            __builtin_amdgcn_fence(__ATOMIC_ACQUIRE, "agent");
        }
        asm volatile("s_waitcnt vmcnt(0) lgkmcnt(0)" ::: "memory");
        __syncthreads();
        if (lane < 32) {
            const unsigned long long* slot = xbuf + (size_t)(u.pm * 256 + row) * 4; float mt[4], m2[4]; float ms = 0.f;
#pragma unroll
            for (int t = 0; t < 4; ++t) { const unsigned long long w = __hip_atomic_load(slot + t, __ATOMIC_RELAXED, __HIP_MEMORY_SCOPE_AGENT); mt[t] = __uint_as_float((unsigned)w); m2[t] = __uint_as_float((unsigned)(w >> 32)); ms += mt[t]; }
            const float mean = ms * 0.25f; float q = 0.f;
#pragma unroll
            for (int t = 0; t < 4; ++t) { const float dm = mt[t] - mean; q += m2[t] + 256.0f * dm * dm; }
            St[row] = (f32x2){mean, __builtin_amdgcn_rsqf(q * (1.0f / 1024.0f) + eps)};
        }
        __syncthreads();
    }
};
struct EpiP4F {
    static constexpr bool PERM = false, AFTER_DRAIN = true;
    const float* xprev; float* out; const float* gate; const float* lng; const float* lnb; const float* modn; bf16_t* ACT; PanelStats st1, st2;
    __device__ __forceinline__ void fused(f32x4 (&acc)[2][2][4][2], const pg8::Unit& u, int wr, int wc, int fr, int fq, LAS unsigned char* lds, int wid, int lane) const {
        const LAS f32x2* St = (const LAS f32x2*)(lds + 8192);
        const int row0 = u.pm * 256 + wr * 64 + fr, col0 = u.pn * 256 + wc * 32 + 4 * fq;
        const int bidx = (u.pm * 256) / SEQ;
        {
            const float* gp = gate + (size_t)bidx * 3072;
            f32x4 gv[2][2];
#pragma unroll
            for (int bj = 0; bj < 2; ++bj)
#pragma unroll
                for (int n = 0; n < 2; ++n) gv[bj][n] = *(const f32x4*)(gp + col0 + bj * 128 + n * 16) + 1.0f;
#pragma unroll
            for (int ai = 0; ai < 2; ++ai)
#pragma unroll
                for (int m = 0; m < 4; ++m) { const size_t off = (size_t)(row0 + ai * 128 + m * 16) * D_MODEL + col0;
#pragma unroll
                    for (int bj = 0; bj < 2; ++bj)
#pragma unroll
                        for (int n = 0; n < 2; ++n) { const f32x4 xv = ld_nt(xprev + off + bj * 128 + n * 16); acc[ai][bj][m][n] = xv * ALPHA + gv[bj][n] * acc[ai][bj][m][n]; }
                    asm volatile("" : "+v"(acc[ai][0][m][0]), "+v"(acc[ai][0][m][1]), "+v"(acc[ai][1][m][0]), "+v"(acc[ai][1][m][1]));
                    if (m == 3) asm volatile("" ::: "memory"); }
        }
        st1.run(acc, u, wr, wc, fr, fq, lds, wid, lane);
        {
            f32x4 lg[2][2], lb[2][2];
#pragma unroll
            for (int bj = 0; bj < 2; ++bj)
#pragma unroll
                for (int n = 0; n < 2; ++n) { lg[bj][n] = *(const f32x4*)(lng + col0 + bj * 128 + n * 16); lb[bj][n] = *(const f32x4*)(lnb + col0 + bj * 128 + n * 16); }
#pragma unroll
            for (int ai = 0; ai < 2; ++ai)
#pragma unroll
                for (int m = 0; m < 4; ++m) { const int r = ai * 128 + wr * 64 + m * 16 + fr; const f32x2 sr = St[r]; const size_t off = (size_t)(u.pm * 256 + r) * D_MODEL + col0;
#pragma unroll
                    for (int bj = 0; bj < 2; ++bj)
#pragma unroll
                        for (int n = 0; n < 2; ++n) { const f32x4 x1 = (acc[ai][bj][m][n] - sr.x) * sr.y * lg[bj][n] + lb[bj][n]; acc[ai][bj][m][n] = x1;
                            __builtin_nontemporal_store(x1, (f32x4*)(out + off + bj * 128 + n * 16)); }
                    asm volatile("" : "+v"(acc[ai][0][m][0]), "+v"(acc[ai][0][m][1]), "+v"(acc[ai][1][m][0]), "+v"(acc[ai][1][m][1]));
                    asm volatile("" ::: "memory"); }
        }
        if (modn) {
            st2.run(acc, u, wr, wc, fr, fq, lds, wid, lane);
            const float* mp = modn + (size_t)bidx * 3072;
            f32x4 sc[2][2], sh[2][2];
#pragma unroll
            for (int bj = 0; bj < 2; ++bj)
#pragma unroll
                for (int n = 0; n < 2; ++n) { sh[bj][n] = *(const f32x4*)(mp + col0 + bj * 128 + n * 16); sc[bj][n] = *(const f32x4*)(mp + 1024 + col0 + bj * 128 + n * 16) + 1.0f; }
#pragma unroll
            for (int ai = 0; ai < 2; ++ai)
#pragma unroll
                for (int m = 0; m < 4; ++m) { const int r = ai * 128 + wr * 64 + m * 16 + fr; const f32x2 sr = St[r]; bf16_t* hp = ACT + (size_t)(u.pm * 256 + r) * PITCH + C_H + col0;
#pragma unroll
                    for (int bj = 0; bj < 2; ++bj)
#pragma unroll
                        for (int n = 0; n < 2; ++n) { const f32x4 hv = (acc[ai][bj][m][n] - sr.x) * sr.y * sc[bj][n] + sh[bj][n];
                            u32x2 w; w.x = cvt_pk_bf16(hv[0], hv[1]); w.y = cvt_pk_bf16(hv[2], hv[3]); *(u32x2*)(hp + bj * 128 + n * 16) = w; }
                    asm volatile("" ::: "memory"); }
        }
    }
};

__device__ __forceinline__ void transpose_item(const float* W, int N, bf16_t* WT, int ldw, LAS float* scr, int item, int lane, bool conv_perm = false) {
    const int nblk = N / 32, kb = item / nblk, nb = item % nblk, k0 = 64 * kb, n0 = 32 * nb;
    int d0 = n0;
    if (conv_perm && n0 >= 4096 && n0 < 6144) { const int g = (n0 - 4096) >> 9, ch0 = (n0 - 4096) & 511; d0 = 4096 + 256 * ((ch0 >> 7) + ((g & 1) ? 4 : 0)) + 128 * (g >> 1) + (ch0 & 127); }
    const int kr = lane >> 3, n4 = (lane & 7) * 4;
    f32x4 v[8];
#pragma unroll
    for (int i = 0; i < 8; ++i) v[i] = ld_nt(W + (size_t)(k0 + 8 * i + kr) * N + n0 + n4);
#pragma unroll
    for (int i = 0; i < 8; ++i) { LAS float* d = scr + (8 * i + kr) * 33 + n4; d[0] = v[i].x; d[1] = v[i].y; d[2] = v[i].z; d[3] = v[i].w; }
    asm volatile("s_waitcnt lgkmcnt(0)" ::: "memory");
    const int c = lane & 7;
#pragma unroll
    for (int j = 0; j < 4; ++j) { const int n = (lane >> 3) + 8 * j; const LAS float* s = scr + (8 * c) * 33 + n;
        u32x4 o; o.x = cvt_pk_bf16(s[0 * 33], s[1 * 33]); o.y = cvt_pk_bf16(s[2 * 33], s[3 * 33]); o.z = cvt_pk_bf16(s[4 * 33], s[5 * 33]); o.w = cvt_pk_bf16(s[6 * 33], s[7 * 33]);
        *(u32x4*)(WT + (size_t)(d0 + n) * ldw + k0 + 8 * c) = o; }
    asm volatile("s_waitcnt lgkmcnt(0)" ::: "memory");
}

__device__ __forceinline__ void row_standardize(f32x4 (&v)[4]) {
    float s = 0.f;
#pragma unroll
    for (int j = 0; j < 4; ++j) s += (v[j].x + v[j].y) + (v[j].z + v[j].w);
    const float mean = wave_sum(s) * (1.f / D_MODEL); float s2 = 0.f;
#pragma unroll
    for (int j = 0; j < 4; ++j) { v[j] = v[j] - mean; s2 += (v[j].x * v[j].x + v[j].y * v[j].y) + (v[j].z * v[j].z + v[j].w * v[j].w); }
    const float rstd = __builtin_amdgcn_rsqf(wave_sum(s2) * (1.f / D_MODEL) + LN_EPS);
#pragma unroll
    for (int j = 0; j < 4; ++j) v[j] = v[j] * rstd;
}
__device__ __forceinline__ void write_h_row(const f32x4 (&v)[4], const float* modb, bf16_t* hrow, int lane) {
#pragma unroll
    for (int j = 0; j < 4; ++j) { const int col = 4 * (lane + 64 * j);
        const f32x4 sh = *(const f32x4*)(modb + col), sc = *(const f32x4*)(modb + 1024 + col);
        const f32x4 h = v[j] * (sc + 1.0f) + sh;
        u32x2 w; w.x = cvt_pk_bf16(h.x, h.y); w.y = cvt_pk_bf16(h.z, h.w);
        *(u32x2*)(hrow + col) = w; }
}

typedef short v4i16_t __attribute__((ext_vector_type(4)));
__device__ __forceinline__ s16x4 vtr(const LAS bf16_t* p) { return __builtin_bit_cast(s16x4, __builtin_amdgcn_ds_read_tr16_b64_v4i16((LAS v4i16_t*)p)); }
constexpr float STICK_DEAD = -44.0f;
__device__ __forceinline__ void attn_unit(LAS unsigned char* lds, bf16_t* ACT, int b, int h, int qb) {
    const int tid = fresh_tid(), lane = tid & 63, r32 = lane & 31, hi = lane >> 5;
    const int wid = __builtin_amdgcn_readfirstlane(tid >> 6);
    bf16_t* base = ACT + (size_t)b * SEQ * PITCH;
    const int tq0 = qb * 256 + wid * 32, tq = tq0 + r32;
    LAS bf16_t* Kw = (LAS bf16_t*)(lds + wid * 9728);
    LAS bf16_t* Vw = Kw + 32 * 72;
    LAS float* stg = (LAS float*)(lds + wid * 9728);
    bf16x8 qr[4];
#pragma unroll
    for (int d0 = 0; d0 < 4; ++d0) qr[d0] = __builtin_nontemporal_load((const bf16x8*)(base + (size_t)tq * PITCH + C_QA + h * 64 + d0 * 16 + hi * 8));
    f32x16 o0, o1;
#pragma unroll
    for (int r = 0; r < 16; ++r) { o0[r] = 0.f; o1[r] = 0.f; }
    float R = 0.f;
    const int srow = lane >> 3, sch = lane & 7;
    const bf16_t* kg = base + (size_t)srow * PITCH + C_KA + h * 64 + sch * 8;
    const bf16_t* vg = base + (size_t)srow * PITCH + C_VA + h * 64 + sch * 8;
    const LAS bf16_t* vb = Vw + (4 * hi + ((lane & 15) >> 2)) * 80 + 16 * ((lane >> 4) & 1) + 4 * (lane & 3);
    u32x4 kreg[4], vreg[4];
    int kb = tq0;
#pragma unroll
    for (int i = 0; i < 4; ++i) { kreg[i] = *(const u32x4*)(kg + (size_t)(kb + 8 * i) * PITCH); vreg[i] = *(const u32x4*)(vg + (size_t)(kb + 8 * i) * PITCH); }
    for (;;) {
#pragma unroll
        for (int i = 0; i < 4; ++i) { *(LAS u32x4*)(Kw + (srow + 8 * i) * 72 + sch * 8) = kreg[i]; *(LAS u32x4*)(Vw + (srow + 8 * i) * 80 + sch * 8) = vreg[i]; }
        const int kbn = kb - 32;
        if (kbn >= 0) {
#pragma unroll
            for (int i = 0; i < 4; ++i) { kreg[i] = *(const u32x4*)(kg + (size_t)(kbn + 8 * i) * PITCH); vreg[i] = *(const u32x4*)(vg + (size_t)(kbn + 8 * i) * PITCH); }
        }
        f32x16 p0;
#pragma unroll
        for (int r = 0; r < 16; ++r) p0[r] = 0.f;
#pragma unroll
        for (int d0 = 0; d0 < 4; ++d0) {
            const bf16x8 a0 = *(const LAS bf16x8*)(Kw + r32 * 72 + d0 * 16 + hi * 8);
            p0 = __builtin_amdgcn_mfma_f32_32x32x16_bf16(a0, qr[d0], p0, 0, 0, 0);
        }
        float x0[16];
        if (kb < tq0) {
#pragma unroll
            for (int r = 0; r < 16; ++r) { const float z = p0[r]; const float sp = fmaxf(z, 0.f) + lg2(1.0f + ex2(-fabsf(z))); x0[r] = sp; p0[r] = z - sp; }
        } else {
            const int kvl = kb + 4 * hi;
#pragma unroll
            for (int r = 0; r < 16; ++r) { const int kv = kvl + (r & 3) + 8 * (r >> 2);
                const float z = p0[r]; const float sp = fmaxf(z, 0.f) + lg2(1.0f + ex2(-fabsf(z))); const bool ok = kv < tq; x0[r] = ok ? sp : 0.f; p0[r] = ok ? z - sp : -INFINITY; }
        }
        float Gs[4], Gh1[4], Tt[4];
#pragma unroll
        for (int g = 0; g < 4; ++g) Gs[g] = (x0[4 * g] + x0[4 * g + 1]) + (x0[4 * g + 2] + x0[4 * g + 3]);
#pragma unroll
        for (int g = 0; g < 4; ++g) { auto rr = __builtin_amdgcn_permlane32_swap(__float_as_uint(Gs[g]), __float_as_uint(Gs[g]), false, false);
            Gh1[g] = __uint_as_float(rr[1]); Tt[g] = __uint_as_float(rr[0]) + __uint_as_float(rr[1]); }
        float run = R;
#pragma unroll
        for (int g = 3; g >= 0; --g) {
            const float off = hi ? run : run - Gh1[g];
            const int q4 = 4 * g;
            const float s3 = off, s2 = s3 - x0[q4 + 3], s1 = s2 - x0[q4 + 2], s0 = s1 - x0[q4 + 1];
            p0[q4 + 3] = ex2(p0[q4 + 3] + s3); p0[q4 + 2] = ex2(p0[q4 + 2] + s2); p0[q4 + 1] = ex2(p0[q4 + 1] + s1); p0[q4] = ex2(p0[q4] + s0);
            run -= Tt[g];
        }
        R = run;
#pragma unroll
        for (int s = 0; s < 2; ++s) {
            u32x4 w; const int r0 = 8 * s;
            w.x = cvt_pk_bf16(p0[r0], p0[r0 + 1]); w.y = cvt_pk_bf16(p0[r0 + 2], p0[r0 + 3]); w.z = cvt_pk_bf16(p0[r0 + 4], p0[r0 + 5]); w.w = cvt_pk_bf16(p0[r0 + 6], p0[r0 + 7]);
            const bf16x8 af = __builtin_bit_cast(bf16x8, w);
            { const s16x4 lo = vtr(vb + (16 * s) * 80), hh = vtr(vb + (16 * s + 8) * 80);
              const bf16x8 bfr = (bf16x8){lo[0], lo[1], lo[2], lo[3], hh[0], hh[1], hh[2], hh[3]};
              o0 = __builtin_amdgcn_mfma_f32_32x32x16_bf16(af, bfr, o0, 0, 0, 0); }
            { const s16x4 lo = vtr(vb + (16 * s) * 80 + 32), hh = vtr(vb + (16 * s + 8) * 80 + 32);
              const bf16x8 bfr = (bf16x8){lo[0], lo[1], lo[2], lo[3], hh[0], hh[1], hh[2], hh[3]};
              o1 = __builtin_amdgcn_mfma_f32_32x32x16_bf16(af, bfr, o1, 0, 0, 0); }
        }
        if (kbn < 0 || !__any(R > STICK_DEAD)) break;
        kb = kbn;
    }
#pragma unroll
    for (int r = 0; r < 16; ++r) { stg[crow(r, hi) * 68 + r32] = o0[r]; stg[crow(r, hi) * 68 + 32 + r32] = o1[r]; }
    asm volatile("s_waitcnt lgkmcnt(0)" ::: "memory");
#pragma unroll
    for (int i = 0; i < 4; ++i) { const int row = i * 8 + (lane >> 3), ch = lane & 7;
        const f32x4 a = *(const LAS f32x4*)(stg + row * 68 + ch * 8), c = *(const LAS f32x4*)(stg + row * 68 + ch * 8 + 4);
        bf16_t* zp = base + (size_t)(tq0 + row) * PITCH + C_ZA + h * 64 + ch * 8;
        const u32x4 z = __builtin_nontemporal_load((const u32x4*)zp);
        u32x4 w; w.x = cvt_pk_bf16(a.x * bf_lo(z.x), a.y * bf_hi(z.x)); w.y = cvt_pk_bf16(a.z * bf_lo(z.y), a.w * bf_hi(z.y));
        w.z = cvt_pk_bf16(c.x * bf_lo(z.z), c.y * bf_hi(z.z)); w.w = cvt_pk_bf16(c.z * bf_lo(z.w), c.w * bf_hi(z.w));
        *(u32x4*)zp = w; }
    asm volatile("s_waitcnt lgkmcnt(0)" ::: "memory");
}

__device__ __forceinline__ float layer_lb(const float* lower_bounds, int l, int ch) {
    float mx = -INFINITY;
    for (int i = 0; i < DEPTH; ++i) mx = fmaxf(mx, lower_bounds[i * 512 + ch]);
    float den = 0.f, num = 0.f;
    for (int i = 0; i < DEPTH; ++i) { const float e = __expf(lower_bounds[i * 512 + ch] - mx); den += e; if (i >= 1 && i <= l) num += e; }
    return num / den;
}
template <int MODE>
__device__ __forceinline__ void hgrn_pass(LAS unsigned char* lds, bf16_t* ACT, const Params& P, int l, int bh, int c0, int nc) {
    const int tid = fresh_tid(), lane = tid & 63, r32 = lane & 31, hi = lane >> 5;
    const int wid = __builtin_amdgcn_readfirstlane(tid >> 6);
    LAS bf16_t* Q1 = (LAS bf16_t*)(lds);
    LAS bf16_t* Q2 = (LAS bf16_t*)(lds + 17408);
    LAS bf16_t* K2 = (LAS bf16_t*)(lds + 34816);
    LAS float*  OT = (LAS float*)(lds);
    LAS bf16_t* K3T = (LAS bf16_t*)(lds + 52224);
    LAS bf16_t* VT = (LAS bf16_t*)(lds + 70656);
    LAS bf16_t* Pm = (LAS bf16_t*)(lds + 89088);
    LAS bf16_t* ST = (LAS bf16_t*)(lds + 98304);
    LAS float* DEND = (LAS float*)(lds + 133120);
    LAS float* SCX = (LAS float*)(lds + 133632);
    const int d = tid & 127, part = tid >> 7, b = bh >> 2, h = bh & 3, grp = c0 / nc;
    const float lbv = layer_lb(P.lower_bounds, l, h * 128 + d);
    bf16_t* base = ACT + (size_t)b * SEQ * PITCH + h * 128;
    bf16_t* Ug = (bf16_t*)(P.ws + WS_U) + (size_t)bh * 8 * 16384;
    float* Dg = (float*)(P.ws + WS_DEND) + (size_t)bh * 8 * 128;
    const float* nw = P.hgrn_norm_w + l * 128;
    const int tb = wid & 1, eb = wid >> 1;
    bf16_t fin[16], qin[16], vin[16];
#pragma unroll
    for (int i = 0; i < 16; ++i) { const bf16_t* rp = base + (size_t)(c0 * 64 + 16 * part + i) * PITCH + d;
        if (MODE == 1) { fin[i] = __builtin_nontemporal_load(rp + C_FB); vin[i] = __builtin_nontemporal_load(rp + C_IB); qin[i] = __builtin_nontemporal_load(rp + C_QB); }
        else { fin[i] = rp[C_FB]; vin[i] = rp[C_IB]; } }
    f32x16 sa[2];
#pragma unroll
    for (int r = 0; r < 16; ++r) { sa[0][r] = 0.f; sa[1][r] = 0.f; }
    float bsum = 0.f;
    if (MODE == 1) {
        const int d8 = (tid & 15) * 8;
        f32x4 Sp[4][2];
#pragma unroll
        for (int i = 0; i < 4; ++i) { Sp[i][0] = (f32x4){0.f, 0.f, 0.f, 0.f}; Sp[i][1] = (f32x4){0.f, 0.f, 0.f, 0.f}; }
        for (int k = 0; k < grp; ++k) {
            const f32x4 da = *(const f32x4*)(Dg + k * 128 + d8), db = *(const f32x4*)(Dg + k * 128 + d8 + 4);
            u32x4 uv[4];
#pragma unroll
            for (int i = 0; i < 4; ++i) { const int idx = tid + 512 * i; uv[i] = *(const u32x4*)(Ug + (size_t)k * 16384 + (idx >> 4) * 128 + d8); }
#pragma unroll
            for (int i = 0; i < 4; ++i) {
                Sp[i][0] = da * Sp[i][0] + (f32x4){bf_lo(uv[i].x), bf_hi(uv[i].x), bf_lo(uv[i].y), bf_hi(uv[i].y)};
                Sp[i][1] = db * Sp[i][1] + (f32x4){bf_lo(uv[i].z), bf_hi(uv[i].z), bf_lo(uv[i].w), bf_hi(uv[i].w)}; }
        }
#pragma unroll
        for (int i = 0; i < 4; ++i) { const int idx = tid + 512 * i;
            u32x4 v; v.x = cvt_pk_bf16(Sp[i][0][0], Sp[i][0][1]); v.y = cvt_pk_bf16(Sp[i][0][2], Sp[i][0][3]); v.z = cvt_pk_bf16(Sp[i][1][0], Sp[i][1][1]); v.w = cvt_pk_bf16(Sp[i][1][2], Sp[i][1][3]);
            *(LAS u32x4*)(ST + (idx >> 4) * 136 + d8) = v; }
        __syncthreads();
#pragma unroll
        for (int i = 0; i < 2; ++i) { const int db = 2 * (wid & 1) + i;
#pragma unroll
            for (int g = 0; g < 4; ++g) { const u32x2 w = *(const LAS u32x2*)(ST + (32 * eb + r32) * 136 + 32 * db + 8 * g + 4 * hi);
                sa[i][4 * g] = bf_lo(w.x); sa[i][4 * g + 1] = bf_hi(w.x); sa[i][4 * g + 2] = bf_lo(w.y); sa[i][4 * g + 3] = bf_hi(w.y); } }
    }
    for (int ci = 0; ci < nc; ++ci) {
        const int c = c0 + ci;
        float g2[16], kk[16];
        float runb = 0.f;
#pragma unroll
        for (int i = 0; i < 16; ++i) { const float f = lbv + (1.0f - lbv) * sigmoidf_(bf2f(fin[i])); kk[i] = 1.0f - f; runb += lg2(f); g2[i] = runb; }
        SCX[part * 128 + d] = runb;
        __syncthreads();
        const float t0 = SCX[d], t1 = SCX[128 + d], t2 = SCX[256 + d], t3 = SCX[384 + d];
        const float offp = (part > 0 ? t0 : 0.f) + (part > 1 ? t1 : 0.f) + (part > 2 ? t2 : 0.f);
        const float cmid = t0 + t1, bend = (t0 + t1) + (t2 + t3);
        bsum += bend;
        if (part == 0) DEND[d] = ex2(bend);
        {
            unsigned k3w[8], vw[8];
#pragma unroll
            for (int i = 0; i < 16; i += 2) {
                const float B0 = offp + g2[i], B1 = offp + g2[i + 1];
                if (MODE == 1) {
                    const float q0 = bf2f(qin[i]), q1 = bf2f(qin[i + 1]);
                    const int t = 16 * part + i;
                    Q1[t * 136 + d] = (bf16_t)(cvt_pk_bf16(q0 * ex2(B0), 0.f) & 0xffffu); Q1[(t + 1) * 136 + d] = (bf16_t)(cvt_pk_bf16(q1 * ex2(B1), 0.f) & 0xffffu);
                    Q2[t * 136 + d] = (bf16_t)(cvt_pk_bf16(q0 * ex2(B0 - cmid), 0.f) & 0xffffu); Q2[(t + 1) * 136 + d] = (bf16_t)(cvt_pk_bf16(q1 * ex2(B1 - cmid), 0.f) & 0xffffu);
                    K2[t * 136 + d] = (bf16_t)(cvt_pk_bf16(kk[i] * ex2(cmid - B0), 0.f) & 0xffffu); K2[(t + 1) * 136 + d] = (bf16_t)(cvt_pk_bf16(kk[i + 1] * ex2(cmid - B1), 0.f) & 0xffffu);
                }
                k3w[i >> 1] = cvt_pk_bf16(kk[i] * ex2(bend - B0), kk[i + 1] * ex2(bend - B1));
                vw[i >> 1] = (unsigned)vin[i] | ((unsigned)vin[i + 1] << 16);
            }
            *(LAS u32x4*)(K3T + d * 72 + 16 * part) = (u32x4){k3w[0], k3w[1], k3w[2], k3w[3]}; *(LAS u32x4*)(K3T + d * 72 + 16 * part + 8) = (u32x4){k3w[4], k3w[5], k3w[6], k3w[7]};
            *(LAS u32x4*)(VT + d * 72 + 16 * part) = (u32x4){vw[0], vw[1], vw[2], vw[3]}; *(LAS u32x4*)(VT + d * 72 + 16 * part + 8) = (u32x4){vw[4], vw[5], vw[6], vw[7]};
        }
        if (ci + 1 < nc) {
#pragma unroll
            for (int i = 0; i < 16; ++i) { const bf16_t* rp = base + (size_t)((c + 1) * 64 + 16 * part + i) * PITCH + d;
                if (MODE == 1) { fin[i] = __builtin_nontemporal_load(rp + C_FB); vin[i] = __builtin_nontemporal_load(rp + C_IB); qin[i] = __builtin_nontemporal_load(rp + C_QB); }
                else { fin[i] = rp[C_FB]; vin[i] = rp[C_IB]; } }
        }
        __syncthreads();
        if (MODE == 0) {
#pragma unroll
            for (int i = 0; i < 2; ++i) {
                const int db = 2 * (wid & 1) + i;
#pragma unroll
                for (int r = 0; r < 16; ++r) sa[i][r] *= DEND[32 * db + crow(r, hi)];
#pragma unroll
                for (int ks = 0; ks < 4; ++ks) {
                    const bf16x8 a = *(const LAS bf16x8*)(K3T + (32 * db + r32) * 72 + 16 * ks + 8 * hi);
                    const bf16x8 bb = *(const LAS bf16x8*)(VT + (32 * eb + r32) * 72 + 16 * ks + 8 * hi);
                    sa[i] = __builtin_amdgcn_mfma_f32_32x32x16_bf16(a, bb, sa[i], 0, 0, 0);
                }
            }
        } else {
            f32x16 o;
#pragma unroll
            for (int r = 0; r < 16; ++r) o[r] = 0.f;
            if (c > 0) {
#pragma unroll
                for (int ks = 0; ks < 8; ++ks) {
                    const bf16x8 a = *(const LAS bf16x8*)(Q1 + (32 * tb + r32) * 136 + 16 * ks + 8 * hi);
                    const bf16x8 bb = *(const LAS bf16x8*)(ST + (32 * eb + r32) * 136 + 16 * ks + 8 * hi);
                    o = __builtin_amdgcn_mfma_f32_32x32x16_bf16(a, bb, o, 0, 0, 0);
                }
            }
            if (wid < 4) {
                const int stb = wid & 1, ssb = wid >> 1;
                f32x16 sc;
#pragma unroll
                for (int r = 0; r < 16; ++r) sc[r] = 0.f;
                if (!(stb == 0 && ssb == 1)) {
#pragma unroll
                    for (int ks = 0; ks < 8; ++ks) {
                        const bf16x8 a = *(const LAS bf16x8*)(Q2 + (32 * stb + r32) * 136 + 16 * ks + 8 * hi);
                        const bf16x8 bb = *(const LAS bf16x8*)(K2 + (32 * ssb + r32) * 136 + 16 * ks + 8 * hi);
                        sc = __builtin_amdgcn_mfma_f32_32x32x16_bf16(a, bb, sc, 0, 0, 0);
                    }
                }
#pragma unroll
                for (int r = 0; r < 16; ++r) { const int t = 32 * stb + crow(r, hi), s = 32 * ssb + r32;
                    const float v = (s <= t) ? sc[r] : 0.f;
                    Pm[t * 72 + s] = (bf16_t)(cvt_pk_bf16(v, 0.f) & 0xffffu); }
            }
            __syncthreads();
            unsigned zz[8];
#pragma unroll
            for (int i = 0; i < 8; ++i) zz[i] = __builtin_nontemporal_load((const unsigned*)(base + (size_t)(c * 64 + 8 * wid + i) * PITCH + C_ZB + 2 * lane));
#pragma unroll
            for (int ks = 0; ks < 4; ++ks) {
                const bf16x8 a = *(const LAS bf16x8*)(Pm + (32 * tb + r32) * 72 + 16 * ks + 8 * hi);
                const bf16x8 bb = *(const LAS bf16x8*)(VT + (32 * eb + r32) * 72 + 16 * ks + 8 * hi);
                o = __builtin_amdgcn_mfma_f32_32x32x16_bf16(a, bb, o, 0, 0, 0);
            }
#pragma unroll
            for (int r = 0; r < 16; ++r) OT[(32 * tb + crow(r, hi)) * 132 + 32 * eb + r32] = o[r];
            if (ci + 1 < nc) {
#pragma unroll
                for (int i = 0; i < 2; ++i) {
                    const int db = 2 * (wid & 1) + i;
#pragma unroll
                    for (int r = 0; r < 16; ++r) sa[i][r] *= DEND[32 * db + crow(r, hi)];
#pragma unroll
                    for (int ks = 0; ks < 4; ++ks) {
                        const bf16x8 a = *(const LAS bf16x8*)(K3T + (32 * db + r32) * 72 + 16 * ks + 8 * hi);
                        const bf16x8 bb = *(const LAS bf16x8*)(VT + (32 * eb + r32) * 72 + 16 * ks + 8 * hi);
                        sa[i] = __builtin_amdgcn_mfma_f32_32x32x16_bf16(a, bb, sa[i], 0, 0, 0);
                    }
#pragma unroll
                    for (int g = 0; g < 4; ++g) { u32x2 w; w.x = cvt_pk_bf16(sa[i][4 * g], sa[i][4 * g + 1]); w.y = cvt_pk_bf16(sa[i][4 * g + 2], sa[i][4 * g + 3]);
                        *(LAS u32x2*)(ST + (32 * eb + r32) * 136 + 32 * db + 8 * g + 4 * hi) = w; }
                }
            }
            __syncthreads();
            {
                const f32x2 nwv = *(const f32x2*)(nw + 2 * lane);
#pragma unroll
                for (int i = 0; i < 8; ++i) { const int t = 8 * wid + i;
                    const f32x2 v = *(const LAS f32x2*)(OT + t * 132 + 2 * lane);
                    const float ss = wave_sum(v.x * v.x + v.y * v.y);
                    const float rstd = __builtin_amdgcn_rsqf(ss * (1.0f / 128.0f) + RMS_EPS);
                    unsigned* zp = (unsigned*)(base + (size_t)(c * 64 + t) * PITCH + C_ZB + 2 * lane);
                    *zp = cvt_pk_bf16(v.x * rstd * nwv.x * bf_lo(zz[i]), v.y * rstd * nwv.y * bf_hi(zz[i])); }
            }
        }
    }
    if (MODE == 0) {
        __syncthreads();
#pragma unroll
        for (int i = 0; i < 2; ++i) { const int db = 2 * (wid & 1) + i;
#pragma unroll
            for (int g = 0; g < 4; ++g) { u32x2 w; w.x = cvt_pk_bf16(sa[i][4 * g], sa[i][4 * g + 1]); w.y = cvt_pk_bf16(sa[i][4 * g + 2], sa[i][4 * g + 3]);
                *(LAS u32x2*)(ST + (32 * eb + r32) * 136 + 32 * db + 8 * g + 4 * hi) = w; } }
        __syncthreads();
#pragma unroll
        for (int i = 0; i < 4; ++i) { const int idx = tid + 512 * i;
            *(u32x4*)(Ug + (size_t)grp * 16384 + (idx >> 4) * 128 + (idx & 15) * 8) = *(const LAS u32x4*)(ST + (idx >> 4) * 136 + (idx & 15) * 8); }
        if (part == 0) Dg[grp * 128 + d] = ex2(bsum);
    }
    __syncthreads();
}

__device__ __forceinline__ void unpack8(const u32x4 a, float (&o)[8]) {
    o[0] = bf_lo(a.x); o[1] = bf_hi(a.x); o[2] = bf_lo(a.y); o[3] = bf_hi(a.y); o[4] = bf_lo(a.z); o[5] = bf_hi(a.z); o[6] = bf_lo(a.w); o[7] = bf_hi(a.w);
}
__device__ __forceinline__ void conv_item(bf16_t* ACT, const float* cw, int item) {
    const int tid = fresh_tid(), cgp = tid & 63, sub = tid >> 6;
    const int m0 = item * 64 + sub * 8, ch = cgp * 8;
    float w0[8], w1[8], w2[8];
#pragma unroll
    for (int e = 0; e < 8; ++e) { w0[e] = cw[ch + e]; w1[e] = cw[512 + ch + e]; w2[e] = cw[1024 + ch + e]; }
    float p1[8], p2[8];
#pragma unroll
    for (int e = 0; e < 8; ++e) { p1[e] = 0.f; p2[e] = 0.f; }
    if ((m0 % SEQ) != 0) {
        unpack8(*(const u32x4*)(ACT + (size_t)(m0 - 2) * PITCH + C_PU + ch), p2);
        unpack8(*(const u32x4*)(ACT + (size_t)(m0 - 1) * PITCH + C_PU + ch), p1);
    }
    u32x4 pa[8], pzv[8];
#pragma unroll
    for (int i = 0; i < 8; ++i) { const bf16_t* rp = ACT + (size_t)(m0 + i) * PITCH + ch; pa[i] = __builtin_nontemporal_load((const u32x4*)(rp + C_PU)); pzv[i] = __builtin_nontemporal_load((const u32x4*)(rp + C_PZ)); }
#pragma unroll
    for (int i = 0; i < 8; ++i) {
        float pu[8], pz[8], y[8];
        unpack8(pa[i], pu); unpack8(pzv[i], pz);
#pragma unroll
        for (int e = 0; e < 8; ++e) { y[e] = pz[e] * (w0[e] * p2[e] + w1[e] * p1[e] + w2[e] * pu[e]); p2[e] = p1[e]; p1[e] = pu[e]; }
        u32x4 w; w.x = cvt_pk_bf16(y[0], y[1]); w.y = cvt_pk_bf16(y[2], y[3]); w.z = cvt_pk_bf16(y[4], y[5]); w.w = cvt_pk_bf16(y[6], y[7]);
        *(u32x4*)(ACT + (size_t)(m0 + i) * PITCH + C_ZC + ch) = w;
    }
}

__device__ __forceinline__ void convert_weights(const Params& P, int l, LAS unsigned char* lds, int gw, int NGW, int wid, int lane) {
    LAS float* scr = (LAS float*)(lds + wid * 16384);
    unsigned char* ws = P.ws;
    constexpr int I_IN = 16 * (IN_COLS / 32), I_B = 8 * 32, I_O = 16 * 32, I_L = I_IN + 3 * I_B + I_O;
    for (int it = gw; it < I_L; it += NGW) {
        int r = it;
        if (r < I_IN) { transpose_item(P.w_in + (size_t)l * 1024 * IN_COLS, IN_COLS, (bf16_t*)(ws + WS_WIN), 1024, scr, r, lane, true); continue; } r -= I_IN;
        if (r < 3 * I_B) { const int j = r / I_B; transpose_item(P.w_branch + (size_t)(l * 3 + j) * 512 * 1024, 1024, (bf16_t*)(ws + WS_WB) + (size_t)j * 1024 * 1024, 1024, scr, r % I_B, lane); continue; } r -= 3 * I_B;
        transpose_item(P.w_out + (size_t)l * 1024 * 1024, 1024, (bf16_t*)(ws + WS_WO), 1024, scr, r, lane);
    }
}

typedef const __attribute__((address_space(4))) Params* KParamsPtr;
#define XB_TMO      128
#define XB_XCNT(j)  (256  + 64 * (j))
#define XB_XSUB(j)  (1280 + 64 * (j))
#define XB_XGEN(j)  (2304 + 64 * (j))
#define XB_TOP      3328
#define XB_TOPGEN   3392
#define XCD_BAR_WORDS 3456
#define XB_SPIN_CAP (1u << 22)
__device__ __forceinline__ unsigned xb_ld(unsigned* p)              { return __hip_atomic_load(p, __ATOMIC_RELAXED, __HIP_MEMORY_SCOPE_AGENT); }
__device__ __forceinline__ unsigned xb_add(unsigned* p, unsigned v) { return __hip_atomic_fetch_add(p, v, __ATOMIC_RELAXED, __HIP_MEMORY_SCOPE_AGENT); }
__device__ __forceinline__ unsigned xb_xcc_id() { return (unsigned)__builtin_amdgcn_s_getreg((3 << 11) | 20) & 0xFu; }
#define XB_SPIN(cond, bar) do { unsigned _sp = 0; while (cond) { __builtin_amdgcn_s_sleep(1); \
    if ((++_sp & 255u) == 0u) { if (xb_ld(&(bar)[XB_TMO])) break; if (_sp > XB_SPIN_CAP) { atomicAdd(&(bar)[XB_TMO], 1u); break; } } } } while (0)
__device__ __forceinline__ void xcd_barrier_complete(unsigned* bar, unsigned x, unsigned& nloc, unsigned& nx) {
    const unsigned G = gridDim.x * gridDim.y * gridDim.z;
    unsigned sum, cnt, mine, sp = 0u;
    for (;;) {
        sum = 0u; cnt = 0u; mine = 0u;
#pragma unroll
        for (unsigned j = 0; j < 16; ++j) { const unsigned c = xb_ld(&bar[XB_XCNT(j)]); sum += c; cnt += (c > 0u) ? 1u : 0u; mine = (j == x) ? c : mine; }
        if (sum == G) break;
        __builtin_amdgcn_s_sleep(1);
        if ((++sp & 255u) == 0u) { if (xb_ld(&bar[XB_TMO])) break; if (sp > XB_SPIN_CAP) { atomicAdd(&bar[XB_TMO], 1u); break; } }
    }
    nloc = mine > 0u ? mine : 1u; nx = cnt > 0u ? cnt : 1u;
}
__device__ __forceinline__ void xcd_barrier(unsigned* bar, volatile LAS unsigned* st) {
    asm volatile("s_waitcnt vmcnt(0)" ::: "memory");
    __syncthreads();
    if (threadIdx.x == 0) {
        __builtin_amdgcn_s_waitcnt(0);
        const unsigned x = xb_xcc_id();
        unsigned nloc = st[0], nx = st[1];
        if (nloc == 0u) { xcd_barrier_complete(bar, x, nloc, nx); st[0] = nloc; st[1] = nx; }
        const unsigned old = xb_add(&bar[XB_XSUB(x)], 1u);
        const unsigned gen = old / nloc;
        if (old + 1u == (gen + 1u) * nloc) {
            __builtin_amdgcn_fence(__ATOMIC_RELEASE, "agent");
            asm volatile("s_waitcnt vmcnt(0)" ::: "memory");
            const unsigned og = xb_add(&bar[XB_TOP], 1u);
            const unsigned tg = og / nx;
            if (og + 1u == (tg + 1u) * nx) xb_add(&bar[XB_TOPGEN], 1u);
            else XB_SPIN(xb_ld(&bar[XB_TOPGEN]) == tg, bar);
            __builtin_amdgcn_fence(__ATOMIC_ACQUIRE, "agent");
            xb_add(&bar[XB_XGEN(x)], 1u);
            asm volatile("s_waitcnt vmcnt(0)" ::: "memory");
        } else {
            XB_SPIN(xb_ld(&bar[XB_XGEN(x)]) == gen, bar);
            __builtin_amdgcn_fence(__ATOMIC_ACQUIRE, "agent");
            asm volatile("s_waitcnt vmcnt(0)" ::: "memory");
        }
    }
    __syncthreads();
}
#define GRID_SYNC() do { asm volatile("s_waitcnt vmcnt(0) lgkmcnt(0)" ::: "memory"); __syncthreads(); grid.sync(); } while (0)
#define XBAR() do { KParamsPtr qb_ = (KParamsPtr)__builtin_amdgcn_kernarg_segment_ptr(); asm volatile("" : "+s"(qb_)); xcd_barrier((unsigned*)(qb_->ws + WS_CTL), (volatile LAS unsigned*)(lds + LDS_BYTES - 16)); } while (0)
#define PHASE_BEGIN() \
    Params P; { KParamsPtr q_ = (KParamsPtr)__builtin_amdgcn_kernarg_segment_ptr(); asm volatile("" : "+s"(q_)); \
        P.x = q_->x; P.c = q_->c; P.w_mod = q_->w_mod; P.b_mod = q_->b_mod; P.w_in = q_->w_in; P.conv_w = q_->conv_w; P.hgrn_norm_w = q_->hgrn_norm_w; P.lower_bounds = q_->lower_bounds; \
        P.w_branch = q_->w_branch; P.w_out = q_->w_out; P.ln_g = q_->ln_g; P.ln_b = q_->ln_b; P.out = q_->out; P.ws = q_->ws; } \
    int bx = blockIdx.x; asm volatile("" : "+s"(bx)); \
    const int G = gridDim.x; \
    const int vcu = (G % 8 == 0) ? (bx % 8) * (G / 8) + bx / 8 : bx; \
    unsigned char* const ws = P.ws; \
    float* const modp = (float*)(ws + WS_MOD); \
    bf16_t* const ACT = (bf16_t*)(ws + WS_ACT); \
    (void)vcu; (void)modp; (void)ACT;
#define WAVE_IDS() \
    const int tid = fresh_tid(), lane = tid & 63, wid = __builtin_amdgcn_readfirstlane(tid >> 6); \
    const int gw = vcu * 8 + wid, NGW = G * 8; (void)lane; (void)gw; (void)NGW;

__global__ void __launch_bounds__(NTHREADS, 2) fwd_megakernel(Params Pk) {
    extern __shared__ __attribute__((aligned(16))) unsigned char lds_raw[];
    LAS unsigned char* lds = (LAS unsigned char*)lds_raw;
    cg::grid_group grid = cg::this_grid();
    if (__builtin_expect(gridDim.y == 4242u, 0)) GRID_SYNC();
    if (threadIdx.x < 4) ((LAS unsigned*)(lds + LDS_BYTES - 16))[threadIdx.x] = 0u;
    __syncthreads();
    if (threadIdx.x == 0) { KParamsPtr q0_ = (KParamsPtr)__builtin_amdgcn_kernarg_segment_ptr(); (void)xb_add(&((unsigned*)(q0_->ws + WS_CTL))[XB_XCNT(xb_xcc_id())], 1u); }

    {
        PHASE_BEGIN(); WAVE_IDS();
        float* modpart = (float*)(ws + WS_MODP);
        LAS float* red = (LAS float*)lds;
        for (int u = bx; u < DEPTH * 192; u += G) {
            const int l = u / 192, r = u % 192, n = (r >> 2) * 64 + lane, kq = r & 3;
            float accb[8];
#pragma unroll
            for (int b = 0; b < 8; ++b) accb[b] = 0.f;
            const float* wp = P.w_mod + ((size_t)l * 1024 + 256 * kq + 32 * wid) * 3072 + n;
            const float* cp = P.c + 256 * kq + 32 * wid;
#pragma unroll 16
            for (int k = 0; k < 32; ++k) { const float wv = __builtin_nontemporal_load(wp + (size_t)k * 3072);
#pragma unroll
                for (int b = 0; b < 8; ++b) accb[b] += cp[b * 1024 + k] * wv; }
            __syncthreads();
#pragma unroll
            for (int b = 0; b < 8; ++b) red[(wid * 8 + b) * 64 + lane] = accb[b];
            __syncthreads();
            { const int b = wid; float sacc = 0.f;
#pragma unroll
              for (int w = 0; w < 8; ++w) sacc += red[(w * 8 + b) * 64 + lane];
              modpart[(((size_t)kq * DEPTH + l) * 8 + b) * 3072 + n] = sacc; }
        }
        __syncthreads();
        convert_weights(P, 0, lds, gw, NGW, wid, lane);
    }
    XBAR();
    {
        PHASE_BEGIN(); WAVE_IDS();
        const float* modpart = (const float*)(ws + WS_MODP);
        for (int i = bx * NTHREADS + tid; i < DEPTH * 8 * 3072; i += G * NTHREADS) {
            const int l = i / (8 * 3072), n = i % 3072;
            float v = P.b_mod[l * 3072 + n];
#pragma unroll
            for (int kq = 0; kq < 4; ++kq) v += modpart[(size_t)kq * DEPTH * 8 * 3072 + i];
            modp[i] = v;
        }
        LAS float* ms = (LAS float*)lds;
        for (int rg = bx; rg < M_TOK / 64; rg += G) {
            const int b = (rg * 64) / SEQ;
            __syncthreads();
            { const int i4 = tid * 4; f32x4 v = *(const f32x4*)(P.b_mod + i4);
#pragma unroll
              for (int kq = 0; kq < 4; ++kq) v = v + *(const f32x4*)(modpart + ((size_t)kq * DEPTH * 8 + b) * 3072 + i4);
              *(LAS f32x4*)(ms + i4) = v; }
            __syncthreads();
#pragma unroll
            for (int it = 0; it < 2; ++it) {
                f32x4 v[4][4];
#pragma unroll
                for (int q = 0; q < 4; ++q) { const int m = rg * 64 + wid * 8 + it * 4 + q;
#pragma unroll
                    for (int j = 0; j < 4; ++j) v[q][j] = ld_nt(P.x + (size_t)m * D_MODEL + 4 * (lane + 64 * j)); }
#pragma unroll
                for (int q = 0; q < 4; ++q) { const int m = rg * 64 + wid * 8 + it * 4 + q;
                    row_standardize(v[q]);
                    bf16_t* hrow = ACT + (size_t)m * PITCH + C_H;
#pragma unroll
                    for (int j = 0; j < 4; ++j) { const int col = 4 * (lane + 64 * j);
                        const f32x4 sh = *(const LAS f32x4*)(ms + col), sc = *(const LAS f32x4*)(ms + 1024 + col);
                        const f32x4 hv = v[q][j] * (sc + 1.0f) + sh;
                        u32x2 w; w.x = cvt_pk_bf16(hv.x, hv.y); w.y = cvt_pk_bf16(hv.z, hv.w);
                        *(u32x2*)(hrow + col) = w; } }
            }
        }
    }
    XBAR();

    for (int l = 0; l < DEPTH; ++l) {
        {
            PHASE_BEGIN();
            SchedP1 S{(const char*)ACT + C_H * 2, (const char*)(ws + WS_WIN), G, vcu};
            EpiP1 E{ACT};
            pg8::gemm_phase<EpiP1, SchedP1>(lds, (unsigned)PITCHB, 2048u, S, E);
        }
        XBAR();
        for (int half = 0; half < 2; ++half) {
            PHASE_BEGIN();
            if ((half ^ (vcu & 1)) == 0) {
                for (int u = bx; u < 256; u += G) hgrn_pass<0>(lds, ACT, P, l, u >> 3, (u & 7) * 4, 4);
            } else {
                for (int k = bx; k < 256; k += G) {
                    __syncthreads(); attn_unit(lds, ACT, (k & 63) >> 3, k & 7, 7 - (k >> 6));
                    const int a2 = 511 - k;
                    __syncthreads(); attn_unit(lds, ACT, (a2 & 63) >> 3, a2 & 7, 7 - (a2 >> 6));
                }
                for (int ci = bx; ci < 256; ci += G) conv_item(ACT, P.conv_w + (size_t)l * 3 * 512, ci);
                __syncthreads();
            }
        }
        XBAR();
        {
            PHASE_BEGIN();
            for (int u = bx; u < 256; u += G) hgrn_pass<1>(lds, ACT, P, l, u >> 3, (u & 7) * 4, 4);
        }
        XBAR();
        {
            PHASE_BEGIN();
            SchedP3 S{(const char*)ACT, (const char*)(ws + WS_WIN) + (size_t)MIX_COLS * 2048, (const char*)(ws + WS_WB), G, vcu};
            EpiP3 E{(unsigned char*)ACT};
            pg8::gemm_phase<EpiP3, SchedP3>(lds, (unsigned)PITCHB, 2048u, S, E);
        }
        XBAR();
        {
            PHASE_BEGIN(); WAVE_IDS();
            SchedP4 S{(const char*)ACT, (const char*)(ws + WS_WO), G, vcu};
            unsigned* pc = (unsigned*)(ws + WS_CTL + CTL_PANEL);
            unsigned long long* xb = (unsigned long long*)(ws + WS_X);
            const bool more = (l + 1 < DEPTH);
            PanelStats st1{xb + (size_t)(2 * l) * 65536, pc + (2 * l) * 4096, LN_EPS};
            PanelStats st2{xb + (size_t)(2 * l + 1) * 65536, pc + (2 * l + 1) * 4096, LN_EPS};
            EpiP4F E{l == 0 ? P.x : P.out, P.out, modp + (size_t)l * 8 * 3072 + 2048, P.ln_g + l * 1024, P.ln_b + l * 1024, more ? modp + (size_t)(l + 1) * 8 * 3072 : nullptr, ACT, st1, st2};
            pg8::gemm_phase<EpiP4F, SchedP4>(lds, (unsigned)PITCHB, 2048u, S, E);
            if (more) { __syncthreads(); convert_weights(P, l + 1, lds, gw, NGW, wid, lane); }
        }
        if (l + 1 < DEPTH) XBAR();
    }
}

extern "C" void kernel_launch(void* const* d_in, const int* in_sizes, int n_in, void* d_out, int out_size, void* d_ws, size_t ws_size, hipStream_t stream) {
    static int grid_blocks = 0;
    if (grid_blocks == 0) {
        if (n_in != 12 || out_size != M_TOK * D_MODEL || ws_size < WS_END) { fprintf(stderr, "kernel_launch: unexpected shapes (n_in %d, out %d, ws %zu < %zu)\n", n_in, out_size, ws_size, (size_t)WS_END); grid_blocks = -1; return; }
        int dev = 0, cus = 0, per_cu = 0;
        hipGetDevice(&dev);
        hipDeviceGetAttribute(&cus, hipDeviceAttributeMultiprocessorCount, dev);
        hipFuncSetAttribute((const void*)fwd_megakernel, hipFuncAttributeMaxDynamicSharedMemorySize, LDS_BYTES);
        hipOccupancyMaxActiveBlocksPerMultiprocessor(&per_cu, (const void*)fwd_megakernel, NTHREADS, LDS_BYTES);
        (void)hipGetLastError();
        if (per_cu < 1) per_cu = 1;
        grid_blocks = cus > 256 ? 256 : cus;
        if (grid_blocks != 256) fprintf(stderr, "kernel_launch: %d CUs reported; this kernel is laid out for 256 workgroups\n", cus);
        if (grid_blocks <= 0) grid_blocks = 256;
    }
    if (grid_blocks < 0) return;
    (void)hipMemsetAsync((char*)d_ws + WS_CTL, 0, CTL_BYTES, stream);
    Params p{};
    p.x = (const float*)d_in[0]; p.c = (const float*)d_in[1]; p.w_mod = (const float*)d_in[2]; p.b_mod = (const float*)d_in[3]; p.w_in = (const float*)d_in[4];
    p.conv_w = (const float*)d_in[5]; p.hgrn_norm_w = (const float*)d_in[6]; p.lower_bounds = (const float*)d_in[7]; p.w_branch = (const float*)d_in[8];
    p.w_out = (const float*)d_in[9]; p.ln_g = (const float*)d_in[10]; p.ln_b = (const float*)d_in[11]; p.out = (float*)d_out; p.ws = (unsigned char*)d_ws;
    void* args[] = {&p};
    hipError_t e = hipLaunchCooperativeKernel((const void*)fwd_megakernel, dim3(grid_blocks), dim3(NTHREADS), args, LDS_BYTES, stream);
    if (e != hipSuccess) fprintf(stderr, "cooperative launch failed: %s (grid %d)\n", hipGetErrorString(e), grid_blocks);
}
```

```cpp
#include <hip/hip_runtime.h>
#include <hip/hip_cooperative_groups.h>
#include <cstdio>
#include <cstdint>
namespace cg = cooperative_groups;

#define LAS __attribute__((address_space(3)))
typedef unsigned short bf16_t;
typedef short bf16x8 __attribute__((ext_vector_type(8)));
typedef short s16x4 __attribute__((ext_vector_type(4)));
typedef float f32x2 __attribute__((ext_vector_type(2)));
typedef float f32x4 __attribute__((ext_vector_type(4)));
typedef float f32x16 __attribute__((ext_vector_type(16)));
typedef unsigned u32x2 __attribute__((ext_vector_type(2)));
typedef unsigned u32x4 __attribute__((ext_vector_type(4)));

constexpr int D_MODEL = 1024, BATCH = 8, SEQ = 2048, DEPTH = 2, M_TOK = BATCH * SEQ;
constexpr int IN_COLS = 9216, MIX_COLS = 6144;
constexpr int PITCH = 7168;
constexpr size_t PITCHB = (size_t)PITCH * 2;
constexpr int C_QA = 0, C_KA = 512, C_VA = 1024, C_ZA = 1536, C_QB = 2048, C_FB = 2560, C_IB = 3072, C_ZB = 3584, C_PU = 4096  , C_PZ = 4608  , C_ZC = 5632  , C_H = 6144;
constexpr int C_MERGED = 4096;
constexpr float LN_EPS = 1e-5f, RMS_EPS = 1e-6f;
constexpr float LOG2E = 1.4426950408889634f;
constexpr float QSCALE = 0.125f * LOG2E;
constexpr float ALPHA = 1.4142135623730951f;

constexpr size_t WS_CTL = 0, CTL_BYTES = 65536;
constexpr size_t WS_MOD = 65536;
constexpr size_t WS_DEND = 256u << 10;
constexpr size_t WS_WIN = 1u << 20;
constexpr size_t WIN_L = (size_t)IN_COLS * 1024 * 2;
constexpr size_t WS_WB = WS_WIN + WIN_L;
constexpr size_t WB_L = (size_t)3 * 1024 * 1024 * 2;
constexpr size_t WS_WO = WS_WB + WB_L;
constexpr size_t WO_L = (size_t)1024 * 1024 * 2;
constexpr size_t WS_ACT = WS_WO + WO_L;
constexpr size_t WS_U = WS_ACT + (size_t)M_TOK * PITCHB;
constexpr size_t WS_X = WS_U + (size_t)32 * 32 * 128 * 128 * 2;
constexpr size_t WS_MODP = WS_X + 3 * 524288;
constexpr size_t WS_END = WS_MODP + (size_t)4 * DEPTH * BATCH * 3072 * 4;
constexpr size_t CTL_PANEL = 16384;

constexpr int LDS_BYTES = 147456;
constexpr int NTHREADS = 512;

struct Params {
    const float* x; const float* c; const float* w_mod; const float* b_mod; const float* w_in; const float* conv_w; const float* hgrn_norm_w;
    const float* lower_bounds; const float* w_branch; const float* w_out; const float* ln_g; const float* ln_b; float* out; unsigned char* ws;
};

typedef __bf16 bf16x2_t __attribute__((ext_vector_type(2)));
__device__ __forceinline__ unsigned cvt_pk_bf16(float lo, float hi) { const f32x2 v = {lo, hi}; const bf16x2_t b = __builtin_convertvector(v, bf16x2_t); return __builtin_bit_cast(unsigned, b); }
__device__ __forceinline__ f32x4 ld_nt(const float* p) { return __builtin_nontemporal_load((const f32x4*)p); }
__device__ __forceinline__ float bf_lo(unsigned w) { return __uint_as_float(w << 16); }
__device__ __forceinline__ float bf_hi(unsigned w) { return __uint_as_float(w & 0xffff0000u); }
__device__ __forceinline__ float bf2f(bf16_t v) { return __uint_as_float((unsigned)v << 16); }
__device__ __forceinline__ float ex2(float v) { return __builtin_amdgcn_exp2f(v); }
__device__ __forceinline__ float lg2(float v) { return __builtin_amdgcn_logf(v); }
__device__ __forceinline__ float sigmoidf_(float v) { return __builtin_amdgcn_rcpf(1.0f + ex2(-v * LOG2E)); }
__device__ __forceinline__ float siluf_(float v) { return v * sigmoidf_(v); }
__device__ __forceinline__ float wave_sum(float v) {
#pragma unroll
    for (int o = 1; o < 64; o <<= 1) v += __shfl_xor(v, o);
    return v;
}
__device__ __forceinline__ int fresh_tid() { int t = threadIdx.x; asm volatile("" : "+v"(t)); return t; }
__device__ __forceinline__ int crow(int r, int hi) { return (r & 3) + 8 * (r >> 2) + 4 * hi; }

namespace pg8 {
constexpr int BM = 256, BK = 64, HALF = 128, HTB = HALF * BK * 2, STAGE_BYTES = 8 * HTB;
__device__ __forceinline__ int lds_byte(int r, int c) { const int st = (r >> 4) * 2 + (c >> 5), rr = r & 15, cc = c & 31, ob = rr * 64 + cc * 2; return st * 1024 + (ob ^ (((ob >> 9) & 1) << 5)); }
__device__ __forceinline__ void stage_rc(int b, int& R, int& C) { const int st = b / 1024, sb = b % 1024, swz = sb ^ (((sb >> 9) & 1) << 5); R = (st >> 1) * 16 + swz / 64; C = (st & 1) * 32 + (swz % 64) / 2; }
__device__ __forceinline__ int perm32(int rho) { const int n = rho >> 4, i = rho & 15; return 8 * (i >> 2) + 4 * n + (i & 3); }

struct Unit { const char* a; const char* b; int nt; int pm, pn, j; };

template <class Epi, class Sched>
__device__ __forceinline__ void gemm_phase(LAS unsigned char* lds, const unsigned ldaB, const unsigned ldbB, const Sched& S, const Epi& E) {
    const int tid = fresh_tid(), wid = __builtin_amdgcn_readfirstlane(tid >> 6), lane = tid & 63, wr = wid >> 2, wc = wid & 3, fr = lane & 15, fq = lane >> 4;
    unsigned voffA[2], voffB[2];
#pragma unroll
    for (int i = 0; i < 2; ++i) { int R, C; stage_rc(tid * 16 + i * 8192, R, C); const int Rb = Epi::PERM ? ((R & ~31) + perm32(R & 31)) : R;
        voffA[i] = (unsigned)R * ldaB + (unsigned)C * 2u; voffB[i] = (unsigned)Rb * ldbB + (unsigned)C * 2u; }
    const size_t kstep = (size_t)(BK * 2);
    const size_t hstepA = (size_t)HALF * ldaB, hstepB = (size_t)HALF * ldbB;
    const unsigned ldsw = (unsigned)wid * 1024u;
    const int aoff = lds_byte(wr * 64 + fr, fq * 8), boff = lds_byte(wc * 32 + fr, fq * 8);
#define PG8_SA(b, h) (((b) * 2 + (h)) * HTB)
#define PG8_SB(b, h) ((4 + (b) * 2 + (h)) * HTB)
#define PG8_STAGE(bufoff, gbase, voff) do { _Pragma("unroll") for (int _i = 0; _i < 2; ++_i) \
        __builtin_amdgcn_global_load_lds((const unsigned*)((const char*)(gbase) + (voff)[_i]), (LAS unsigned*)(lds + (bufoff) + ldsw + _i * 8192), 16, 0, 0); } while (0)
#define PG8_LDA(dst, b, h) do { _Pragma("unroll") for (int m = 0; m < 4; ++m) _Pragma("unroll") for (int k = 0; k < 2; ++k) dst[m][k] = *(const LAS bf16x8*)(lds + PG8_SA(b, h) + aoff + m * 2048 + k * 1024); } while (0)
#define PG8_LDB(dst, b, h) do { _Pragma("unroll") for (int n = 0; n < 2; ++n) _Pragma("unroll") for (int k = 0; k < 2; ++k) dst[n][k] = *(const LAS bf16x8*)(lds + PG8_SB(b, h) + boff + n * 2048 + k * 1024); } while (0)
#define PG8_MMA(ai, bj, At, Bt) do { __builtin_amdgcn_s_setprio(1); _Pragma("unroll") for (int m = 0; m < 4; ++m) _Pragma("unroll") for (int n = 0; n < 2; ++n) _Pragma("unroll") for (int k = 0; k < 2; ++k) \
        acc[ai][bj][m][n] = __builtin_amdgcn_mfma_f32_16x16x32_bf16(Bt[n][k], At[m][k], acc[ai][bj][m][n], 0, 0, 0); __builtin_amdgcn_s_setprio(0); } while (0)
#define PG8_WAIT_V(n) asm volatile("s_waitcnt vmcnt(" #n ")" ::: "memory")
#define PG8_WAIT_L(n) asm volatile("s_waitcnt lgkmcnt(" #n ")" ::: "memory")
#define PG8_BAR __builtin_amdgcn_s_barrier()
#define PG8_SCHED __builtin_amdgcn_sched_barrier(0)
    Unit cur, nxt; int ui = 0;
    if (!S.next(0, cur)) return;
    f32x4 acc[2][2][4][2];
#pragma unroll
    for (int a = 0; a < 2; ++a)
#pragma unroll
        for (int b = 0; b < 2; ++b)
#pragma unroll
            for (int m = 0; m < 4; ++m)
#pragma unroll
                for (int n = 0; n < 2; ++n) acc[a][b][m][n] = (f32x4){0.f, 0.f, 0.f, 0.f};
    bf16x8 At[4][2], B0[2][2], B1[2][2];
    const char* cA = cur.a; const char* cB = cur.b;
    PG8_STAGE(PG8_SB(0, 0), cB, voffB); PG8_STAGE(PG8_SB(0, 1), cB + hstepB, voffB); PG8_STAGE(PG8_SA(0, 0), cA, voffA); PG8_STAGE(PG8_SA(0, 1), cA + hstepA, voffA);
    if (wr == 1) PG8_BAR;
    PG8_WAIT_V(2); PG8_BAR;
    PG8_STAGE(PG8_SB(1, 0), cB + kstep, voffB); PG8_STAGE(PG8_SA(1, 0), cA + kstep, voffA); PG8_STAGE(PG8_SB(1, 1), cB + hstepB + kstep, voffB);
    PG8_WAIT_V(6); PG8_BAR;
    for (;;) {
        const bool has_next = S.next(ui + 1, nxt);
        const char* nA = has_next ? nxt.a : cA; const char* nB = has_next ? nxt.b : cB;
        const int nt = cur.nt;
        for (int t = 0; t < nt; t += 2) {
            const bool last = (t == nt - 2);
            const char* a1 = cA + (size_t)(t + 1) * kstep;
            const char* a2 = last ? nA : cA + (size_t)(t + 2) * kstep; const char* b2 = last ? nB : cB + (size_t)(t + 2) * kstep;
            const char* a3 = a2 + kstep; const char* b3 = b2 + kstep;
            PG8_LDB(B0, 0, 0); PG8_LDB(B1, 0, 1); PG8_SCHED; PG8_LDA(At, 0, 0); PG8_STAGE(PG8_SA(1, 1), a1 + hstepA, voffA);
            PG8_WAIT_V(8); PG8_WAIT_L(0); PG8_BAR; PG8_MMA(0, 0, At, B0); PG8_MMA(0, 1, At, B1); PG8_BAR; PG8_SCHED;
            PG8_LDA(At, 0, 1); PG8_STAGE(PG8_SB(0, 0), b2, voffB); PG8_STAGE(PG8_SB(0, 1), b2 + hstepB, voffB); PG8_STAGE(PG8_SA(0, 0), a2, voffA);
            PG8_WAIT_V(8); PG8_WAIT_L(0); PG8_BAR; PG8_MMA(1, 0, At, B0); PG8_MMA(1, 1, At, B1); PG8_BAR; PG8_SCHED;
            PG8_LDB(B0, 1, 0); PG8_LDB(B1, 1, 1); PG8_SCHED; PG8_LDA(At, 1, 0); PG8_STAGE(PG8_SA(0, 1), a2 + hstepA, voffA);
            PG8_WAIT_V(8); PG8_WAIT_L(0); PG8_BAR; PG8_MMA(0, 0, At, B0); PG8_MMA(0, 1, At, B1); PG8_BAR; PG8_SCHED;
            PG8_LDA(At, 1, 1); PG8_STAGE(PG8_SB(1, 0), b3, voffB); PG8_STAGE(PG8_SB(1, 1), b3 + hstepB, voffB); PG8_STAGE(PG8_SA(1, 0), a3, voffA);
            PG8_WAIT_V(8); PG8_WAIT_L(0); PG8_BAR; PG8_MMA(1, 0, At, B0); PG8_MMA(1, 1, At, B1); PG8_BAR; PG8_SCHED;
        }
        if (wr == 0) PG8_BAR;
        if constexpr (!Epi::AFTER_DRAIN) E(acc, cur, wr, wc, fr, fq);
        if (!has_next) break;
#pragma unroll
        for (int a = 0; a < 2; ++a)
#pragma unroll
            for (int b = 0; b < 2; ++b)
#pragma unroll
                for (int m = 0; m < 4; ++m)
#pragma unroll
                    for (int n = 0; n < 2; ++n) acc[a][b][m][n] = (f32x4){0.f, 0.f, 0.f, 0.f};
        cur = nxt; cA = nA; cB = nB; ++ui;
        if (wr == 1) PG8_BAR;
    }
    PG8_WAIT_V(0);
    PG8_BAR;
    if constexpr (Epi::AFTER_DRAIN) E.fused(acc, cur, wr, wc, fr, fq, lds, wid, lane);
#undef PG8_SA
#undef PG8_SB
#undef PG8_STAGE
#undef PG8_LDA
#undef PG8_LDB
#undef PG8_MMA
#undef PG8_WAIT_V
#undef PG8_WAIT_L
#undef PG8_BAR
#undef PG8_SCHED
}
}

struct SchedP1 {
    const char* A; const char* B; int G, vcu;
    __device__ __forceinline__ bool next(int i, pg8::Unit& u) const {
        const int U = i * G + vcu; if (U >= 64 * 24) return false;
        u.pm = 8 * ((U >> 5) & 7) + (U & 7); u.pn = 4 * (U >> 8) + ((U & 31) >> 3); u.j = 0; u.nt = 16;
        u.a = A + (size_t)u.pm * 256 * PITCHB; u.b = B + (size_t)u.pn * 256 * 2048; return true;
    }
};
struct SchedP3 {
    const char* ACTb; const char* Wg; const char* Wb; int G, vcu;
    __device__ __forceinline__ bool next(int i, pg8::Unit& u) const {
        const int T = vcu + (i / 6) * G; if (T >= 256) return false;
        const int s = i % 6; u.pm = 8 * (T >> 5) + (T & 7); u.pn = (T & 31) >> 3; u.j = s;
        const int j = s >> 1;
        if ((s & 1) == 0) { u.nt = 16; u.a = ACTb + (size_t)u.pm * 256 * PITCHB + C_H * 2; u.b = Wg + (size_t)(1024 * j + 256 * u.pn) * 2048; }
        else { u.nt = 8; u.a = ACTb + (size_t)u.pm * 256 * PITCHB + (size_t)(C_ZA + 2048 * j) * 2; u.b = Wb + (size_t)(1024 * j + 256 * u.pn) * 2048; }
        return true;
    }
};
struct SchedP4 {
    const char* ACTb; const char* Wo; int G, vcu;
    __device__ __forceinline__ bool next(int i, pg8::Unit& u) const {
        const int T = vcu + i * G; if (T >= 256) return false;
        u.pm = 8 * (T >> 5) + (T & 7); u.pn = (T & 31) >> 3; u.j = 0; u.nt = 16;
        u.a = ACTb + (size_t)u.pm * 256 * PITCHB + C_MERGED * 2; u.b = Wo + (size_t)(256 * u.pn) * 2048; return true;
    }
};

struct EpiP1 {
    static constexpr bool PERM = true, AFTER_DRAIN = false;
    bf16_t* ACT;
    __device__ __forceinline__ void operator()(const f32x4 (&acc)[2][2][4][2], const pg8::Unit& u, int wr, int wc, int fr, int fq) const {
        const int row0 = u.pm * 256 + wr * 64 + fr;
        if (u.pn >= 16) {
            const int T = u.pn - 16, col0 = (T < 4 ? C_PU + 128 * T : C_PZ + 128 * (T - 4)) + wc * 32 + 8 * fq;
#pragma unroll
            for (int ai = 0; ai < 2; ++ai)
#pragma unroll
                for (int m = 0; m < 4; ++m) { bf16_t* rowp = ACT + (size_t)(row0 + ai * 128 + m * 16) * PITCH + col0;
                    f32x4 v0 = acc[ai][1][m][0], v1 = acc[ai][1][m][1];
                    if (T >= 4) {
#pragma unroll
                        for (int e = 0; e < 4; ++e) { v0[e] = siluf_(v0[e]); v1[e] = siluf_(v1[e]); } }
                    v0 = v0 * acc[ai][0][m][0]; v1 = v1 * acc[ai][0][m][1];
                    u32x4 w; w.x = cvt_pk_bf16(v0[0], v0[1]); w.y = cvt_pk_bf16(v0[2], v0[3]); w.z = cvt_pk_bf16(v1[0], v1[1]); w.w = cvt_pk_bf16(v1[2], v1[3]);
                    *(u32x4*)rowp = w; }
            return;
        }
        const int grp = u.pn >> 1;
        const int kind = (grp == 0) ? 1 : ((grp == 3 || grp == 4 || grp == 7) ? 2 : 0);
        const int col0 = u.pn * 256 + wc * 32 + 8 * fq;
#pragma unroll
        for (int ai = 0; ai < 2; ++ai)
#pragma unroll
            for (int m = 0; m < 4; ++m) { bf16_t* rowp = ACT + (size_t)(row0 + ai * 128 + m * 16) * PITCH + col0;
#pragma unroll
                for (int bj = 0; bj < 2; ++bj) { f32x4 v0 = acc[ai][bj][m][0], v1 = acc[ai][bj][m][1];
                    if (kind == 1) { v0 = v0 * QSCALE; v1 = v1 * QSCALE; }
                    else if (kind == 2) {
#pragma unroll
                        for (int e = 0; e < 4; ++e) { v0[e] = siluf_(v0[e]); v1[e] = siluf_(v1[e]); } }
                    u32x4 w; w.x = cvt_pk_bf16(v0[0], v0[1]); w.y = cvt_pk_bf16(v0[2], v0[3]); w.z = cvt_pk_bf16(v1[0], v1[1]); w.w = cvt_pk_bf16(v1[2], v1[3]);
                    *(u32x4*)(rowp + bj * 128) = w; } }
    }
};
struct EpiP3 {
    static constexpr bool PERM = true, AFTER_DRAIN = false;
    unsigned char* ACTb;
    __device__ __forceinline__ void operator()(const f32x4 (&acc)[2][2][4][2], const pg8::Unit& u, int wr, int wc, int fr, int fq) const {
        const int s = u.j, j = s >> 1;
        const int row0 = u.pm * 256 + wr * 64 + fr, cl0 = wc * 32 + 8 * fq;
        const unsigned toff = 512u * (unsigned)u.pn, soff = 5120u + 512u * (unsigned)u.pn, moff = (unsigned)(C_MERGED + 256 * u.pn) * 2u;
        if ((s & 1) == 0) {
#pragma unroll
            for (int ai = 0; ai < 2; ++ai)
#pragma unroll
                for (int m = 0; m < 4; ++m) { unsigned char* rowp = ACTb + (size_t)(row0 + ai * 128 + m * 16) * PITCHB;
#pragma unroll
                    for (int bj = 0; bj < 2; ++bj) { const f32x4 v0 = acc[ai][bj][m][0], v1 = acc[ai][bj][m][1];
                        u32x4 w; w.x = cvt_pk_bf16(v0[0], v0[1]); w.y = cvt_pk_bf16(v0[2], v0[3]); w.z = cvt_pk_bf16(v1[0], v1[1]); w.w = cvt_pk_bf16(v1[2], v1[3]);
                        *(u32x4*)(rowp + soff + (cl0 + bj * 128) * 2) = w; } }
        } else {
#pragma unroll
            for (int ai = 0; ai < 2; ++ai) {
                u32x4 gq[4][2], tq[4][2];
#pragma unroll
                for (int m = 0; m < 4; ++m) { unsigned char* rowp = ACTb + (size_t)(row0 + ai * 128 + m * 16) * PITCHB;
#pragma unroll
                    for (int bj = 0; bj < 2; ++bj) { gq[m][bj] = *(const u32x4*)(rowp + soff + (cl0 + bj * 128) * 2); if (j > 0) tq[m][bj] = *(const u32x4*)(rowp + toff + (cl0 + bj * 128) * 2); } }
#pragma unroll
                for (int m = 0; m < 4; ++m) { unsigned char* rowp = ACTb + (size_t)(row0 + ai * 128 + m * 16) * PITCHB;
#pragma unroll
                    for (int bj = 0; bj < 2; ++bj) { const f32x4 v0 = acc[ai][bj][m][0], v1 = acc[ai][bj][m][1]; const u32x4 g = gq[m][bj];
                        f32x4 t0 = (f32x4){sigmoidf_(bf_lo(g.x)) * v0[0], sigmoidf_(bf_hi(g.x)) * v0[1], sigmoidf_(bf_lo(g.y)) * v0[2], sigmoidf_(bf_hi(g.y)) * v0[3]};
                        f32x4 t1 = (f32x4){sigmoidf_(bf_lo(g.z)) * v1[0], sigmoidf_(bf_hi(g.z)) * v1[1], sigmoidf_(bf_lo(g.w)) * v1[2], sigmoidf_(bf_hi(g.w)) * v1[3]};
                        if (j > 0) { const u32x4 tv = tq[m][bj];
                            t0 = t0 + (f32x4){bf_lo(tv.x), bf_hi(tv.x), bf_lo(tv.y), bf_hi(tv.y)}; t1 = t1 + (f32x4){bf_lo(tv.z), bf_hi(tv.z), bf_lo(tv.w), bf_hi(tv.w)}; }
                        u32x4 w; w.x = cvt_pk_bf16(t0[0], t0[1]); w.y = cvt_pk_bf16(t0[2], t0[3]); w.z = cvt_pk_bf16(t1[0], t1[1]); w.w = cvt_pk_bf16(t1[2], t1[3]);
                        if (j < 2) *(u32x4*)(rowp + toff + (cl0 + bj * 128) * 2) = w; else *(u32x4*)(rowp + moff + (cl0 + bj * 128) * 2) = w;
                    } }
            }
        }
    }
};
struct PanelStats {
    unsigned long long* xbuf;
    unsigned* cnt;
    float eps;
    __device__ __forceinline__ void run(const f32x4 (&v)[2][2][4][2], const pg8::Unit& u, int wr, int wc, int fr, int fq, LAS unsigned char* lds, int wid, int lane) const {
        LAS f32x2* Pt = (LAS f32x2*)lds;
        LAS f32x2* St = (LAS f32x2*)(lds + 8192);
#pragma unroll
        for (int ai = 0; ai < 2; ++ai)
#pragma unroll
            for (int m = 0; m < 4; ++m) {
                float s = 0.f;
#pragma unroll
                for (int bj = 0; bj < 2; ++bj)
#pragma unroll
                    for (int n = 0; n < 2; ++n) { const f32x4 x = v[ai][bj][m][n]; s += (x[0] + x[1]) + (x[2] + x[3]); }
                s += __shfl_xor(s, 16); s += __shfl_xor(s, 32);
                const float mw = s * (1.0f / 64.0f); float q = 0.f;
#pragma unroll
                for (int bj = 0; bj < 2; ++bj)
#pragma unroll
                    for (int n = 0; n < 2; ++n) { const f32x4 d = v[ai][bj][m][n] - mw; q += (d[0] * d[0] + d[1] * d[1]) + (d[2] * d[2] + d[3] * d[3]); }
                q += __shfl_xor(q, 16); q += __shfl_xor(q, 32);
                if (fq == 0) Pt[(ai * 128 + wr * 64 + m * 16 + fr) * 4 + wc] = (f32x2){mw, q};
            }
        __syncthreads();
        const int row = wid * 32 + (lane & 31);
        if (lane < 32) {
            const f32x2 a = Pt[row * 4 + 0], b = Pt[row * 4 + 1], c = Pt[row * 4 + 2], d = Pt[row * 4 + 3];
            const float mt = (a.x + b.x + c.x + d.x) * 0.25f;
            const float da = a.x - mt, db = b.x - mt, dc = c.x - mt, dd = d.x - mt;
            const float m2 = (a.y + b.y) + (c.y + d.y) + 64.0f * ((da * da + db * db) + (dc * dc + dd * dd));
            __hip_atomic_store(xbuf + ((size_t)(u.pm * 256 + row) * 4 + u.pn), ((unsigned long long)__float_as_uint(m2) << 32) | __float_as_uint(mt), __ATOMIC_RELAXED, __HIP_MEMORY_SCOPE_AGENT);
        }
        asm volatile("s_waitcnt vmcnt(0)" ::: "memory");
        if (lane == 0) __hip_atomic_fetch_add(cnt + 64 * u.pm, 1u, __ATOMIC_RELAXED, __HIP_MEMORY_SCOPE_AGENT);
        if (wid == 0) {
            unsigned sp = 0;
            while ((unsigned)__builtin_amdgcn_readfirstlane(__hip_atomic_load(cnt + 64 * u.pm, __ATOMIC_RELAXED, __HIP_MEMORY_SCOPE_AGENT)) < 32u) { __builtin_amdgcn_s_sleep(2); if (++sp > (1u << 24)) break; }
            __builtin_amdgcn_fence(__ATOMIC_ACQUIRE, "agent");
        }
        asm volatile("s_waitcnt vmcnt(0) lgkmcnt(0)" ::: "memory");
        __syncthreads();
        if (lane < 32) {
            const unsigned long long* slot = xbuf + (size_t)(u.pm * 256 + row) * 4; float mt[4], m2[4]; float ms = 0.f;
#pragma unroll
            for (int t = 0; t < 4; ++t) { const unsigned long long w = __hip_atomic_load(slot + t, __ATOMIC_RELAXED, __HIP_MEMORY_SCOPE_AGENT); mt[t] = __uint_as_float((unsigned)w); m2[t] = __uint_as_float((unsigned)(w >> 32)); ms += mt[t]; }
            const float mean = ms * 0.25f; float q = 0.f;
#pragma unroll
            for (int t = 0; t < 4; ++t) { const float dm = mt[t] - mean; q += m2[t] + 256.0f * dm * dm; }
            St[row] = (f32x2){mean, __builtin_amdgcn_rsqf(q * (1.0f / 1024.0f) + eps)};
        }
        __syncthreads();
    }
};
struct EpiP4F {
    static constexpr bool PERM = false, AFTER_DRAIN = true;
    const float* xprev; float* out; const float* gate; const float* lng; const float* lnb; const float* modn; bf16_t* ACT; PanelStats st1, st2;
    __device__ __forceinline__ void fused(f32x4 (&acc)[2][2][4][2], const pg8::Unit& u, int wr, int wc, int fr, int fq, LAS unsigned char* lds, int wid, int lane) const {
        const LAS f32x2* St = (const LAS f32x2*)(lds + 8192);
        const int row0 = u.pm * 256 + wr * 64 + fr, col0 = u.pn * 256 + wc * 32 + 4 * fq;
        const int bidx = (u.pm * 256) / SEQ;
        {
            const float* gp = gate + (size_t)bidx * 3072;
            f32x4 gv[2][2];
#pragma unroll
            for (int bj = 0; bj < 2; ++bj)
#pragma unroll
                for (int n = 0; n < 2; ++n) gv[bj][n] = *(const f32x4*)(gp + col0 + bj * 128 + n * 16) + 1.0f;
#pragma unroll
            for (int ai = 0; ai < 2; ++ai)
#pragma unroll
                for (int m = 0; m < 4; ++m) { const size_t off = (size_t)(row0 + ai * 128 + m * 16) * D_MODEL + col0;
#pragma unroll
                    for (int bj = 0; bj < 2; ++bj)
#pragma unroll
                        for (int n = 0; n < 2; ++n) { const f32x4 xv = ld_nt(xprev + off + bj * 128 + n * 16); acc[ai][bj][m][n] = xv * ALPHA + gv[bj][n] * acc[ai][bj][m][n]; }
                    asm volatile("" : "+v"(acc[ai][0][m][0]), "+v"(acc[ai][0][m][1]), "+v"(acc[ai][1][m][0]), "+v"(acc[ai][1][m][1]));
                    if (m == 3) asm volatile("" ::: "memory"); }
        }
        st1.run(acc, u, wr, wc, fr, fq, lds, wid, lane);
        {
            f32x4 lg[2][2], lb[2][2];
#pragma unroll
            for (int bj = 0; bj < 2; ++bj)
#pragma unroll
                for (int n = 0; n < 2; ++n) { lg[bj][n] = *(const f32x4*)(lng + col0 + bj * 128 + n * 16); lb[bj][n] = *(const f32x4*)(lnb + col0 + bj * 128 + n * 16); }
#pragma unroll
            for (int ai = 0; ai < 2; ++ai)
#pragma unroll
                for (int m = 0; m < 4; ++m) { const int r = ai * 128 + wr * 64 + m * 16 + fr; const f32x2 sr = St[r]; const size_t off = (size_t)(u.pm * 256 + r) * D_MODEL + col0;
#pragma unroll
                    for (int bj = 0; bj < 2; ++bj)
#pragma unroll
                        for (int n = 0; n < 2; ++n) { const f32x4 x1 = (acc[ai][bj][m][n] - sr.x) * sr.y * lg[bj][n] + lb[bj][n]; acc[ai][bj][m][n] = x1;
                            __builtin_nontemporal_store(x1, (f32x4*)(out + off + bj * 128 + n * 16)); }
                    asm volatile("" : "+v"(acc[ai][0][m][0]), "+v"(acc[ai][0][m][1]), "+v"(acc[ai][1][m][0]), "+v"(acc[ai][1][m][1]));
                    asm volatile("" ::: "memory"); }
        }
        if (modn) {
            st2.run(acc, u, wr, wc, fr, fq, lds, wid, lane);
            const float* mp = modn + (size_t)bidx * 3072;
            f32x4 sc[2][2], sh[2][2];
#pragma unroll
            for (int bj = 0; bj < 2; ++bj)
#pragma unroll
                for (int n = 0; n < 2; ++n) { sh[bj][n] = *(const f32x4*)(mp + col0 + bj * 128 + n * 16); sc[bj][n] = *(const f32x4*)(mp + 1024 + col0 + bj * 128 + n * 16) + 1.0f; }
#pragma unroll
            for (int ai = 0; ai < 2; ++ai)
#pragma unroll
                for (int m = 0; m < 4; ++m) { const int r = ai * 128 + wr * 64 + m * 16 + fr; const f32x2 sr = St[r]; bf16_t* hp = ACT + (size_t)(u.pm * 256 + r) * PITCH + C_H + col0;
#pragma unroll
                    for (int bj = 0; bj < 2; ++bj)
#pragma unroll
                        for (int n = 0; n < 2; ++n) { const f32x4 hv = (acc[ai][bj][m][n] - sr.x) * sr.y * sc[bj][n] + sh[bj][n];
                            u32x2 w; w.x = cvt_pk_bf16(hv[0], hv[1]); w.y = cvt_pk_bf16(hv[2], hv[3]); *(u32x2*)(hp + bj * 128 + n * 16) = w; }
                    asm volatile("" ::: "memory"); }
        }
    }
};

__device__ __forceinline__ void transpose_item(const float* W, int N, bf16_t* WT, int ldw, LAS float* scr, int item, int lane, bool conv_perm = false) {
    const int nblk = N / 32, kb = item / nblk, nb = item % nblk, k0 = 64 * kb, n0 = 32 * nb;
    int d0 = n0;
    if (conv_perm && n0 >= 4096 && n0 < 6144) { const int g = (n0 - 4096) >> 9, ch0 = (n0 - 4096) & 511; d0 = 4096 + 256 * ((ch0 >> 7) + ((g & 1) ? 4 : 0)) + 128 * (g >> 1) + (ch0 & 127); }
    const int kr = lane >> 3, n4 = (lane & 7) * 4;
    f32x4 v[8];
#pragma unroll
    for (int i = 0; i < 8; ++i) v[i] = ld_nt(W + (size_t)(k0 + 8 * i + kr) * N + n0 + n4);
#pragma unroll
    for (int i = 0; i < 8; ++i) { LAS float* d = scr + (8 * i + kr) * 33 + n4; d[0] = v[i].x; d[1] = v[i].y; d[2] = v[i].z; d[3] = v[i].w; }
    asm volatile("s_waitcnt lgkmcnt(0)" ::: "memory");
    const int c = lane & 7;
#pragma unroll
    for (int j = 0; j < 4; ++j) { const int n = (lane >> 3) + 8 * j; const LAS float* s = scr + (8 * c) * 33 + n;
        u32x4 o; o.x = cvt_pk_bf16(s[0 * 33], s[1 * 33]); o.y = cvt_pk_bf16(s[2 * 33], s[3 * 33]); o.z = cvt_pk_bf16(s[4 * 33], s[5 * 33]); o.w = cvt_pk_bf16(s[6 * 33], s[7 * 33]);
        *(u32x4*)(WT + (size_t)(d0 + n) * ldw + k0 + 8 * c) = o; }
    asm volatile("s_waitcnt lgkmcnt(0)" ::: "memory");
}

__device__ __forceinline__ void row_standardize(f32x4 (&v)[4]) {
    float s = 0.f;
#pragma unroll
    for (int j = 0; j < 4; ++j) s += (v[j].x + v[j].y) + (v[j].z + v[j].w);
    const float mean = wave_sum(s) * (1.f / D_MODEL); float s2 = 0.f;
#pragma unroll
    for (int j = 0; j < 4; ++j) { v[j] = v[j] - mean; s2 += (v[j].x * v[j].x + v[j].y * v[j].y) + (v[j].z * v[j].z + v[j].w * v[j].w); }
    const float rstd = __builtin_amdgcn_rsqf(wave_sum(s2) * (1.f / D_MODEL) + LN_EPS);
#pragma unroll
    for (int j = 0; j < 4; ++j) v[j] = v[j] * rstd;
}
__device__ __forceinline__ void write_h_row(const f32x4 (&v)[4], const float* modb, bf16_t* hrow, int lane) {
#pragma unroll
    for (int j = 0; j < 4; ++j) { const int col = 4 * (lane + 64 * j);
        const f32x4 sh = *(const f32x4*)(modb + col), sc = *(const f32x4*)(modb + 1024 + col);
        const f32x4 h = v[j] * (sc + 1.0f) + sh;
        u32x2 w; w.x = cvt_pk_bf16(h.x, h.y); w.y = cvt_pk_bf16(h.z, h.w);
        *(u32x2*)(hrow + col) = w; }
}

typedef short v4i16_t __attribute__((ext_vector_type(4)));
__device__ __forceinline__ s16x4 vtr(const LAS bf16_t* p) { return __builtin_bit_cast(s16x4, __builtin_amdgcn_ds_read_tr16_b64_v4i16((LAS v4i16_t*)p)); }
constexpr float STICK_DEAD = -44.0f;
__device__ __forceinline__ void attn_unit(LAS unsigned char* lds, bf16_t* ACT, int b, int h, int qb) {
    const int tid = fresh_tid(), lane = tid & 63, r32 = lane & 31, hi = lane >> 5;
    const int wid = __builtin_amdgcn_readfirstlane(tid >> 6);
    bf16_t* base = ACT + (size_t)b * SEQ * PITCH;
    const int tq0 = qb * 256 + wid * 32, tq = tq0 + r32;
    LAS bf16_t* Kw = (LAS bf16_t*)(lds + wid * 9728);
    LAS bf16_t* Vw = Kw + 32 * 72;
    LAS float* stg = (LAS float*)(lds + wid * 9728);
    bf16x8 qr[4];
#pragma unroll
    for (int d0 = 0; d0 < 4; ++d0) qr[d0] = __builtin_nontemporal_load((const bf16x8*)(base + (size_t)tq * PITCH + C_QA + h * 64 + d0 * 16 + hi * 8));
    f32x16 o0, o1;
#pragma unroll
    for (int r = 0; r < 16; ++r) { o0[r] = 0.f; o1[r] = 0.f; }
    float R = 0.f;
    const int srow = lane >> 3, sch = lane & 7;
    const bf16_t* kg = base + (size_t)srow * PITCH + C_KA + h * 64 + sch * 8;
    const bf16_t* vg = base + (size_t)srow * PITCH + C_VA + h * 64 + sch * 8;
    const LAS bf16_t* vb = Vw + (4 * hi + ((lane & 15) >> 2)) * 80 + 16 * ((lane >> 4) & 1) + 4 * (lane & 3);
    u32x4 kreg[4], vreg[4];
    int kb = tq0;
#pragma unroll
    for (int i = 0; i < 4; ++i) { kreg[i] = *(const u32x4*)(kg + (size_t)(kb + 8 * i) * PITCH); vreg[i] = *(const u32x4*)(vg + (size_t)(kb + 8 * i) * PITCH); }
    for (;;) {
#pragma unroll
        for (int i = 0; i < 4; ++i) { *(LAS u32x4*)(Kw + (srow + 8 * i) * 72 + sch * 8) = kreg[i]; *(LAS u32x4*)(Vw + (srow + 8 * i) * 80 + sch * 8) = vreg[i]; }
        const int kbn = kb - 32;
        if (kbn >= 0) {
#pragma unroll
            for (int i = 0; i < 4; ++i) { kreg[i] = *(const u32x4*)(kg + (size_t)(kbn + 8 * i) * PITCH); vreg[i] = *(const u32x4*)(vg + (size_t)(kbn + 8 * i) * PITCH); }
        }
        f32x16 p0;
#pragma unroll
        for (int r = 0; r < 16; ++r) p0[r] = 0.f;
#pragma unroll
        for (int d0 = 0; d0 < 4; ++d0) {
            const bf16x8 a0 = *(const LAS bf16x8*)(Kw + r32 * 72 + d0 * 16 + hi * 8);
            p0 = __builtin_amdgcn_mfma_f32_32x32x16_bf16(a0, qr[d0], p0, 0, 0, 0);
        }
        float x0[16];
        if (kb < tq0) {
#pragma unroll
            for (int r = 0; r < 16; ++r) { const float z = p0[r]; const float sp = fmaxf(z, 0.f) + lg2(1.0f + ex2(-fabsf(z))); x0[r] = sp; p0[r] = z - sp; }
        } else {
            const int kvl = kb + 4 * hi;
#pragma unroll
            for (int r = 0; r < 16; ++r) { const int kv = kvl + (r & 3) + 8 * (r >> 2);
                const float z = p0[r]; const float sp = fmaxf(z, 0.f) + lg2(1.0f + ex2(-fabsf(z))); const bool ok = kv < tq; x0[r] = ok ? sp : 0.f; p0[r] = ok ? z - sp : -INFINITY; }
        }
        float Gs[4], Gh1[4], Tt[4];
#pragma unroll
        for (int g = 0; g < 4; ++g) Gs[g] = (x0[4 * g] + x0[4 * g + 1]) + (x0[4 * g + 2] + x0[4 * g + 3]);
#pragma unroll
        for (int g = 0; g < 4; ++g) { auto rr = __builtin_amdgcn_permlane32_swap(__float_as_uint(Gs[g]), __float_as_uint(Gs[g]), false, false);
            Gh1[g] = __uint_as_float(rr[1]); Tt[g] = __uint_as_float(rr[0]) + __uint_as_float(rr[1]); }
        float run = R;
#pragma unroll
        for (int g = 3; g >= 0; --g) {
            const float off = hi ? run : run - Gh1[g];
            const int q4 = 4 * g;
            const float s3 = off, s2 = s3 - x0[q4 + 3], s1 = s2 - x0[q4 + 2], s0 = s1 - x0[q4 + 1];
            p0[q4 + 3] = ex2(p0[q4 + 3] + s3); p0[q4 + 2] = ex2(p0[q4 + 2] + s2); p0[q4 + 1] = ex2(p0[q4 + 1] + s1); p0[q4] = ex2(p0[q4] + s0);
            run -= Tt[g];
        }
        R = run;
#pragma unroll
        for (int s = 0; s < 2; ++s) {
            u32x4 w; const int r0 = 8 * s;
            w.x = cvt_pk_bf16(p0[r0], p0[r0 + 1]); w.y = cvt_pk_bf16(p0[r0 + 2], p0[r0 + 3]); w.z = cvt_pk_bf16(p0[r0 + 4], p0[r0 + 5]); w.w = cvt_pk_bf16(p0[r0 + 6], p0[r0 + 7]);
            const bf16x8 af = __builtin_bit_cast(bf16x8, w);
            { const s16x4 lo = vtr(vb + (16 * s) * 80), hh = vtr(vb + (16 * s + 8) * 80);
              const bf16x8 bfr = (bf16x8){lo[0], lo[1], lo[2], lo[3], hh[0], hh[1], hh[2], hh[3]};
              o0 = __builtin_amdgcn_mfma_f32_32x32x16_bf16(af, bfr, o0, 0, 0, 0); }
            { const s16x4 lo = vtr(vb + (16 * s) * 80 + 32), hh = vtr(vb + (16 * s + 8) * 80 + 32);
              const bf16x8 bfr = (bf16x8){lo[0], lo[1], lo[2], lo[3], hh[0], hh[1], hh[2], hh[3]};
              o1 = __builtin_amdgcn_mfma_f32_32x32x16_bf16(af, bfr, o1, 0, 0, 0); }
        }
        if (kbn < 0 || !__any(R > STICK_DEAD)) break;
        kb = kbn;
    }
#pragma unroll
    for (int r = 0; r < 16; ++r) { stg[crow(r, hi) * 68 + r32] = o0[r]; stg[crow(r, hi) * 68 + 32 + r32] = o1[r]; }
    asm volatile("s_waitcnt lgkmcnt(0)" ::: "memory");
#pragma unroll
    for (int i = 0; i < 4; ++i) { const int row = i * 8 + (lane >> 3), ch = lane & 7;
        const f32x4 a = *(const LAS f32x4*)(stg + row * 68 + ch * 8), c = *(const LAS f32x4*)(stg + row * 68 + ch * 8 + 4);
        bf16_t* zp = base + (size_t)(tq0 + row) * PITCH + C_ZA + h * 64 + ch * 8;
        const u32x4 z = __builtin_nontemporal_load((const u32x4*)zp);
        u32x4 w; w.x = cvt_pk_bf16(a.x * bf_lo(z.x), a.y * bf_hi(z.x)); w.y = cvt_pk_bf16(a.z * bf_lo(z.y), a.w * bf_hi(z.y));
        w.z = cvt_pk_bf16(c.x * bf_lo(z.z), c.y * bf_hi(z.z)); w.w = cvt_pk_bf16(c.z * bf_lo(z.w), c.w * bf_hi(z.w));
        *(u32x4*)zp = w; }
    asm volatile("s_waitcnt lgkmcnt(0)" ::: "memory");
}

__device__ __forceinline__ float layer_lb(const float* lower_bounds, int l, int ch) {
    float mx = -INFINITY;
    for (int i = 0; i < DEPTH; ++i) mx = fmaxf(mx, lower_bounds[i * 512 + ch]);
    float den = 0.f, num = 0.f;
    for (int i = 0; i < DEPTH; ++i) { const float e = __expf(lower_bounds[i * 512 + ch] - mx); den += e; if (i >= 1 && i <= l) num += e; }
    return num / den;
}
template <int MODE>
__device__ __forceinline__ void hgrn_pass(LAS unsigned char* lds, bf16_t* ACT, const Params& P, int l, int bh, int c0, int nc) {
    const int tid = fresh_tid(), lane = tid & 63, r32 = lane & 31, hi = lane >> 5;
    const int wid = __builtin_amdgcn_readfirstlane(tid >> 6);
    LAS bf16_t* Q1 = (LAS bf16_t*)(lds);
    LAS bf16_t* Q2 = (LAS bf16_t*)(lds + 17408);
    LAS bf16_t* K2 = (LAS bf16_t*)(lds + 34816);
    LAS float*  OT = (LAS float*)(lds);
    LAS bf16_t* K3T = (LAS bf16_t*)(lds + 52224);
    LAS bf16_t* VT = (LAS bf16_t*)(lds + 70656);
    LAS bf16_t* Pm = (LAS bf16_t*)(lds + 89088);
    LAS bf16_t* ST = (LAS bf16_t*)(lds + 98304);
    LAS float* DEND = (LAS float*)(lds + 133120);
    LAS float* SCX = (LAS float*)(lds + 133632);
    const int d = tid & 127, part = tid >> 7, b = bh >> 2, h = bh & 3, grp = c0 / nc;
    const float lbv = layer_lb(P.lower_bounds, l, h * 128 + d);
    bf16_t* base = ACT + (size_t)b * SEQ * PITCH + h * 128;
    bf16_t* Ug = (bf16_t*)(P.ws + WS_U) + (size_t)bh * 8 * 16384;
    float* Dg = (float*)(P.ws + WS_DEND) + (size_t)bh * 8 * 128;
    const float* nw = P.hgrn_norm_w + l * 128;
    const int tb = wid & 1, eb = wid >> 1;
    bf16_t fin[16], qin[16], vin[16];
#pragma unroll
    for (int i = 0; i < 16; ++i) { const bf16_t* rp = base + (size_t)(c0 * 64 + 16 * part + i) * PITCH + d;
        if (MODE == 1) { fin[i] = __builtin_nontemporal_load(rp + C_FB); vin[i] = __builtin_nontemporal_load(rp + C_IB); qin[i] = __builtin_nontemporal_load(rp + C_QB); }
        else { fin[i] = rp[C_FB]; vin[i] = rp[C_IB]; } }
    f32x16 sa[2];
#pragma unroll
    for (int r = 0; r < 16; ++r) { sa[0][r] = 0.f; sa[1][r] = 0.f; }
    float bsum = 0.f;
    if (MODE == 1) {
        const int d8 = (tid & 15) * 8;
        f32x4 Sp[4][2];
#pragma unroll
        for (int i = 0; i < 4; ++i) { Sp[i][0] = (f32x4){0.f, 0.f, 0.f, 0.f}; Sp[i][1] = (f32x4){0.f, 0.f, 0.f, 0.f}; }
        for (int k = 0; k < grp; ++k) {
            const f32x4 da = *(const f32x4*)(Dg + k * 128 + d8), db = *(const f32x4*)(Dg + k * 128 + d8 + 4);
            u32x4 uv[4];
#pragma unroll
            for (int i = 0; i < 4; ++i) { const int idx = tid + 512 * i; uv[i] = *(const u32x4*)(Ug + (size_t)k * 16384 + (idx >> 4) * 128 + d8); }
#pragma unroll
            for (int i = 0; i < 4; ++i) {
                Sp[i][0] = da * Sp[i][0] + (f32x4){bf_lo(uv[i].x), bf_hi(uv[i].x), bf_lo(uv[i].y), bf_hi(uv[i].y)};
                Sp[i][1] = db * Sp[i][1] + (f32x4){bf_lo(uv[i].z), bf_hi(uv[i].z), bf_lo(uv[i].w), bf_hi(uv[i].w)}; }
        }
#pragma unroll
        for (int i = 0; i < 4; ++i) { const int idx = tid + 512 * i;
            u32x4 v; v.x = cvt_pk_bf16(Sp[i][0][0], Sp[i][0][1]); v.y = cvt_pk_bf16(Sp[i][0][2], Sp[i][0][3]); v.z = cvt_pk_bf16(Sp[i][1][0], Sp[i][1][1]); v.w = cvt_pk_bf16(Sp[i][1][2], Sp[i][1][3]);
            *(LAS u32x4*)(ST + (idx >> 4) * 136 + d8) = v; }
        __syncthreads();
#pragma unroll
        for (int i = 0; i < 2; ++i) { const int db = 2 * (wid & 1) + i;
#pragma unroll
            for (int g = 0; g < 4; ++g) { const u32x2 w = *(const LAS u32x2*)(ST + (32 * eb + r32) * 136 + 32 * db + 8 * g + 4 * hi);
                sa[i][4 * g] = bf_lo(w.x); sa[i][4 * g + 1] = bf_hi(w.x); sa[i][4 * g + 2] = bf_lo(w.y); sa[i][4 * g + 3] = bf_hi(w.y); } }
    }
    for (int ci = 0; ci < nc; ++ci) {
        const int c = c0 + ci;
        float g2[16], kk[16];
        float runb = 0.f;
#pragma unroll
        for (int i = 0; i < 16; ++i) { const float f = lbv + (1.0f - lbv) * sigmoidf_(bf2f(fin[i])); kk[i] = 1.0f - f; runb += lg2(f); g2[i] = runb; }
        SCX[part * 128 + d] = runb;
        __syncthreads();
        const float t0 = SCX[d], t1 = SCX[128 + d], t2 = SCX[256 + d], t3 = SCX[384 + d];
        const float offp = (part > 0 ? t0 : 0.f) + (part > 1 ? t1 : 0.f) + (part > 2 ? t2 : 0.f);
        const float cmid = t0 + t1, bend = (t0 + t1) + (t2 + t3);
        bsum += bend;
        if (part == 0) DEND[d] = ex2(bend);
        {
            unsigned k3w[8], vw[8];
#pragma unroll
            for (int i = 0; i < 16; i += 2) {
                const float B0 = offp + g2[i], B1 = offp + g2[i + 1];
                if (MODE == 1) {
                    const float q0 = bf2f(qin[i]), q1 = bf2f(qin[i + 1]);
                    const int t = 16 * part + i;
                    Q1[t * 136 + d] = (bf16_t)(cvt_pk_bf16(q0 * ex2(B0), 0.f) & 0xffffu); Q1[(t + 1) * 136 + d] = (bf16_t)(cvt_pk_bf16(q1 * ex2(B1), 0.f) & 0xffffu);
                    Q2[t * 136 + d] = (bf16_t)(cvt_pk_bf16(q0 * ex2(B0 - cmid), 0.f) & 0xffffu); Q2[(t + 1) * 136 + d] = (bf16_t)(cvt_pk_bf16(q1 * ex2(B1 - cmid), 0.f) & 0xffffu);
                    K2[t * 136 + d] = (bf16_t)(cvt_pk_bf16(kk[i] * ex2(cmid - B0), 0.f) & 0xffffu); K2[(t + 1) * 136 + d] = (bf16_t)(cvt_pk_bf16(kk[i + 1] * ex2(cmid - B1), 0.f) & 0xffffu);
                }
                k3w[i >> 1] = cvt_pk_bf16(kk[i] * ex2(bend - B0), kk[i + 1] * ex2(bend - B1));
                vw[i >> 1] = (unsigned)vin[i] | ((unsigned)vin[i + 1] << 16);
            }
            *(LAS u32x4*)(K3T + d * 72 + 16 * part) = (u32x4){k3w[0], k3w[1], k3w[2], k3w[3]}; *(LAS u32x4*)(K3T + d * 72 + 16 * part + 8) = (u32x4){k3w[4], k3w[5], k3w[6], k3w[7]};
            *(LAS u32x4*)(VT + d * 72 + 16 * part) = (u32x4){vw[0], vw[1], vw[2], vw[3]}; *(LAS u32x4*)(VT + d * 72 + 16 * part + 8) = (u32x4){vw[4], vw[5], vw[6], vw[7]};
        }
        if (ci + 1 < nc) {
#pragma unroll
            for (int i = 0; i < 16; ++i) { const bf16_t* rp = base + (size_t)((c + 1) * 64 + 16 * part + i) * PITCH + d;
                if (MODE == 1) { fin[i] = __builtin_nontemporal_load(rp + C_FB); vin[i] = __builtin_nontemporal_load(rp + C_IB); qin[i] = __builtin_nontemporal_load(rp + C_QB); }
                else { fin[i] = rp[C_FB]; vin[i] = rp[C_IB]; } }
        }
        __syncthreads();
        if (MODE == 0) {
#pragma unroll
            for (int i = 0; i < 2; ++i) {
                const int db = 2 * (wid & 1) + i;
#pragma unroll
                for (int r = 0; r < 16; ++r) sa[i][r] *= DEND[32 * db + crow(r, hi)];
#pragma unroll
                for (int ks = 0; ks < 4; ++ks) {
                    const bf16x8 a = *(const LAS bf16x8*)(K3T + (32 * db + r32) * 72 + 16 * ks + 8 * hi);
                    const bf16x8 bb = *(const LAS bf16x8*)(VT + (32 * eb + r32) * 72 + 16 * ks + 8 * hi);
                    sa[i] = __builtin_amdgcn_mfma_f32_32x32x16_bf16(a, bb, sa[i], 0, 0, 0);
                }
            }
        } else {
            f32x16 o;
#pragma unroll
            for (int r = 0; r < 16; ++r) o[r] = 0.f;
            if (c > 0) {
#pragma unroll
                for (int ks = 0; ks < 8; ++ks) {
                    const bf16x8 a = *(const LAS bf16x8*)(Q1 + (32 * tb + r32) * 136 + 16 * ks + 8 * hi);
                    const bf16x8 bb = *(const LAS bf16x8*)(ST + (32 * eb + r32) * 136 + 16 * ks + 8 * hi);
                    o = __builtin_amdgcn_mfma_f32_32x32x16_bf16(a, bb, o, 0, 0, 0);
                }
            }
            if (wid < 4) {
                const int stb = wid & 1, ssb = wid >> 1;
                f32x16 sc;
#pragma unroll
                for (int r = 0; r < 16; ++r) sc[r] = 0.f;
                if (!(stb == 0 && ssb == 1)) {
#pragma unroll
                    for (int ks = 0; ks < 8; ++ks) {
                        const bf16x8 a = *(const LAS bf16x8*)(Q2 + (32 * stb + r32) * 136 + 16 * ks + 8 * hi);
                        const bf16x8 bb = *(const LAS bf16x8*)(K2 + (32 * ssb + r32) * 136 + 16 * ks + 8 * hi);
                        sc = __builtin_amdgcn_mfma_f32_32x32x16_bf16(a, bb, sc, 0, 0, 0);
                    }
                }
#pragma unroll
                for (int r = 0; r < 16; ++r) { const int t = 32 * stb + crow(r, hi), s = 32 * ssb + r32;
                    const float v = (s <= t) ? sc[r] : 0.f;
                    Pm[t * 72 + s] = (bf16_t)(cvt_pk_bf16(v, 0.f) & 0xffffu); }
            }
            __syncthreads();
            unsigned zz[8];
#pragma unroll
            for (int i = 0; i < 8; ++i) zz[i] = __builtin_nontemporal_load((const unsigned*)(base + (size_t)(c * 64 + 8 * wid + i) * PITCH + C_ZB + 2 * lane));
#pragma unroll
            for (int ks = 0; ks < 4; ++ks) {
                const bf16x8 a = *(const LAS bf16x8*)(Pm + (32 * tb + r32) * 72 + 16 * ks + 8 * hi);
                const bf16x8 bb = *(const LAS bf16x8*)(VT + (32 * eb + r32) * 72 + 16 * ks + 8 * hi);
                o = __builtin_amdgcn_mfma_f32_32x32x16_bf16(a, bb, o, 0, 0, 0);
            }
#pragma unroll
            for (int r = 0; r < 16; ++r) OT[(32 * tb + crow(r, hi)) * 132 + 32 * eb + r32] = o[r];
            if (ci + 1 < nc) {
#pragma unroll
                for (int i = 0; i < 2; ++i) {
                    const int db = 2 * (wid & 1) + i;
#pragma unroll
                    for (int r = 0; r < 16; ++r) sa[i][r] *= DEND[32 * db + crow(r, hi)];
#pragma unroll
                    for (int ks = 0; ks < 4; ++ks) {
                        const bf16x8 a = *(const LAS bf16x8*)(K3T + (32 * db + r32) * 72 + 16 * ks + 8 * hi);
                        const bf16x8 bb = *(const LAS bf16x8*)(VT + (32 * eb + r32) * 72 + 16 * ks + 8 * hi);
                        sa[i] = __builtin_amdgcn_mfma_f32_32x32x16_bf16(a, bb, sa[i], 0, 0, 0);
                    }
#pragma unroll
                    for (int g = 0; g < 4; ++g) { u32x2 w; w.x = cvt_pk_bf16(sa[i][4 * g], sa[i][4 * g + 1]); w.y = cvt_pk_bf16(sa[i][4 * g + 2], sa[i][4 * g + 3]);
                        *(LAS u32x2*)(ST + (32 * eb + r32) * 136 + 32 * db + 8 * g + 4 * hi) = w; }
                }
            }
            __syncthreads();
            {
                const f32x2 nwv = *(const f32x2*)(nw + 2 * lane);
#pragma unroll
                for (int i = 0; i < 8; ++i) { const int t = 8 * wid + i;
                    const f32x2 v = *(const LAS f32x2*)(OT + t * 132 + 2 * lane);
                    const float ss = wave_sum(v.x * v.x + v.y * v.y);
                    const float rstd = __builtin_amdgcn_rsqf(ss * (1.0f / 128.0f) + RMS_EPS);
                    unsigned* zp = (unsigned*)(base + (size_t)(c * 64 + t) * PITCH + C_ZB + 2 * lane);
                    *zp = cvt_pk_bf16(v.x * rstd * nwv.x * bf_lo(zz[i]), v.y * rstd * nwv.y * bf_hi(zz[i])); }
            }
        }
    }
    if (MODE == 0) {
        __syncthreads();
#pragma unroll
        for (int i = 0; i < 2; ++i) { const int db = 2 * (wid & 1) + i;
#pragma unroll
            for (int g = 0; g < 4; ++g) { u32x2 w; w.x = cvt_pk_bf16(sa[i][4 * g], sa[i][4 * g + 1]); w.y = cvt_pk_bf16(sa[i][4 * g + 2], sa[i][4 * g + 3]);
                *(LAS u32x2*)(ST + (32 * eb + r32) * 136 + 32 * db + 8 * g + 4 * hi) = w; } }
        __syncthreads();
#pragma unroll
        for (int i = 0; i < 4; ++i) { const int idx = tid + 512 * i;
            *(u32x4*)(Ug + (size_t)grp * 16384 + (idx >> 4) * 128 + (idx & 15) * 8) = *(const LAS u32x4*)(ST + (idx >> 4) * 136 + (idx & 15) * 8); }
        if (part == 0) Dg[grp * 128 + d] = ex2(bsum);
    }
    __syncthreads();
}

__device__ __forceinline__ void unpack8(const u32x4 a, float (&o)[8]) {
    o[0] = bf_lo(a.x); o[1] = bf_hi(a.x); o[2] = bf_lo(a.y); o[3] = bf_hi(a.y); o[4] = bf_lo(a.z); o[5] = bf_hi(a.z); o[6] = bf_lo(a.w); o[7] = bf_hi(a.w);
}
__device__ __forceinline__ void conv_item(bf16_t* ACT, const float* cw, int item) {
    const int tid = fresh_tid(), cgp = tid & 63, sub = tid >> 6;
    const int m0 = item * 64 + sub * 8, ch = cgp * 8;
    float w0[8], w1[8], w2[8];
#pragma unroll
    for (int e = 0; e < 8; ++e) { w0[e] = cw[ch + e]; w1[e] = cw[512 + ch + e]; w2[e] = cw[1024 + ch + e]; }
    float p1[8], p2[8];
#pragma unroll
    for (int e = 0; e < 8; ++e) { p1[e] = 0.f; p2[e] = 0.f; }
    if ((m0 % SEQ) != 0) {
        unpack8(*(const u32x4*)(ACT + (size_t)(m0 - 2) * PITCH + C_PU + ch), p2);
        unpack8(*(const u32x4*)(ACT + (size_t)(m0 - 1) * PITCH + C_PU + ch), p1);
    }
    u32x4 pa[8], pzv[8];
#pragma unroll
    for (int i = 0; i < 8; ++i) { const bf16_t* rp = ACT + (size_t)(m0 + i) * PITCH + ch; pa[i] = __builtin_nontemporal_load((const u32x4*)(rp + C_PU)); pzv[i] = __builtin_nontemporal_load((const u32x4*)(rp + C_PZ)); }
#pragma unroll
    for (int i = 0; i < 8; ++i) {
        float pu[8], pz[8], y[8];
        unpack8(pa[i], pu); unpack8(pzv[i], pz);
#pragma unroll
        for (int e = 0; e < 8; ++e) { y[e] = pz[e] * (w0[e] * p2[e] + w1[e] * p1[e] + w2[e] * pu[e]); p2[e] = p1[e]; p1[e] = pu[e]; }
        u32x4 w; w.x = cvt_pk_bf16(y[0], y[1]); w.y = cvt_pk_bf16(y[2], y[3]); w.z = cvt_pk_bf16(y[4], y[5]); w.w = cvt_pk_bf16(y[6], y[7]);
        *(u32x4*)(ACT + (size_t)(m0 + i) * PITCH + C_ZC + ch) = w;
    }
}

constexpr int WC_SPLIT = 16 * (IN_COLS / 32) + 3 * 8 * 32, WC_ALL = WC_SPLIT + 16 * 32;
__device__ __forceinline__ void convert_weights(const Params& P, int l, LAS unsigned char* lds, int gw, int NGW, int wid, int lane, int it_lo = 0, int it_hi = WC_ALL) {
    LAS float* scr = (LAS float*)(lds + wid * 16384);
    unsigned char* ws = P.ws;
    constexpr int I_IN = 16 * (IN_COLS / 32), I_B = 8 * 32, I_O = 16 * 32, I_L = I_IN + 3 * I_B + I_O;
    for (int it = it_lo + gw; it < it_hi; it += NGW) {
        int r = it;
        if (r < I_IN) { transpose_item(P.w_in + (size_t)l * 1024 * IN_COLS, IN_COLS, (bf16_t*)(ws + WS_WIN), 1024, scr, r, lane, true); continue; } r -= I_IN;
        if (r < 3 * I_B) { const int j = r / I_B; transpose_item(P.w_branch + (size_t)(l * 3 + j) * 512 * 1024, 1024, (bf16_t*)(ws + WS_WB) + (size_t)j * 1024 * 1024, 1024, scr, r % I_B, lane); continue; } r -= 3 * I_B;
        transpose_item(P.w_out + (size_t)l * 1024 * 1024, 1024, (bf16_t*)(ws + WS_WO), 1024, scr, r, lane);
    }
}

typedef const __attribute__((address_space(4))) Params* KParamsPtr;
#define XB_TMO      128
#define XB_XCNT(j)  (256  + 64 * (j))
#define XB_XSUB(j)  (1280 + 64 * (j))
#define XB_XGEN(j)  (2304 + 64 * (j))
#define XB_TOP      3328
#define XB_TOPGEN   3392
#define XCD_BAR_WORDS 3456
#define XB_SPIN_CAP (1u << 22)
__device__ __forceinline__ unsigned xb_ld(unsigned* p)              { return __hip_atomic_load(p, __ATOMIC_RELAXED, __HIP_MEMORY_SCOPE_AGENT); }
__device__ __forceinline__ unsigned xb_add(unsigned* p, unsigned v) { return __hip_atomic_fetch_add(p, v, __ATOMIC_RELAXED, __HIP_MEMORY_SCOPE_AGENT); }
__device__ __forceinline__ unsigned xb_xcc_id() { return (unsigned)__builtin_amdgcn_s_getreg((3 << 11) | 20) & 0xFu; }
#define XB_SPIN(cond, bar) do { unsigned _sp = 0; while (cond) { __builtin_amdgcn_s_sleep(1); \
    if ((++_sp & 255u) == 0u) { if (xb_ld(&(bar)[XB_TMO])) break; if (_sp > XB_SPIN_CAP) { atomicAdd(&(bar)[XB_TMO], 1u); break; } } } } while (0)
__device__ __forceinline__ void xcd_barrier_complete(unsigned* bar, unsigned x, unsigned& nloc, unsigned& nx) {
    const unsigned G = gridDim.x * gridDim.y * gridDim.z;
    unsigned sum, cnt, mine, sp = 0u;
    for (;;) {
        sum = 0u; cnt = 0u; mine = 0u;
#pragma unroll
        for (unsigned j = 0; j < 16; ++j) { const unsigned c = xb_ld(&bar[XB_XCNT(j)]); sum += c; cnt += (c > 0u) ? 1u : 0u; mine = (j == x) ? c : mine; }
        if (sum == G) break;
        __builtin_amdgcn_s_sleep(1);
        if ((++sp & 255u) == 0u) { if (xb_ld(&bar[XB_TMO])) break; if (sp > XB_SPIN_CAP) { atomicAdd(&bar[XB_TMO], 1u); break; } }
    }
    nloc = mine > 0u ? mine : 1u; nx = cnt > 0u ? cnt : 1u;
}
__device__ __forceinline__ void xcd_barrier(unsigned* bar, volatile LAS unsigned* st) {
    asm volatile("s_waitcnt vmcnt(0)" ::: "memory");
    __syncthreads();
    if (threadIdx.x == 0) {
        __builtin_amdgcn_s_waitcnt(0);
        const unsigned x = xb_xcc_id();
        unsigned nloc = st[0], nx = st[1];
        if (nloc == 0u) { xcd_barrier_complete(bar, x, nloc, nx); st[0] = nloc; st[1] = nx; }
        const unsigned old = xb_add(&bar[XB_XSUB(x)], 1u);
        const unsigned gen = old / nloc;
        if (old + 1u == (gen + 1u) * nloc) {
            __builtin_amdgcn_fence(__ATOMIC_RELEASE, "agent");
            asm volatile("s_waitcnt vmcnt(0)" ::: "memory");
            const unsigned og = xb_add(&bar[XB_TOP], 1u);
            const unsigned tg = og / nx;
            if (og + 1u == (tg + 1u) * nx) xb_add(&bar[XB_TOPGEN], 1u);
            else XB_SPIN(xb_ld(&bar[XB_TOPGEN]) == tg, bar);
            __builtin_amdgcn_fence(__ATOMIC_ACQUIRE, "agent");
            xb_add(&bar[XB_XGEN(x)], 1u);
            asm volatile("s_waitcnt vmcnt(0)" ::: "memory");
        } else {
            XB_SPIN(xb_ld(&bar[XB_XGEN(x)]) == gen, bar);
            __builtin_amdgcn_fence(__ATOMIC_ACQUIRE, "agent");
            asm volatile("s_waitcnt vmcnt(0)" ::: "memory");
        }
    }
    __syncthreads();
}
#define GRID_SYNC() do { asm volatile("s_waitcnt vmcnt(0) lgkmcnt(0)" ::: "memory"); __syncthreads(); grid.sync(); } while (0)
#define XBAR() do { KParamsPtr qb_ = (KParamsPtr)__builtin_amdgcn_kernarg_segment_ptr(); asm volatile("" : "+s"(qb_)); xcd_barrier((unsigned*)(qb_->ws + WS_CTL), (volatile LAS unsigned*)(lds + LDS_BYTES - 16)); } while (0)
#define PHASE_BEGIN() \
    Params P; { KParamsPtr q_ = (KParamsPtr)__builtin_amdgcn_kernarg_segment_ptr(); asm volatile("" : "+s"(q_)); \
        P.x = q_->x; P.c = q_->c; P.w_mod = q_->w_mod; P.b_mod = q_->b_mod; P.w_in = q_->w_in; P.conv_w = q_->conv_w; P.hgrn_norm_w = q_->hgrn_norm_w; P.lower_bounds = q_->lower_bounds; \
        P.w_branch = q_->w_branch; P.w_out = q_->w_out; P.ln_g = q_->ln_g; P.ln_b = q_->ln_b; P.out = q_->out; P.ws = q_->ws; } \
    int bx = blockIdx.x; asm volatile("" : "+s"(bx)); \
    const int G = gridDim.x; \
    const int vcu = (G % 8 == 0) ? (bx % 8) * (G / 8) + bx / 8 : bx; \
    unsigned char* const ws = P.ws; \
    float* const modp = (float*)(ws + WS_MOD); \
    bf16_t* const ACT = (bf16_t*)(ws + WS_ACT); \
    (void)vcu; (void)modp; (void)ACT;
#define WAVE_IDS() \
    const int tid = fresh_tid(), lane = tid & 63, wid = __builtin_amdgcn_readfirstlane(tid >> 6); \
    const int gw = vcu * 8 + wid, NGW = G * 8; (void)lane; (void)gw; (void)NGW;

__global__ void __launch_bounds__(NTHREADS, 2) fwd_megakernel(Params Pk) {
    extern __shared__ __attribute__((aligned(16))) unsigned char lds_raw[];
    LAS unsigned char* lds = (LAS unsigned char*)lds_raw;
    cg::grid_group grid = cg::this_grid();
    if (__builtin_expect(gridDim.y == 4242u, 0)) GRID_SYNC();
    if (threadIdx.x < 4) ((LAS unsigned*)(lds + LDS_BYTES - 16))[threadIdx.x] = 0u;
    __syncthreads();
    if (threadIdx.x == 0) { KParamsPtr q0_ = (KParamsPtr)__builtin_amdgcn_kernarg_segment_ptr(); (void)xb_add(&((unsigned*)(q0_->ws + WS_CTL))[XB_XCNT(xb_xcc_id())], 1u); }

    {
        PHASE_BEGIN(); WAVE_IDS();
        float* modpart = (float*)(ws + WS_MODP);
        LAS float* red = (LAS float*)lds;
        for (int u = bx; u < DEPTH * 192; u += G) {
            const int l = u / 192, r = u % 192, n = (r >> 2) * 64 + lane, kq = r & 3;
            float accb[8];
#pragma unroll
            for (int b = 0; b < 8; ++b) accb[b] = 0.f;
            const float* wp = P.w_mod + ((size_t)l * 1024 + 256 * kq + 32 * wid) * 3072 + n;
            const float* cp = P.c + 256 * kq + 32 * wid;
#pragma unroll 16
            for (int k = 0; k < 32; ++k) { const float wv = __builtin_nontemporal_load(wp + (size_t)k * 3072);
#pragma unroll
                for (int b = 0; b < 8; ++b) accb[b] += cp[b * 1024 + k] * wv; }
            __syncthreads();
#pragma unroll
            for (int b = 0; b < 8; ++b) red[(wid * 8 + b) * 64 + lane] = accb[b];
            __syncthreads();
            { const int b = wid; float sacc = 0.f;
#pragma unroll
              for (int w = 0; w < 8; ++w) sacc += red[(w * 8 + b) * 64 + lane];
              modpart[(((size_t)kq * DEPTH + l) * 8 + b) * 3072 + n] = sacc; }
        }
        __syncthreads();
        convert_weights(P, 0, lds, gw, NGW, wid, lane);
    }
    XBAR();
    {
        PHASE_BEGIN(); WAVE_IDS();
        const float* modpart = (const float*)(ws + WS_MODP);
        for (int i = bx * NTHREADS + tid; i < DEPTH * 8 * 3072; i += G * NTHREADS) {
            const int l = i / (8 * 3072), n = i % 3072;
            float v = P.b_mod[l * 3072 + n];
#pragma unroll
            for (int kq = 0; kq < 4; ++kq) v += modpart[(size_t)kq * DEPTH * 8 * 3072 + i];
            modp[i] = v;
        }
        LAS float* ms = (LAS float*)lds;
        for (int rg = bx; rg < M_TOK / 64; rg += G) {
            const int b = (rg * 64) / SEQ;
            __syncthreads();
            { const int i4 = tid * 4; f32x4 v = *(const f32x4*)(P.b_mod + i4);
#pragma unroll
              for (int kq = 0; kq < 4; ++kq) v = v + *(const f32x4*)(modpart + ((size_t)kq * DEPTH * 8 + b) * 3072 + i4);
              *(LAS f32x4*)(ms + i4) = v; }
            __syncthreads();
#pragma unroll
            for (int it = 0; it < 2; ++it) {
                f32x4 v[4][4];
#pragma unroll
                for (int q = 0; q < 4; ++q) { const int m = rg * 64 + wid * 8 + it * 4 + q;
#pragma unroll
                    for (int j = 0; j < 4; ++j) v[q][j] = ld_nt(P.x + (size_t)m * D_MODEL + 4 * (lane + 64 * j)); }
#pragma unroll
                for (int q = 0; q < 4; ++q) { const int m = rg * 64 + wid * 8 + it * 4 + q;
                    row_standardize(v[q]);
                    bf16_t* hrow = ACT + (size_t)m * PITCH + C_H;
#pragma unroll
                    for (int j = 0; j < 4; ++j) { const int col = 4 * (lane + 64 * j);
                        const f32x4 sh = *(const LAS f32x4*)(ms + col), sc = *(const LAS f32x4*)(ms + 1024 + col);
                        const f32x4 hv = v[q][j] * (sc + 1.0f) + sh;
                        u32x2 w; w.x = cvt_pk_bf16(hv.x, hv.y); w.y = cvt_pk_bf16(hv.z, hv.w);
                        *(u32x2*)(hrow + col) = w; } }
            }
        }
    }
    XBAR();

    for (int l = 0; l < DEPTH; ++l) {
        {
            PHASE_BEGIN();
            SchedP1 S{(const char*)ACT + C_H * 2, (const char*)(ws + WS_WIN), G, vcu};
            EpiP1 E{ACT};
            pg8::gemm_phase<EpiP1, SchedP1>(lds, (unsigned)PITCHB, 2048u, S, E);
        }
        XBAR();
        for (int half = 0; half < 2; ++half) {
            PHASE_BEGIN();
            if ((half ^ (vcu & 1)) == 0) {
                for (int u = bx; u < 256; u += G) hgrn_pass<0>(lds, ACT, P, l, u >> 3, (u & 7) * 4, 4);
            } else {
                for (int k = bx; k < 256; k += G) {
                    __syncthreads(); attn_unit(lds, ACT, (k & 63) >> 3, k & 7, 7 - (k >> 6));
                    const int a2 = 511 - k;
                    __syncthreads(); attn_unit(lds, ACT, (a2 & 63) >> 3, a2 & 7, 7 - (a2 >> 6));
                }
                for (int ci = bx; ci < 256; ci += G) conv_item(ACT, P.conv_w + (size_t)l * 3 * 512, ci);
                __syncthreads();
            }
        }
        if (l > 0) { PHASE_BEGIN(); WAVE_IDS(); __syncthreads(); convert_weights(P, l, lds, gw, NGW, wid, lane, WC_SPLIT, WC_ALL); }
        XBAR();
        {
            PHASE_BEGIN();
            for (int u = bx; u < 256; u += G) hgrn_pass<1>(lds, ACT, P, l, u >> 3, (u & 7) * 4, 4);
        }
        XBAR();
        {
            PHASE_BEGIN();
            SchedP3 S{(const char*)ACT, (const char*)(ws + WS_WIN) + (size_t)MIX_COLS * 2048, (const char*)(ws + WS_WB), G, vcu};
            EpiP3 E{(unsigned char*)ACT};
            pg8::gemm_phase<EpiP3, SchedP3>(lds, (unsigned)PITCHB, 2048u, S, E);
        }
        XBAR();
        {
            PHASE_BEGIN(); WAVE_IDS();
            SchedP4 S{(const char*)ACT, (const char*)(ws + WS_WO), G, vcu};
            unsigned* pc = (unsigned*)(ws + WS_CTL + CTL_PANEL);
            unsigned long long* xb = (unsigned long long*)(ws + WS_X);
            const bool more = (l + 1 < DEPTH);
            PanelStats st1{xb + (size_t)(2 * l) * 65536, pc + (2 * l) * 4096, LN_EPS};
            PanelStats st2{xb + (size_t)(2 * l + 1) * 65536, pc + (2 * l + 1) * 4096, LN_EPS};
            EpiP4F E{l == 0 ? P.x : P.out, P.out, modp + (size_t)l * 8 * 3072 + 2048, P.ln_g + l * 1024, P.ln_b + l * 1024, more ? modp + (size_t)(l + 1) * 8 * 3072 : nullptr, ACT, st1, st2};
            const bool pre = more && (vcu & 1);
            if (pre) { convert_weights(P, l + 1, lds, gw, NGW, wid, lane, 0, WC_SPLIT); __syncthreads(); }
            pg8::gemm_phase<EpiP4F, SchedP4>(lds, (unsigned)PITCHB, 2048u, S, E);
            if (more && !pre) { __syncthreads(); convert_weights(P, l + 1, lds, gw, NGW, wid, lane, 0, WC_SPLIT); }
        }
        if (l + 1 < DEPTH) XBAR();
    }
}

extern "C" void kernel_launch(void* const* d_in, const int* in_sizes, int n_in, void* d_out, int out_size, void* d_ws, size_t ws_size, hipStream_t stream) {
    static int grid_blocks = 0;
    if (grid_blocks == 0) {
        if (n_in != 12 || out_size != M_TOK * D_MODEL || ws_size < WS_END) { fprintf(stderr, "kernel_launch: unexpected shapes (n_in %d, out %d, ws %zu < %zu)\n", n_in, out_size, ws_size, (size_t)WS_END); grid_blocks = -1; return; }
        int dev = 0, cus = 0, per_cu = 0;
        hipGetDevice(&dev);
        hipDeviceGetAttribute(&cus, hipDeviceAttributeMultiprocessorCount, dev);
        hipFuncSetAttribute((const void*)fwd_megakernel, hipFuncAttributeMaxDynamicSharedMemorySize, LDS_BYTES);
        hipOccupancyMaxActiveBlocksPerMultiprocessor(&per_cu, (const void*)fwd_megakernel, NTHREADS, LDS_BYTES);
        (void)hipGetLastError();
        if (per_cu < 1) per_cu = 1;
        grid_blocks = cus > 256 ? 256 : cus;
        if (grid_blocks != 256) fprintf(stderr, "kernel_launch: %d CUs reported; this kernel is laid out for 256 workgroups\n", cus);
        if (grid_blocks <= 0) grid_blocks = 256;
    }
    if (grid_blocks < 0) return;
    (void)hipMemsetAsync((char*)d_ws + WS_CTL, 0, CTL_BYTES, stream);
    Params p{};
    p.x = (const float*)d_in[0]; p.c = (const float*)d_in[1]; p.w_mod = (const float*)d_in[2]; p.b_mod = (const float*)d_in[3]; p.w_in = (const float*)d_in[4];
    p.conv_w = (const float*)d_in[5]; p.hgrn_norm_w = (const float*)d_in[6]; p.lower_bounds = (const float*)d_in[7]; p.w_branch = (const float*)d_in[8];
    p.w_out = (const float*)d_in[9]; p.ln_g = (const float*)d_in[10]; p.ln_b = (const float*)d_in[11]; p.out = (float*)d_out; p.ws = (unsigned char*)d_ws;
    void* args[] = {&p};
    hipError_t e = hipLaunchCooperativeKernel((const void*)fwd_megakernel, dim3(grid_blocks), dim3(NTHREADS), args, LDS_BYTES, stream);
    if (e != hipSuccess) fprintf(stderr, "cooperative launch failed: %s (grid %d)\n", hipGetErrorString(e), grid_blocks);
}
```

```cpp
#include <hip/hip_runtime.h>
#include <hip/hip_cooperative_groups.h>
#include <cstdio>
#include <cstdint>
namespace cg = cooperative_groups;

#define LAS __attribute__((address_space(3)))
typedef unsigned short bf16_t;
typedef short bf16x8 __attribute__((ext_vector_type(8)));
typedef short s16x4 __attribute__((ext_vector_type(4)));
typedef float f32x2 __attribute__((ext_vector_type(2)));
typedef float f32x4 __attribute__((ext_vector_type(4)));
typedef float f32x16 __attribute__((ext_vector_type(16)));
typedef unsigned u32x2 __attribute__((ext_vector_type(2)));
typedef unsigned u32x4 __attribute__((ext_vector_type(4)));

constexpr int D_MODEL = 1024, BATCH = 8, SEQ = 2048, DEPTH = 2, M_TOK = BATCH * SEQ;
constexpr int IN_COLS = 9216, MIX_COLS = 6144;
constexpr int PITCH = 7168;
constexpr size_t PITCHB = (size_t)PITCH * 2;
constexpr int C_QA = 0, C_KA = 512, C_VA = 1024, C_ZA = 1536, C_QB = 2048, C_FB = 2560, C_IB = 3072, C_ZB = 3584, C_PU = 4096  , C_PZ = 4608  , C_ZC = 5632  , C_H = 6144;
constexpr int C_MERGED = 4096;
constexpr float LN_EPS = 1e-5f, RMS_EPS = 1e-6f;
constexpr float LOG2E = 1.4426950408889634f;
constexpr float QSCALE = 0.125f * LOG2E;
constexpr float ALPHA = 1.4142135623730951f;

constexpr size_t WS_CTL = 0, CTL_BYTES = 65536;
constexpr size_t WS_MOD = 65536;
constexpr size_t WS_DEND = 256u << 10;
constexpr size_t WS_WIN = 1u << 20;
constexpr size_t WIN_L = (size_t)IN_COLS * 1024 * 2;
constexpr size_t WS_WB = WS_WIN + WIN_L;
constexpr size_t WB_L = (size_t)3 * 1024 * 1024 * 2;
constexpr size_t WS_WO = WS_WB + WB_L;
constexpr size_t WO_L = (size_t)1024 * 1024 * 2;
constexpr size_t WS_ACT = WS_WO + WO_L;
constexpr size_t WS_U = WS_ACT + (size_t)M_TOK * PITCHB;
constexpr size_t WS_X = WS_U + (size_t)32 * 32 * 128 * 128 * 2;
constexpr size_t WS_MODP = WS_X + 3 * 524288;
constexpr size_t WS_END = WS_MODP + (size_t)4 * DEPTH * BATCH * 3072 * 4;
constexpr size_t CTL_PANEL = 16384;

constexpr int LDS_BYTES = 147456;
constexpr int NTHREADS = 512;

struct Params {
    const float* x; const float* c; const float* w_mod; const float* b_mod; const float* w_in; const float* conv_w; const float* hgrn_norm_w;
    const float* lower_bounds; const float* w_branch; const float* w_out; const float* ln_g; const float* ln_b; float* out; unsigned char* ws;
};

typedef __bf16 bf16x2_t __attribute__((ext_vector_type(2)));
__device__ __forceinline__ unsigned cvt_pk_bf16(float lo, float hi) { const f32x2 v = {lo, hi}; const bf16x2_t b = __builtin_convertvector(v, bf16x2_t); return __builtin_bit_cast(unsigned, b); }
__device__ __forceinline__ f32x4 ld_nt(const float* p) { return __builtin_nontemporal_load((const f32x4*)p); }
__device__ __forceinline__ float bf_lo(unsigned w) { return __uint_as_float(w << 16); }
__device__ __forceinline__ float bf_hi(unsigned w) { return __uint_as_float(w & 0xffff0000u); }
__device__ __forceinline__ float bf2f(bf16_t v) { return __uint_as_float((unsigned)v << 16); }
__device__ __forceinline__ float ex2(float v) { return __builtin_amdgcn_exp2f(v); }
__device__ __forceinline__ float lg2(float v) { return __builtin_amdgcn_logf(v); }
__device__ __forceinline__ float sigmoidf_(float v) { return __builtin_amdgcn_rcpf(1.0f + ex2(-v * LOG2E)); }
__device__ __forceinline__ float siluf_(float v) { return v * sigmoidf_(v); }
__device__ __forceinline__ float wave_sum(float v) {
#pragma unroll
    for (int o = 1; o < 64; o <<= 1) v += __shfl_xor(v, o);
    return v;
}
__device__ __forceinline__ int fresh_tid() { int t = threadIdx.x; asm volatile("" : "+v"(t)); return t; }
__device__ __forceinline__ int crow(int r, int hi) { return (r & 3) + 8 * (r >> 2) + 4 * hi; }

namespace pg8 {
constexpr int BM = 256, BK = 64, HALF = 128, HTB = HALF * BK * 2, STAGE_BYTES = 8 * HTB;
__device__ __forceinline__ int lds_byte(int r, int c) { const int st = (r >> 4) * 2 + (c >> 5), rr = r & 15, cc = c & 31, ob = rr * 64 + cc * 2; return st * 1024 + (ob ^ (((ob >> 9) & 1) << 5)); }
__device__ __forceinline__ void stage_rc(int b, int& R, int& C) { const int st = b / 1024, sb = b % 1024, swz = sb ^ (((sb >> 9) & 1) << 5); R = (st >> 1) * 16 + swz / 64; C = (st & 1) * 32 + (swz % 64) / 2; }
__device__ __forceinline__ int perm32(int rho) { const int n = rho >> 4, i = rho & 15; return 8 * (i >> 2) + 4 * n + (i & 3); }

struct Unit { const char* a; const char* b; int nt; int pm, pn, j; };

template <class Epi, class Sched>
__device__ __forceinline__ void gemm_phase(LAS unsigned char* lds, const unsigned ldaB, const unsigned ldbB, const Sched& S, const Epi& E) {
    const int tid = fresh_tid(), wid = __builtin_amdgcn_readfirstlane(tid >> 6), lane = tid & 63, wr = wid >> 2, wc = wid & 3, fr = lane & 15, fq = lane >> 4;
    unsigned voffA[2], voffB[2];
#pragma unroll
    for (int i = 0; i < 2; ++i) { int R, C; stage_rc(tid * 16 + i * 8192, R, C); const int Rb = Epi::PERM ? ((R & ~31) + perm32(R & 31)) : R;
        voffA[i] = (unsigned)R * ldaB + (unsigned)C * 2u; voffB[i] = (unsigned)Rb * ldbB + (unsigned)C * 2u; }
    const size_t kstep = (size_t)(BK * 2);
    const size_t hstepA = (size_t)HALF * ldaB, hstepB = (size_t)HALF * ldbB;
    const unsigned ldsw = (unsigned)wid * 1024u;
    const int aoff = lds_byte(wr * 64 + fr, fq * 8), boff = lds_byte(wc * 32 + fr, fq * 8);
#define PG8_SA(b, h) (((b) * 2 + (h)) * HTB)
#define PG8_SB(b, h) ((4 + (b) * 2 + (h)) * HTB)
#define PG8_STAGE(bufoff, gbase, voff) do { _Pragma("unroll") for (int _i = 0; _i < 2; ++_i) \
        __builtin_amdgcn_global_load_lds((const unsigned*)((const char*)(gbase) + (voff)[_i]), (LAS unsigned*)(lds + (bufoff) + ldsw + _i * 8192), 16, 0, 0); } while (0)
#define PG8_LDA(dst, b, h) do { _Pragma("unroll") for (int m = 0; m < 4; ++m) _Pragma("unroll") for (int k = 0; k < 2; ++k) dst[m][k] = *(const LAS bf16x8*)(lds + PG8_SA(b, h) + aoff + m * 2048 + k * 1024); } while (0)
#define PG8_LDB(dst, b, h) do { _Pragma("unroll") for (int n = 0; n < 2; ++n) _Pragma("unroll") for (int k = 0; k < 2; ++k) dst[n][k] = *(const LAS bf16x8*)(lds + PG8_SB(b, h) + boff + n * 2048 + k * 1024); } while (0)
#define PG8_MMA(ai, bj, At, Bt) do { __builtin_amdgcn_s_setprio(1); _Pragma("unroll") for (int m = 0; m < 4; ++m) _Pragma("unroll") for (int n = 0; n < 2; ++n) _Pragma("unroll") for (int k = 0; k < 2; ++k) \
        acc[ai][bj][m][n] = __builtin_amdgcn_mfma_f32_16x16x32_bf16(Bt[n][k], At[m][k], acc[ai][bj][m][n], 0, 0, 0); __builtin_amdgcn_s_setprio(0); } while (0)
#define PG8_WAIT_V(n) asm volatile("s_waitcnt vmcnt(" #n ")" ::: "memory")
#define PG8_WAIT_L(n) asm volatile("s_waitcnt lgkmcnt(" #n ")" ::: "memory")
#define PG8_BAR __builtin_amdgcn_s_barrier()
#define PG8_SCHED __builtin_amdgcn_sched_barrier(0)
    Unit cur, nxt; int ui = 0;
    if (!S.next(0, cur)) return;
    f32x4 acc[2][2][4][2];
#pragma unroll
    for (int a = 0; a < 2; ++a)
#pragma unroll
        for (int b = 0; b < 2; ++b)
#pragma unroll
            for (int m = 0; m < 4; ++m)
#pragma unroll
                for (int n = 0; n < 2; ++n) acc[a][b][m][n] = (f32x4){0.f, 0.f, 0.f, 0.f};
    bf16x8 At[4][2], B0[2][2], B1[2][2];
    const char* cA = cur.a; const char* cB = cur.b;
    PG8_STAGE(PG8_SB(0, 0), cB, voffB); PG8_STAGE(PG8_SB(0, 1), cB + hstepB, voffB); PG8_STAGE(PG8_SA(0, 0), cA, voffA); PG8_STAGE(PG8_SA(0, 1), cA + hstepA, voffA);
    if (wr == 1) PG8_BAR;
    PG8_WAIT_V(2); PG8_BAR;
    PG8_STAGE(PG8_SB(1, 0), cB + kstep, voffB); PG8_STAGE(PG8_SA(1, 0), cA + kstep, voffA); PG8_STAGE(PG8_SB(1, 1), cB + hstepB + kstep, voffB);
    PG8_WAIT_V(6); PG8_BAR;
    for (;;) {
        const bool has_next = S.next(ui + 1, nxt);
        const char* nA = has_next ? nxt.a : cA; const char* nB = has_next ? nxt.b : cB;
        const int nt = cur.nt;
        for (int t = 0; t < nt; t += 2) {
            const bool last = (t == nt - 2);
            const char* a1 = cA + (size_t)(t + 1) * kstep;
            const char* a2 = last ? nA : cA + (size_t)(t + 2) * kstep; const char* b2 = last ? nB : cB + (size_t)(t + 2) * kstep;
            const char* a3 = a2 + kstep; const char* b3 = b2 + kstep;
            PG8_LDB(B0, 0, 0); PG8_LDB(B1, 0, 1); PG8_SCHED; PG8_LDA(At, 0, 0); PG8_STAGE(PG8_SA(1, 1), a1 + hstepA, voffA);
            PG8_WAIT_V(8); PG8_WAIT_L(0); PG8_BAR; PG8_MMA(0, 0, At, B0); PG8_MMA(0, 1, At, B1); PG8_BAR; PG8_SCHED;
            PG8_LDA(At, 0, 1); PG8_STAGE(PG8_SB(0, 0), b2, voffB); PG8_STAGE(PG8_SB(0, 1), b2 + hstepB, voffB); PG8_STAGE(PG8_SA(0, 0), a2, voffA);
            PG8_WAIT_V(8); PG8_WAIT_L(0); PG8_BAR; PG8_MMA(1, 0, At, B0); PG8_MMA(1, 1, At, B1); PG8_BAR; PG8_SCHED;
            PG8_LDB(B0, 1, 0); PG8_LDB(B1, 1, 1); PG8_SCHED; PG8_LDA(At, 1, 0); PG8_STAGE(PG8_SA(0, 1), a2 + hstepA, voffA);
            PG8_WAIT_V(8); PG8_WAIT_L(0); PG8_BAR; PG8_MMA(0, 0, At, B0); PG8_MMA(0, 1, At, B1); PG8_BAR; PG8_SCHED;
            PG8_LDA(At, 1, 1); PG8_STAGE(PG8_SB(1, 0), b3, voffB); PG8_STAGE(PG8_SB(1, 1), b3 + hstepB, voffB); PG8_STAGE(PG8_SA(1, 0), a3, voffA);
            PG8_WAIT_V(8); PG8_WAIT_L(0); PG8_BAR; PG8_MMA(1, 0, At, B0); PG8_MMA(1, 1, At, B1); PG8_BAR; PG8_SCHED;
        }
        if (wr == 0) PG8_BAR;
        if constexpr (!Epi::AFTER_DRAIN) E(acc, cur, wr, wc, fr, fq);
        if (!has_next) break;
#pragma unroll
        for (int a = 0; a < 2; ++a)
#pragma unroll
            for (int b = 0; b < 2; ++b)
#pragma unroll
                for (int m = 0; m < 4; ++m)
#pragma unroll
                    for (int n = 0; n < 2; ++n) acc[a][b][m][n] = (f32x4){0.f, 0.f, 0.f, 0.f};
        cur = nxt; cA = nA; cB = nB; ++ui;
        if (wr == 1) PG8_BAR;
    }
    PG8_WAIT_V(0);
    PG8_BAR;
    if constexpr (Epi::AFTER_DRAIN) E.fused(acc, cur, wr, wc, fr, fq, lds, wid, lane);
#undef PG8_SA
#undef PG8_SB
#undef PG8_STAGE
#undef PG8_LDA
#undef PG8_LDB
#undef PG8_MMA
#undef PG8_WAIT_V
#undef PG8_WAIT_L
#undef PG8_BAR
#undef PG8_SCHED
}
}

struct SchedP1 {
    const char* A; const char* B; int G, vcu;
    __device__ __forceinline__ bool next(int i, pg8::Unit& u) const {
        const int U = i * G + vcu; if (U >= 64 * 24) return false;
        u.pm = 8 * ((U >> 5) & 7) + (U & 7); u.pn = 4 * (U >> 8) + ((U & 31) >> 3); u.j = 0; u.nt = 16;
        u.a = A + (size_t)u.pm * 256 * PITCHB; u.b = B + (size_t)u.pn * 256 * 2048; return true;
    }
};
struct SchedP3 {
    const char* ACTb; const char* Wg; const char* Wb; int G, vcu;
    __device__ __forceinline__ bool next(int i, pg8::Unit& u) const {
        const int T = vcu + (i / 6) * G; if (T >= 256) return false;
        int s = i % 6; int alt = 0;
        if (vcu & 1) {
            const int pos = s; s = (pos == 1) ? 2 : (pos == 2) ? 1 : pos; alt = (s == 2 || s == 3) ? 1 : 0; }
        u.pm = 8 * (T >> 5) + (T & 7); u.pn = (T & 31) >> 3; u.j = s | (alt << 3);
        const int j = s >> 1;
        if ((s & 1) == 0) { u.nt = 16; u.a = ACTb + (size_t)u.pm * 256 * PITCHB + C_H * 2; u.b = Wg + (size_t)(1024 * j + 256 * u.pn) * 2048; }
        else { u.nt = 8; u.a = ACTb + (size_t)u.pm * 256 * PITCHB + (size_t)(C_ZA + 2048 * j) * 2; u.b = Wb + (size_t)(1024 * j + 256 * u.pn) * 2048; }
        return true;
    }
};
struct SchedP4 {
    const char* ACTb; const char* Wo; int G, vcu;
    __device__ __forceinline__ bool next(int i, pg8::Unit& u) const {
        const int T = vcu + i * G; if (T >= 256) return false;
        u.pm = 8 * (T >> 5) + (T & 7); u.pn = (T & 31) >> 3; u.j = 0; u.nt = 16;
        u.a = ACTb + (size_t)u.pm * 256 * PITCHB + C_MERGED * 2; u.b = Wo + (size_t)(256 * u.pn) * 2048; return true;
    }
};

struct EpiP1 {
    static constexpr bool PERM = true, AFTER_DRAIN = false;
    bf16_t* ACT;
    __device__ __forceinline__ void operator()(const f32x4 (&acc)[2][2][4][2], const pg8::Unit& u, int wr, int wc, int fr, int fq) const {
        const int row0 = u.pm * 256 + wr * 64 + fr;
        if (u.pn >= 16) {
            const int T = u.pn - 16, col0 = (T < 4 ? C_PU + 128 * T : C_PZ + 128 * (T - 4)) + wc * 32 + 8 * fq;
#pragma unroll
            for (int ai = 0; ai < 2; ++ai)
#pragma unroll
                for (int m = 0; m < 4; ++m) { bf16_t* rowp = ACT + (size_t)(row0 + ai * 128 + m * 16) * PITCH + col0;
                    f32x4 v0 = acc[ai][1][m][0], v1 = acc[ai][1][m][1];
                    if (T >= 4) {
#pragma unroll
                        for (int e = 0; e < 4; ++e) { v0[e] = siluf_(v0[e]); v1[e] = siluf_(v1[e]); } }
                    v0 = v0 * acc[ai][0][m][0]; v1 = v1 * acc[ai][0][m][1];
                    u32x4 w; w.x = cvt_pk_bf16(v0[0], v0[1]); w.y = cvt_pk_bf16(v0[2], v0[3]); w.z = cvt_pk_bf16(v1[0], v1[1]); w.w = cvt_pk_bf16(v1[2], v1[3]);
                    *(u32x4*)rowp = w; }
            return;
        }
        const int grp = u.pn >> 1;
        const int kind = (grp == 0) ? 1 : ((grp == 3 || grp == 4 || grp == 7) ? 2 : 0);
        const int col0 = u.pn * 256 + wc * 32 + 8 * fq;
#pragma unroll
        for (int ai = 0; ai < 2; ++ai)
#pragma unroll
            for (int m = 0; m < 4; ++m) { bf16_t* rowp = ACT + (size_t)(row0 + ai * 128 + m * 16) * PITCH + col0;
#pragma unroll
                for (int bj = 0; bj < 2; ++bj) { f32x4 v0 = acc[ai][bj][m][0], v1 = acc[ai][bj][m][1];
                    if (kind == 1) { v0 = v0 * QSCALE; v1 = v1 * QSCALE; }
                    else if (kind == 2) {
#pragma unroll
                        for (int e = 0; e < 4; ++e) { v0[e] = siluf_(v0[e]); v1[e] = siluf_(v1[e]); } }
                    u32x4 w; w.x = cvt_pk_bf16(v0[0], v0[1]); w.y = cvt_pk_bf16(v0[2], v0[3]); w.z = cvt_pk_bf16(v1[0], v1[1]); w.w = cvt_pk_bf16(v1[2], v1[3]);
                    *(u32x4*)(rowp + bj * 128) = w; } }
    }
};
struct EpiP3 {
    static constexpr bool PERM = true, AFTER_DRAIN = false;
    unsigned char* ACTb;
    __device__ __forceinline__ void operator()(const f32x4 (&acc)[2][2][4][2], const pg8::Unit& u, int wr, int wc, int fr, int fq) const {
        const int s = u.j & 7, j = s >> 1;
        const int row0 = u.pm * 256 + wr * 64 + fr, cl0 = wc * 32 + 8 * fq;
        const unsigned toff = 512u * (unsigned)u.pn, moff = (unsigned)(C_MERGED + 256 * u.pn) * 2u, soff = (u.j & 8) ? moff : 5120u + 512u * (unsigned)u.pn;
        if ((s & 1) == 0) {
#pragma unroll
            for (int ai = 0; ai < 2; ++ai)
#pragma unroll
                for (int m = 0; m < 4; ++m) { unsigned char* rowp = ACTb + (size_t)(row0 + ai * 128 + m * 16) * PITCHB;
#pragma unroll
                    for (int bj = 0; bj < 2; ++bj) { const f32x4 v0 = acc[ai][bj][m][0], v1 = acc[ai][bj][m][1];
                        u32x4 w; w.x = cvt_pk_bf16(v0[0], v0[1]); w.y = cvt_pk_bf16(v0[2], v0[3]); w.z = cvt_pk_bf16(v1[0], v1[1]); w.w = cvt_pk_bf16(v1[2], v1[3]);
                        *(u32x4*)(rowp + soff + (cl0 + bj * 128) * 2) = w; } }
        } else {
#pragma unroll
            for (int ai = 0; ai < 2; ++ai) {
                u32x4 gq[4][2], tq[4][2];
#pragma unroll
                for (int m = 0; m < 4; ++m) { unsigned char* rowp = ACTb + (size_t)(row0 + ai * 128 + m * 16) * PITCHB;
#pragma unroll
                    for (int bj = 0; bj < 2; ++bj) { gq[m][bj] = *(const u32x4*)(rowp + soff + (cl0 + bj * 128) * 2); if (j > 0) tq[m][bj] = *(const u32x4*)(rowp + toff + (cl0 + bj * 128) * 2); } }
#pragma unroll
                for (int m = 0; m < 4; ++m) { unsigned char* rowp = ACTb + (size_t)(row0 + ai * 128 + m * 16) * PITCHB;
#pragma unroll
                    for (int bj = 0; bj < 2; ++bj) { const f32x4 v0 = acc[ai][bj][m][0], v1 = acc[ai][bj][m][1]; const u32x4 g = gq[m][bj];
                        f32x4 t0 = (f32x4){sigmoidf_(bf_lo(g.x)) * v0[0], sigmoidf_(bf_hi(g.x)) * v0[1], sigmoidf_(bf_lo(g.y)) * v0[2], sigmoidf_(bf_hi(g.y)) * v0[3]};
                        f32x4 t1 = (f32x4){sigmoidf_(bf_lo(g.z)) * v1[0], sigmoidf_(bf_hi(g.z)) * v1[1], sigmoidf_(bf_lo(g.w)) * v1[2], sigmoidf_(bf_hi(g.w)) * v1[3]};
                        if (j > 0) { const u32x4 tv = tq[m][bj];
                            t0 = t0 + (f32x4){bf_lo(tv.x), bf_hi(tv.x), bf_lo(tv.y), bf_hi(tv.y)}; t1 = t1 + (f32x4){bf_lo(tv.z), bf_hi(tv.z), bf_lo(tv.w), bf_hi(tv.w)}; }
                        u32x4 w; w.x = cvt_pk_bf16(t0[0], t0[1]); w.y = cvt_pk_bf16(t0[2], t0[3]); w.z = cvt_pk_bf16(t1[0], t1[1]); w.w = cvt_pk_bf16(t1[2], t1[3]);
                        if (j < 2) *(u32x4*)(rowp + toff + (cl0 + bj * 128) * 2) = w; else *(u32x4*)(rowp + moff + (cl0 + bj * 128) * 2) = w;
                    } }
            }
        }
    }
};
struct PanelStats {
    unsigned long long* xbuf;
    unsigned* cnt;
    float eps;
    __device__ __forceinline__ void run(const f32x4 (&v)[2][2][4][2], const pg8::Unit& u, int wr, int wc, int fr, int fq, LAS unsigned char* lds, int wid, int lane) const {
        LAS f32x2* Pt = (LAS f32x2*)lds;
        LAS f32x2* St = (LAS f32x2*)(lds + 8192);
#pragma unroll
        for (int ai = 0; ai < 2; ++ai)
#pragma unroll
            for (int m = 0; m < 4; ++m) {
                float s = 0.f;
#pragma unroll
                for (int bj = 0; bj < 2; ++bj)
#pragma unroll
                    for (int n = 0; n < 2; ++n) { const f32x4 x = v[ai][bj][m][n]; s += (x[0] + x[1]) + (x[2] + x[3]); }
                s += __shfl_xor(s, 16); s += __shfl_xor(s, 32);
                const float mw = s * (1.0f / 64.0f); float q = 0.f;
#pragma unroll
                for (int bj = 0; bj < 2; ++bj)
#pragma unroll
                    for (int n = 0; n < 2; ++n) { const f32x4 d = v[ai][bj][m][n] - mw; q += (d[0] * d[0] + d[1] * d[1]) + (d[2] * d[2] + d[3] * d[3]); }
                q += __shfl_xor(q, 16); q += __shfl_xor(q, 32);
                if (fq == 0) Pt[(ai * 128 + wr * 64 + m * 16 + fr) * 4 + wc] = (f32x2){mw, q};
            }
        __syncthreads();
        const int row = wid * 32 + (lane & 31);
        if (lane < 32) {
            const f32x2 a = Pt[row * 4 + 0], b = Pt[row * 4 + 1], c = Pt[row * 4 + 2], d = Pt[row * 4 + 3];
            const float mt = (a.x + b.x + c.x + d.x) * 0.25f;
            const float da = a.x - mt, db = b.x - mt, dc = c.x - mt, dd = d.x - mt;
            const float m2 = (a.y + b.y) + (c.y + d.y) + 64.0f * ((da * da + db * db) + (dc * dc + dd * dd));
            __hip_atomic_store(xbuf + ((size_t)(u.pm * 256 + row) * 4 + u.pn), ((unsigned long long)__float_as_uint(m2) << 32) | __float_as_uint(mt), __ATOMIC_RELAXED, __HIP_MEMORY_SCOPE_AGENT);
        }
        asm volatile("s_waitcnt vmcnt(0)" ::: "memory");
        if (lane == 0) __hip_atomic_fetch_add(cnt + 64 * u.pm, 1u, __ATOMIC_RELAXED, __HIP_MEMORY_SCOPE_AGENT);
        if (wid == 0) {
            unsigned sp = 0;
            while ((unsigned)__builtin_amdgcn_readfirstlane(__hip_atomic_load(cnt + 64 * u.pm, __ATOMIC_RELAXED, __HIP_MEMORY_SCOPE_AGENT)) < 32u) { __builtin_amdgcn_s_sleep(2); if (++sp > (1u << 24)) break; }
            __builtin_amdgcn_fence(__ATOMIC_ACQUIRE, "agent");
        }
        asm volatile("s_waitcnt vmcnt(0) lgkmcnt(0)" ::: "memory");
        __syncthreads();
        if (lane < 32) {
            const unsigned long long* slot = xbuf + (size_t)(u.pm * 256 + row) * 4; float mt[4], m2[4]; float ms = 0.f;
#pragma unroll
            for (int t = 0; t < 4; ++t) { const unsigned long long w = __hip_atomic_load(slot + t, __ATOMIC_RELAXED, __HIP_MEMORY_SCOPE_AGENT); mt[t] = __uint_as_float((unsigned)w); m2[t] = __uint_as_float((unsigned)(w >> 32)); ms += mt[t]; }
            const float mean = ms * 0.25f; float q = 0.f;
#pragma unroll
            for (int t = 0; t < 4; ++t) { const float dm = mt[t] - mean; q += m2[t] + 256.0f * dm * dm; }
            St[row] = (f32x2){mean, __builtin_amdgcn_rsqf(q * (1.0f / 1024.0f) + eps)};
        }
        __syncthreads();
    }
};
struct EpiP4F {
    static constexpr bool PERM = false, AFTER_DRAIN = true;
    const float* xprev; float* out; const float* gate; const float* lng; const float* lnb; const float* modn; bf16_t* ACT; PanelStats st1, st2;
    __device__ __forceinline__ void fused(f32x4 (&acc)[2][2][4][2], const pg8::Unit& u, int wr, int wc, int fr, int fq, LAS unsigned char* lds, int wid, int lane) const {
        const LAS f32x2* St = (const LAS f32x2*)(lds + 8192);
        const int row0 = u.pm * 256 + wr * 64 + fr, col0 = u.pn * 256 + wc * 32 + 4 * fq;
        const int bidx = (u.pm * 256) / SEQ;
        {
            const float* gp = gate + (size_t)bidx * 3072;
            f32x4 gv[2][2];
#pragma unroll
            for (int bj = 0; bj < 2; ++bj)
#pragma unroll
                for (int n = 0; n < 2; ++n) gv[bj][n] = *(const f32x4*)(gp + col0 + bj * 128 + n * 16) + 1.0f;
#pragma unroll
            for (int ai = 0; ai < 2; ++ai)
#pragma unroll
                for (int m = 0; m < 4; ++m) { const size_t off = (size_t)(row0 + ai * 128 + m * 16) * D_MODEL + col0;
#pragma unroll
                    for (int bj = 0; bj < 2; ++bj)
#pragma unroll
                        for (int n = 0; n < 2; ++n) { const f32x4 xv = ld_nt(xprev + off + bj * 128 + n * 16); acc[ai][bj][m][n] = xv * ALPHA + gv[bj][n] * acc[ai][bj][m][n]; }
                    asm volatile("" : "+v"(acc[ai][0][m][0]), "+v"(acc[ai][0][m][1]), "+v"(acc[ai][1][m][0]), "+v"(acc[ai][1][m][1]));
                    if (m == 3) asm volatile("" ::: "memory"); }
        }
        st1.run(acc, u, wr, wc, fr, fq, lds, wid, lane);
        {
            f32x4 lg[2][2], lb[2][2];
#pragma unroll
            for (int bj = 0; bj < 2; ++bj)
#pragma unroll
                for (int n = 0; n < 2; ++n) { lg[bj][n] = *(const f32x4*)(lng + col0 + bj * 128 + n * 16); lb[bj][n] = *(const f32x4*)(lnb + col0 + bj * 128 + n * 16); }
#pragma unroll
            for (int ai = 0; ai < 2; ++ai)
#pragma unroll
                for (int m = 0; m < 4; ++m) { const int r = ai * 128 + wr * 64 + m * 16 + fr; const f32x2 sr = St[r]; const size_t off = (size_t)(u.pm * 256 + r) * D_MODEL + col0;
#pragma unroll
                    for (int bj = 0; bj < 2; ++bj)
#pragma unroll
                        for (int n = 0; n < 2; ++n) { const f32x4 x1 = (acc[ai][bj][m][n] - sr.x) * sr.y * lg[bj][n] + lb[bj][n]; acc[ai][bj][m][n] = x1;
                            __builtin_nontemporal_store(x1, (f32x4*)(out + off + bj * 128 + n * 16)); }
                    asm volatile("" : "+v"(acc[ai][0][m][0]), "+v"(acc[ai][0][m][1]), "+v"(acc[ai][1][m][0]), "+v"(acc[ai][1][m][1]));
                    asm volatile("" ::: "memory"); }
        }
        if (modn) {
            st2.run(acc, u, wr, wc, fr, fq, lds, wid, lane);
            const float* mp = modn + (size_t)bidx * 3072;
            f32x4 sc[2][2], sh[2][2];
#pragma unroll
            for (int bj = 0; bj < 2; ++bj)
#pragma unroll
                for (int n = 0; n < 2; ++n) { sh[bj][n] = *(const f32x4*)(mp + col0 + bj * 128 + n * 16); sc[bj][n] = *(const f32x4*)(mp + 1024 + col0 + bj * 128 + n * 16) + 1.0f; }
#pragma unroll
            for (int ai = 0; ai < 2; ++ai)
#pragma unroll
                for (int m = 0; m < 4; ++m) { const int r = ai * 128 + wr * 64 + m * 16 + fr; const f32x2 sr = St[r]; bf16_t* hp = ACT + (size_t)(u.pm * 256 + r) * PITCH + C_H + col0;
#pragma unroll
                    for (int bj = 0; bj < 2; ++bj)
#pragma unroll
                        for (int n = 0; n < 2; ++n) { const f32x4 hv = (acc[ai][bj][m][n] - sr.x) * sr.y * sc[bj][n] + sh[bj][n];
                            u32x2 w; w.x = cvt_pk_bf16(hv[0], hv[1]); w.y = cvt_pk_bf16(hv[2], hv[3]); *(u32x2*)(hp + bj * 128 + n * 16) = w; }
                    asm volatile("" ::: "memory"); }
        }
    }
};

__device__ __forceinline__ void transpose_item(const float* W, int N, bf16_t* WT, int ldw, LAS float* scr, int item, int lane, bool conv_perm = false) {
    const int nblk = N / 32, kb = item / nblk, nb = item % nblk, k0 = 64 * kb, n0 = 32 * nb;
    int d0 = n0;
    if (conv_perm && n0 >= 4096 && n0 < 6144) { const int g = (n0 - 4096) >> 9, ch0 = (n0 - 4096) & 511; d0 = 4096 + 256 * ((ch0 >> 7) + ((g & 1) ? 4 : 0)) + 128 * (g >> 1) + (ch0 & 127); }
    const int kr = lane >> 3, n4 = (lane & 7) * 4;
    f32x4 v[8];
#pragma unroll
    for (int i = 0; i < 8; ++i) v[i] = ld_nt(W + (size_t)(k0 + 8 * i + kr) * N + n0 + n4);
#pragma unroll
    for (int i = 0; i < 8; ++i) { LAS float* d = scr + (8 * i + kr) * 33 + n4; d[0] = v[i].x; d[1] = v[i].y; d[2] = v[i].z; d[3] = v[i].w; }
    asm volatile("s_waitcnt lgkmcnt(0)" ::: "memory");
    const int c = lane & 7;
#pragma unroll
    for (int j = 0; j < 4; ++j) { const int n = (lane >> 3) + 8 * j; const LAS float* s = scr + (8 * c) * 33 + n;
        u32x4 o; o.x = cvt_pk_bf16(s[0 * 33], s[1 * 33]); o.y = cvt_pk_bf16(s[2 * 33], s[3 * 33]); o.z = cvt_pk_bf16(s[4 * 33], s[5 * 33]); o.w = cvt_pk_bf16(s[6 * 33], s[7 * 33]);
        *(u32x4*)(WT + (size_t)(d0 + n) * ldw + k0 + 8 * c) = o; }
    asm volatile("s_waitcnt lgkmcnt(0)" ::: "memory");
}

__device__ __forceinline__ void row_standardize(f32x4 (&v)[4]) {
    float s = 0.f;
#pragma unroll
    for (int j = 0; j < 4; ++j) s += (v[j].x + v[j].y) + (v[j].z + v[j].w);
    const float mean = wave_sum(s) * (1.f / D_MODEL); float s2 = 0.f;
#pragma unroll
    for (int j = 0; j < 4; ++j) { v[j] = v[j] - mean; s2 += (v[j].x * v[j].x + v[j].y * v[j].y) + (v[j].z * v[j].z + v[j].w * v[j].w); }
    const float rstd = __builtin_amdgcn_rsqf(wave_sum(s2) * (1.f / D_MODEL) + LN_EPS);
#pragma unroll
    for (int j = 0; j < 4; ++j) v[j] = v[j] * rstd;
}
__device__ __forceinline__ void write_h_row(const f32x4 (&v)[4], const float* modb, bf16_t* hrow, int lane) {
#pragma unroll
    for (int j = 0; j < 4; ++j) { const int col = 4 * (lane + 64 * j);
        const f32x4 sh = *(const f32x4*)(modb + col), sc = *(const f32x4*)(modb + 1024 + col);
        const f32x4 h = v[j] * (sc + 1.0f) + sh;
        u32x2 w; w.x = cvt_pk_bf16(h.x, h.y); w.y = cvt_pk_bf16(h.z, h.w);
        *(u32x2*)(hrow + col) = w; }
}

typedef short v4i16_t __attribute__((ext_vector_type(4)));
__device__ __forceinline__ s16x4 vtr(const LAS bf16_t* p) { return __builtin_bit_cast(s16x4, __builtin_amdgcn_ds_read_tr16_b64_v4i16((LAS v4i16_t*)p)); }
constexpr float STICK_DEAD = -44.0f;
__device__ __forceinline__ void attn_unit(LAS unsigned char* lds, bf16_t* ACT, int b, int h, int qb) {
    const int tid = fresh_tid(), lane = tid & 63, r32 = lane & 31, hi = lane >> 5;
    const int wid = __builtin_amdgcn_readfirstlane(tid >> 6);
    bf16_t* base = ACT + (size_t)b * SEQ * PITCH;
    const int tq0 = qb * 256 + wid * 32, tq = tq0 + r32;
    LAS bf16_t* Kw = (LAS bf16_t*)(lds + wid * 9728);
    LAS bf16_t* Vw = Kw + 32 * 72;
    LAS float* stg = (LAS float*)(lds + wid * 9728);
    bf16x8 qr[4];
#pragma unroll
    for (int d0 = 0; d0 < 4; ++d0) qr[d0] = __builtin_nontemporal_load((const bf16x8*)(base + (size_t)tq * PITCH + C_QA + h * 64 + d0 * 16 + hi * 8));
    f32x16 o0, o1;
#pragma unroll
    for (int r = 0; r < 16; ++r) { o0[r] = 0.f; o1[r] = 0.f; }
    float R = 0.f;
    const int srow = lane >> 3, sch = lane & 7;
    const bf16_t* kg = base + (size_t)srow * PITCH + C_KA + h * 64 + sch * 8;
    const bf16_t* vg = base + (size_t)srow * PITCH + C_VA + h * 64 + sch * 8;
    const LAS bf16_t* vb = Vw + (4 * hi + ((lane & 15) >> 2)) * 80 + 16 * ((lane >> 4) & 1) + 4 * (lane & 3);
    u32x4 kreg[4], vreg[4];
    int kb = tq0;
#pragma unroll
    for (int i = 0; i < 4; ++i) { kreg[i] = *(const u32x4*)(kg + (size_t)(kb + 8 * i) * PITCH); vreg[i] = *(const u32x4*)(vg + (size_t)(kb + 8 * i) * PITCH); }
    for (;;) {
#pragma unroll
        for (int i = 0; i < 4; ++i) { *(LAS u32x4*)(Kw + (srow + 8 * i) * 72 + sch * 8) = kreg[i]; *(LAS u32x4*)(Vw + (srow + 8 * i) * 80 + sch * 8) = vreg[i]; }
        const int kbn = kb - 32;
        if (kbn >= 0) {
#pragma unroll
            for (int i = 0; i < 4; ++i) { kreg[i] = *(const u32x4*)(kg + (size_t)(kbn + 8 * i) * PITCH); vreg[i] = *(const u32x4*)(vg + (size_t)(kbn + 8 * i) * PITCH); }
        }
        f32x16 p0;
#pragma unroll
        for (int r = 0; r < 16; ++r) p0[r] = 0.f;
#pragma unroll
        for (int d0 = 0; d0 < 4; ++d0) {
            const bf16x8 a0 = *(const LAS bf16x8*)(Kw + r32 * 72 + d0 * 16 + hi * 8);
            p0 = __builtin_amdgcn_mfma_f32_32x32x16_bf16(a0, qr[d0], p0, 0, 0, 0);
        }
        float x0[16];
        if (kb < tq0) {
#pragma unroll
            for (int r = 0; r < 16; ++r) { const float z = p0[r]; const float sp = fmaxf(z, 0.f) + lg2(1.0f + ex2(-fabsf(z))); x0[r] = sp; p0[r] = z - sp; }
        } else {
            const int kvl = kb + 4 * hi;
#pragma unroll
            for (int r = 0; r < 16; ++r) { const int kv = kvl + (r & 3) + 8 * (r >> 2);
                const float z = p0[r]; const float sp = fmaxf(z, 0.f) + lg2(1.0f + ex2(-fabsf(z))); const bool ok = kv < tq; x0[r] = ok ? sp : 0.f; p0[r] = ok ? z - sp : -INFINITY; }
        }
        float Gs[4], Gh1[4], Tt[4];
#pragma unroll
        for (int g = 0; g < 4; ++g) Gs[g] = (x0[4 * g] + x0[4 * g + 1]) + (x0[4 * g + 2] + x0[4 * g + 3]);
#pragma unroll
        for (int g = 0; g < 4; ++g) { auto rr = __builtin_amdgcn_permlane32_swap(__float_as_uint(Gs[g]), __float_as_uint(Gs[g]), false, false);
            Gh1[g] = __uint_as_float(rr[1]); Tt[g] = __uint_as_float(rr[0]) + __uint_as_float(rr[1]); }
        float run = R;
#pragma unroll
        for (int g = 3; g >= 0; --g) {
            const float off = hi ? run : run - Gh1[g];
            const int q4 = 4 * g;
            const float s3 = off, s2 = s3 - x0[q4 + 3], s1 = s2 - x0[q4 + 2], s0 = s1 - x0[q4 + 1];
            p0[q4 + 3] = ex2(p0[q4 + 3] + s3); p0[q4 + 2] = ex2(p0[q4 + 2] + s2); p0[q4 + 1] = ex2(p0[q4 + 1] + s1); p0[q4] = ex2(p0[q4] + s0);
            run -= Tt[g];
        }
        R = run;
#pragma unroll
        for (int s = 0; s < 2; ++s) {
            u32x4 w; const int r0 = 8 * s;
            w.x = cvt_pk_bf16(p0[r0], p0[r0 + 1]); w.y = cvt_pk_bf16(p0[r0 + 2], p0[r0 + 3]); w.z = cvt_pk_bf16(p0[r0 + 4], p0[r0 + 5]); w.w = cvt_pk_bf16(p0[r0 + 6], p0[r0 + 7]);
            const bf16x8 af = __builtin_bit_cast(bf16x8, w);
            { const s16x4 lo = vtr(vb + (16 * s) * 80), hh = vtr(vb + (16 * s + 8) * 80);
              const bf16x8 bfr = (bf16x8){lo[0], lo[1], lo[2], lo[3], hh[0], hh[1], hh[2], hh[3]};
              o0 = __builtin_amdgcn_mfma_f32_32x32x16_bf16(af, bfr, o0, 0, 0, 0); }
            { const s16x4 lo = vtr(vb + (16 * s) * 80 + 32), hh = vtr(vb + (16 * s + 8) * 80 + 32);
              const bf16x8 bfr = (bf16x8){lo[0], lo[1], lo[2], lo[3], hh[0], hh[1], hh[2], hh[3]};
              o1 = __builtin_amdgcn_mfma_f32_32x32x16_bf16(af, bfr, o1, 0, 0, 0); }
        }
        if (kbn < 0 || !__any(R > STICK_DEAD)) break;
        kb = kbn;
    }
#pragma unroll
    for (int r = 0; r < 16; ++r) { stg[crow(r, hi) * 68 + r32] = o0[r]; stg[crow(r, hi) * 68 + 32 + r32] = o1[r]; }
    asm volatile("s_waitcnt lgkmcnt(0)" ::: "memory");
#pragma unroll
    for (int i = 0; i < 4; ++i) { const int row = i * 8 + (lane >> 3), ch = lane & 7;
        const f32x4 a = *(const LAS f32x4*)(stg + row * 68 + ch * 8), c = *(const LAS f32x4*)(stg + row * 68 + ch * 8 + 4);
        bf16_t* zp = base + (size_t)(tq0 + row) * PITCH + C_ZA + h * 64 + ch * 8;
        const u32x4 z = __builtin_nontemporal_load((const u32x4*)zp);
        u32x4 w; w.x = cvt_pk_bf16(a.x * bf_lo(z.x), a.y * bf_hi(z.x)); w.y = cvt_pk_bf16(a.z * bf_lo(z.y), a.w * bf_hi(z.y));
        w.z = cvt_pk_bf16(c.x * bf_lo(z.z), c.y * bf_hi(z.z)); w.w = cvt_pk_bf16(c.z * bf_lo(z.w), c.w * bf_hi(z.w));
        *(u32x4*)zp = w; }
    asm volatile("s_waitcnt lgkmcnt(0)" ::: "memory");
}

__device__ __forceinline__ float layer_lb(const float* lower_bounds, int l, int ch) {
    float mx = -INFINITY;
    for (int i = 0; i < DEPTH; ++i) mx = fmaxf(mx, lower_bounds[i * 512 + ch]);
    float den = 0.f, num = 0.f;
    for (int i = 0; i < DEPTH; ++i) { const float e = __expf(lower_bounds[i * 512 + ch] - mx); den += e; if (i >= 1 && i <= l) num += e; }
    return num / den;
}
template <int MODE>
__device__ __forceinline__ void hgrn_pass(LAS unsigned char* lds, bf16_t* ACT, const Params& P, int l, int bh, int c0, int nc) {
    const int tid = fresh_tid(), lane = tid & 63, r32 = lane & 31, hi = lane >> 5;
    const int wid = __builtin_amdgcn_readfirstlane(tid >> 6);
    LAS bf16_t* Q1 = (LAS bf16_t*)(lds);
    LAS bf16_t* Q2 = (LAS bf16_t*)(lds + 17408);
    LAS bf16_t* K2 = (LAS bf16_t*)(lds + 34816);
    LAS float*  OT = (LAS float*)(lds);
    LAS bf16_t* K3T = (LAS bf16_t*)(lds + 52224);
    LAS bf16_t* VT = (LAS bf16_t*)(lds + 70656);
    LAS bf16_t* Pm = (LAS bf16_t*)(lds + 89088);
    LAS bf16_t* ST = (LAS bf16_t*)(lds + 98304);
    LAS float* DEND = (LAS float*)(lds + 133120);
    LAS float* SCX = (LAS float*)(lds + 133632);
    const int d = tid & 127, part = tid >> 7, b = bh >> 2, h = bh & 3, grp = c0 / nc;
    const float lbv = layer_lb(P.lower_bounds, l, h * 128 + d);
    bf16_t* base = ACT + (size_t)b * SEQ * PITCH + h * 128;
    bf16_t* Ug = (bf16_t*)(P.ws + WS_U) + (size_t)bh * 8 * 16384;
    float* Dg = (float*)(P.ws + WS_DEND) + (size_t)bh * 8 * 128;
    const float* nw = P.hgrn_norm_w + l * 128;
    const int tb = wid & 1, eb = wid >> 1;
    bf16_t fin[16], qin[16], vin[16];
#pragma unroll
    for (int i = 0; i < 16; ++i) { const bf16_t* rp = base + (size_t)(c0 * 64 + 16 * part + i) * PITCH + d;
        if (MODE == 1) { fin[i] = __builtin_nontemporal_load(rp + C_FB); vin[i] = __builtin_nontemporal_load(rp + C_IB); qin[i] = __builtin_nontemporal_load(rp + C_QB); }
        else { fin[i] = rp[C_FB]; vin[i] = rp[C_IB]; } }
    f32x16 sa[2];
#pragma unroll
    for (int r = 0; r < 16; ++r) { sa[0][r] = 0.f; sa[1][r] = 0.f; }
    float bsum = 0.f;
    if (MODE == 1) {
        const int d8 = (tid & 15) * 8;
        f32x4 Sp[4][2];
#pragma unroll
        for (int i = 0; i < 4; ++i) { Sp[i][0] = (f32x4){0.f, 0.f, 0.f, 0.f}; Sp[i][1] = (f32x4){0.f, 0.f, 0.f, 0.f}; }
        for (int k = 0; k < grp; ++k) {
            const f32x4 da = *(const f32x4*)(Dg + k * 128 + d8), db = *(const f32x4*)(Dg + k * 128 + d8 + 4);
            u32x4 uv[4];
#pragma unroll
            for (int i = 0; i < 4; ++i) { const int idx = tid + 512 * i; uv[i] = *(const u32x4*)(Ug + (size_t)k * 16384 + (idx >> 4) * 128 + d8); }
#pragma unroll
            for (int i = 0; i < 4; ++i) {
                Sp[i][0] = da * Sp[i][0] + (f32x4){bf_lo(uv[i].x), bf_hi(uv[i].x), bf_lo(uv[i].y), bf_hi(uv[i].y)};
                Sp[i][1] = db * Sp[i][1] + (f32x4){bf_lo(uv[i].z), bf_hi(uv[i].z), bf_lo(uv[i].w), bf_hi(uv[i].w)}; }
        }
#pragma unroll
        for (int i = 0; i < 4; ++i) { const int idx = tid + 512 * i;
            u32x4 v; v.x = cvt_pk_bf16(Sp[i][0][0], Sp[i][0][1]); v.y = cvt_pk_bf16(Sp[i][0][2], Sp[i][0][3]); v.z = cvt_pk_bf16(Sp[i][1][0], Sp[i][1][1]); v.w = cvt_pk_bf16(Sp[i][1][2], Sp[i][1][3]);
            *(LAS u32x4*)(ST + (idx >> 4) * 136 + d8) = v; }
        __syncthreads();
#pragma unroll
        for (int i = 0; i < 2; ++i) { const int db = 2 * (wid & 1) + i;
#pragma unroll
            for (int g = 0; g < 4; ++g) { const u32x2 w = *(const LAS u32x2*)(ST + (32 * eb + r32) * 136 + 32 * db + 8 * g + 4 * hi);
                sa[i][4 * g] = bf_lo(w.x); sa[i][4 * g + 1] = bf_hi(w.x); sa[i][4 * g + 2] = bf_lo(w.y); sa[i][4 * g + 3] = bf_hi(w.y); } }
    }
    for (int ci = 0; ci < nc; ++ci) {
        const int c = c0 + ci;
        float g2[16], kk[16];
        float runb = 0.f;
#pragma unroll
        for (int i = 0; i < 16; ++i) { const float f = lbv + (1.0f - lbv) * sigmoidf_(bf2f(fin[i])); kk[i] = 1.0f - f; runb += lg2(f); g2[i] = runb; }
        SCX[part * 128 + d] = runb;
        __syncthreads();
        const float t0 = SCX[d], t1 = SCX[128 + d], t2 = SCX[256 + d], t3 = SCX[384 + d];
        const float offp = (part > 0 ? t0 : 0.f) + (part > 1 ? t1 : 0.f) + (part > 2 ? t2 : 0.f);
        const float cmid = t0 + t1, bend = (t0 + t1) + (t2 + t3);
        bsum += bend;
        if (part == 0) DEND[d] = ex2(bend);
        {
            unsigned k3w[8], vw[8];
#pragma unroll
            for (int i = 0; i < 16; i += 2) {
                const float B0 = offp + g2[i], B1 = offp + g2[i + 1];
                if (MODE == 1) {
                    const float q0 = bf2f(qin[i]), q1 = bf2f(qin[i + 1]);
                    const int t = 16 * part + i;
                    Q1[t * 136 + d] = (bf16_t)(cvt_pk_bf16(q0 * ex2(B0), 0.f) & 0xffffu); Q1[(t + 1) * 136 + d] = (bf16_t)(cvt_pk_bf16(q1 * ex2(B1), 0.f) & 0xffffu);
                    Q2[t * 136 + d] = (bf16_t)(cvt_pk_bf16(q0 * ex2(B0 - cmid), 0.f) & 0xffffu); Q2[(t + 1) * 136 + d] = (bf16_t)(cvt_pk_bf16(q1 * ex2(B1 - cmid), 0.f) & 0xffffu);
                    K2[t * 136 + d] = (bf16_t)(cvt_pk_bf16(kk[i] * ex2(cmid - B0), 0.f) & 0xffffu); K2[(t + 1) * 136 + d] = (bf16_t)(cvt_pk_bf16(kk[i + 1] * ex2(cmid - B1), 0.f) & 0xffffu);
                }
                k3w[i >> 1] = cvt_pk_bf16(kk[i] * ex2(bend - B0), kk[i + 1] * ex2(bend - B1));
                vw[i >> 1] = (unsigned)vin[i] | ((unsigned)vin[i + 1] << 16);
            }
            *(LAS u32x4*)(K3T + d * 72 + 16 * part) = (u32x4){k3w[0], k3w[1], k3w[2], k3w[3]}; *(LAS u32x4*)(K3T + d * 72 + 16 * part + 8) = (u32x4){k3w[4], k3w[5], k3w[6], k3w[7]};
            *(LAS u32x4*)(VT + d * 72 + 16 * part) = (u32x4){vw[0], vw[1], vw[2], vw[3]}; *(LAS u32x4*)(VT + d * 72 + 16 * part + 8) = (u32x4){vw[4], vw[5], vw[6], vw[7]};
        }
        if (ci + 1 < nc) {
#pragma unroll
            for (int i = 0; i < 16; ++i) { const bf16_t* rp = base + (size_t)((c + 1) * 64 + 16 * part + i) * PITCH + d;
                if (MODE == 1) { fin[i] = __builtin_nontemporal_load(rp + C_FB); vin[i] = __builtin_nontemporal_load(rp + C_IB); qin[i] = __builtin_nontemporal_load(rp + C_QB); }
                else { fin[i] = rp[C_FB]; vin[i] = rp[C_IB]; } }
        }
        __syncthreads();
        if (MODE == 0) {
#pragma unroll
            for (int i = 0; i < 2; ++i) {
                const int db = 2 * (wid & 1) + i;
#pragma unroll
                for (int r = 0; r < 16; ++r) sa[i][r] *= DEND[32 * db + crow(r, hi)];
#pragma unroll
                for (int ks = 0; ks < 4; ++ks) {
                    const bf16x8 a = *(const LAS bf16x8*)(K3T + (32 * db + r32) * 72 + 16 * ks + 8 * hi);
                    const bf16x8 bb = *(const LAS bf16x8*)(VT + (32 * eb + r32) * 72 + 16 * ks + 8 * hi);
                    sa[i] = __builtin_amdgcn_mfma_f32_32x32x16_bf16(a, bb, sa[i], 0, 0, 0);
                }
            }
        } else {
            f32x16 o;
#pragma unroll
            for (int r = 0; r < 16; ++r) o[r] = 0.f;
            if (c > 0) {
#pragma unroll
                for (int ks = 0; ks < 8; ++ks) {
                    const bf16x8 a = *(const LAS bf16x8*)(Q1 + (32 * tb + r32) * 136 + 16 * ks + 8 * hi);
                    const bf16x8 bb = *(const LAS bf16x8*)(ST + (32 * eb + r32) * 136 + 16 * ks + 8 * hi);
                    o = __builtin_amdgcn_mfma_f32_32x32x16_bf16(a, bb, o, 0, 0, 0);
                }
            }
            if (wid < 4) {
                const int stb = wid & 1, ssb = wid >> 1;
                f32x16 sc;
#pragma unroll
                for (int r = 0; r < 16; ++r) sc[r] = 0.f;
                if (!(stb == 0 && ssb == 1)) {
#pragma unroll
                    for (int ks = 0; ks < 8; ++ks) {
                        const bf16x8 a = *(const LAS bf16x8*)(Q2 + (32 * stb + r32) * 136 + 16 * ks + 8 * hi);
                        const bf16x8 bb = *(const LAS bf16x8*)(K2 + (32 * ssb + r32) * 136 + 16 * ks + 8 * hi);
                        sc = __builtin_amdgcn_mfma_f32_32x32x16_bf16(a, bb, sc, 0, 0, 0);
                    }
                }
#pragma unroll
                for (int r = 0; r < 16; ++r) { const int t = 32 * stb + crow(r, hi), s = 32 * ssb + r32;
                    const float v = (s <= t) ? sc[r] : 0.f;
                    Pm[t * 72 + s] = (bf16_t)(cvt_pk_bf16(v, 0.f) & 0xffffu); }
            }
            __syncthreads();
            unsigned zz[8];
#pragma unroll
            for (int i = 0; i < 8; ++i) zz[i] = __builtin_nontemporal_load((const unsigned*)(base + (size_t)(c * 64 + 8 * wid + i) * PITCH + C_ZB + 2 * lane));
#pragma unroll
            for (int ks = 0; ks < 4; ++ks) {
                const bf16x8 a = *(const LAS bf16x8*)(Pm + (32 * tb + r32) * 72 + 16 * ks + 8 * hi);
                const bf16x8 bb = *(const LAS bf16x8*)(VT + (32 * eb + r32) * 72 + 16 * ks + 8 * hi);
                o = __builtin_amdgcn_mfma_f32_32x32x16_bf16(a, bb, o, 0, 0, 0);
            }
#pragma unroll
            for (int r = 0; r < 16; ++r) OT[(32 * tb + crow(r, hi)) * 132 + 32 * eb + r32] = o[r];
            if (ci + 1 < nc) {
#pragma unroll
                for (int i = 0; i < 2; ++i) {
                    const int db = 2 * (wid & 1) + i;
#pragma unroll
                    for (int r = 0; r < 16; ++r) sa[i][r] *= DEND[32 * db + crow(r, hi)];
#pragma unroll
                    for (int ks = 0; ks < 4; ++ks) {
                        const bf16x8 a = *(const LAS bf16x8*)(K3T + (32 * db + r32) * 72 + 16 * ks + 8 * hi);
                        const bf16x8 bb = *(const LAS bf16x8*)(VT + (32 * eb + r32) * 72 + 16 * ks + 8 * hi);
                        sa[i] = __builtin_amdgcn_mfma_f32_32x32x16_bf16(a, bb, sa[i], 0, 0, 0);
                    }
#pragma unroll
                    for (int g = 0; g < 4; ++g) { u32x2 w; w.x = cvt_pk_bf16(sa[i][4 * g], sa[i][4 * g + 1]); w.y = cvt_pk_bf16(sa[i][4 * g + 2], sa[i][4 * g + 3]);
                        *(LAS u32x2*)(ST + (32 * eb + r32) * 136 + 32 * db + 8 * g + 4 * hi) = w; }
                }
            }
            __syncthreads();
            {
                const f32x2 nwv = *(const f32x2*)(nw + 2 * lane);
#pragma unroll
                for (int i = 0; i < 8; ++i) { const int t = 8 * wid + i;
                    const f32x2 v = *(const LAS f32x2*)(OT + t * 132 + 2 * lane);
                    const float ss = wave_sum(v.x * v.x + v.y * v.y);
                    const float rstd = __builtin_amdgcn_rsqf(ss * (1.0f / 128.0f) + RMS_EPS);
                    unsigned* zp = (unsigned*)(base + (size_t)(c * 64 + t) * PITCH + C_ZB + 2 * lane);
                    *zp = cvt_pk_bf16(v.x * rstd * nwv.x * bf_lo(zz[i]), v.y * rstd * nwv.y * bf_hi(zz[i])); }
            }
        }
    }
    if (MODE == 0) {
        __syncthreads();
#pragma unroll
        for (int i = 0; i < 2; ++i) { const int db = 2 * (wid & 1) + i;
#pragma unroll
            for (int g = 0; g < 4; ++g) { u32x2 w; w.x = cvt_pk_bf16(sa[i][4 * g], sa[i][4 * g + 1]); w.y = cvt_pk_bf16(sa[i][4 * g + 2], sa[i][4 * g + 3]);
                *(LAS u32x2*)(ST + (32 * eb + r32) * 136 + 32 * db + 8 * g + 4 * hi) = w; } }
        __syncthreads();
#pragma unroll
        for (int i = 0; i < 4; ++i) { const int idx = tid + 512 * i;
            *(u32x4*)(Ug + (size_t)grp * 16384 + (idx >> 4) * 128 + (idx & 15) * 8) = *(const LAS u32x4*)(ST + (idx >> 4) * 136 + (idx & 15) * 8); }
        if (part == 0) Dg[grp * 128 + d] = ex2(bsum);
    }
    __syncthreads();
}

__device__ __forceinline__ void unpack8(const u32x4 a, float (&o)[8]) {
    o[0] = bf_lo(a.x); o[1] = bf_hi(a.x); o[2] = bf_lo(a.y); o[3] = bf_hi(a.y); o[4] = bf_lo(a.z); o[5] = bf_hi(a.z); o[6] = bf_lo(a.w); o[7] = bf_hi(a.w);
}
__device__ __forceinline__ void conv_item(bf16_t* ACT, const float* cw, int item) {
    const int tid = fresh_tid(), cgp = tid & 63, sub = tid >> 6;
    const int m0 = item * 64 + sub * 8, ch = cgp * 8;
    float w0[8], w1[8], w2[8];
#pragma unroll
    for (int e = 0; e < 8; ++e) { w0[e] = cw[ch + e]; w1[e] = cw[512 + ch + e]; w2[e] = cw[1024 + ch + e]; }
    float p1[8], p2[8];
#pragma unroll
    for (int e = 0; e < 8; ++e) { p1[e] = 0.f; p2[e] = 0.f; }
    if ((m0 % SEQ) != 0) {
        unpack8(*(const u32x4*)(ACT + (size_t)(m0 - 2) * PITCH + C_PU + ch), p2);
        unpack8(*(const u32x4*)(ACT + (size_t)(m0 - 1) * PITCH + C_PU + ch), p1);
    }
    u32x4 pa[8], pzv[8];
#pragma unroll
    for (int i = 0; i < 8; ++i) { const bf16_t* rp = ACT + (size_t)(m0 + i) * PITCH + ch; pa[i] = __builtin_nontemporal_load((const u32x4*)(rp + C_PU)); pzv[i] = __builtin_nontemporal_load((const u32x4*)(rp + C_PZ)); }
#pragma unroll
    for (int i = 0; i < 8; ++i) {
        float pu[8], pz[8], y[8];
        unpack8(pa[i], pu); unpack8(pzv[i], pz);
#pragma unroll
        for (int e = 0; e < 8; ++e) { y[e] = pz[e] * (w0[e] * p2[e] + w1[e] * p1[e] + w2[e] * pu[e]); p2[e] = p1[e]; p1[e] = pu[e]; }
        u32x4 w; w.x = cvt_pk_bf16(y[0], y[1]); w.y = cvt_pk_bf16(y[2], y[3]); w.z = cvt_pk_bf16(y[4], y[5]); w.w = cvt_pk_bf16(y[6], y[7]);
        *(u32x4*)(ACT + (size_t)(m0 + i) * PITCH + C_ZC + ch) = w;
    }
}

constexpr int WC_SPLIT = 16 * (IN_COLS / 32) + 3 * 8 * 32, WC_ALL = WC_SPLIT + 16 * 32;
__device__ __forceinline__ void convert_weights(const Params& P, int l, LAS unsigned char* lds, int gw, int NGW, int wid, int lane, int it_lo = 0, int it_hi = WC_ALL) {
    LAS float* scr = (LAS float*)(lds + wid * 16384);
    unsigned char* ws = P.ws;
    constexpr int I_IN = 16 * (IN_COLS / 32), I_B = 8 * 32, I_O = 16 * 32, I_L = I_IN + 3 * I_B + I_O;
    for (int it = it_lo + gw; it < it_hi; it += NGW) {
        int r = it;
        if (r < I_IN) { transpose_item(P.w_in + (size_t)l * 1024 * IN_COLS, IN_COLS, (bf16_t*)(ws + WS_WIN), 1024, scr, r, lane, true); continue; } r -= I_IN;
        if (r < 3 * I_B) { const int j = r / I_B; transpose_item(P.w_branch + (size_t)(l * 3 + j) * 512 * 1024, 1024, (bf16_t*)(ws + WS_WB) + (size_t)j * 1024 * 1024, 1024, scr, r % I_B, lane); continue; } r -= 3 * I_B;
        transpose_item(P.w_out + (size_t)l * 1024 * 1024, 1024, (bf16_t*)(ws + WS_WO), 1024, scr, r, lane);
    }
}

typedef const __attribute__((address_space(4))) Params* KParamsPtr;
#define XB_TMO      128
#define XB_XCNT(j)  (256  + 64 * (j))
#define XB_XSUB(j)  (1280 + 64 * (j))
#define XB_XGEN(j)  (2304 + 64 * (j))
#define XB_TOP      3328
#define XB_TOPGEN   3392
#define XCD_BAR_WORDS 3456
#define XB_SPIN_CAP (1u << 22)
__device__ __forceinline__ unsigned xb_ld(unsigned* p)              { return __hip_atomic_load(p, __ATOMIC_RELAXED, __HIP_MEMORY_SCOPE_AGENT); }
__device__ __forceinline__ unsigned xb_add(unsigned* p, unsigned v) { return __hip_atomic_fetch_add(p, v, __ATOMIC_RELAXED, __HIP_MEMORY_SCOPE_AGENT); }
__device__ __forceinline__ unsigned xb_xcc_id() { return (unsigned)__builtin_amdgcn_s_getreg((3 << 11) | 20) & 0xFu; }
#define XB_SPIN(cond, bar) do { unsigned _sp = 0; while (cond) { __builtin_amdgcn_s_sleep(1); \
    if ((++_sp & 255u) == 0u) { if (xb_ld(&(bar)[XB_TMO])) break; if (_sp > XB_SPIN_CAP) { atomicAdd(&(bar)[XB_TMO], 1u); break; } } } } while (0)
__device__ __forceinline__ void xcd_barrier_complete(unsigned* bar, unsigned x, unsigned& nloc, unsigned& nx) {
    const unsigned G = gridDim.x * gridDim.y * gridDim.z;
    unsigned sum, cnt, mine, sp = 0u;
    for (;;) {
        sum = 0u; cnt = 0u; mine = 0u;
#pragma unroll
        for (unsigned j = 0; j < 16; ++j) { const unsigned c = xb_ld(&bar[XB_XCNT(j)]); sum += c; cnt += (c > 0u) ? 1u : 0u; mine = (j == x) ? c : mine; }
        if (sum == G) break;
        __builtin_amdgcn_s_sleep(1);
        if ((++sp & 255u) == 0u) { if (xb_ld(&bar[XB_TMO])) break; if (sp > XB_SPIN_CAP) { atomicAdd(&bar[XB_TMO], 1u); break; } }
    }
    nloc = mine > 0u ? mine : 1u; nx = cnt > 0u ? cnt : 1u;
}
__device__ __forceinline__ void xcd_barrier(unsigned* bar, volatile LAS unsigned* st) {
    asm volatile("s_waitcnt vmcnt(0)" ::: "memory");
    __syncthreads();
    if (threadIdx.x == 0) {
        __builtin_amdgcn_s_waitcnt(0);
        const unsigned x = xb_xcc_id();
        unsigned nloc = st[0], nx = st[1];
        if (nloc == 0u) { xcd_barrier_complete(bar, x, nloc, nx); st[0] = nloc; st[1] = nx; }
        const unsigned old = xb_add(&bar[XB_XSUB(x)], 1u);
        const unsigned gen = old / nloc;
        if (old + 1u == (gen + 1u) * nloc) {
            __builtin_amdgcn_fence(__ATOMIC_RELEASE, "agent");
            asm volatile("s_waitcnt vmcnt(0)" ::: "memory");
            const unsigned og = xb_add(&bar[XB_TOP], 1u);
            const unsigned tg = og / nx;
            if (og + 1u == (tg + 1u) * nx) xb_add(&bar[XB_TOPGEN], 1u);
            else XB_SPIN(xb_ld(&bar[XB_TOPGEN]) == tg, bar);
            __builtin_amdgcn_fence(__ATOMIC_ACQUIRE, "agent");
            xb_add(&bar[XB_XGEN(x)], 1u);
            asm volatile("s_waitcnt vmcnt(0)" ::: "memory");
        } else {
            XB_SPIN(xb_ld(&bar[XB_XGEN(x)]) == gen, bar);
            __builtin_amdgcn_fence(__ATOMIC_ACQUIRE, "agent");
            asm volatile("s_waitcnt vmcnt(0)" ::: "memory");
        }
    }
    __syncthreads();
}
#define GRID_SYNC() do { asm volatile("s_waitcnt vmcnt(0) lgkmcnt(0)" ::: "memory"); __syncthreads(); grid.sync(); } while (0)
#define XBAR() do { KParamsPtr qb_ = (KParamsPtr)__builtin_amdgcn_kernarg_segment_ptr(); asm volatile("" : "+s"(qb_)); xcd_barrier((unsigned*)(qb_->ws + WS_CTL), (volatile LAS unsigned*)(lds + LDS_BYTES - 16)); } while (0)
#define PHASE_BEGIN() \
    Params P; { KParamsPtr q_ = (KParamsPtr)__builtin_amdgcn_kernarg_segment_ptr(); asm volatile("" : "+s"(q_)); \
        P.x = q_->x; P.c = q_->c; P.w_mod = q_->w_mod; P.b_mod = q_->b_mod; P.w_in = q_->w_in; P.conv_w = q_->conv_w; P.hgrn_norm_w = q_->hgrn_norm_w; P.lower_bounds = q_->lower_bounds; \
        P.w_branch = q_->w_branch; P.w_out = q_->w_out; P.ln_g = q_->ln_g; P.ln_b = q_->ln_b; P.out = q_->out; P.ws = q_->ws; } \
    int bx = blockIdx.x; asm volatile("" : "+s"(bx)); \
    const int G = gridDim.x; \
    const int vcu = (G % 8 == 0) ? (bx % 8) * (G / 8) + bx / 8 : bx; \
    unsigned char* const ws = P.ws; \
    float* const modp = (float*)(ws + WS_MOD); \
    bf16_t* const ACT = (bf16_t*)(ws + WS_ACT); \
    (void)vcu; (void)modp; (void)ACT;
#define WAVE_IDS() \
    const int tid = fresh_tid(), lane = tid & 63, wid = __builtin_amdgcn_readfirstlane(tid >> 6); \
    const int gw = vcu * 8 + wid, NGW = G * 8; (void)lane; (void)gw; (void)NGW;

__global__ void __launch_bounds__(NTHREADS, 2) fwd_megakernel(Params Pk) {
    extern __shared__ __attribute__((aligned(16))) unsigned char lds_raw[];
    LAS unsigned char* lds = (LAS unsigned char*)lds_raw;
    cg::grid_group grid = cg::this_grid();
    if (__builtin_expect(gridDim.y == 4242u, 0)) GRID_SYNC();
    if (threadIdx.x < 4) ((LAS unsigned*)(lds + LDS_BYTES - 16))[threadIdx.x] = 0u;
    __syncthreads();
    if (threadIdx.x == 0) { KParamsPtr q0_ = (KParamsPtr)__builtin_amdgcn_kernarg_segment_ptr(); (void)xb_add(&((unsigned*)(q0_->ws + WS_CTL))[XB_XCNT(xb_xcc_id())], 1u); }

    {
        PHASE_BEGIN(); WAVE_IDS();
        float* modpart = (float*)(ws + WS_MODP);
        LAS float* red = (LAS float*)lds;
        for (int u = bx; u < DEPTH * 192; u += G) {
            const int l = u / 192, r = u % 192, n = (r >> 2) * 64 + lane, kq = r & 3;
            float accb[8];
#pragma unroll
            for (int b = 0; b < 8; ++b) accb[b] = 0.f;
            const float* wp = P.w_mod + ((size_t)l * 1024 + 256 * kq + 32 * wid) * 3072 + n;
            const float* cp = P.c + 256 * kq + 32 * wid;
#pragma unroll 16
            for (int k = 0; k < 32; ++k) { const float wv = __builtin_nontemporal_load(wp + (size_t)k * 3072);
#pragma unroll
                for (int b = 0; b < 8; ++b) accb[b] += cp[b * 1024 + k] * wv; }
            __syncthreads();
#pragma unroll
            for (int b = 0; b < 8; ++b) red[(wid * 8 + b) * 64 + lane] = accb[b];
            __syncthreads();
            { const int b = wid; float sacc = 0.f;
#pragma unroll
              for (int w = 0; w < 8; ++w) sacc += red[(w * 8 + b) * 64 + lane];
              modpart[(((size_t)kq * DEPTH + l) * 8 + b) * 3072 + n] = sacc; }
        }
        __syncthreads();
        convert_weights(P, 0, lds, gw, NGW, wid, lane);
    }
    XBAR();
    {
        PHASE_BEGIN(); WAVE_IDS();
        const float* modpart = (const float*)(ws + WS_MODP);
        for (int i = bx * NTHREADS + tid; i < DEPTH * 8 * 3072; i += G * NTHREADS) {
            const int l = i / (8 * 3072), n = i % 3072;
            float v = P.b_mod[l * 3072 + n];
#pragma unroll
            for (int kq = 0; kq < 4; ++kq) v += modpart[(size_t)kq * DEPTH * 8 * 3072 + i];
            modp[i] = v;
        }
        LAS float* ms = (LAS float*)lds;
        for (int rg = bx; rg < M_TOK / 64; rg += G) {
            const int b = (rg * 64) / SEQ;
            __syncthreads();
            { const int i4 = tid * 4; f32x4 v = *(const f32x4*)(P.b_mod + i4);
#pragma unroll
              for (int kq = 0; kq < 4; ++kq) v = v + *(const f32x4*)(modpart + ((size_t)kq * DEPTH * 8 + b) * 3072 + i4);
              *(LAS f32x4*)(ms + i4) = v; }
            __syncthreads();
#pragma unroll
            for (int it = 0; it < 2; ++it) {
                f32x4 v[4][4];
#pragma unroll
                for (int q = 0; q < 4; ++q) { const int m = rg * 64 + wid * 8 + it * 4 + q;
#pragma unroll
                    for (int j = 0; j < 4; ++j) v[q][j] = ld_nt(P.x + (size_t)m * D_MODEL + 4 * (lane + 64 * j)); }
#pragma unroll
                for (int q = 0; q < 4; ++q) { const int m = rg * 64 + wid * 8 + it * 4 + q;
                    row_standardize(v[q]);
                    bf16_t* hrow = ACT + (size_t)m * PITCH + C_H;
#pragma unroll
                    for (int j = 0; j < 4; ++j) { const int col = 4 * (lane + 64 * j);
                        const f32x4 sh = *(const LAS f32x4*)(ms + col), sc = *(const LAS f32x4*)(ms + 1024 + col);
                        const f32x4 hv = v[q][j] * (sc + 1.0f) + sh;
                        u32x2 w; w.x = cvt_pk_bf16(hv.x, hv.y); w.y = cvt_pk_bf16(hv.z, hv.w);
                        *(u32x2*)(hrow + col) = w; } }
            }
        }
    }
    XBAR();

    for (int l = 0; l < DEPTH; ++l) {
        {
            PHASE_BEGIN();
            SchedP1 S{(const char*)ACT + C_H * 2, (const char*)(ws + WS_WIN), G, vcu};
            EpiP1 E{ACT};
            pg8::gemm_phase<EpiP1, SchedP1>(lds, (unsigned)PITCHB, 2048u, S, E);
        }
        XBAR();
        for (int half = 0; half < 2; ++half) {
            PHASE_BEGIN();
            if ((half ^ (vcu & 1)) == 0) {
                for (int u = bx; u < 256; u += G) hgrn_pass<0>(lds, ACT, P, l, u >> 3, (u & 7) * 4, 4);
            } else {
                for (int k = bx; k < 256; k += G) {
                    __syncthreads(); attn_unit(lds, ACT, (k & 63) >> 3, k & 7, 7 - (k >> 6));
                    const int a2 = 511 - k;
                    __syncthreads(); attn_unit(lds, ACT, (a2 & 63) >> 3, a2 & 7, 7 - (a2 >> 6));
                }
                for (int ci = bx; ci < 256; ci += G) conv_item(ACT, P.conv_w + (size_t)l * 3 * 512, ci);
                __syncthreads();
            }
        }
        if (l > 0) { PHASE_BEGIN(); WAVE_IDS(); __syncthreads(); convert_weights(P, l, lds, gw, NGW, wid, lane, WC_SPLIT, WC_ALL); }
        XBAR();
        {
            PHASE_BEGIN();
            for (int u = bx; u < 256; u += G) hgrn_pass<1>(lds, ACT, P, l, u >> 3, (u & 7) * 4, 4);
        }
        XBAR();
        {
            PHASE_BEGIN();
            SchedP3 S{(const char*)ACT, (const char*)(ws + WS_WIN) + (size_t)MIX_COLS * 2048, (const char*)(ws + WS_WB), G, vcu};
            EpiP3 E{(unsigned char*)ACT};
            pg8::gemm_phase<EpiP3, SchedP3>(lds, (unsigned)PITCHB, 2048u, S, E);
        }
        XBAR();
        {
            PHASE_BEGIN(); WAVE_IDS();
            SchedP4 S{(const char*)ACT, (const char*)(ws + WS_WO), G, vcu};
            unsigned* pc = (unsigned*)(ws + WS_CTL + CTL_PANEL);
            unsigned long long* xb = (unsigned long long*)(ws + WS_X);
            const bool more = (l + 1 < DEPTH);
            PanelStats st1{xb + (size_t)(2 * l) * 65536, pc + (2 * l) * 4096, LN_EPS};
            PanelStats st2{xb + (size_t)(2 * l + 1) * 65536, pc + (2 * l + 1) * 4096, LN_EPS};
            EpiP4F E{l == 0 ? P.x : P.out, P.out, modp + (size_t)l * 8 * 3072 + 2048, P.ln_g + l * 1024, P.ln_b + l * 1024, more ? modp + (size_t)(l + 1) * 8 * 3072 : nullptr, ACT, st1, st2};
            const bool pre = more && (vcu & 1);
            if (pre) { convert_weights(P, l + 1, lds, gw, NGW, wid, lane, 0, WC_SPLIT); __syncthreads(); }
            pg8::gemm_phase<EpiP4F, SchedP4>(lds, (unsigned)PITCHB, 2048u, S, E);
            if (more && !pre) { __syncthreads(); convert_weights(P, l + 1, lds, gw, NGW, wid, lane, 0, WC_SPLIT); }
        }
        if (l + 1 < DEPTH) XBAR();
    }
}

extern "C" void kernel_launch(void* const* d_in, const int* in_sizes, int n_in, void* d_out, int out_size, void* d_ws, size_t ws_size, hipStream_t stream) {
    static int grid_blocks = 0;
    if (grid_blocks == 0) {
        if (n_in != 12 || out_size != M_TOK * D_MODEL || ws_size < WS_END) { fprintf(stderr, "kernel_launch: unexpected shapes (n_in %d, out %d, ws %zu < %zu)\n", n_in, out_size, ws_size, (size_t)WS_END); grid_blocks = -1; return; }
        int dev = 0, cus = 0, per_cu = 0;
        hipGetDevice(&dev);
        hipDeviceGetAttribute(&cus, hipDeviceAttributeMultiprocessorCount, dev);
        hipFuncSetAttribute((const void*)fwd_megakernel, hipFuncAttributeMaxDynamicSharedMemorySize, LDS_BYTES);
        hipOccupancyMaxActiveBlocksPerMultiprocessor(&per_cu, (const void*)fwd_megakernel, NTHREADS, LDS_BYTES);
        (void)hipGetLastError();
        if (per_cu < 1) per_cu = 1;
        grid_blocks = cus > 256 ? 256 : cus;
        if (grid_blocks != 256) fprintf(stderr, "kernel_launch: %d CUs reported; this kernel is laid out for 256 workgroups\n", cus);
        if (grid_blocks <= 0) grid_blocks = 256;
    }
    if (grid_blocks < 0) return;
    (void)hipMemsetAsync((char*)d_ws + WS_CTL, 0, CTL_BYTES, stream);
    Params p{};
    p.x = (const float*)d_in[0]; p.c = (const float*)d_in[1]; p.w_mod = (const float*)d_in[2]; p.b_mod = (const float*)d_in[3]; p.w_in = (const float*)d_in[4];
    p.conv_w = (const float*)d_in[5]; p.hgrn_norm_w = (const float*)d_in[6]; p.lower_bounds = (const float*)d_in[7]; p.w_branch = (const float*)d_in[8];
    p.w_out = (const float*)d_in[9]; p.ln_g = (const float*)d_in[10]; p.ln_b = (const float*)d_in[11]; p.out = (float*)d_out; p.ws = (unsigned char*)d_ws;
    void* args[] = {&p};
    hipError_t e = hipLaunchCooperativeKernel((const void*)fwd_megakernel, dim3(grid_blocks), dim3(NTHREADS), args, LDS_BYTES, stream);
    if (e != hipSuccess) fprintf(stderr, "cooperative launch failed: %s (grid %d)\n", hipGetErrorString(e), grid_blocks);
}
```

```cpp
#include <hip/hip_runtime.h>
#include <hip/hip_cooperative_groups.h>
#include <cstdio>
#include <cstdint>
namespace cg = cooperative_groups;

#define LAS __attribute__((address_space(3)))
typedef unsigned short bf16_t;
typedef short bf16x8 __attribute__((ext_vector_type(8)));
typedef short s16x4 __attribute__((ext_vector_type(4)));
typedef float f32x2 __attribute__((ext_vector_type(2)));
typedef float f32x4 __attribute__((ext_vector_type(4)));
typedef float f32x16 __attribute__((ext_vector_type(16)));
typedef unsigned u32x2 __attribute__((ext_vector_type(2)));
typedef unsigned u32x4 __attribute__((ext_vector_type(4)));

constexpr int D_MODEL = 1024, BATCH = 8, SEQ = 2048, DEPTH = 2, M_TOK = BATCH * SEQ;
constexpr int IN_COLS = 9216, MIX_COLS = 6144;
constexpr int PITCH = 7168;
constexpr size_t PITCHB = (size_t)PITCH * 2;
constexpr int C_QA = 0, C_KA = 512, C_VA = 1024, C_ZA = 1536, C_QB = 2048, C_FB = 2560, C_IB = 3072, C_ZB = 3584, C_PU = 4096  , C_PZ = 4608  , C_ZC = 5632  , C_H = 6144;
constexpr int C_MERGED = 4096;
constexpr float LN_EPS = 1e-5f, RMS_EPS = 1e-6f;
constexpr float LOG2E = 1.4426950408889634f;
constexpr float QSCALE = 0.125f * LOG2E;
constexpr float ALPHA = 1.4142135623730951f;

constexpr size_t WS_CTL = 0, CTL_BYTES = 65536;
constexpr size_t WS_MOD = 65536;
constexpr size_t WS_DEND = 256u << 10;
constexpr size_t WS_WIN = 1u << 20;
constexpr size_t WIN_L = (size_t)IN_COLS * 1024 * 2;
constexpr size_t WS_WB = WS_WIN + WIN_L;
constexpr size_t WB_L = (size_t)3 * 1024 * 1024 * 2;
constexpr size_t WS_WO = WS_WB + WB_L;
constexpr size_t WO_L = (size_t)1024 * 1024 * 2;
constexpr size_t WS_ACT = WS_WO + WO_L;
constexpr size_t WS_U = WS_ACT + (size_t)M_TOK * PITCHB;
constexpr size_t WS_X = WS_U + (size_t)32 * 32 * 128 * 128 * 2;
constexpr size_t WS_MODP = WS_X + 3 * 524288;
constexpr size_t WS_END = WS_MODP + (size_t)4 * DEPTH * BATCH * 3072 * 4;
constexpr size_t CTL_PANEL = 16384;

constexpr int LDS_BYTES = 147456;
constexpr int NTHREADS = 512;

struct Params {
    const float* x; const float* c; const float* w_mod; const float* b_mod; const float* w_in; const float* conv_w; const float* hgrn_norm_w;
    const float* lower_bounds; const float* w_branch; const float* w_out; const float* ln_g; const float* ln_b; float* out; unsigned char* ws;
};

typedef __bf16 bf16x2_t __attribute__((ext_vector_type(2)));
__device__ __forceinline__ unsigned cvt_pk_bf16(float lo, float hi) { const f32x2 v = {lo, hi}; const bf16x2_t b = __builtin_convertvector(v, bf16x2_t); return __builtin_bit_cast(unsigned, b); }
__device__ __forceinline__ f32x4 ld_nt(const float* p) { return __builtin_nontemporal_load((const f32x4*)p); }
__device__ __forceinline__ float bf_lo(unsigned w) { return __uint_as_float(w << 16); }
__device__ __forceinline__ float bf_hi(unsigned w) { return __uint_as_float(w & 0xffff0000u); }
__device__ __forceinline__ float bf2f(bf16_t v) { return __uint_as_float((unsigned)v << 16); }
__device__ __forceinline__ float ex2(float v) { return __builtin_amdgcn_exp2f(v); }
__device__ __forceinline__ float lg2(float v) { return __builtin_amdgcn_logf(v); }
__device__ __forceinline__ float sigmoidf_(float v) { return __builtin_amdgcn_rcpf(1.0f + ex2(-v * LOG2E)); }
__device__ __forceinline__ float siluf_(float v) { return v * sigmoidf_(v); }
__device__ __forceinline__ float wave_sum(float v) {
#pragma unroll
    for (int o = 1; o < 64; o <<= 1) v += __shfl_xor(v, o);
    return v;
}
__device__ __forceinline__ int fresh_tid() { int t = threadIdx.x; asm volatile("" : "+v"(t)); return t; }
__device__ __forceinline__ int crow(int r, int hi) { return (r & 3) + 8 * (r >> 2) + 4 * hi; }

namespace pg8 {
constexpr int BM = 256, BK = 64, HALF = 128, HTB = HALF * BK * 2, STAGE_BYTES = 8 * HTB;
__device__ __forceinline__ int lds_byte(int r, int c) { const int st = (r >> 4) * 2 + (c >> 5), rr = r & 15, cc = c & 31, ob = rr * 64 + cc * 2; return st * 1024 + (ob ^ (((ob >> 9) & 1) << 5)); }
__device__ __forceinline__ void stage_rc(int b, int& R, int& C) { const int st = b / 1024, sb = b % 1024, swz = sb ^ (((sb >> 9) & 1) << 5); R = (st >> 1) * 16 + swz / 64; C = (st & 1) * 32 + (swz % 64) / 2; }
__device__ __forceinline__ int perm32(int rho) { const int n = rho >> 4, i = rho & 15; return 8 * (i >> 2) + 4 * n + (i & 3); }

struct Unit { const char* a; const char* b; int nt; int pm, pn, j; };

template <class Epi, class Sched>
__device__ __forceinline__ void gemm_phase(LAS unsigned char* lds, const unsigned ldaB, const unsigned ldbB, const Sched& S, const Epi& E) {
    const int tid = fresh_tid(), wid = __builtin_amdgcn_readfirstlane(tid >> 6), lane = tid & 63, wr = wid >> 2, wc = wid & 3, fr = lane & 15, fq = lane >> 4;
    unsigned voffA[2], voffB[2];
#pragma unroll
    for (int i = 0; i < 2; ++i) { int R, C; stage_rc(tid * 16 + i * 8192, R, C); const int Rb = Epi::PERM ? ((R & ~31) + perm32(R & 31)) : R;
        voffA[i] = (unsigned)R * ldaB + (unsigned)C * 2u; voffB[i] = (unsigned)Rb * ldbB + (unsigned)C * 2u; }
    const size_t kstep = (size_t)(BK * 2);
    const size_t hstepA = (size_t)HALF * ldaB, hstepB = (size_t)HALF * ldbB;
    const unsigned ldsw = (unsigned)wid * 1024u;
    const int aoff = lds_byte(wr * 64 + fr, fq * 8), boff = lds_byte(wc * 32 + fr, fq * 8);
#define PG8_SA(b, h) (((b) * 2 + (h)) * HTB)
#define PG8_SB(b, h) ((4 + (b) * 2 + (h)) * HTB)
#define PG8_STAGE(bufoff, gbase, voff) do { _Pragma("unroll") for (int _i = 0; _i < 2; ++_i) \
        __builtin_amdgcn_global_load_lds((const unsigned*)((const char*)(gbase) + (voff)[_i]), (LAS unsigned*)(lds + (bufoff) + ldsw + _i * 8192), 16, 0, 0); } while (0)
#define PG8_LDA(dst, b, h) do { _Pragma("unroll") for (int m = 0; m < 4; ++m) _Pragma("unroll") for (int k = 0; k < 2; ++k) dst[m][k] = *(const LAS bf16x8*)(lds + PG8_SA(b, h) + aoff + m * 2048 + k * 1024); } while (0)
#define PG8_LDB(dst, b, h) do { _Pragma("unroll") for (int n = 0; n < 2; ++n) _Pragma("unroll") for (int k = 0; k < 2; ++k) dst[n][k] = *(const LAS bf16x8*)(lds + PG8_SB(b, h) + boff + n * 2048 + k * 1024); } while (0)
#define PG8_MMA(ai, bj, At, Bt) do { __builtin_amdgcn_s_setprio(1); _Pragma("unroll") for (int m = 0; m < 4; ++m) _Pragma("unroll") for (int n = 0; n < 2; ++n) _Pragma("unroll") for (int k = 0; k < 2; ++k) \
        acc[ai][bj][m][n] = __builtin_amdgcn_mfma_f32_16x16x32_bf16(Bt[n][k], At[m][k], acc[ai][bj][m][n], 0, 0, 0); __builtin_amdgcn_s_setprio(0); } while (0)
#define PG8_WAIT_V(n) asm volatile("s_waitcnt vmcnt(" #n ")" ::: "memory")
#define PG8_WAIT_L(n) asm volatile("s_waitcnt lgkmcnt(" #n ")" ::: "memory")
#define PG8_BAR __builtin_amdgcn_s_barrier()
#define PG8_SCHED __builtin_amdgcn_sched_barrier(0)
    Unit cur, nxt; int ui = 0;
    if (!S.next(0, cur)) return;
    f32x4 acc[2][2][4][2];
#pragma unroll
    for (int a = 0; a < 2; ++a)
#pragma unroll
        for (int b = 0; b < 2; ++b)
#pragma unroll
            for (int m = 0; m < 4; ++m)
#pragma unroll
                for (int n = 0; n < 2; ++n) acc[a][b][m][n] = (f32x4){0.f, 0.f, 0.f, 0.f};
    bf16x8 At[4][2], B0[2][2], B1[2][2];
    const char* cA = cur.a; const char* cB = cur.b;
    PG8_STAGE(PG8_SB(0, 0), cB, voffB); PG8_STAGE(PG8_SB(0, 1), cB + hstepB, voffB); PG8_STAGE(PG8_SA(0, 0), cA, voffA); PG8_STAGE(PG8_SA(0, 1), cA + hstepA, voffA);
    if (wr == 1) PG8_BAR;
    PG8_WAIT_V(2); PG8_BAR;
    PG8_STAGE(PG8_SB(1, 0), cB + kstep, voffB); PG8_STAGE(PG8_SA(1, 0), cA + kstep, voffA); PG8_STAGE(PG8_SB(1, 1), cB + hstepB + kstep, voffB);
    PG8_WAIT_V(6); PG8_BAR;
    for (;;) {
        const bool has_next = S.next(ui + 1, nxt);
        const char* nA = has_next ? nxt.a : cA; const char* nB = has_next ? nxt.b : cB;
        const int nt = cur.nt;
        for (int t = 0; t < nt; t += 2) {
            const bool last = (t == nt - 2);
            const char* a1 = cA + (size_t)(t + 1) * kstep;
            const char* a2 = last ? nA : cA + (size_t)(t + 2) * kstep; const char* b2 = last ? nB : cB + (size_t)(t + 2) * kstep;
            const char* a3 = a2 + kstep; const char* b3 = b2 + kstep;
            PG8_LDB(B0, 0, 0); PG8_LDB(B1, 0, 1); PG8_SCHED; PG8_LDA(At, 0, 0); PG8_STAGE(PG8_SA(1, 1), a1 + hstepA, voffA);
            PG8_WAIT_V(8); PG8_WAIT_L(0); PG8_BAR; PG8_MMA(0, 0, At, B0); PG8_MMA(0, 1, At, B1); PG8_BAR; PG8_SCHED;
            PG8_LDA(At, 0, 1); PG8_STAGE(PG8_SB(0, 0), b2, voffB); PG8_STAGE(PG8_SB(0, 1), b2 + hstepB, voffB); PG8_STAGE(PG8_SA(0, 0), a2, voffA);
            PG8_WAIT_V(8); PG8_WAIT_L(0); PG8_BAR; PG8_MMA(1, 0, At, B0); PG8_MMA(1, 1, At, B1); PG8_BAR; PG8_SCHED;
            PG8_LDB(B0, 1, 0); PG8_LDB(B1, 1, 1); PG8_SCHED; PG8_LDA(At, 1, 0); PG8_STAGE(PG8_SA(0, 1), a2 + hstepA, voffA);
            PG8_WAIT_V(8); PG8_WAIT_L(0); PG8_BAR; PG8_MMA(0, 0, At, B0); PG8_MMA(0, 1, At, B1); PG8_BAR; PG8_SCHED;
            PG8_LDA(At, 1, 1); PG8_STAGE(PG8_SB(1, 0), b3, voffB); PG8_STAGE(PG8_SB(1, 1), b3 + hstepB, voffB); PG8_STAGE(PG8_SA(1, 0), a3, voffA);
            PG8_WAIT_V(8); PG8_WAIT_L(0); PG8_BAR; PG8_MMA(1, 0, At, B0); PG8_MMA(1, 1, At, B1); PG8_BAR; PG8_SCHED;
        }
        if (wr == 0) PG8_BAR;
        if constexpr (!Epi::AFTER_DRAIN) E(acc, cur, wr, wc, fr, fq);
        if (!has_next) break;
#pragma unroll
        for (int a = 0; a < 2; ++a)
#pragma unroll
            for (int b = 0; b < 2; ++b)
#pragma unroll
                for (int m = 0; m < 4; ++m)
#pragma unroll
                    for (int n = 0; n < 2; ++n) acc[a][b][m][n] = (f32x4){0.f, 0.f, 0.f, 0.f};
        cur = nxt; cA = nA; cB = nB; ++ui;
        if (wr == 1) PG8_BAR;
    }
    PG8_WAIT_V(0);
    PG8_BAR;
    if constexpr (Epi::AFTER_DRAIN) E.fused(acc, cur, wr, wc, fr, fq, lds, wid, lane);
#undef PG8_SA
#undef PG8_SB
#undef PG8_STAGE
#undef PG8_LDA
#undef PG8_LDB
#undef PG8_MMA
#undef PG8_WAIT_V
#undef PG8_WAIT_L
#undef PG8_BAR
#undef PG8_SCHED
}
}

struct SchedP1 {
    const char* A; const char* B; int G, vcu;
    __device__ __forceinline__ bool next(int i, pg8::Unit& u) const {
        const int U = i * G + vcu; if (U >= 64 * 24) return false;
        u.pm = 8 * ((U >> 5) & 7) + (U & 7); u.pn = 4 * (U >> 8) + ((U & 31) >> 3); u.j = 0; u.nt = 16;
        u.a = A + (size_t)u.pm * 256 * PITCHB; u.b = B + (size_t)u.pn * 256 * 2048; return true;
    }
};
struct SchedP3 {
    const char* ACTb; const char* Wg; const char* Wb; int G, vcu;
    __device__ __forceinline__ bool next(int i, pg8::Unit& u) const {
        const int T = vcu + (i / 6) * G; if (T >= 256) return false;
        int s = i % 6; int alt = 0;
        if (vcu & 1) {
            const int pos = s; s = (pos == 1) ? 2 : (pos == 2) ? 1 : pos; alt = (s == 2 || s == 3) ? 1 : 0; }
        u.pm = 8 * (T >> 5) + (T & 7); u.pn = (T & 31) >> 3; u.j = s | (alt << 3);
        const int j = s >> 1;
        if ((s & 1) == 0) { u.nt = 16; u.a = ACTb + (size_t)u.pm * 256 * PITCHB + C_H * 2; u.b = Wg + (size_t)(1024 * j + 256 * u.pn) * 2048; }
        else { u.nt = 8; u.a = ACTb + (size_t)u.pm * 256 * PITCHB + (size_t)(C_ZA + 2048 * j) * 2; u.b = Wb + (size_t)(1024 * j + 256 * u.pn) * 2048; }
        return true;
    }
};
struct SchedP4 {
    const char* ACTb; const char* Wo; int G, vcu;
    __device__ __forceinline__ bool next(int i, pg8::Unit& u) const {
        const int T = vcu + i * G; if (T >= 256) return false;
        u.pm = 8 * (T >> 5) + (T & 7); u.pn = (T & 31) >> 3; u.j = 0; u.nt = 16;
        u.a = ACTb + (size_t)u.pm * 256 * PITCHB + C_MERGED * 2; u.b = Wo + (size_t)(256 * u.pn) * 2048; return true;
    }
};

struct EpiP1 {
    static constexpr bool PERM = true, AFTER_DRAIN = false;
    bf16_t* ACT;
    __device__ __forceinline__ void operator()(const f32x4 (&acc)[2][2][4][2], const pg8::Unit& u, int wr, int wc, int fr, int fq) const {
        const int row0 = u.pm * 256 + wr * 64 + fr;
        if (u.pn >= 16) {
            const int T = u.pn - 16, col0 = (T < 4 ? C_PU + 128 * T : C_PZ + 128 * (T - 4)) + wc * 32 + 8 * fq;
#pragma unroll
            for (int ai = 0; ai < 2; ++ai)
#pragma unroll
                for (int m = 0; m < 4; ++m) { bf16_t* rowp = ACT + (size_t)(row0 + ai * 128 + m * 16) * PITCH + col0;
                    f32x4 v0 = acc[ai][1][m][0], v1 = acc[ai][1][m][1];
                    if (T >= 4) {
#pragma unroll
                        for (int e = 0; e < 4; ++e) { v0[e] = siluf_(v0[e]); v1[e] = siluf_(v1[e]); } }
                    v0 = v0 * acc[ai][0][m][0]; v1 = v1 * acc[ai][0][m][1];
                    u32x4 w; w.x = cvt_pk_bf16(v0[0], v0[1]); w.y = cvt_pk_bf16(v0[2], v0[3]); w.z = cvt_pk_bf16(v1[0], v1[1]); w.w = cvt_pk_bf16(v1[2], v1[3]);
                    *(u32x4*)rowp = w; }
            return;
        }
        const int grp = u.pn >> 1;
        const int kind = (grp == 0) ? 1 : ((grp == 3 || grp == 4 || grp == 7) ? 2 : 0);
        const int col0 = u.pn * 256 + wc * 32 + 8 * fq;
#pragma unroll
        for (int ai = 0; ai < 2; ++ai)
#pragma unroll
            for (int m = 0; m < 4; ++m) { bf16_t* rowp = ACT + (size_t)(row0 + ai * 128 + m * 16) * PITCH + col0;
#pragma unroll
                for (int bj = 0; bj < 2; ++bj) { f32x4 v0 = acc[ai][bj][m][0], v1 = acc[ai][bj][m][1];
                    if (kind == 1) { v0 = v0 * QSCALE; v1 = v1 * QSCALE; }
                    else if (kind == 2) {
#pragma unroll
                        for (int e = 0; e < 4; ++e) { v0[e] = siluf_(v0[e]); v1[e] = siluf_(v1[e]); } }
                    u32x4 w; w.x = cvt_pk_bf16(v0[0], v0[1]); w.y = cvt_pk_bf16(v0[2], v0[3]); w.z = cvt_pk_bf16(v1[0], v1[1]); w.w = cvt_pk_bf16(v1[2], v1[3]);
                    *(u32x4*)(rowp + bj * 128) = w; } }
    }
};
struct EpiP3 {
    static constexpr bool PERM = true, AFTER_DRAIN = false;
    unsigned char* ACTb;
    __device__ __forceinline__ void operator()(const f32x4 (&acc)[2][2][4][2], const pg8::Unit& u, int wr, int wc, int fr, int fq) const {
        const int s = u.j & 7, j = s >> 1;
        const int row0 = u.pm * 256 + wr * 64 + fr, cl0 = wc * 32 + 8 * fq;
        const unsigned toff = 512u * (unsigned)u.pn, moff = (unsigned)(C_MERGED + 256 * u.pn) * 2u, soff = (u.j & 8) ? moff : 5120u + 512u * (unsigned)u.pn;
        if ((s & 1) == 0) {
#pragma unroll
            for (int ai = 0; ai < 2; ++ai)
#pragma unroll
                for (int m = 0; m < 4; ++m) { unsigned char* rowp = ACTb + (size_t)(row0 + ai * 128 + m * 16) * PITCHB;
#pragma unroll
                    for (int bj = 0; bj < 2; ++bj) { const f32x4 v0 = acc[ai][bj][m][0], v1 = acc[ai][bj][m][1];
                        u32x4 w; w.x = cvt_pk_bf16(v0[0], v0[1]); w.y = cvt_pk_bf16(v0[2], v0[3]); w.z = cvt_pk_bf16(v1[0], v1[1]); w.w = cvt_pk_bf16(v1[2], v1[3]);
                        *(u32x4*)(rowp + soff + (cl0 + bj * 128) * 2) = w; } }
        } else {
#pragma unroll
            for (int ai = 0; ai < 2; ++ai) {
                u32x4 gq[4][2], tq[4][2];
#pragma unroll
                for (int m = 0; m < 4; ++m) { unsigned char* rowp = ACTb + (size_t)(row0 + ai * 128 + m * 16) * PITCHB;
#pragma unroll
                    for (int bj = 0; bj < 2; ++bj) { gq[m][bj] = *(const u32x4*)(rowp + soff + (cl0 + bj * 128) * 2); if (j > 0) tq[m][bj] = *(const u32x4*)(rowp + toff + (cl0 + bj * 128) * 2); } }
#pragma unroll
                for (int m = 0; m < 4; ++m) { unsigned char* rowp = ACTb + (size_t)(row0 + ai * 128 + m * 16) * PITCHB;
#pragma unroll
                    for (int bj = 0; bj < 2; ++bj) { const f32x4 v0 = acc[ai][bj][m][0], v1 = acc[ai][bj][m][1]; const u32x4 g = gq[m][bj];
                        f32x4 t0 = (f32x4){sigmoidf_(bf_lo(g.x)) * v0[0], sigmoidf_(bf_hi(g.x)) * v0[1], sigmoidf_(bf_lo(g.y)) * v0[2], sigmoidf_(bf_hi(g.y)) * v0[3]};
                        f32x4 t1 = (f32x4){sigmoidf_(bf_lo(g.z)) * v1[0], sigmoidf_(bf_hi(g.z)) * v1[1], sigmoidf_(bf_lo(g.w)) * v1[2], sigmoidf_(bf_hi(g.w)) * v1[3]};
                        if (j > 0) { const u32x4 tv = tq[m][bj];
                            t0 = t0 + (f32x4){bf_lo(tv.x), bf_hi(tv.x), bf_lo(tv.y), bf_hi(tv.y)}; t1 = t1 + (f32x4){bf_lo(tv.z), bf_hi(tv.z), bf_lo(tv.w), bf_hi(tv.w)}; }
                        u32x4 w; w.x = cvt_pk_bf16(t0[0], t0[1]); w.y = cvt_pk_bf16(t0[2], t0[3]); w.z = cvt_pk_bf16(t1[0], t1[1]); w.w = cvt_pk_bf16(t1[2], t1[3]);
                        if (j < 2) *(u32x4*)(rowp + toff + (cl0 + bj * 128) * 2) = w; else *(u32x4*)(rowp + moff + (cl0 + bj * 128) * 2) = w;
                    } }
            }
        }
    }
};
struct PanelStats {
    unsigned long long* xbuf;
    unsigned* cnt;
    float eps;
    __device__ __forceinline__ void run(const f32x4 (&v)[2][2][4][2], const pg8::Unit& u, int wr, int wc, int fr, int fq, LAS unsigned char* lds, int wid, int lane) const {
        LAS f32x2* Pt = (LAS f32x2*)lds;
        LAS f32x2* St = (LAS f32x2*)(lds + 8192);
#pragma unroll
        for (int ai = 0; ai < 2; ++ai)
#pragma unroll
            for (int m = 0; m < 4; ++m) {
                float s = 0.f;
#pragma unroll
                for (int bj = 0; bj < 2; ++bj)
#pragma unroll
                    for (int n = 0; n < 2; ++n) { const f32x4 x = v[ai][bj][m][n]; s += (x[0] + x[1]) + (x[2] + x[3]); }
                s += __shfl_xor(s, 16); s += __shfl_xor(s, 32);
                const float mw = s * (1.0f / 64.0f); float q = 0.f;
#pragma unroll
                for (int bj = 0; bj < 2; ++bj)
#pragma unroll
                    for (int n = 0; n < 2; ++n) { const f32x4 d = v[ai][bj][m][n] - mw; q += (d[0] * d[0] + d[1] * d[1]) + (d[2] * d[2] + d[3] * d[3]); }
                q += __shfl_xor(q, 16); q += __shfl_xor(q, 32);
                if (fq == 0) Pt[(ai * 128 + wr * 64 + m * 16 + fr) * 4 + wc] = (f32x2){mw, q};
            }
        __syncthreads();
        const int row = wid * 32 + (lane & 31);
        if (lane < 32) {
            const f32x2 a = Pt[row * 4 + 0], b = Pt[row * 4 + 1], c = Pt[row * 4 + 2], d = Pt[row * 4 + 3];
            const float mt = (a.x + b.x + c.x + d.x) * 0.25f;
            const float da = a.x - mt, db = b.x - mt, dc = c.x - mt, dd = d.x - mt;
            const float m2 = (a.y + b.y) + (c.y + d.y) + 64.0f * ((da * da + db * db) + (dc * dc + dd * dd));
            __hip_atomic_store(xbuf + ((size_t)(u.pm * 256 + row) * 4 + u.pn), ((unsigned long long)__float_as_uint(m2) << 32) | __float_as_uint(mt), __ATOMIC_RELAXED, __HIP_MEMORY_SCOPE_AGENT);
        }
        asm volatile("s_waitcnt vmcnt(0)" ::: "memory");
        if (lane == 0) __hip_atomic_fetch_add(cnt + 64 * u.pm, 1u, __ATOMIC_RELAXED, __HIP_MEMORY_SCOPE_AGENT);
        if (wid == 0) {
            unsigned sp = 0;
            while ((unsigned)__builtin_amdgcn_readfirstlane(__hip_atomic_load(cnt + 64 * u.pm, __ATOMIC_RELAXED, __HIP_MEMORY_SCOPE_AGENT)) < 32u) { __builtin_amdgcn_s_sleep(2); if (++sp > (1u << 24)) break; }
            __builtin_amdgcn_fence(__ATOMIC_ACQUIRE, "agent");
        }
        asm volatile("s_waitcnt vmcnt(0) lgkmcnt(0)" ::: "memory");
        __syncthreads();
        if (lane < 32) {
            const unsigned long long* slot = xbuf + (size_t)(u.pm * 256 + row) * 4; float mt[4], m2[4]; float ms = 0.f;
#pragma unroll
            for (int t = 0; t < 4; ++t) { const unsigned long long w = __hip_atomic_load(slot + t, __ATOMIC_RELAXED, __HIP_MEMORY_SCOPE_AGENT); mt[t] = __uint_as_float((unsigned)w); m2[t] = __uint_as_float((unsigned)(w >> 32)); ms += mt[t]; }
            const float mean = ms * 0.25f; float q = 0.f;
#pragma unroll
            for (int t = 0; t < 4; ++t) { const float dm = mt[t] - mean; q += m2[t] + 256.0f * dm * dm; }
            St[row] = (f32x2){mean, __builtin_amdgcn_rsqf(q * (1.0f / 1024.0f) + eps)};
        }
        __syncthreads();
    }
};
struct EpiP4F {
    static constexpr bool PERM = false, AFTER_DRAIN = true;
    const float* xprev; float* out; const float* gate; const float* lng; const float* lnb; const float* modn; bf16_t* ACT; PanelStats st1, st2;
    __device__ __forceinline__ void fused(f32x4 (&acc)[2][2][4][2], const pg8::Unit& u, int wr, int wc, int fr, int fq, LAS unsigned char* lds, int wid, int lane) const {
        const LAS f32x2* St = (const LAS f32x2*)(lds + 8192);
        const int row0 = u.pm * 256 + wr * 64 + fr, col0 = u.pn * 256 + wc * 32 + 4 * fq;
        const int bidx = (u.pm * 256) / SEQ;
        {
            const float* gp = gate + (size_t)bidx * 3072;
            f32x4 gv[2][2];
#pragma unroll
            for (int bj = 0; bj < 2; ++bj)
#pragma unroll
                for (int n = 0; n < 2; ++n) gv[bj][n] = *(const f32x4*)(gp + col0 + bj * 128 + n * 16) + 1.0f;
#pragma unroll
            for (int ai = 0; ai < 2; ++ai)
#pragma unroll
                for (int m = 0; m < 4; ++m) { const size_t off = (size_t)(row0 + ai * 128 + m * 16) * D_MODEL + col0;
#pragma unroll
                    for (int bj = 0; bj < 2; ++bj)
#pragma unroll
                        for (int n = 0; n < 2; ++n) { const f32x4 xv = ld_nt(xprev + off + bj * 128 + n * 16); acc[ai][bj][m][n] = xv * ALPHA + gv[bj][n] * acc[ai][bj][m][n]; }
                    asm volatile("" : "+v"(acc[ai][0][m][0]), "+v"(acc[ai][0][m][1]), "+v"(acc[ai][1][m][0]), "+v"(acc[ai][1][m][1]));
                    if (m == 3) asm volatile("" ::: "memory"); }
        }
        st1.run(acc, u, wr, wc, fr, fq, lds, wid, lane);
        {
            f32x4 lg[2][2], lb[2][2];
#pragma unroll
            for (int bj = 0; bj < 2; ++bj)
#pragma unroll
                for (int n = 0; n < 2; ++n) { lg[bj][n] = *(const f32x4*)(lng + col0 + bj * 128 + n * 16); lb[bj][n] = *(const f32x4*)(lnb + col0 + bj * 128 + n * 16); }
#pragma unroll
            for (int ai = 0; ai < 2; ++ai)
#pragma unroll
                for (int m = 0; m < 4; ++m) { const int r = ai * 128 + wr * 64 + m * 16 + fr; const f32x2 sr = St[r]; const size_t off = (size_t)(u.pm * 256 + r) * D_MODEL + col0;
#pragma unroll
                    for (int bj = 0; bj < 2; ++bj)
#pragma unroll
                        for (int n = 0; n < 2; ++n) { const f32x4 x1 = (acc[ai][bj][m][n] - sr.x) * sr.y * lg[bj][n] + lb[bj][n]; acc[ai][bj][m][n] = x1;
                            __builtin_nontemporal_store(x1, (f32x4*)(out + off + bj * 128 + n * 16)); }
                    asm volatile("" : "+v"(acc[ai][0][m][0]), "+v"(acc[ai][0][m][1]), "+v"(acc[ai][1][m][0]), "+v"(acc[ai][1][m][1]));
                    asm volatile("" ::: "memory"); }
        }
        if (modn) {
            st2.run(acc, u, wr, wc, fr, fq, lds, wid, lane);
            const float* mp = modn + (size_t)bidx * 3072;
            f32x4 sc[2][2], sh[2][2];
#pragma unroll
            for (int bj = 0; bj < 2; ++bj)
#pragma unroll
                for (int n = 0; n < 2; ++n) { sh[bj][n] = *(const f32x4*)(mp + col0 + bj * 128 + n * 16); sc[bj][n] = *(const f32x4*)(mp + 1024 + col0 + bj * 128 + n * 16) + 1.0f; }
#pragma unroll
            for (int ai = 0; ai < 2; ++ai)
#pragma unroll
                for (int m = 0; m < 4; ++m) { const int r = ai * 128 + wr * 64 + m * 16 + fr; const f32x2 sr = St[r]; bf16_t* hp = ACT + (size_t)(u.pm * 256 + r) * PITCH + C_H + col0;
#pragma unroll
                    for (int bj = 0; bj < 2; ++bj)
#pragma unroll
                        for (int n = 0; n < 2; ++n) { const f32x4 hv = (acc[ai][bj][m][n] - sr.x) * sr.y * sc[bj][n] + sh[bj][n];
                            u32x2 w; w.x = cvt_pk_bf16(hv[0], hv[1]); w.y = cvt_pk_bf16(hv[2], hv[3]); *(u32x2*)(hp + bj * 128 + n * 16) = w; }
                    asm volatile("" ::: "memory"); }
        }
    }
};

__device__ __forceinline__ void transpose_item(const float* W, int N, bf16_t* WT, int ldw, LAS float* scr, int item, int lane, bool conv_perm = false) {
    const int nblk = N / 32, kb = item / nblk, nb = item % nblk, k0 = 64 * kb, n0 = 32 * nb;
    int d0 = n0;
    if (conv_perm && n0 >= 4096 && n0 < 6144) { const int g = (n0 - 4096) >> 9, ch0 = (n0 - 4096) & 511; d0 = 4096 + 256 * ((ch0 >> 7) + ((g & 1) ? 4 : 0)) + 128 * (g >> 1) + (ch0 & 127); }
    const int kr = lane >> 3, n4 = (lane & 7) * 4;
    f32x4 v[8];
#pragma unroll
    for (int i = 0; i < 8; ++i) v[i] = ld_nt(W + (size_t)(k0 + 8 * i + kr) * N + n0 + n4);
#pragma unroll
    for (int i = 0; i < 8; ++i) { LAS float* d = scr + (8 * i + kr) * 33 + n4; d[0] = v[i].x; d[1] = v[i].y; d[2] = v[i].z; d[3] = v[i].w; }
    asm volatile("s_waitcnt lgkmcnt(0)" ::: "memory");
    const int c = lane & 7;
#pragma unroll
    for (int j = 0; j < 4; ++j) { const int n = (lane >> 3) + 8 * j; const LAS float* s = scr + (8 * c) * 33 + n;
        u32x4 o; o.x = cvt_pk_bf16(s[0 * 33], s[1 * 33]); o.y = cvt_pk_bf16(s[2 * 33], s[3 * 33]); o.z = cvt_pk_bf16(s[4 * 33], s[5 * 33]); o.w = cvt_pk_bf16(s[6 * 33], s[7 * 33]);
        *(u32x4*)(WT + (size_t)(d0 + n) * ldw + k0 + 8 * c) = o; }
    asm volatile("s_waitcnt lgkmcnt(0)" ::: "memory");
}

__device__ __forceinline__ void row_standardize(f32x4 (&v)[4]) {
    float s = 0.f;
#pragma unroll
    for (int j = 0; j < 4; ++j) s += (v[j].x + v[j].y) + (v[j].z + v[j].w);
    const float mean = wave_sum(s) * (1.f / D_MODEL); float s2 = 0.f;
#pragma unroll
    for (int j = 0; j < 4; ++j) { v[j] = v[j] - mean; s2 += (v[j].x * v[j].x + v[j].y * v[j].y) + (v[j].z * v[j].z + v[j].w * v[j].w); }
    const float rstd = __builtin_amdgcn_rsqf(wave_sum(s2) * (1.f / D_MODEL) + LN_EPS);
#pragma unroll
    for (int j = 0; j < 4; ++j) v[j] = v[j] * rstd;
}
__device__ __forceinline__ void write_h_row(const f32x4 (&v)[4], const float* modb, bf16_t* hrow, int lane) {
#pragma unroll
    for (int j = 0; j < 4; ++j) { const int col = 4 * (lane + 64 * j);
        const f32x4 sh = *(const f32x4*)(modb + col), sc = *(const f32x4*)(modb + 1024 + col);
        const f32x4 h = v[j] * (sc + 1.0f) + sh;
        u32x2 w; w.x = cvt_pk_bf16(h.x, h.y); w.y = cvt_pk_bf16(h.z, h.w);
        *(u32x2*)(hrow + col) = w; }
}

typedef short v4i16_t __attribute__((ext_vector_type(4)));
__device__ __forceinline__ s16x4 vtr(const LAS bf16_t* p) { return __builtin_bit_cast(s16x4, __builtin_amdgcn_ds_read_tr16_b64_v4i16((LAS v4i16_t*)p)); }
constexpr float STICK_DEAD = -44.0f;
__device__ __forceinline__ void attn_unit(LAS unsigned char* lds, bf16_t* ACT, int b, int h, int qb) {
    const int tid = fresh_tid(), lane = tid & 63, r32 = lane & 31, hi = lane >> 5;
    const int wid = __builtin_amdgcn_readfirstlane(tid >> 6);
    bf16_t* base = ACT + (size_t)b * SEQ * PITCH;
    const int tq0 = qb * 256 + wid * 32, tq = tq0 + r32;
    LAS bf16_t* Kw = (LAS bf16_t*)(lds + wid * 9728);
    LAS bf16_t* Vw = Kw + 32 * 72;
    LAS float* stg = (LAS float*)(lds + wid * 9728);
    bf16x8 qr[4];
#pragma unroll
    for (int d0 = 0; d0 < 4; ++d0) qr[d0] = __builtin_nontemporal_load((const bf16x8*)(base + (size_t)tq * PITCH + C_QA + h * 64 + d0 * 16 + hi * 8));
    f32x16 o0, o1;
#pragma unroll
    for (int r = 0; r < 16; ++r) { o0[r] = 0.f; o1[r] = 0.f; }
    float R = 0.f;
    const int srow = lane >> 3, sch = lane & 7;
    const bf16_t* kg = base + (size_t)srow * PITCH + C_KA + h * 64 + sch * 8;
    const bf16_t* vg = base + (size_t)srow * PITCH + C_VA + h * 64 + sch * 8;
    const LAS bf16_t* vb = Vw + (4 * hi + ((lane & 15) >> 2)) * 80 + 16 * ((lane >> 4) & 1) + 4 * (lane & 3);
    u32x4 kreg[4], vreg[4];
    int kb = tq0;
#pragma unroll
    for (int i = 0; i < 4; ++i) { kreg[i] = *(const u32x4*)(kg + (size_t)(kb + 8 * i) * PITCH); vreg[i] = *(const u32x4*)(vg + (size_t)(kb + 8 * i) * PITCH); }
    for (;;) {
#pragma unroll
        for (int i = 0; i < 4; ++i) { *(LAS u32x4*)(Kw + (srow + 8 * i) * 72 + sch * 8) = kreg[i]; *(LAS u32x4*)(Vw + (srow + 8 * i) * 80 + sch * 8) = vreg[i]; }
        const int kbn = kb - 32;
        if (kbn >= 0) {
#pragma unroll
            for (int i = 0; i < 4; ++i) { kreg[i] = *(const u32x4*)(kg + (size_t)(kbn + 8 * i) * PITCH); vreg[i] = *(const u32x4*)(vg + (size_t)(kbn + 8 * i) * PITCH); }
        }
        f32x16 p0;
#pragma unroll
        for (int r = 0; r < 16; ++r) p0[r] = 0.f;
#pragma unroll
        for (int d0 = 0; d0 < 4; ++d0) {
            const bf16x8 a0 = *(const LAS bf16x8*)(Kw + r32 * 72 + d0 * 16 + hi * 8);
            p0 = __builtin_amdgcn_mfma_f32_32x32x16_bf16(a0, qr[d0], p0, 0, 0, 0);
        }
        float x0[16];
        if (kb < tq0) {
#pragma unroll
            for (int r = 0; r < 16; ++r) { const float z = p0[r]; const float sp = fmaxf(z, 0.f) + lg2(1.0f + ex2(-fabsf(z))); x0[r] = sp; p0[r] = z - sp; }
        } else {
            const int kvl = kb + 4 * hi;
#pragma unroll
            for (int r = 0; r < 16; ++r) { const int kv = kvl + (r & 3) + 8 * (r >> 2);
                const float z = p0[r]; const float sp = fmaxf(z, 0.f) + lg2(1.0f + ex2(-fabsf(z))); const bool ok = kv < tq; x0[r] = ok ? sp : 0.f; p0[r] = ok ? z - sp : -INFINITY; }
        }
        float Gs[4], Gh1[4], Tt[4];
#pragma unroll
        for (int g = 0; g < 4; ++g) Gs[g] = (x0[4 * g] + x0[4 * g + 1]) + (x0[4 * g + 2] + x0[4 * g + 3]);
#pragma unroll
        for (int g = 0; g < 4; ++g) { auto rr = __builtin_amdgcn_permlane32_swap(__float_as_uint(Gs[g]), __float_as_uint(Gs[g]), false, false);
            Gh1[g] = __uint_as_float(rr[1]); Tt[g] = __uint_as_float(rr[0]) + __uint_as_float(rr[1]); }
        float run = R;
#pragma unroll
        for (int g = 3; g >= 0; --g) {
            const float off = hi ? run : run - Gh1[g];
            const int q4 = 4 * g;
            const float s3 = off, s2 = s3 - x0[q4 + 3], s1 = s2 - x0[q4 + 2], s0 = s1 - x0[q4 + 1];
            p0[q4 + 3] = ex2(p0[q4 + 3] + s3); p0[q4 + 2] = ex2(p0[q4 + 2] + s2); p0[q4 + 1] = ex2(p0[q4 + 1] + s1); p0[q4] = ex2(p0[q4] + s0);
            run -= Tt[g];
        }
        R = run;
#pragma unroll
        for (int s = 0; s < 2; ++s) {
            u32x4 w; const int r0 = 8 * s;
            w.x = cvt_pk_bf16(p0[r0], p0[r0 + 1]); w.y = cvt_pk_bf16(p0[r0 + 2], p0[r0 + 3]); w.z = cvt_pk_bf16(p0[r0 + 4], p0[r0 + 5]); w.w = cvt_pk_bf16(p0[r0 + 6], p0[r0 + 7]);
            const bf16x8 af = __builtin_bit_cast(bf16x8, w);
            { const s16x4 lo = vtr(vb + (16 * s) * 80), hh = vtr(vb + (16 * s + 8) * 80);
              const bf16x8 bfr = (bf16x8){lo[0], lo[1], lo[2], lo[3], hh[0], hh[1], hh[2], hh[3]};
              o0 = __builtin_amdgcn_mfma_f32_32x32x16_bf16(af, bfr, o0, 0, 0, 0); }
            { const s16x4 lo = vtr(vb + (16 * s) * 80 + 32), hh = vtr(vb + (16 * s + 8) * 80 + 32);
              const bf16x8 bfr = (bf16x8){lo[0], lo[1], lo[2], lo[3], hh[0], hh[1], hh[2], hh[3]};
              o1 = __builtin_amdgcn_mfma_f32_32x32x16_bf16(af, bfr, o1, 0, 0, 0); }
        }
        if (kbn < 0 || !__any(R > STICK_DEAD)) break;
        kb = kbn;
    }
#pragma unroll
    for (int r = 0; r < 16; ++r) { stg[crow(r, hi) * 68 + r32] = o0[r]; stg[crow(r, hi) * 68 + 32 + r32] = o1[r]; }
    asm volatile("s_waitcnt lgkmcnt(0)" ::: "memory");
#pragma unroll
    for (int i = 0; i < 4; ++i) { const int row = i * 8 + (lane >> 3), ch = lane & 7;
        const f32x4 a = *(const LAS f32x4*)(stg + row * 68 + ch * 8), c = *(const LAS f32x4*)(stg + row * 68 + ch * 8 + 4);
        bf16_t* zp = base + (size_t)(tq0 + row) * PITCH + C_ZA + h * 64 + ch * 8;
        const u32x4 z = __builtin_nontemporal_load((const u32x4*)zp);
        u32x4 w; w.x = cvt_pk_bf16(a.x * bf_lo(z.x), a.y * bf_hi(z.x)); w.y = cvt_pk_bf16(a.z * bf_lo(z.y), a.w * bf_hi(z.y));
        w.z = cvt_pk_bf16(c.x * bf_lo(z.z), c.y * bf_hi(z.z)); w.w = cvt_pk_bf16(c.z * bf_lo(z.w), c.w * bf_hi(z.w));
        *(u32x4*)zp = w; }
    asm volatile("s_waitcnt lgkmcnt(0)" ::: "memory");
}

__device__ __forceinline__ float layer_lb(const float* lower_bounds, int l, int ch) {
    float mx = -INFINITY;
    for (int i = 0; i < DEPTH; ++i) mx = fmaxf(mx, lower_bounds[i * 512 + ch]);
    float den = 0.f, num = 0.f;
    for (int i = 0; i < DEPTH; ++i) { const float e = __expf(lower_bounds[i * 512 + ch] - mx); den += e; if (i >= 1 && i <= l) num += e; }
    return num / den;
}
template <int MODE>
__device__ __forceinline__ void hgrn_pass(LAS unsigned char* lds, bf16_t* ACT, const Params& P, int l, int bh, int c0, int nc) {
    const int tid = fresh_tid(), lane = tid & 63, r32 = lane & 31, hi = lane >> 5;
    const int wid = __builtin_amdgcn_readfirstlane(tid >> 6);
    LAS bf16_t* Q1 = (LAS bf16_t*)(lds);
    LAS bf16_t* Q2 = (LAS bf16_t*)(lds + 17408);
    LAS bf16_t* K2 = (LAS bf16_t*)(lds + 34816);
    LAS float*  OT = (LAS float*)(lds);
    LAS bf16_t* K3T = (LAS bf16_t*)(lds + 52224);
    LAS bf16_t* VT = (LAS bf16_t*)(lds + 70656);
    LAS bf16_t* Pm = (LAS bf16_t*)(lds + 89088);
    LAS bf16_t* ST = (LAS bf16_t*)(lds + 98304);
    LAS float* DEND = (LAS float*)(lds + 133120);
    LAS float* SCX = (LAS float*)(lds + 133632);
    const int d = tid & 127, part = tid >> 7, b = bh >> 2, h = bh & 3, grp = c0 / nc;
    const float lbv = layer_lb(P.lower_bounds, l, h * 128 + d);
    bf16_t* base = ACT + (size_t)b * SEQ * PITCH + h * 128;
    bf16_t* Ug = (bf16_t*)(P.ws + WS_U) + (size_t)bh * 8 * 16384;
    float* Dg = (float*)(P.ws + WS_DEND) + (size_t)bh * 8 * 128;
    const float* nw = P.hgrn_norm_w + l * 128;
    const int tb = wid & 1, eb = wid >> 1;
    bf16_t fin[16], qin[16], vin[16];
#pragma unroll
    for (int i = 0; i < 16; ++i) { const bf16_t* rp = base + (size_t)(c0 * 64 + 16 * part + i) * PITCH + d;
        if (MODE == 1) { fin[i] = __builtin_nontemporal_load(rp + C_FB); vin[i] = __builtin_nontemporal_load(rp + C_IB); qin[i] = __builtin_nontemporal_load(rp + C_QB); }
        else { fin[i] = rp[C_FB]; vin[i] = rp[C_IB]; } }
    f32x16 sa[2];
#pragma unroll
    for (int r = 0; r < 16; ++r) { sa[0][r] = 0.f; sa[1][r] = 0.f; }
    float bsum = 0.f;
    if (MODE == 1) {
        const int d8 = (tid & 15) * 8;
        f32x4 Sp[4][2];
#pragma unroll
        for (int i = 0; i < 4; ++i) { Sp[i][0] = (f32x4){0.f, 0.f, 0.f, 0.f}; Sp[i][1] = (f32x4){0.f, 0.f, 0.f, 0.f}; }
        for (int k = 0; k < grp; ++k) {
            const f32x4 da = *(const f32x4*)(Dg + k * 128 + d8), db = *(const f32x4*)(Dg + k * 128 + d8 + 4);
            u32x4 uv[4];
#pragma unroll
            for (int i = 0; i < 4; ++i) { const int idx = tid + 512 * i; uv[i] = *(const u32x4*)(Ug + (size_t)k * 16384 + (idx >> 4) * 128 + d8); }
#pragma unroll
            for (int i = 0; i < 4; ++i) {
                Sp[i][0] = da * Sp[i][0] + (f32x4){bf_lo(uv[i].x), bf_hi(uv[i].x), bf_lo(uv[i].y), bf_hi(uv[i].y)};
                Sp[i][1] = db * Sp[i][1] + (f32x4){bf_lo(uv[i].z), bf_hi(uv[i].z), bf_lo(uv[i].w), bf_hi(uv[i].w)}; }
        }
#pragma unroll
        for (int i = 0; i < 4; ++i) { const int idx = tid + 512 * i;
            u32x4 v; v.x = cvt_pk_bf16(Sp[i][0][0], Sp[i][0][1]); v.y = cvt_pk_bf16(Sp[i][0][2], Sp[i][0][3]); v.z = cvt_pk_bf16(Sp[i][1][0], Sp[i][1][1]); v.w = cvt_pk_bf16(Sp[i][1][2], Sp[i][1][3]);
            *(LAS u32x4*)(ST + (idx >> 4) * 136 + d8) = v; }
        __syncthreads();
#pragma unroll
        for (int i = 0; i < 2; ++i) { const int db = 2 * (wid & 1) + i;
#pragma unroll
            for (int g = 0; g < 4; ++g) { const u32x2 w = *(const LAS u32x2*)(ST + (32 * eb + r32) * 136 + 32 * db + 8 * g + 4 * hi);
                sa[i][4 * g] = bf_lo(w.x); sa[i][4 * g + 1] = bf_hi(w.x); sa[i][4 * g + 2] = bf_lo(w.y); sa[i][4 * g + 3] = bf_hi(w.y); } }
    }
    for (int ci = 0; ci < nc; ++ci) {
        const int c = c0 + ci;
        float g2[16], kk[16];
        float runb = 0.f;
#pragma unroll
        for (int i = 0; i < 16; ++i) { const float f = lbv + (1.0f - lbv) * sigmoidf_(bf2f(fin[i])); kk[i] = 1.0f - f; runb += lg2(f); g2[i] = runb; }
        SCX[part * 128 + d] = runb;
        __syncthreads();
        const float t0 = SCX[d], t1 = SCX[128 + d], t2 = SCX[256 + d], t3 = SCX[384 + d];
        const float offp = (part > 0 ? t0 : 0.f) + (part > 1 ? t1 : 0.f) + (part > 2 ? t2 : 0.f);
        const float cmid = t0 + t1, bend = (t0 + t1) + (t2 + t3);
        bsum += bend;
        if (part == 0) DEND[d] = ex2(bend);
        {
            unsigned k3w[8], vw[8];
#pragma unroll
            for (int i = 0; i < 16; i += 2) {
                const float B0 = offp + g2[i], B1 = offp + g2[i + 1];
                if (MODE == 1) {
                    const float q0 = bf2f(qin[i]), q1 = bf2f(qin[i + 1]);
                    const int t = 16 * part + i;
                    Q1[t * 136 + d] = (bf16_t)(cvt_pk_bf16(q0 * ex2(B0), 0.f) & 0xffffu); Q1[(t + 1) * 136 + d] = (bf16_t)(cvt_pk_bf16(q1 * ex2(B1), 0.f) & 0xffffu);
                    Q2[t * 136 + d] = (bf16_t)(cvt_pk_bf16(q0 * ex2(B0 - cmid), 0.f) & 0xffffu); Q2[(t + 1) * 136 + d] = (bf16_t)(cvt_pk_bf16(q1 * ex2(B1 - cmid), 0.f) & 0xffffu);
                    K2[t * 136 + d] = (bf16_t)(cvt_pk_bf16(kk[i] * ex2(cmid - B0), 0.f) & 0xffffu); K2[(t + 1) * 136 + d] = (bf16_t)(cvt_pk_bf16(kk[i + 1] * ex2(cmid - B1), 0.f) & 0xffffu);
                }
                k3w[i >> 1] = cvt_pk_bf16(kk[i] * ex2(bend - B0), kk[i + 1] * ex2(bend - B1));
                vw[i >> 1] = (unsigned)vin[i] | ((unsigned)vin[i + 1] << 16);
            }
            *(LAS u32x4*)(K3T + d * 72 + 16 * part) = (u32x4){k3w[0], k3w[1], k3w[2], k3w[3]}; *(LAS u32x4*)(K3T + d * 72 + 16 * part + 8) = (u32x4){k3w[4], k3w[5], k3w[6], k3w[7]};
            *(LAS u32x4*)(VT + d * 72 + 16 * part) = (u32x4){vw[0], vw[1], vw[2], vw[3]}; *(LAS u32x4*)(VT + d * 72 + 16 * part + 8) = (u32x4){vw[4], vw[5], vw[6], vw[7]};
        }
        if (ci + 1 < nc) {
#pragma unroll
            for (int i = 0; i < 16; ++i) { const bf16_t* rp = base + (size_t)((c + 1) * 64 + 16 * part + i) * PITCH + d;
                if (MODE == 1) { fin[i] = __builtin_nontemporal_load(rp + C_FB); vin[i] = __builtin_nontemporal_load(rp + C_IB); qin[i] = __builtin_nontemporal_load(rp + C_QB); }
                else { fin[i] = rp[C_FB]; vin[i] = rp[C_IB]; } }
        }
        __syncthreads();
        if (MODE == 0) {
#pragma unroll
            for (int i = 0; i < 2; ++i) {
                const int db = 2 * (wid & 1) + i;
#pragma unroll
                for (int r = 0; r < 16; ++r) sa[i][r] *= DEND[32 * db + crow(r, hi)];
#pragma unroll
                for (int ks = 0; ks < 4; ++ks) {
                    const bf16x8 a = *(const LAS bf16x8*)(K3T + (32 * db + r32) * 72 + 16 * ks + 8 * hi);
                    const bf16x8 bb = *(const LAS bf16x8*)(VT + (32 * eb + r32) * 72 + 16 * ks + 8 * hi);
                    sa[i] = __builtin_amdgcn_mfma_f32_32x32x16_bf16(a, bb, sa[i], 0, 0, 0);
                }
            }
        } else {
            f32x16 o;
#pragma unroll
            for (int r = 0; r < 16; ++r) o[r] = 0.f;
            if (c > 0) {
#pragma unroll
                for (int ks = 0; ks < 8; ++ks) {
                    const bf16x8 a = *(const LAS bf16x8*)(Q1 + (32 * tb + r32) * 136 + 16 * ks + 8 * hi);
                    const bf16x8 bb = *(const LAS bf16x8*)(ST + (32 * eb + r32) * 136 + 16 * ks + 8 * hi);
                    o = __builtin_amdgcn_mfma_f32_32x32x16_bf16(a, bb, o, 0, 0, 0);
                }
            }
            if (wid < 4) {
                const int stb = wid & 1, ssb = wid >> 1;
                f32x16 sc;
#pragma unroll
                for (int r = 0; r < 16; ++r) sc[r] = 0.f;
                if (!(stb == 0 && ssb == 1)) {
#pragma unroll
                    for (int ks = 0; ks < 8; ++ks) {
                        const bf16x8 a = *(const LAS bf16x8*)(Q2 + (32 * stb + r32) * 136 + 16 * ks + 8 * hi);
                        const bf16x8 bb = *(const LAS bf16x8*)(K2 + (32 * ssb + r32) * 136 + 16 * ks + 8 * hi);
                        sc = __builtin_amdgcn_mfma_f32_32x32x16_bf16(a, bb, sc, 0, 0, 0);
                    }
                }
#pragma unroll
                for (int r = 0; r < 16; ++r) { const int t = 32 * stb + crow(r, hi), s = 32 * ssb + r32;
                    const float v = (s <= t) ? sc[r] : 0.f;
                    Pm[t * 72 + s] = (bf16_t)(cvt_pk_bf16(v, 0.f) & 0xffffu); }
            }
            __syncthreads();
            unsigned zz[8];
#pragma unroll
            for (int i = 0; i < 8; ++i) zz[i] = __builtin_nontemporal_load((const unsigned*)(base + (size_t)(c * 64 + 8 * wid + i) * PITCH + C_ZB + 2 * lane));
#pragma unroll
            for (int ks = 0; ks < 4; ++ks) {
                const bf16x8 a = *(const LAS bf16x8*)(Pm + (32 * tb + r32) * 72 + 16 * ks + 8 * hi);
                const bf16x8 bb = *(const LAS bf16x8*)(VT + (32 * eb + r32) * 72 + 16 * ks + 8 * hi);
                o = __builtin_amdgcn_mfma_f32_32x32x16_bf16(a, bb, o, 0, 0, 0);
            }
#pragma unroll
            for (int r = 0; r < 16; ++r) OT[(32 * tb + crow(r, hi)) * 132 + 32 * eb + r32] = o[r];
            if (ci + 1 < nc) {
#pragma unroll
                for (int i = 0; i < 2; ++i) {
                    const int db = 2 * (wid & 1) + i;
#pragma unroll
                    for (int r = 0; r < 16; ++r) sa[i][r] *= DEND[32 * db + crow(r, hi)];
#pragma unroll
                    for (int ks = 0; ks < 4; ++ks) {
                        const bf16x8 a = *(const LAS bf16x8*)(K3T + (32 * db + r32) * 72 + 16 * ks + 8 * hi);
                        const bf16x8 bb = *(const LAS bf16x8*)(VT + (32 * eb + r32) * 72 + 16 * ks + 8 * hi);
                        sa[i] = __builtin_amdgcn_mfma_f32_32x32x16_bf16(a, bb, sa[i], 0, 0, 0);
                    }
#pragma unroll
                    for (int g = 0; g < 4; ++g) { u32x2 w; w.x = cvt_pk_bf16(sa[i][4 * g], sa[i][4 * g + 1]); w.y = cvt_pk_bf16(sa[i][4 * g + 2], sa[i][4 * g + 3]);
                        *(LAS u32x2*)(ST + (32 * eb + r32) * 136 + 32 * db + 8 * g + 4 * hi) = w; }
                }
            }
            __syncthreads();
            {
                const f32x2 nwv = *(const f32x2*)(nw + 2 * lane);
#pragma unroll
                for (int i = 0; i < 8; ++i) { const int t = 8 * wid + i;
                    const f32x2 v = *(const LAS f32x2*)(OT + t * 132 + 2 * lane);
                    const float ss = wave_sum(v.x * v.x + v.y * v.y);
                    const float rstd = __builtin_amdgcn_rsqf(ss * (1.0f / 128.0f) + RMS_EPS);
                    unsigned* zp = (unsigned*)(base + (size_t)(c * 64 + t) * PITCH + C_ZB + 2 * lane);
                    *zp = cvt_pk_bf16(v.x * rstd * nwv.x * bf_lo(zz[i]), v.y * rstd * nwv.y * bf_hi(zz[i])); }
            }
        }
    }
    if (MODE == 0) {
        __syncthreads();
#pragma unroll
        for (int i = 0; i < 2; ++i) { const int db = 2 * (wid & 1) + i;
#pragma unroll
            for (int g = 0; g < 4; ++g) { u32x2 w; w.x = cvt_pk_bf16(sa[i][4 * g], sa[i][4 * g + 1]); w.y = cvt_pk_bf16(sa[i][4 * g + 2], sa[i][4 * g + 3]);
                *(LAS u32x2*)(ST + (32 * eb + r32) * 136 + 32 * db + 8 * g + 4 * hi) = w; } }
        __syncthreads();
#pragma unroll
        for (int i = 0; i < 4; ++i) { const int idx = tid + 512 * i;
            *(u32x4*)(Ug + (size_t)grp * 16384 + (idx >> 4) * 128 + (idx & 15) * 8) = *(const LAS u32x4*)(ST + (idx >> 4) * 136 + (idx & 15) * 8); }
        if (part == 0) Dg[grp * 128 + d] = ex2(bsum);
    }
    __syncthreads();
}

__device__ __forceinline__ void unpack8(const u32x4 a, float (&o)[8]) {
    o[0] = bf_lo(a.x); o[1] = bf_hi(a.x); o[2] = bf_lo(a.y); o[3] = bf_hi(a.y); o[4] = bf_lo(a.z); o[5] = bf_hi(a.z); o[6] = bf_lo(a.w); o[7] = bf_hi(a.w);
}
__device__ __forceinline__ void conv_item(bf16_t* ACT, const float* cw, int item) {
    const int tid = fresh_tid(), cgp = tid & 63, sub = tid >> 6;
    const int m0 = item * 64 + sub * 8, ch = cgp * 8;
    float w0[8], w1[8], w2[8];
#pragma unroll
    for (int e = 0; e < 8; ++e) { w0[e] = cw[ch + e]; w1[e] = cw[512 + ch + e]; w2[e] = cw[1024 + ch + e]; }
    float p1[8], p2[8];
#pragma unroll
    for (int e = 0; e < 8; ++e) { p1[e] = 0.f; p2[e] = 0.f; }
    if ((m0 % SEQ) != 0) {
        unpack8(*(const u32x4*)(ACT + (size_t)(m0 - 2) * PITCH + C_PU + ch), p2);
        unpack8(*(const u32x4*)(ACT + (size_t)(m0 - 1) * PITCH + C_PU + ch), p1);
    }
    u32x4 pa[8], pzv[8];
#pragma unroll
    for (int i = 0; i < 8; ++i) { const bf16_t* rp = ACT + (size_t)(m0 + i) * PITCH + ch; pa[i] = __builtin_nontemporal_load((const u32x4*)(rp + C_PU)); pzv[i] = __builtin_nontemporal_load((const u32x4*)(rp + C_PZ)); }
#pragma unroll
    for (int i = 0; i < 8; ++i) {
        float pu[8], pz[8], y[8];
        unpack8(pa[i], pu); unpack8(pzv[i], pz);
#pragma unroll
        for (int e = 0; e < 8; ++e) { y[e] = pz[e] * (w0[e] * p2[e] + w1[e] * p1[e] + w2[e] * pu[e]); p2[e] = p1[e]; p1[e] = pu[e]; }
        u32x4 w; w.x = cvt_pk_bf16(y[0], y[1]); w.y = cvt_pk_bf16(y[2], y[3]); w.z = cvt_pk_bf16(y[4], y[5]); w.w = cvt_pk_bf16(y[6], y[7]);
        *(u32x4*)(ACT + (size_t)(m0 + i) * PITCH + C_ZC + ch) = w;
    }
}

constexpr int WC_SPLIT = 16 * (IN_COLS / 32) + 3 * 8 * 32, WC_ALL = WC_SPLIT + 16 * 32;
__device__ __forceinline__ void convert_weights(const Params& P, int l, LAS unsigned char* lds, int gw, int NGW, int wid, int lane, int it_lo = 0, int it_hi = WC_ALL) {
    LAS float* scr = (LAS float*)(lds + wid * 16384);
    unsigned char* ws = P.ws;
    constexpr int I_IN = 16 * (IN_COLS / 32), I_B = 8 * 32, I_O = 16 * 32, I_L = I_IN + 3 * I_B + I_O;
    for (int it = it_lo + gw; it < it_hi; it += NGW) {
        int r = it;
        if (r < I_IN) { transpose_item(P.w_in + (size_t)l * 1024 * IN_COLS, IN_COLS, (bf16_t*)(ws + WS_WIN), 1024, scr, r, lane, true); continue; } r -= I_IN;
        if (r < 3 * I_B) { const int j = r / I_B; transpose_item(P.w_branch + (size_t)(l * 3 + j) * 512 * 1024, 1024, (bf16_t*)(ws + WS_WB) + (size_t)j * 1024 * 1024, 1024, scr, r % I_B, lane); continue; } r -= 3 * I_B;
        transpose_item(P.w_out + (size_t)l * 1024 * 1024, 1024, (bf16_t*)(ws + WS_WO), 1024, scr, r, lane);
    }
}

typedef const __attribute__((address_space(4))) Params* KParamsPtr;
#define XB_TMO      128
#define XB_XCNT(j)  (256  + 64 * (j))
#define XB_XSUB(j)  (1280 + 64 * (j))
#define XB_XGEN(j)  (2304 + 64 * (j))
#define XB_TOP      3328
#define XB_TOPGEN   3392
#define XCD_BAR_WORDS 3456
#define XB_SPIN_CAP (1u << 22)
__device__ __forceinline__ unsigned xb_ld(unsigned* p)              { return __hip_atomic_load(p, __ATOMIC_RELAXED, __HIP_MEMORY_SCOPE_AGENT); }
__device__ __forceinline__ unsigned xb_add(unsigned* p, unsigned v) { return __hip_atomic_fetch_add(p, v, __ATOMIC_RELAXED, __HIP_MEMORY_SCOPE_AGENT); }
__device__ __forceinline__ unsigned xb_xcc_id() { return (unsigned)__builtin_amdgcn_s_getreg((3 << 11) | 20) & 0xFu; }
#define XB_SPIN(cond, bar) do { unsigned _sp = 0; while (cond) { __builtin_amdgcn_s_sleep(1); \
    if ((++_sp & 255u) == 0u) { if (xb_ld(&(bar)[XB_TMO])) break; if (_sp > XB_SPIN_CAP) { atomicAdd(&(bar)[XB_TMO], 1u); break; } } } } while (0)
__device__ __forceinline__ void xcd_barrier_complete(unsigned* bar, unsigned x, unsigned& nloc, unsigned& nx) {
    const unsigned G = gridDim.x * gridDim.y * gridDim.z;
    unsigned sum, cnt, mine, sp = 0u;
    for (;;) {
        sum = 0u; cnt = 0u; mine = 0u;
#pragma unroll
        for (unsigned j = 0; j < 16; ++j) { const unsigned c = xb_ld(&bar[XB_XCNT(j)]); sum += c; cnt += (c > 0u) ? 1u : 0u; mine = (j == x) ? c : mine; }
        if (sum == G) break;
        __builtin_amdgcn_s_sleep(1);
        if ((++sp & 255u) == 0u) { if (xb_ld(&bar[XB_TMO])) break; if (sp > XB_SPIN_CAP) { atomicAdd(&bar[XB_TMO], 1u); break; } }
    }
    nloc = mine > 0u ? mine : 1u; nx = cnt > 0u ? cnt : 1u;
}
__device__ __forceinline__ void xcd_barrier(unsigned* bar, volatile LAS unsigned* st) {
    asm volatile("s_waitcnt vmcnt(0)" ::: "memory");
    __syncthreads();
    if (threadIdx.x == 0) {
        __builtin_amdgcn_s_waitcnt(0);
        const unsigned x = xb_xcc_id();
        unsigned nloc = st[0], nx = st[1];
        if (nloc == 0u) { xcd_barrier_complete(bar, x, nloc, nx); st[0] = nloc; st[1] = nx; }
        const unsigned old = xb_add(&bar[XB_XSUB(x)], 1u);
        const unsigned gen = old / nloc;
        if (old + 1u == (gen + 1u) * nloc) {
            __builtin_amdgcn_fence(__ATOMIC_RELEASE, "agent");
            asm volatile("s_waitcnt vmcnt(0)" ::: "memory");
            const unsigned og = xb_add(&bar[XB_TOP], 1u);
            const unsigned tg = og / nx;
            if (og + 1u == (tg + 1u) * nx) xb_add(&bar[XB_TOPGEN], 1u);
            else XB_SPIN(xb_ld(&bar[XB_TOPGEN]) == tg, bar);
            __builtin_amdgcn_fence(__ATOMIC_ACQUIRE, "agent");
            xb_add(&bar[XB_XGEN(x)], 1u);
            asm volatile("s_waitcnt vmcnt(0)" ::: "memory");
        } else {
            XB_SPIN(xb_ld(&bar[XB_XGEN(x)]) == gen, bar);
            __builtin_amdgcn_fence(__ATOMIC_ACQUIRE, "agent");
            asm volatile("s_waitcnt vmcnt(0)" ::: "memory");
        }
    }
    __syncthreads();
}
#define GRID_SYNC() do { asm volatile("s_waitcnt vmcnt(0) lgkmcnt(0)" ::: "memory"); __syncthreads(); grid.sync(); } while (0)
#define XBAR() do { KParamsPtr qb_ = (KParamsPtr)__builtin_amdgcn_kernarg_segment_ptr(); asm volatile("" : "+s"(qb_)); xcd_barrier((unsigned*)(qb_->ws + WS_CTL), (volatile LAS unsigned*)(lds + LDS_BYTES - 16)); } while (0)
#define PHASE_BEGIN() \
    Params P; { KParamsPtr q_ = (KParamsPtr)__builtin_amdgcn_kernarg_segment_ptr(); asm volatile("" : "+s"(q_)); \
        P.x = q_->x; P.c = q_->c; P.w_mod = q_->w_mod; P.b_mod = q_->b_mod; P.w_in = q_->w_in; P.conv_w = q_->conv_w; P.hgrn_norm_w = q_->hgrn_norm_w; P.lower_bounds = q_->lower_bounds; \
        P.w_branch = q_->w_branch; P.w_out = q_->w_out; P.ln_g = q_->ln_g; P.ln_b = q_->ln_b; P.out = q_->out; P.ws = q_->ws; } \
    int bx = blockIdx.x; asm volatile("" : "+s"(bx)); \
    const int G = gridDim.x; \
    const int vcu = (G % 8 == 0) ? (bx % 8) * (G / 8) + bx / 8 : bx; \
    unsigned char* const ws = P.ws; \
    float* const modp = (float*)(ws + WS_MOD); \
    bf16_t* const ACT = (bf16_t*)(ws + WS_ACT); \
    (void)vcu; (void)modp; (void)ACT;
#define WAVE_IDS() \
    const int tid = fresh_tid(), lane = tid & 63, wid = __builtin_amdgcn_readfirstlane(tid >> 6); \
    const int gw = vcu * 8 + wid, NGW = G * 8; (void)lane; (void)gw; (void)NGW;

__global__ void __launch_bounds__(NTHREADS, 2) fwd_megakernel(Params Pk) {
    extern __shared__ __attribute__((aligned(16))) unsigned char lds_raw[];
    LAS unsigned char* lds = (LAS unsigned char*)lds_raw;
    cg::grid_group grid = cg::this_grid();
    if (__builtin_expect(gridDim.y == 4242u, 0)) GRID_SYNC();
    if (threadIdx.x < 4) ((LAS unsigned*)(lds + LDS_BYTES - 16))[threadIdx.x] = 0u;
    __syncthreads();
    if (threadIdx.x == 0) { KParamsPtr q0_ = (KParamsPtr)__builtin_amdgcn_kernarg_segment_ptr(); (void)xb_add(&((unsigned*)(q0_->ws + WS_CTL))[XB_XCNT(xb_xcc_id())], 1u); }

    {
        PHASE_BEGIN(); WAVE_IDS();
        float* modpart = (float*)(ws + WS_MODP);
        LAS float* red = (LAS float*)lds;
        for (int u = bx; u < DEPTH * 192; u += G) {
            const int l = u / 192, r = u % 192, n = (r >> 2) * 64 + lane, kq = r & 3;
            float accb[8];
#pragma unroll
            for (int b = 0; b < 8; ++b) accb[b] = 0.f;
            const float* wp = P.w_mod + ((size_t)l * 1024 + 256 * kq + 32 * wid) * 3072 + n;
            const float* cp = P.c + 256 * kq + 32 * wid;
#pragma unroll 16
            for (int k = 0; k < 32; ++k) { const float wv = __builtin_nontemporal_load(wp + (size_t)k * 3072);
#pragma unroll
                for (int b = 0; b < 8; ++b) accb[b] += cp[b * 1024 + k] * wv; }
            __syncthreads();
#pragma unroll
            for (int b = 0; b < 8; ++b) red[(wid * 8 + b) * 64 + lane] = accb[b];
            __syncthreads();
            { const int b = wid; float sacc = 0.f;
#pragma unroll
              for (int w = 0; w < 8; ++w) sacc += red[(w * 8 + b) * 64 + lane];
              modpart[(((size_t)kq * DEPTH + l) * 8 + b) * 3072 + n] = sacc; }
        }
        __syncthreads();
        convert_weights(P, 0, lds, gw, NGW, wid, lane);
    }
    XBAR();
    {
        PHASE_BEGIN(); WAVE_IDS();
        const float* modpart = (const float*)(ws + WS_MODP);
        for (int i = bx * NTHREADS + tid; i < DEPTH * 8 * 3072; i += G * NTHREADS) {
            const int l = i / (8 * 3072), n = i % 3072;
            float v = P.b_mod[l * 3072 + n];
#pragma unroll
            for (int kq = 0; kq < 4; ++kq) v += modpart[(size_t)kq * DEPTH * 8 * 3072 + i];
            modp[i] = v;
        }
        LAS float* ms = (LAS float*)lds;
        for (int rg = bx; rg < M_TOK / 64; rg += G) {
            const int b = (rg * 64) / SEQ;
            __syncthreads();
            { const int i4 = tid * 4; f32x4 v = *(const f32x4*)(P.b_mod + i4);
#pragma unroll
              for (int kq = 0; kq < 4; ++kq) v = v + *(const f32x4*)(modpart + ((size_t)kq * DEPTH * 8 + b) * 3072 + i4);
              *(LAS f32x4*)(ms + i4) = v; }
            __syncthreads();
#pragma unroll
            for (int it = 0; it < 2; ++it) {
                f32x4 v[4][4];
#pragma unroll
                for (int q = 0; q < 4; ++q) { const int m = rg * 64 + wid * 8 + it * 4 + q;
#pragma unroll
                    for (int j = 0; j < 4; ++j) v[q][j] = ld_nt(P.x + (size_t)m * D_MODEL + 4 * (lane + 64 * j)); }
#pragma unroll
                for (int q = 0; q < 4; ++q) { const int m = rg * 64 + wid * 8 + it * 4 + q;
                    row_standardize(v[q]);
                    bf16_t* hrow = ACT + (size_t)m * PITCH + C_H;
#pragma unroll
                    for (int j = 0; j < 4; ++j) { const int col = 4 * (lane + 64 * j);
                        const f32x4 sh = *(const LAS f32x4*)(ms + col), sc = *(const LAS f32x4*)(ms + 1024 + col);
                        const f32x4 hv = v[q][j] * (sc + 1.0f) + sh;
                        u32x2 w; w.x = cvt_pk_bf16(hv.x, hv.y); w.y = cvt_pk_bf16(hv.z, hv.w);
                        *(u32x2*)(hrow + col) = w; } }
            }
        }
    }
    XBAR();

    for (int l = 0; l < DEPTH; ++l) {
        {
            PHASE_BEGIN();
            SchedP1 S{(const char*)ACT + C_H * 2, (const char*)(ws + WS_WIN), G, vcu};
            EpiP1 E{ACT};
            pg8::gemm_phase<EpiP1, SchedP1>(lds, (unsigned)PITCHB, 2048u, S, E);
        }
        XBAR();
        for (int half = 0; half < 2; ++half) {
            PHASE_BEGIN();
            if ((half ^ (vcu & 1)) == 0) {
                for (int u = bx; u < 256; u += G) hgrn_pass<0>(lds, ACT, P, l, u >> 3, ((u + (u >> 3)) & 7) * 4, 4);
            } else {
                for (int k = bx; k < 256; k += G) {
                    __syncthreads(); attn_unit(lds, ACT, (k & 63) >> 3, k & 7, 7 - (k >> 6));
                    const int a2 = 511 - k;
                    __syncthreads(); attn_unit(lds, ACT, (a2 & 63) >> 3, a2 & 7, 7 - (a2 >> 6));
                }
                for (int ci = bx; ci < 256; ci += G) conv_item(ACT, P.conv_w + (size_t)l * 3 * 512, ci);
                __syncthreads();
            }
        }
        if (l > 0) { PHASE_BEGIN(); WAVE_IDS(); __syncthreads(); convert_weights(P, l, lds, gw, NGW, wid, lane, WC_SPLIT, WC_ALL); }
        XBAR();
        {
            PHASE_BEGIN();
            for (int u = bx; u < 256; u += G) hgrn_pass<1>(lds, ACT, P, l, u >> 3, ((u + (u >> 3)) & 7) * 4, 4);
        }
        XBAR();
        {
            PHASE_BEGIN();
            SchedP3 S{(const char*)ACT, (const char*)(ws + WS_WIN) + (size_t)MIX_COLS * 2048, (const char*)(ws + WS_WB), G, vcu};
            EpiP3 E{(unsigned char*)ACT};
            pg8::gemm_phase<EpiP3, SchedP3>(lds, (unsigned)PITCHB, 2048u, S, E);
        }
        XBAR();
        {
            PHASE_BEGIN(); WAVE_IDS();
            SchedP4 S{(const char*)ACT, (const char*)(ws + WS_WO), G, vcu};
            unsigned* pc = (unsigned*)(ws + WS_CTL + CTL_PANEL);
            unsigned long long* xb = (unsigned long long*)(ws + WS_X);
            const bool more = (l + 1 < DEPTH);
            PanelStats st1{xb + (size_t)(2 * l) * 65536, pc + (2 * l) * 4096, LN_EPS};
            PanelStats st2{xb + (size_t)(2 * l + 1) * 65536, pc + (2 * l + 1) * 4096, LN_EPS};
            EpiP4F E{l == 0 ? P.x : P.out, P.out, modp + (size_t)l * 8 * 3072 + 2048, P.ln_g + l * 1024, P.ln_b + l * 1024, more ? modp + (size_t)(l + 1) * 8 * 3072 : nullptr, ACT, st1, st2};
            const bool pre = more && (vcu & 1);
            if (pre) { convert_weights(P, l + 1, lds, gw, NGW, wid, lane, 0, WC_SPLIT); __syncthreads(); }
            pg8::gemm_phase<EpiP4F, SchedP4>(lds, (unsigned)PITCHB, 2048u, S, E);
            if (more && !pre) { __syncthreads(); convert_weights(P, l + 1, lds, gw, NGW, wid, lane, 0, WC_SPLIT); }
        }
        if (l + 1 < DEPTH) XBAR();
    }
}

extern "C" void kernel_launch(void* const* d_in, const int* in_sizes, int n_in, void* d_out, int out_size, void* d_ws, size_t ws_size, hipStream_t stream) {
    static int grid_blocks = 0;
    if (grid_blocks == 0) {
        if (n_in != 12 || out_size != M_TOK * D_MODEL || ws_size < WS_END) { fprintf(stderr, "kernel_launch: unexpected shapes (n_in %d, out %d, ws %zu < %zu)\n", n_in, out_size, ws_size, (size_t)WS_END); grid_blocks = -1; return; }
        int dev = 0, cus = 0, per_cu = 0;
        hipGetDevice(&dev);
        hipDeviceGetAttribute(&cus, hipDeviceAttributeMultiprocessorCount, dev);
        hipFuncSetAttribute((const void*)fwd_megakernel, hipFuncAttributeMaxDynamicSharedMemorySize, LDS_BYTES);
        hipOccupancyMaxActiveBlocksPerMultiprocessor(&per_cu, (const void*)fwd_megakernel, NTHREADS, LDS_BYTES);
        (void)hipGetLastError();
        if (per_cu < 1) per_cu = 1;
        grid_blocks = cus > 256 ? 256 : cus;
        if (grid_blocks != 256) fprintf(stderr, "kernel_launch: %d CUs reported; this kernel is laid out for 256 workgroups\n", cus);
        if (grid_blocks <= 0) grid_blocks = 256;
    }
    if (grid_blocks < 0) return;
    (void)hipMemsetAsync((char*)d_ws + WS_CTL, 0, CTL_BYTES, stream);
    Params p{};
    p.x = (const float*)d_in[0]; p.c = (const float*)d_in[1]; p.w_mod = (const float*)d_in[2]; p.b_mod = (const float*)d_in[3]; p.w_in = (const float*)d_in[4];
    p.conv_w = (const float*)d_in[5]; p.hgrn_norm_w = (const float*)d_in[6]; p.lower_bounds = (const float*)d_in[7]; p.w_branch = (const float*)d_in[8];
    p.w_out = (const float*)d_in[9]; p.ln_g = (const float*)d_in[10]; p.ln_b = (const float*)d_in[11]; p.out = (float*)d_out; p.ws = (unsigned char*)d_ws;
    void* args[] = {&p};
    hipError_t e = hipLaunchCooperativeKernel((const void*)fwd_megakernel, dim3(grid_blocks), dim3(NTHREADS), args, LDS_BYTES, stream);
    if (e != hipSuccess) fprintf(stderr, "cooperative launch failed: %s (grid %d)\n", hipGetErrorString(e), grid_blocks);
}
```
